# Optimizing an MI355X kernel written in HIP

```python
import math
import jax, jax.numpy as jnp
from jax import lax
import numpy as np

D_MODEL = 2048
BATCH = 4
SEQ = 4096
DEPTH = 4

N_A = DEPTH // 2
N_B = DEPTH - N_A
MEM_LEN = 256
HEAD_DIM = 128
MEM_HEADS = 4
MEM_W = MEM_HEADS * HEAD_DIM
MIX_W = D_MODEL - MEM_W
CHUNK = 128
GMLP_GROUPS = 6
GMLP_GW = MIX_W // GMLP_GROUPS
DIFF_HEADS = MIX_W // (2 * HEAD_DIM)
DIFF_VDIM = 2 * HEAD_DIM
D_FF = 5632
ROPE_THETA = 10000.0
EPS = 1e-6
Q_BLOCK = 128

kernel_name = "yoco_gmlp_diffattn_macaron_memxattn"


def rmsnorm(x, g):
    x32 = x.astype(jnp.float32)
    y = x32 * lax.rsqrt(jnp.mean(x32 * x32, axis=-1, keepdims=True) + EPS)
    return (y * g.astype(jnp.float32)).astype(x.dtype)


def rope_tables(seq):
    pos = jnp.arange(seq, dtype=jnp.float32)
    inv = ROPE_THETA ** (-jnp.arange(0, HEAD_DIM, 2, dtype=jnp.float32) / HEAD_DIM)
    ang = pos[:, None] * inv[None, :]
    ang = jnp.concatenate([ang, ang], axis=-1)
    return jnp.cos(ang), jnp.sin(ang)


def apply_rope(x, cos, sin):
    x1, x2 = jnp.split(x, 2, axis=-1)
    rot = jnp.concatenate([-x2, x1], axis=-1)
    return (x * cos + rot * sin).astype(x.dtype)


def swiglu(h, w_gu, w_down):
    g, u = jnp.split(h @ w_gu, 2, axis=-1)
    return (jax.nn.silu(g) * u) @ w_down


def gmlp_mix(z, v_norm_g, w_s, b_s):
    B, S, _ = z.shape
    u, v = jnp.split(z, 2, axis=-1)
    v = rmsnorm(v, v_norm_g)
    v = v.reshape(B, S // CHUNK, CHUNK, GMLP_GROUPS, GMLP_GW)
    causal = jnp.tril(jnp.ones((CHUNK, CHUNK), dtype=bool))
    w = jnp.where(causal[None], w_s, jnp.zeros_like(w_s))
    mixed = jnp.einsum('gts,bcsgd->bctgd', w, v) + jnp.transpose(b_s)[None, None, :, :, None]
    return u * mixed.reshape(B, S, MIX_W)


def diff_attention(q, k, v, lam, lam_init, subln_g):
    B, _, H, S, d = q.shape
    nb = S // Q_BLOCK
    qb = q.reshape(B, 2, H, nb, Q_BLOCK, d).transpose(3, 0, 1, 2, 4, 5)
    starts = jnp.arange(nb, dtype=jnp.int32) * Q_BLOCK
    kpos = jnp.arange(S, dtype=jnp.int32)
    scale = HEAD_DIM ** -0.5

    def block(args):
        qi, s0 = args
        s = jnp.einsum('bchqd,bchkd->bchqk', qi, k).astype(jnp.float32) * scale
        qpos = s0 + jnp.arange(Q_BLOCK, dtype=jnp.int32)
        mask = kpos[None, :] <= qpos[:, None]
        s = jnp.where(mask, s, -jnp.inf)
        p = jax.nn.softmax(s, axis=-1)
        a = p[:, 0] - lam * p[:, 1]
        return jnp.einsum('bhqk,bhkd->bhqd', a.astype(v.dtype), v)

    o = lax.map(block, (qb, starts))
    o = o.transpose(1, 0, 3, 2, 4).reshape(B, S, H, DIFF_VDIM)
    o = rmsnorm(o, subln_g) * (1.0 - lam_init)
    return o.reshape(B, S, MIX_W)


def mem_attention(qm, mk, mv):
    B, H, S, d = qm.shape
    s = jnp.einsum('bhqd,bhkd->bhqk', qm, mk).astype(jnp.float32) * (HEAD_DIM ** -0.5)
    p = jax.nn.softmax(s, axis=-1)
    o = jnp.einsum('bhqk,bhkd->bhqd', p.astype(mv.dtype), mv)
    return o.transpose(0, 2, 1, 3).reshape(B, S, MEM_W)


def setup_inputs(seed: int = 0) -> dict:
    key = jax.random.key(seed)
    ks = jax.random.split(key, 24)

    def nrm(k, shape, scale):
        return jax.random.normal(k, shape, jnp.float32) * scale

    def gain(k, shape):
        return 1.0 + 0.02 * jax.random.normal(k, shape, jnp.float32)

    return {
        "x": nrm(ks[0], (BATCH, SEQ, D_MODEL), 1.0),
        "mem": nrm(ks[1], (BATCH, MEM_LEN, D_MODEL), 1.0),
        "norm_g": gain(ks[2], (DEPTH, 3, D_MODEL)),
        "ffn_w_gu": nrm(ks[3], (DEPTH, 2, D_MODEL, 2 * D_FF), D_MODEL ** -0.5),
        "ffn_w_down": nrm(ks[4], (DEPTH, 2, D_FF, D_MODEL), D_FF ** -0.5),
        "w_out": nrm(ks[5], (DEPTH, D_MODEL, D_MODEL), D_MODEL ** -0.5),
        "mem_norm_g": gain(ks[6], (DEPTH, D_MODEL)),
        "mem_w_kv": nrm(ks[7], (DEPTH, D_MODEL, 2 * MEM_W), D_MODEL ** -0.5),
        "mem_q_norm_g": gain(ks[8], (DEPTH, HEAD_DIM)),
        "mem_k_norm_g": gain(ks[9], (DEPTH, HEAD_DIM)),
        "a_w_in": nrm(ks[10], (N_A, D_MODEL, 2 * MIX_W + MEM_W), D_MODEL ** -0.5),
        "a_v_norm_g": gain(ks[11], (N_A, MIX_W)),
        "a_w_s": nrm(ks[12], (N_A, GMLP_GROUPS, CHUNK, CHUNK), CHUNK ** -0.5),
        "a_b_s": gain(ks[13], (N_A, GMLP_GROUPS, CHUNK)),
        "kv_norm_g": gain(ks[14], (D_MODEL,)),
        "w_kv": nrm(ks[15], (D_MODEL, 2 * DIFF_HEADS * HEAD_DIM + DIFF_HEADS * DIFF_VDIM), D_MODEL ** -0.5),
        "k_norm_g": gain(ks[16], (HEAD_DIM,)),
        "b_w_in": nrm(ks[17], (N_B, D_MODEL, MIX_W + MEM_W), D_MODEL ** -0.5),
        "b_q_norm_g": gain(ks[18], (N_B, HEAD_DIM)),
        "b_lambda": nrm(ks[19], (N_B, 4, HEAD_DIM), 0.1),
        "b_subln_g": gain(ks[20], (N_B, DIFF_VDIM)),
    }


def reference(x, mem, norm_g, ffn_w_gu, ffn_w_down, w_out, mem_norm_g, mem_w_kv,
              mem_q_norm_g, mem_k_norm_g, a_w_in, a_v_norm_g, a_w_s, a_b_s,
              kv_norm_g, w_kv, k_norm_g, b_w_in, b_q_norm_g, b_lambda, b_subln_g):
    B, S, _ = x.shape
    M = mem.shape[1]
    cos, sin = rope_tables(S)
    HQK = DIFF_HEADS * HEAD_DIM
    k_sh = None
    v_sh = None
    for l in range(DEPTH):
        if l == N_A:
            kv = rmsnorm(x, kv_norm_g) @ w_kv
            k_sh = kv[..., :2 * HQK].reshape(B, S, 2, DIFF_HEADS, HEAD_DIM).transpose(0, 2, 3, 1, 4)
            k_sh = apply_rope(rmsnorm(k_sh, k_norm_g), cos, sin)
            v_sh = kv[..., 2 * HQK:].reshape(B, S, DIFF_HEADS, DIFF_VDIM).transpose(0, 2, 1, 3)

        x = x + 0.5 * swiglu(rmsnorm(x, norm_g[l, 0]), ffn_w_gu[l, 0], ffn_w_down[l, 0])

        mkv = rmsnorm(mem, mem_norm_g[l]) @ mem_w_kv[l]
        mk = mkv[..., :MEM_W].reshape(B, M, MEM_HEADS, HEAD_DIM).transpose(0, 2, 1, 3)
        mk = rmsnorm(mk, mem_k_norm_g[l])
        mv = mkv[..., MEM_W:].reshape(B, M, MEM_HEADS, HEAD_DIM).transpose(0, 2, 1, 3)

        h = rmsnorm(x, norm_g[l, 1])
        if l < N_A:
            z = h @ a_w_in[l]
            mix = gmlp_mix(jax.nn.gelu(z[..., :2 * MIX_W], approximate=False),
                           a_v_norm_g[l], a_w_s[l], a_b_s[l])
            qm = z[..., 2 * MIX_W:]
        else:
            j = l - N_A
            z = h @ b_w_in[j]
            q = z[..., :MIX_W].reshape(B, S, 2, DIFF_HEADS, HEAD_DIM).transpose(0, 2, 3, 1, 4)
            q = apply_rope(rmsnorm(q, b_q_norm_g[j]), cos, sin)
            lam_init = 0.8 - 0.6 * math.exp(-0.3 * l)
            lp = b_lambda[j].astype(jnp.float32)
            lam = jnp.exp(jnp.sum(lp[0] * lp[1])) - jnp.exp(jnp.sum(lp[2] * lp[3])) + lam_init
            mix = diff_attention(q, k_sh, v_sh, lam, lam_init, b_subln_g[j])
            qm = z[..., MIX_W:]
        qm = rmsnorm(qm.reshape(B, S, MEM_HEADS, HEAD_DIM), mem_q_norm_g[l]).transpose(0, 2, 1, 3)
        mo = mem_attention(qm, mk, mv)
        x = x + jnp.concatenate([mix, mo], axis=-1) @ w_out[l]

        x = x + 0.5 * swiglu(rmsnorm(x, norm_g[l, 2]), ffn_w_gu[l, 1], ffn_w_down[l, 1])
    return x
```

```cpp
#include <hip/hip_runtime.h>
#include <hip/hip_bf16.h>
#include <cstdio>
#include <cstdint>

constexpr int BATCH = 4, SEQ = 4096, DM = 2048, DEPTH = 4, NA = 2;
constexpr int M = BATCH * SEQ;
constexpr int MEML = 256, HD = 128, MEMH = 4, MEMW = 512, MIXW = 1536, CHUNK = 128, GG = 6, GW = 256, DH = 6, DV = 256, FF = 5632;
constexpr int NGU = 2 * FF;
constexpr int NAIN = 2 * MIXW + MEMW;
constexpr int NBIN = MIXW + MEMW;
constexpr int NKV = 2 * DH * HD + DH * DV;
constexpr float EPS = 1e-6f;
namespace pg8 {
#define PG8_LAS __attribute__((address_space(3)))
typedef unsigned short bf16_t;
typedef short bf16x8 __attribute__((ext_vector_type(8)));
typedef float f32x4 __attribute__((ext_vector_type(4)));
typedef unsigned u32x4 __attribute__((ext_vector_type(4)));
constexpr int BM = 256, BK = 64, HALF = 128, HTB = HALF * BK * 2  , STAGE_BYTES = 8 * HTB, NXCD = 8, WGM = 8;

__host__ __device__ __forceinline__ int lds_byte(int r, int c) { const int st = (r >> 4) * 2 + (c >> 5), rr = r & 15, cc = c & 31, ob = rr * 64 + cc * 2; return st * 1024 + (ob ^ (((ob >> 9) & 1) << 5)); }
__host__ __device__ __forceinline__ void stage_rc(int b, int& R, int& C) { const int st = b / 1024, sb = b % 1024, swz = sb ^ (((sb >> 9) & 1) << 5); R = (st >> 1) * 16 + swz / 64; C = (st & 1) * 32 + (swz % 64) / 2; }
__host__ __device__ __forceinline__ int perm32(int rho) { const int n = rho >> 4, i = rho & 15; return 8 * (i >> 2) + 4 * n + (i & 3); }

struct Unit { int pm, pn; };
struct Gemm { const bf16_t* A; const bf16_t* Bt; int M, N, K; };

struct StaticOrder {
    int nM, nN, nwg, G, c;
    __host__ __device__ void init(int M, int N, int G_, int c_) { nM = M / BM; nN = N / BM; nwg = nM * nN; G = G_; c = c_; }
    __host__ __device__ bool next(int i, Unit& u) const {
        const long L = (long)i * G + c; if (L >= nwg) return false;
        int wgid = (int)L; { const int q = nwg / NXCD, r = nwg % NXCD, xcd = wgid % NXCD, off = wgid / NXCD; wgid = (xcd < r ? xcd * (q + 1) : r * (q + 1) + (xcd - r) * q) + off; }
        const int nig = WGM * nN, gid = wgid / nig, fm = gid * WGM, gsz = (nM - fm) < WGM ? (nM - fm) : WGM;
        u.pm = fm + ((wgid % nig) % gsz); u.pn = (wgid % nig) / gsz; return true;
    }
    __device__ __forceinline__ void a_ready(const Unit&) const {}
    __device__ __forceinline__ void done(const Unit&) const {}
};
__device__ __forceinline__ unsigned cvt_pk_bf16(float lo, float hi) { unsigned r; asm volatile("v_cvt_pk_bf16_f32 %0, %1, %2" : "=v"(r) : "v"(lo), "v"(hi)); return r; }
typedef float f32x2 __attribute__((ext_vector_type(2)));
__device__ __forceinline__ f32x2 gelu_pk(f32x2 v) {
    const f32x2 av = __builtin_elementwise_abs(v), d = av * 0.2316418882f + 1.0f;
    f32x2 t; t.x = __builtin_amdgcn_rcpf(d.x); t.y = __builtin_amdgcn_rcpf(d.y);
    f32x2 q = t * 0.5307027145f + (-0.7265760135f); q = q * t + 0.7107068705f; q = q * t + (-0.142248368f); q = q * t + 0.127414796f; q = q * t;
    const f32x2 s = (v * v) * (-0.72134752044f);
    f32x2 e; e.x = __builtin_amdgcn_exp2f(s.x); e.y = __builtin_amdgcn_exp2f(s.y);
    const f32x2 m = v * (q * e), r = v - m;
    f32x2 o; o.x = v.x < 0.f ? m.x : r.x; o.y = v.y < 0.f ? m.y : r.y; return o;
}
__device__ __forceinline__ float silu_f(float g) { return g * __builtin_amdgcn_rcpf(1.0f + __builtin_amdgcn_exp2f(-1.4426950408889634f * g)); }
__device__ __forceinline__ u32x4 pack8_bf16(f32x4 a, f32x4 b) { u32x4 w; w.x = cvt_pk_bf16(a[0], a[1]); w.y = cvt_pk_bf16(a[2], a[3]); w.z = cvt_pk_bf16(b[0], b[1]); w.w = cvt_pk_bf16(b[2], b[3]); return w; }

struct EpiSwiglu {
    static constexpr bool PERM = true, AFTER_DRAIN = false;
    bf16_t* H; int ldh;
    __device__ __forceinline__ void operator()(const f32x4 (&acc)[2][2][4][2], const Unit& u, int wr, int wc, int fr, int fq) const {
        const int row0 = u.pm * BM + wr * 64 + fr, col0 = u.pn * HALF + wc * 32 + 8 * fq;
#pragma unroll
        for (int ai = 0; ai < 2; ++ai)
#pragma unroll
            for (int m = 0; m < 4; ++m) {
                const f32x4 g0 = acc[ai][0][m][0], g1 = acc[ai][0][m][1], u0 = acc[ai][1][m][0], u1 = acc[ai][1][m][1];
                f32x4 h0, h1;
#pragma unroll
                for (int j = 0; j < 4; ++j) { h0[j] = silu_f(g0[j]) * u0[j]; h1[j] = silu_f(g1[j]) * u1[j]; }
                *(u32x4*)(H + (size_t)(row0 + ai * HALF + m * 16) * ldh + col0) = pack8_bf16(h0, h1);
            }
    }
};
struct EpiResid {
    static constexpr bool PERM = false, AFTER_DRAIN = false;
    const float* base; float* out; int ld; float scale;
    __device__ __forceinline__ void operator()(const f32x4 (&acc)[2][2][4][2], const Unit& u, int wr, int wc, int fr, int fq) const {
        const int row0 = u.pm * BM + wr * 64 + fr, col0 = u.pn * BM + wc * 32 + 4 * fq;
#pragma unroll
        for (int ai = 0; ai < 2; ++ai)
#pragma unroll
            for (int m = 0; m < 4; ++m) { const size_t off = (size_t)(row0 + ai * HALF + m * 16) * ld + col0;
#pragma unroll
                for (int bj = 0; bj < 2; ++bj)
#pragma unroll
                    for (int n = 0; n < 2; ++n) { const f32x4 b = *(const f32x4*)(base + off + bj * HALF + n * 16); *(f32x4*)(out + off + bj * HALF + n * 16) = b + acc[ai][bj][m][n] * scale; }
                asm volatile("" ::: "memory"); }
    }
};
struct EpiAin {
    static constexpr bool PERM = true, AFTER_DRAIN = false;
    bf16_t* ZA; float* vstat; float* qm;
    __device__ __forceinline__ void operator()(const f32x4 (&acc)[2][2][4][2], const Unit& u, int wr, int wc, int fr, int fq) const {
        const int row0 = u.pm * BM + wr * 64 + fr;
        if (u.pn < 12) {
            const int col0 = u.pn * BM + wc * 32 + 8 * fq; const bool st = u.pn >= 6;
#pragma unroll
            for (int ai = 0; ai < 2; ++ai)
#pragma unroll
                for (int m = 0; m < 4; ++m) { const int row = row0 + ai * HALF + m * 16; float ss = 0.f;
#pragma unroll
                    for (int bj = 0; bj < 2; ++bj) { f32x4 v0 = acc[ai][bj][m][0], v1 = acc[ai][bj][m][1];
                        f32x2 a = gelu_pk((f32x2){v0[0], v0[1]}), b = gelu_pk((f32x2){v0[2], v0[3]}), c = gelu_pk((f32x2){v1[0], v1[1]}), d = gelu_pk((f32x2){v1[2], v1[3]});
                        v0 = (f32x4){a.x, a.y, b.x, b.y}; v1 = (f32x4){c.x, c.y, d.x, d.y};
                        ss += (v0[0] * v0[0] + v0[1] * v0[1]) + (v0[2] * v0[2] + v0[3] * v0[3]) + (v1[0] * v1[0] + v1[1] * v1[1]) + (v1[2] * v1[2] + v1[3] * v1[3]);
                        *(u32x4*)(ZA + (size_t)row * 3072 + col0 + bj * HALF) = pack8_bf16(v0, v1); }
                    if (st) { ss += __shfl_xor(ss, 16); ss += __shfl_xor(ss, 32); if (fq == 0) vstat[(size_t)row * 24 + (u.pn - 6) * 4 + wc] = ss; } }
        } else {
            const int col0 = (u.pn - 12) * BM + wc * 32 + 8 * fq;
#pragma unroll
            for (int ai = 0; ai < 2; ++ai)
#pragma unroll
                for (int m = 0; m < 4; ++m) { float* p = qm + (size_t)(row0 + ai * HALF + m * 16) * 512 + col0;
#pragma unroll
                    for (int bj = 0; bj < 2; ++bj) { *(f32x4*)(p + bj * HALF) = acc[ai][bj][m][0]; *(f32x4*)(p + bj * HALF + 4) = acc[ai][bj][m][1]; } }
        }
    }
};
struct EpiF32Split {
    static constexpr bool PERM = true, AFTER_DRAIN = false;
    float* d0; int ld0; int split; float* d1; int ld1; int pnmod;
    __device__ __forceinline__ void operator()(const f32x4 (&acc)[2][2][4][2], const Unit& u, int wr, int wc, int fr, int fq) const {
        const int row0 = u.pm * BM + wr * 64 + fr; int pn = pnmod ? (u.pn % pnmod) : u.pn; float* d = d0; int ld = ld0;
        if (pn >= split) { d = d1; ld = ld1; pn -= split; }
        const int col0 = pn * BM + wc * 32 + 8 * fq;
#pragma unroll
        for (int ai = 0; ai < 2; ++ai)
#pragma unroll
            for (int m = 0; m < 4; ++m) { float* p = d + (size_t)(row0 + ai * HALF + m * 16) * ld + col0;
#pragma unroll
                for (int bj = 0; bj < 2; ++bj) { *(f32x4*)(p + bj * HALF) = acc[ai][bj][m][0]; *(f32x4*)(p + bj * HALF + 4) = acc[ai][bj][m][1]; } }
    }
};
struct EpiKv {
    static constexpr bool PERM = true, AFTER_DRAIN = false;
    float* kraw; bf16_t* vsh;
    __device__ __forceinline__ void operator()(const f32x4 (&acc)[2][2][4][2], const Unit& u, int wr, int wc, int fr, int fq) const {
        const int row0 = u.pm * BM + wr * 64 + fr;
        if (u.pn < 6) {
            const int col0 = u.pn * BM + wc * 32 + 8 * fq;
#pragma unroll
            for (int ai = 0; ai < 2; ++ai)
#pragma unroll
                for (int m = 0; m < 4; ++m) { float* p = kraw + (size_t)(row0 + ai * HALF + m * 16) * 1536 + col0;
#pragma unroll
                    for (int bj = 0; bj < 2; ++bj) { *(f32x4*)(p + bj * HALF) = acc[ai][bj][m][0]; *(f32x4*)(p + bj * HALF + 4) = acc[ai][bj][m][1]; } }
        } else {
            const int h = u.pn - 6;
#pragma unroll
            for (int ai = 0; ai < 2; ++ai)
#pragma unroll
                for (int m = 0; m < 4; ++m) { const int row = row0 + ai * HALF + m * 16, b = row >> 12, s = row & 4095;
#pragma unroll
                    for (int bj = 0; bj < 2; ++bj) *(u32x4*)(vsh + ((size_t)((b * 6 + h) * 2 + bj) * 4096 + s) * 128 + wc * 32 + 8 * fq) = pack8_bf16(acc[ai][bj][m][0], acc[ai][bj][m][1]); }
        }
    }
};
struct MemKvOrder {
    int G, c;
    __device__ bool next(int i, Unit& u) const { const int L = i * G + c; if (L >= 64) return false; const int layer = L >> 4, r = L & 15; u.pm = layer * 4 + (r >> 2); u.pn = layer * 4 + (r & 3); return true; }
    __device__ __forceinline__ void a_ready(const Unit&) const {}
    __device__ __forceinline__ void done(const Unit&) const {}
};
template <class Epi, class Sched, bool ALIGN_EPI = false, bool SP2 = false>
__device__ __forceinline__ void gemm_phase(PG8_LAS unsigned char* lds, const Gemm g, const Sched& S, const Epi& E) {
    const int tid = threadIdx.x, wid = __builtin_amdgcn_readfirstlane(tid >> 6), lane = tid & 63, wr = wid >> 2, wc = wid & 3, fr = lane & 15, fq = lane >> 4;
    const int K = g.K, nt = K / BK;
    unsigned voffA[2], voffB[2];
#pragma unroll
    for (int i = 0; i < 2; ++i) { int R, C; stage_rc(tid * 16 + i * 8192, R, C); const int Rb = Epi::PERM ? ((R & ~31) + perm32(R & 31)) : R;
        voffA[i] = (unsigned)(R * K + C) * 2u; voffB[i] = (unsigned)(Rb * K + C) * 2u; }
    const size_t kstep = (size_t)(BK * 2);
    const size_t hstep = (size_t)HALF * K * 2;
    const size_t tstep = 2 * hstep;
    const unsigned ldsw = (unsigned)wid * 1024u;
    const int aoff = lds_byte(wr * 64 + fr, fq * 8), boff = lds_byte(wc * 32 + fr, fq * 8);
#define PG8_SA(b, h) (((b) * 2 + (h)) * HTB)
#define PG8_SB(b, h) ((4 + (b) * 2 + (h)) * HTB)
#define PG8_STAGE(bufoff, gbase, voff) do { _Pragma("unroll") for (int _i = 0; _i < 2; ++_i) \
        __builtin_amdgcn_global_load_lds((const unsigned*)((const char*)(gbase) + (voff)[_i]), (PG8_LAS unsigned*)(lds + (bufoff) + ldsw + _i * 8192), 16, 0, 0); } while (0)
#define PG8_LDA(dst, b, h) do { _Pragma("unroll") for (int m = 0; m < 4; ++m) _Pragma("unroll") for (int k = 0; k < 2; ++k) dst[m][k] = *(const PG8_LAS bf16x8*)(lds + PG8_SA(b, h) + aoff + m * 2048 + k * 1024); } while (0)
#define PG8_LDB(dst, b, h) do { _Pragma("unroll") for (int n = 0; n < 2; ++n) _Pragma("unroll") for (int k = 0; k < 2; ++k) dst[n][k] = *(const PG8_LAS bf16x8*)(lds + PG8_SB(b, h) + boff + n * 2048 + k * 1024); } while (0)
#define PG8_MMA(ai, bj, At, Bt) do { __builtin_amdgcn_s_setprio(1); _Pragma("unroll") for (int m = 0; m < 4; ++m) _Pragma("unroll") for (int n = 0; n < 2; ++n) _Pragma("unroll") for (int k = 0; k < 2; ++k) \
        acc[ai][bj][m][n] = __builtin_amdgcn_mfma_f32_16x16x32_bf16(Bt[n][k], At[m][k], acc[ai][bj][m][n], 0, 0, 0); __builtin_amdgcn_s_setprio(0); } while (0)
#define PG8_WAIT_V(n) asm volatile("s_waitcnt vmcnt(" #n ")" ::: "memory")
#define PG8_WAIT_L(n) asm volatile("s_waitcnt lgkmcnt(" #n ")" ::: "memory")
#define PG8_BAR __builtin_amdgcn_s_barrier()
#define PG8_SCHED __builtin_amdgcn_sched_barrier(0)
    Unit cur, nxt; int ui = 0;
    if (!S.next(0, cur)) return;
    f32x4 acc[2][2][4][2];
#pragma unroll
    for (int a = 0; a < 2; ++a)
#pragma unroll
        for (int b = 0; b < 2; ++b)
#pragma unroll
            for (int m = 0; m < 4; ++m)
#pragma unroll
                for (int n = 0; n < 2; ++n) acc[a][b][m][n] = (f32x4){0.f, 0.f, 0.f, 0.f};
    bf16x8 At[4][2], B0[2][2], B1[2][2];
    const char* cA = (const char*)g.A + (size_t)cur.pm * tstep; const char* cB = (const char*)g.Bt + (size_t)cur.pn * tstep;
    S.a_ready(cur);
    if constexpr (SP2) {
        PG8_STAGE(PG8_SB(0, 0), cB, voffB); PG8_STAGE(PG8_SB(0, 1), cB + hstep, voffB); PG8_STAGE(PG8_SA(0, 0), cA, voffA); PG8_STAGE(PG8_SA(0, 1), cA + hstep, voffA);
        if (wr == 1) PG8_BAR;
        PG8_WAIT_V(2); PG8_BAR;
        PG8_STAGE(PG8_SB(1, 0), cB + kstep, voffB); PG8_STAGE(PG8_SA(1, 0), cA + kstep, voffA); PG8_STAGE(PG8_SB(1, 1), cB + hstep + kstep, voffB);
        PG8_WAIT_V(6); PG8_BAR;
    } else {
        PG8_STAGE(PG8_SB(0, 0), cB, voffB); PG8_STAGE(PG8_SA(0, 0), cA, voffA); PG8_STAGE(PG8_SB(0, 1), cB + hstep, voffB); PG8_STAGE(PG8_SA(0, 1), cA + hstep, voffA);
        if (wr == 1) PG8_BAR;
        PG8_WAIT_V(4); PG8_BAR;
        PG8_STAGE(PG8_SB(1, 0), cB + kstep, voffB); PG8_STAGE(PG8_SA(1, 0), cA + kstep, voffA); PG8_STAGE(PG8_SB(1, 1), cB + hstep + kstep, voffB);
        PG8_WAIT_V(6); PG8_BAR;
    }
    for (;;) {
        const bool has_next = S.next(ui + 1, nxt);
        const char* nA = has_next ? (const char*)g.A + (size_t)nxt.pm * tstep : cA; const char* nB = has_next ? (const char*)g.Bt + (size_t)nxt.pn * tstep : cB;
        for (int t = 0; t < nt; t += 2) {
            const bool last = (t == nt - 2);
            const char* a1 = cA + (size_t)(t + 1) * kstep;
            const char* a2 = last ? nA : cA + (size_t)(t + 2) * kstep; const char* b2 = last ? nB : cB + (size_t)(t + 2) * kstep;
            const char* a3 = a2 + kstep; const char* b3 = b2 + kstep;
            if (last && has_next) S.a_ready(nxt);
            if constexpr (SP2) {
            PG8_LDB(B0, 0, 0); PG8_LDB(B1, 0, 1); PG8_SCHED; PG8_LDA(At, 0, 0); PG8_STAGE(PG8_SA(1, 1), a1 + hstep, voffA);
            PG8_WAIT_V(8); PG8_WAIT_L(0); PG8_BAR; PG8_MMA(0, 0, At, B0); PG8_MMA(0, 1, At, B1); PG8_BAR; PG8_SCHED;
            PG8_LDA(At, 0, 1); PG8_STAGE(PG8_SB(0, 0), b2, voffB); PG8_STAGE(PG8_SB(0, 1), b2 + hstep, voffB); PG8_STAGE(PG8_SA(0, 0), a2, voffA);
            PG8_WAIT_V(8); PG8_WAIT_L(0); PG8_BAR; PG8_MMA(1, 0, At, B0); PG8_MMA(1, 1, At, B1); PG8_BAR; PG8_SCHED;
            PG8_LDB(B0, 1, 0); PG8_LDB(B1, 1, 1); PG8_SCHED; PG8_LDA(At, 1, 0); PG8_STAGE(PG8_SA(0, 1), a2 + hstep, voffA);
            PG8_WAIT_V(8); PG8_WAIT_L(0); PG8_BAR; PG8_MMA(0, 0, At, B0); PG8_MMA(0, 1, At, B1); PG8_BAR; PG8_SCHED;
            PG8_LDA(At, 1, 1); PG8_STAGE(PG8_SB(1, 0), b3, voffB); PG8_STAGE(PG8_SB(1, 1), b3 + hstep, voffB); PG8_STAGE(PG8_SA(1, 0), a3, voffA);
            PG8_WAIT_V(8); PG8_WAIT_L(0); PG8_BAR; PG8_MMA(1, 0, At, B0); PG8_MMA(1, 1, At, B1); PG8_BAR; PG8_SCHED;
            } else {
            PG8_LDB(B0, 0, 0); PG8_SCHED; PG8_LDA(At, 0, 0); PG8_STAGE(PG8_SA(1, 1), a1 + hstep, voffA);
            PG8_WAIT_L(8); PG8_BAR; PG8_WAIT_L(0); PG8_MMA(0, 0, At, B0); PG8_BAR; PG8_SCHED;
            PG8_LDB(B1, 0, 1); PG8_STAGE(PG8_SB(0, 0), b2, voffB);
            PG8_BAR; PG8_WAIT_L(0); PG8_MMA(0, 1, At, B1); PG8_BAR;
            PG8_LDA(At, 0, 1); PG8_STAGE(PG8_SA(0, 0), a2, voffA);
            PG8_BAR; PG8_WAIT_L(0); PG8_MMA(1, 0, At, B0); PG8_BAR; PG8_SCHED;
            PG8_STAGE(PG8_SB(0, 1), b2 + hstep, voffB);
            PG8_WAIT_V(6); PG8_BAR; PG8_MMA(1, 1, At, B1); PG8_BAR;
            PG8_LDB(B0, 1, 0); PG8_SCHED; PG8_LDA(At, 1, 0); PG8_STAGE(PG8_SA(0, 1), a2 + hstep, voffA);
            PG8_WAIT_L(8); PG8_BAR; PG8_WAIT_L(0); PG8_MMA(0, 0, At, B0); PG8_BAR; PG8_SCHED;
            PG8_LDB(B1, 1, 1); PG8_STAGE(PG8_SB(1, 0), b3, voffB);
            PG8_BAR; PG8_WAIT_L(0); PG8_MMA(0, 1, At, B1); PG8_BAR;
            PG8_LDA(At, 1, 1); PG8_STAGE(PG8_SA(1, 0), a3, voffA);
            PG8_BAR; PG8_WAIT_L(0); PG8_MMA(1, 0, At, B0); PG8_BAR; PG8_SCHED;
            PG8_STAGE(PG8_SB(1, 1), b3 + hstep, voffB);
            PG8_WAIT_V(6); PG8_BAR; PG8_MMA(1, 1, At, B1); PG8_BAR;
            }
        }
        if constexpr (ALIGN_EPI) { if (wr == 0) PG8_BAR; }
        if constexpr (!Epi::AFTER_DRAIN) { E(acc, cur, wr, wc, fr, fq); S.done(cur); }
        if (!has_next) break;
#pragma unroll
        for (int a = 0; a < 2; ++a)
#pragma unroll
            for (int b = 0; b < 2; ++b)
#pragma unroll
                for (int m = 0; m < 4; ++m)
#pragma unroll
                    for (int n = 0; n < 2; ++n) acc[a][b][m][n] = (f32x4){0.f, 0.f, 0.f, 0.f};
        cur = nxt; cA = nA; cB = nB; ++ui;
        if constexpr (ALIGN_EPI) { if (wr == 1) PG8_BAR; }
    }
    PG8_WAIT_V(0);
    if constexpr (!ALIGN_EPI) { if (wr == 0) PG8_BAR; }
    PG8_BAR;
    if constexpr (Epi::AFTER_DRAIN) { E.fused(acc, cur, wr, wc, fr, fq, lds, wid, lane); S.done(cur); }
#undef PG8_SA
#undef PG8_SB
#undef PG8_STAGE
#undef PG8_LDA
#undef PG8_LDB
#undef PG8_MMA
#undef PG8_WAIT_V
#undef PG8_WAIT_L
#undef PG8_BAR
#undef PG8_SCHED
}
}
namespace att {
constexpr int D = 128; constexpr float THR = 8.f; constexpr bool WSKIP = false;
constexpr float SCALE = 0.08838834764831845f;
constexpr int NW = 8, QBLK = 32, KVBLK = 64, QB = NW * QBLK;
constexpr int SHM_V = KVBLK * D * 2, SHM_K = KVBLK * D * 2;
constexpr int LDS_BYTES = 2 * SHM_V + 2 * SHM_K + NW * 64 * 4;

using bf16 = __hip_bfloat16;
typedef short bf16x8 __attribute__((ext_vector_type(8)));
typedef short s16x4 __attribute__((ext_vector_type(4)));
typedef float f32x16 __attribute__((ext_vector_type(16)));
typedef float f32x4 __attribute__((ext_vector_type(4)));
typedef unsigned u32x4 __attribute__((ext_vector_type(4)));
template <class A, class Bt> struct same_t { static constexpr bool v = false; };
template <class A> struct same_t<A, A> { static constexpr bool v = true; };

#define KSWZ(row, colB) ((row) * 256 + ((colB) ^ (((row) & 7) << 4)))
#define SBAR() __builtin_amdgcn_sched_barrier(0)
__device__ __forceinline__ int v_st(int k, int c) { const int kk = (k & ~0xC) | ((k & 4) << 1) | ((k & 8) >> 1); return ((kk >> 3) * 4 + (c >> 5)) * 512 + ((kk & 7) * 32 + (c & 31)) * 2; }
__device__ __forceinline__ int v_rd_base(int lane) { return ((lane & 3) << 3) | (((lane >> 2) & 3) << 6) | (((lane >> 4) & 1) << 5) | (((lane >> 5) & 1) << 8); }
constexpr int v_rd_off(int d0, int ks, int half) { return d0 * 512 + ks * 4096 + half * 2048; }
__device__ __forceinline__ int crow(int r, int hi) { return (r & 3) + 8 * (r >> 2) + 4 * hi; }
__device__ __forceinline__ unsigned cvtpk(float lo, float hi) {
    unsigned r; asm volatile("v_cvt_pk_bf16_f32 %0, %1, %2" : "=v"(r) : "v"(lo), "v"(hi)); return r;
}
__device__ __forceinline__ bf16x8 pack8(f32x4 a, f32x4 b) {
    u32x4 w = {cvtpk(a[0], a[1]), cvtpk(a[2], a[3]), cvtpk(b[0], b[1]), cvtpk(b[2], b[3])};
    return *reinterpret_cast<bf16x8*>(&w);
}
template <class T> __device__ __forceinline__ bf16x8 load8(const T* p) {
    if constexpr (same_t<T, float>::v) { return pack8(*(const f32x4*)p, *(const f32x4*)(p + 4)); }
    else { return *reinterpret_cast<const bf16x8*>(p); }
}
__device__ __forceinline__ void mask_tile(f32x16& p0, f32x16& p1, int dq, unsigned W) {
    const float NEG = -__builtin_inff();
#pragma unroll
    for (int r = 0; r < 16; ++r) {
        const int c = (r & 3) + 8 * (r >> 2);
        if ((unsigned)(dq - c) >= W) p0[r] = NEG;
        if ((unsigned)(dq - c - 32) >= W) p1[r] = NEG;
    }
}
__device__ __forceinline__ void partialSM(f32x16& p0, f32x16& p1, float& m_reg, float& mn, float& alpha) {
    float pmax = p0[0]; for (int r = 1; r < 16; ++r) pmax = fmaxf(pmax, p0[r]); for (int r = 0; r < 16; ++r) pmax = fmaxf(pmax, p1[r]);
    { auto rr = __builtin_amdgcn_permlane32_swap(__float_as_uint(pmax), __float_as_uint(pmax), false, false);
      pmax = fmaxf(__uint_as_float(rr[0]), __uint_as_float(rr[1])); }
    constexpr float C2 = 1.4426950408889634f * SCALE;
    if (__builtin_expect(__all((pmax - m_reg) * SCALE <= THR), 1)) { mn = m_reg; alpha = 1.f; }
    else { mn = fmaxf(m_reg, pmax); alpha = __builtin_amdgcn_exp2f((m_reg - mn) * C2); m_reg = mn; }
    const float mnL = -mn * C2;
    for (int r = 0; r < 16; ++r) p0[r] = fmaf(p0[r], C2, mnL); for (int r = 0; r < 16; ++r) p1[r] = fmaf(p1[r], C2, mnL);
    for (int r = 0; r < 16; ++r) p0[r] = __builtin_amdgcn_exp2f(p0[r]);
}
__device__ __forceinline__ void finishSM(f32x16& p0, f32x16& p1, float alpha, float& l_reg, bf16x8& pa0, bf16x8& pa1, bf16x8& pa2, bf16x8& pa3) {
    for (int r = 0; r < 16; ++r) p1[r] = __builtin_amdgcn_exp2f(p1[r]);
    float ps = 0; for (int r = 0; r < 16; ++r) ps += p0[r]; for (int r = 0; r < 16; ++r) ps += p1[r];
    { auto rr = __builtin_amdgcn_permlane32_swap(__float_as_uint(ps), __float_as_uint(ps), false, false);
      ps = __uint_as_float(rr[0]) + __uint_as_float(rr[1]); }
    l_reg = l_reg * alpha + ps;
#define PK4(P, B_, OUT) do { unsigned a0 = cvtpk(P[B_+0], P[B_+1]), a1 = cvtpk(P[B_+2], P[B_+3]);                          \
        unsigned b0 = cvtpk(P[B_+4], P[B_+5]), b1 = cvtpk(P[B_+6], P[B_+7]);                                             \
        auto r0 = __builtin_amdgcn_permlane32_swap(a0, b0, false, false); auto r1 = __builtin_amdgcn_permlane32_swap(a1, b1, false, false); \
        u32x4 w = {r0[0], r1[0], r0[1], r1[1]}; OUT = *reinterpret_cast<bf16x8*>(&w); } while (0)
    PK4(p0, 0, pa0); PK4(p0, 8, pa1); PK4(p1, 0, pa2); PK4(p1, 8, pa3);
#undef PK4
}
template <int KB, bool SK>
__device__ __forceinline__ void qkt(f32x16& p0, f32x16& p1, const char* K_lds, int r32, int hi, const bf16x8* qr, bool act) {
    if (SK && !act) { const float NEG = -__builtin_inff();
#pragma unroll
        for (int r = 0; r < 16; ++r) { p0[r] = NEG; p1[r] = NEG; } return; }
    p0 = f32x16{}; p1 = f32x16{};
    const char* kb[4];
#pragma unroll
    for (int dd = 0; dd < 4; ++dd) kb[dd] = K_lds + KB * SHM_K + KSWZ(r32, (dd * 16 + hi * 8) * 2);
#pragma unroll
    for (int d0 = 0; d0 < 8; ++d0) { const char* a = kb[d0 & 3] + (d0 >> 2) * 128;
        bf16x8 b0 = *reinterpret_cast<const bf16x8*>(a);
        bf16x8 b1 = *reinterpret_cast<const bf16x8*>(a + 32 * 256);
        p0 = __builtin_amdgcn_mfma_f32_32x32x16_bf16(b0, qr[d0], p0, 0, 0, 0);
        p1 = __builtin_amdgcn_mfma_f32_32x32x16_bf16(b1, qr[d0], p1, 0, 0, 0); }
}
template <int VB, bool SK>
__device__ __forceinline__ void pv_tile(f32x16* o, int vb0, bf16x8 pa0, bf16x8 pa1, bf16x8 pa2, bf16x8 pa3, bool act) {
    if (SK && !act) return;
#define TRRD(dst, off) asm volatile("ds_read_b64_tr_b16 %0, %1 offset:%2" : "=&v"(dst) : "v"(vb0), "i"(off) : "memory")
#define PV_D0(d0) do { s16x4 l0, l1, l2, l3, h0, h1, h2, h3; constexpr int b_ = VB * SHM_V + v_rd_off(d0, 0, 0);     \
        TRRD(l0, b_); TRRD(h0, b_ + 2048); TRRD(l1, b_ + 4096); TRRD(h1, b_ + 6144); TRRD(l2, b_ + 8192); TRRD(h2, b_ + 10240); TRRD(l3, b_ + 12288); TRRD(h3, b_ + 14336); \
        asm volatile("s_waitcnt lgkmcnt(0)" ::: "memory"); SBAR();                 \
        o[d0] = __builtin_amdgcn_mfma_f32_32x32x16_bf16(pa0, (bf16x8){l0[0], l0[1], l0[2], l0[3], h0[0], h0[1], h0[2], h0[3]}, o[d0], 0, 0, 0);   \
        o[d0] = __builtin_amdgcn_mfma_f32_32x32x16_bf16(pa1, (bf16x8){l1[0], l1[1], l1[2], l1[3], h1[0], h1[1], h1[2], h1[3]}, o[d0], 0, 0, 0);   \
        o[d0] = __builtin_amdgcn_mfma_f32_32x32x16_bf16(pa2, (bf16x8){l2[0], l2[1], l2[2], l2[3], h2[0], h2[1], h2[2], h2[3]}, o[d0], 0, 0, 0);   \
        o[d0] = __builtin_amdgcn_mfma_f32_32x32x16_bf16(pa3, (bf16x8){l3[0], l3[1], l3[2], l3[3], h3[0], h3[1], h3[2], h3[3]}, o[d0], 0, 0, 0); } while (0)
    PV_D0(0); PV_D0(1); PV_D0(2); PV_D0(3);
#undef PV_D0
#undef TRRD
}

template <class TIn, class TOut> struct BlockRef { const TIn* Q; const TIn* K; const TIn* V; TOut* O; int P0; int ldo; };
template <class TIn> struct Seam {
    bf16x8 qr[8];
    bf16x8 st_v0, st_v1, st_k0, st_k1; f32x4 sf0, sf1, sf2, sf3;
    f32x4 tq[16];
};
__device__ __forceinline__ int swa_jlo(int P0, int W) { const int lowk = P0 - W + 1; return lowk > 0 ? lowk / KVBLK : 0; }
#define ROW(p, k0, rr) ((p) + (size_t)((k0) + (rr)) * D + sc)
#define VMW() asm volatile("s_waitcnt vmcnt(0)" ::: "memory")
#define VMWN(n) asm volatile("s_waitcnt vmcnt(%0)" :: "i"(n) : "memory")
#define SLOAD_H(Kp, Vp, k0) do { S.st_v0 = load8<TIn>(ROW(Vp, k0, sr)); S.st_v1 = load8<TIn>(ROW(Vp, k0, 32 + sr));              \
                         S.st_k0 = load8<TIn>(ROW(Kp, k0, sr)); S.st_k1 = load8<TIn>(ROW(Kp, k0, 32 + sr)); } while (0)
#define SWRITE_HK(bf) do { *(bf16x8*)(K_lds + (bf) * SHM_K + kws) = S.st_k0; *(bf16x8*)(K_lds + (bf) * SHM_K + kws + 32 * 256) = S.st_k1; } while (0)
#define SWRITE_HV(bf) do { *(bf16x8*)(V_lds + (bf) * SHM_V + vst0) = S.st_v0; *(bf16x8*)(V_lds + (bf) * SHM_V + vst1) = S.st_v1; } while (0)
#define SWRITE_H(bf) do { SWRITE_HV(bf); SWRITE_HK(bf); } while (0)
#define SLOAD_F(p, k0) do { S.sf0 = *(const f32x4*)ROW(p, k0, sr); S.sf1 = *(const f32x4*)(ROW(p, k0, sr) + 4);                \
                            S.sf2 = *(const f32x4*)ROW(p, k0, 32 + sr); S.sf3 = *(const f32x4*)(ROW(p, k0, 32 + sr) + 4); } while (0)
#define SWRITE_KF(bf) do { *(bf16x8*)(K_lds + (bf) * SHM_K + kws) = pack8(S.sf0, S.sf1); *(bf16x8*)(K_lds + (bf) * SHM_K + kws + 32 * 256) = pack8(S.sf2, S.sf3); } while (0)
#define SWRITE_VF(bf) do { *(bf16x8*)(V_lds + (bf) * SHM_V + vst0) = pack8(S.sf0, S.sf1); *(bf16x8*)(V_lds + (bf) * SHM_V + vst1) = pack8(S.sf2, S.sf3); } while (0)
template <class TIn, class TOut>
__device__ __forceinline__ void causal_swa_prime(const BlockRef<TIn, TOut>& cur, int W, char* lds, Seam<TIn>& S) {
    constexpr bool F32 = same_t<TIn, float>::v;
    const int tid = threadIdx.x, wid = __builtin_amdgcn_readfirstlane(tid >> 6), lane = tid & 63, r32 = lane & 31, hi = lane >> 5;
    const int sr = tid >> 4, sc = (tid & 15) * 8, kws = KSWZ(sr, sc * 2); char* K_lds = lds + 2 * SHM_V;
    const int kb0 = swa_jlo(cur.P0, W) * KVBLK;
    for (int d0 = 0; d0 < 8; ++d0) S.qr[d0] = load8<TIn>(cur.Q + (size_t)(wid * QBLK + r32) * D + d0 * 16 + hi * 8);
    if constexpr (F32) { SLOAD_F((const float*)cur.K, kb0); VMW(); SWRITE_KF(0); SBAR(); SLOAD_F((const float*)cur.V, kb0); }
    else { SLOAD_H(cur.K, cur.V, kb0); VMW(); SWRITE_HK(0); }
    __syncthreads();
}
template <class TIn, class TOut>
__device__ __forceinline__ void causal_swa_block(const BlockRef<TIn, TOut>& cur, const BlockRef<TIn, TOut>& nxt, int skv, int W, char* lds, Seam<TIn>& S) {
    constexpr bool F32 = same_t<TIn, float>::v;
    const int tid = threadIdx.x, wid = __builtin_amdgcn_readfirstlane(tid >> 6), lane = tid & 63, r32 = lane & 31, hi = lane >> 5;
    const int j_lo = swa_jlo(cur.P0, W);
    int j_hi = (cur.P0 + QB - 1) / KVBLK + 1; if (j_hi > skv / KVBLK) j_hi = skv / KVBLK;
    const int NT = j_hi - j_lo;
    const int kbn = swa_jlo(nxt.P0, W) * KVBLK;
    const int qlo = cur.P0 + wid * QBLK, qm = qlo + r32 - 4 * hi;
    char* V_lds = lds; char* K_lds = lds + 2 * SHM_V;
    float* ws = (float*)(lds + 2 * SHM_V + 2 * SHM_K) + wid * 64; float* li_l = ws, * al_l = ws + 32;
    float m_reg = -1e30f, l_reg = 0; f32x16 o[4] = {};
    const int sr = tid >> 4, sc = (tid & 15) * 8, vst0 = v_st(sr, sc), vst1 = v_st(32 + sr, sc), kws = KSWZ(sr, sc * 2);
    const int vb0 = (int)(uintptr_t)V_lds + v_rd_base(lane);
    const TIn* Kh = cur.K; const TIn* Vh = cur.V;
#define RESC(a) do { if (__any((a) < 1.f)) { if (hi == 0) al_l[r32] = (a); asm volatile("s_waitcnt lgkmcnt(0)" ::: "memory");              \
                     for (int d_ = 0; d_ < 4; ++d_) for (int r = 0; r < 16; ++r) o[d_][r] *= al_l[crow(r, hi)]; } } while (0)
#define KBASE(t) ((j_lo + (t)) * KVBLK)
#define ACT(t) (KBASE(t) <= qlo + QBLK - 1 && KBASE(t) + KVBLK - 1 >= qlo - W + 1)
#define MASKT(P0_, P1_, t) do { const int kb_ = KBASE(t); if ((!SK || ACT(t)) && (kb_ + KVBLK - 1 > qlo || kb_ <= qlo + QBLK - 1 - W)) mask_tile(P0_, P1_, qm - kb_, (unsigned)W); } while (0)
    constexpr int NQL = F32 ? 16 : 8;
    constexpr bool SK = WSKIP && !F32;
#define SEAM_K0() do { VMWN(NQL); if constexpr (F32) { SWRITE_KF(0); SBAR(); SLOAD_F((const float*)nxt.V, kbn); } else { SWRITE_HK(0); } SBAR(); } while (0)
    f32x16 pA0, pA1, pB0, pB1; float mnA, mnB, alA, alB; bf16x8 pa0, pa1, pa2, pa3;
    if constexpr (F32) { VMW(); SWRITE_VF(0); SBAR(); } else { SWRITE_HV(0); SBAR(); }
    if (NT > 1) { if constexpr (F32) SLOAD_F((const float*)Kh, KBASE(1)); else SLOAD_H(Kh, Vh, KBASE(1)); }
    SBAR(); qkt<0, SK>(pA0, pA1, K_lds, r32, hi, S.qr, ACT(0));
    if constexpr (F32) { if (NT > 1) { VMW(); SWRITE_KF(1); SBAR(); SLOAD_F((const float*)Vh, KBASE(1)); } }
    MASKT(pA0, pA1, 0); partialSM(pA0, pA1, m_reg, mnA, alA);
    if (NT > 1) { VMW(); if constexpr (F32) { SWRITE_VF(1); SBAR(); if (NT > 2) SLOAD_F((const float*)Kh, KBASE(2)); } else SWRITE_H(1); }
    __syncthreads();
#define HALF_STEP(PX0, PX1, mnX, alX, PY0, PY1, alY, t, KB, VB, SB) do {                                                      \
        SBAR(); qkt<KB, SK>(PX0, PX1, K_lds, r32, hi, S.qr, ACT(t));                                             \
        finishSM(PY0, PY1, alY, l_reg, pa0, pa1, pa2, pa3); SBAR();                                                           \
        if ((t) + 1 < NT) { if constexpr (F32) { VMW(); SWRITE_KF(SB); SBAR(); SLOAD_F((const float*)Vh, KBASE((t) + 1)); }  \
                            else { SLOAD_H(Kh, Vh, KBASE((t) + 1)); } SBAR(); }                                               \
        pv_tile<VB, SK>(o, vb0, pa0, pa1, pa2, pa3, ACT((t) - 1)); MASKT(PX0, PX1, (t)); partialSM(PX0, PX1, m_reg, mnX, alX);                                        \
        __syncthreads();                                                                                                      \
        if ((t) + 1 < NT) { VMW(); if constexpr (F32) { SWRITE_VF(SB); SBAR(); if ((t) + 2 < NT) SLOAD_F((const float*)Kh, KBASE((t) + 2)); } \
                            else { SWRITE_H(SB); } }                                                                          \
        RESC(alX); __syncthreads(); } while (0)
    for (int t = 1; t + 1 < NT; t += 2) {
        HALF_STEP(pB0, pB1, mnB, alB, pA0, pA1, alA, t, 1, 0, 0);
        HALF_STEP(pA0, pA1, mnA, alA, pB0, pB1, alB, t + 1, 0, 1, 1);
    }
    const bool even = (NT & 1) == 0;
    if (even) { SBAR(); qkt<1, SK>(pB0, pB1, K_lds, r32, hi, S.qr, ACT(NT - 1)); SBAR(); }
#define QROW(e) (nxt.Q + (size_t)(wid * QBLK + r32) * D + ((e) >> 1) * 16 + hi * 8 + ((e) & 1) * 4)
    if constexpr (F32) { SLOAD_F((const float*)nxt.K, kbn); SBAR();
#pragma unroll
        for (int e = 0; e < 8; ++e) S.tq[e] = *(const f32x4*)QROW(e); }
    else { SLOAD_H(nxt.K, nxt.V, kbn); SBAR();
#pragma unroll
        for (int d0 = 0; d0 < 8; ++d0) S.qr[d0] = load8<TIn>(nxt.Q + (size_t)(wid * QBLK + r32) * D + d0 * 16 + hi * 8); }
    SBAR();
    finishSM(pA0, pA1, alA, l_reg, pa0, pa1, pa2, pa3); SBAR();
    if constexpr (F32) {
#pragma unroll
        for (int e = 8; e < 16; ++e) S.tq[e] = *(const f32x4*)QROW(e); SBAR(); }
#undef QROW
    pv_tile<0, SK>(o, vb0, pa0, pa1, pa2, pa3, ACT(even ? NT - 2 : NT - 1));
    if (even) { MASKT(pB0, pB1, NT - 1); partialSM(pB0, pB1, m_reg, mnB, alB); __syncthreads(); RESC(alB);
        finishSM(pB0, pB1, alB, l_reg, pa0, pa1, pa2, pa3); SBAR(); pv_tile<1, SK>(o, vb0, pa0, pa1, pa2, pa3, ACT(NT - 1)); }
    SBAR(); SEAM_K0();
    if (hi == 0) li_l[r32] = l_reg; asm volatile("s_waitcnt lgkmcnt(0)" ::: "memory");
    float rli[16];
#pragma unroll
    for (int r = 0; r < 16; ++r) rli[r] = __builtin_amdgcn_rcpf(li_l[crow(r, hi)]);
    const int LDO = cur.ldo; TOut* Ow = cur.O + (size_t)(wid * QBLK) * LDO;
#pragma unroll
    for (int r = 0; r < 16; ++r) { const int orow = crow(r, hi);
#pragma unroll
        for (int d0 = 0; d0 < 4; ++d0) { const float v = o[d0][r] * rli[r];
            if constexpr (same_t<TOut, float>::v) { Ow[(size_t)orow * LDO + d0 * 32 + r32] = v; }
            else { const float vn = __shfl_xor(v, 1);
                   if ((r32 & 1) == 0) *(unsigned*)(Ow + (size_t)orow * LDO + d0 * 32 + r32) = cvtpk(v, vn); } } }
    if constexpr (F32) {
#pragma unroll
        for (int d0 = 0; d0 < 8; ++d0) S.qr[d0] = pack8(S.tq[2 * d0], S.tq[2 * d0 + 1]); }
    __syncthreads();
#undef RESC
#undef KBASE
#undef ACT
#undef MASKT
#undef SEAM_K0
#undef HALF_STEP
}
#undef ROW
#undef VMW
#undef VMWN
#undef SLOAD_H
#undef SWRITE_HK
#undef SWRITE_HV
#undef SWRITE_H
#undef SLOAD_F
#undef SWRITE_KF
#undef SWRITE_VF

}
constexpr size_t al256(size_t x) { return (x + 255) & ~(size_t)255; }
constexpr size_t WS_CTL = 0, CTL_ZERO_BYTES = 1u << 20;
constexpr size_t WS_WGU   = CTL_ZERO_BYTES;
constexpr size_t WS_WDN   = WS_WGU  + (size_t)8 * NGU * DM * 2;
constexpr size_t WS_WOUT  = WS_WDN  + (size_t)8 * DM * FF * 2;
constexpr size_t WS_WMEM  = WS_WOUT + (size_t)4 * DM * DM * 2;
constexpr size_t WS_WAIN  = WS_WMEM + (size_t)4 * 1024 * DM * 2;
constexpr size_t WS_WKV   = WS_WAIN + (size_t)2 * NAIN * DM * 2;
constexpr size_t WS_WBIN  = WS_WKV  + (size_t)NKV * DM * 2;
constexpr size_t WS_COS   = WS_WBIN + (size_t)2 * NBIN * DM * 2;
constexpr size_t WS_SIN   = WS_COS  + (size_t)SEQ * 64 * 4;
constexpr size_t WS_MEMN  = WS_SIN  + (size_t)SEQ * 64 * 4;
constexpr size_t WS_MKVR  = WS_MEMN + (size_t)4 * 1024 * DM * 2;
constexpr size_t WS_MK    = WS_MKVR + (size_t)4 * 1024 * 1024 * 4;
constexpr size_t WS_MV    = WS_MK   + (size_t)4 * 1024 * 512 * 2;
constexpr size_t WS_HN    = WS_MV   + (size_t)4 * 1024 * 512 * 2;
constexpr size_t WS_HKV   = WS_HN   + (size_t)M * DM * 2;
constexpr size_t WS_HID   = WS_HKV  + (size_t)M * DM * 2;
constexpr size_t WS_ZA    = WS_HID  + (size_t)M * FF * 2;
constexpr size_t WS_VSTAT = WS_ZA   + (size_t)M * 3072 * 2;
constexpr size_t WS_QMRAW = WS_VSTAT + (size_t)M * 24 * 4;
constexpr size_t WS_QRAW  = WS_QMRAW + (size_t)M * 512 * 4;
constexpr size_t WS_QB    = WS_QRAW + (size_t)M * 1536 * 4;
constexpr size_t WS_KSH   = WS_QB   + (size_t)M * 1536 * 2;
constexpr size_t WS_VSH   = WS_KSH  + (size_t)M * 1536 * 2;
constexpr size_t WS_QMB   = WS_VSH  + (size_t)M * 1536 * 2;
constexpr size_t WS_OATT  = WS_QMB  + (size_t)M * 512 * 2;
constexpr size_t WS_CAT   = WS_OATT + (size_t)96 * SEQ * 128 * 4;
constexpr size_t WS_END   = WS_CAT  + (size_t)M * DM * 2;
static_assert(WS_WGU % 256 == 0 && WS_COS % 256 == 0 && WS_VSTAT % 256 == 0 && WS_QMRAW % 256 == 0 && WS_END % 256 == 0, "ws alignment");

constexpr int RING_OFF = 0, RING_BYTES = 131072;
constexpr int LDSCTL_OFF = 139264, MISC_OFF = LDSCTL_OFF + 320;
constexpr int LDS_BYTES = 147456;
constexpr int NWAVES = 8;

#define GAS __attribute__((address_space(1)))
#define LAS __attribute__((address_space(3)))
typedef unsigned short bf16r;
typedef unsigned v4u __attribute__((ext_vector_type(4)));
typedef unsigned v2u __attribute__((ext_vector_type(2)));
typedef float f32x4 __attribute__((ext_vector_type(4)));
typedef short bf16x8 __attribute__((ext_vector_type(8)));
typedef GAS unsigned gu32;
#define LDS_WAIT() asm volatile("s_waitcnt lgkmcnt(0)" ::: "memory")
#define VM_WAIT() asm volatile("s_waitcnt vmcnt(0)" ::: "memory")
__device__ __forceinline__ unsigned f2bf(float f) { unsigned u = __builtin_bit_cast(unsigned, f); return (u + 0x7fffu + ((u >> 16) & 1u)) >> 16; }
__device__ __forceinline__ unsigned pk2(float lo, float hi) { return f2bf(lo) | (f2bf(hi) << 16); }
__device__ __forceinline__ float bf2f(unsigned short b) { return __builtin_bit_cast(float, ((unsigned)b) << 16); }
__device__ __forceinline__ float wave_sum(float v) {
#pragma unroll
    for (int o = 1; o < 64; o <<= 1) v += __shfl_xor(v, o);
    return v;
}
#define XB_TMO      128
#define XB_XCNT(j)  (256  + 64 * (j))
#define XB_XSUB(j)  (1280 + 64 * (j))
#define XB_XGEN(j)  (2304 + 64 * (j))
#define XB_TOP      3328
#define XB_TOPGEN   3392
#define XCD_BAR_WORDS 3456
#define XB_SPIN_CAP (1u << 18)

__device__ __forceinline__ unsigned xb_ld(unsigned* p)              { return __hip_atomic_load(p, __ATOMIC_RELAXED, __HIP_MEMORY_SCOPE_AGENT); }
__device__ __forceinline__ unsigned xb_add(unsigned* p, unsigned v) { return __hip_atomic_fetch_add(p, v, __ATOMIC_RELAXED, __HIP_MEMORY_SCOPE_AGENT); }
__device__ __forceinline__ unsigned xb_xcc_id() { return (unsigned)__builtin_amdgcn_s_getreg((3 << 11) | 20) & 0xFu; }
#define XB_SPIN(cond, bar) do { unsigned _sp = 0; while (cond) { __builtin_amdgcn_s_sleep(1); \
    if ((++_sp & 255u) == 0u) { if (xb_ld(&(bar)[XB_TMO])) break; if (_sp > XB_SPIN_CAP) { atomicAdd(&(bar)[XB_TMO], 1u); break; } } } } while (0)

struct XcdBarrier {
    unsigned* bar; unsigned x;
    volatile LAS unsigned* st;
};

__device__ __forceinline__ XcdBarrier xcd_barrier_post(unsigned* bar, volatile LAS unsigned* st) {
    XcdBarrier b; b.bar = bar; b.x = xb_xcc_id(); b.st = st;
    if (threadIdx.x == 0) (void)xb_add(&bar[XB_XCNT(b.x)], 1u);
    return b;
}
__device__ __forceinline__ void xcd_barrier_complete(unsigned* bar, unsigned x, unsigned& nloc, unsigned& nx) {
    const unsigned G = gridDim.x * gridDim.y * gridDim.z;
    unsigned sum, cnt, mine, sp = 0u;
    for (;;) {
        sum = 0u; cnt = 0u; mine = 0u;
#pragma unroll
        for (unsigned j = 0; j < 16; ++j) { const unsigned c = xb_ld(&bar[XB_XCNT(j)]); sum += c; cnt += (c > 0u) ? 1u : 0u; mine = (j == x) ? c : mine; }
        if (sum == G) break;
        __builtin_amdgcn_s_sleep(1);
        if ((++sp & 255u) == 0u) { if (xb_ld(&bar[XB_TMO])) break; if (sp > XB_SPIN_CAP) { atomicAdd(&bar[XB_TMO], 1u); break; } }
    }
    nloc = mine > 0u ? mine : 1u; nx = cnt > 0u ? cnt : 1u;
}

__device__ __forceinline__ void xcd_barrier(const XcdBarrier& b) {
    asm volatile("s_waitcnt vmcnt(0)" ::: "memory");
    __syncthreads();
    if (threadIdx.x == 0) {
        unsigned* bar = b.bar;
        __builtin_amdgcn_s_waitcnt(0);
        unsigned nloc = b.st[0], nx = b.st[1];
        if (nloc == 0u) { xcd_barrier_complete(bar, b.x, nloc, nx); b.st[0] = nloc; b.st[1] = nx; }
        const unsigned old = xb_add(&bar[XB_XSUB(b.x)], 1u);
        const unsigned gen = old / nloc;
        if (old + 1u == (gen + 1u) * nloc) {
            __builtin_amdgcn_fence(__ATOMIC_RELEASE, "agent");
            asm volatile("s_waitcnt vmcnt(0)" ::: "memory");
            const unsigned og = xb_add(&bar[XB_TOP], 1u);
            const unsigned tg = og / nx;
            if (og + 1u == (tg + 1u) * nx) xb_add(&bar[XB_TOPGEN], 1u);
            else XB_SPIN(xb_ld(&bar[XB_TOPGEN]) == tg, bar);
            __builtin_amdgcn_fence(__ATOMIC_ACQUIRE, "agent");
            xb_add(&bar[XB_XGEN(b.x)], 1u);
            asm volatile("s_waitcnt vmcnt(0)" ::: "memory");
        } else {
            XB_SPIN(xb_ld(&bar[XB_XGEN(b.x)]) == gen, bar);
            __builtin_amdgcn_fence(__ATOMIC_ACQUIRE, "agent");
            asm volatile("s_waitcnt vmcnt(0)" ::: "memory");
        }
    }
    __syncthreads();
}
struct Frame {
    unsigned char* lds_g;
    LAS unsigned char* lds;
    volatile LAS unsigned* MISC;
    gu32* ctl;
    int tid, lane, wave;
    int vcu, G;
    unsigned char* ws;
};

__device__ __forceinline__ void transpose_item(const float* W, int K, int N, bf16r* WT, size_t dst_row0, int k0, int n0, LAS float* scr, int lane) {
#pragma unroll 4
    for (int i = 0; i < 16; ++i) { const int kk = 4 * i + (lane >> 4); const f32x4 v = *(const f32x4*)(W + (size_t)(k0 + kk) * N + n0 + (lane & 15) * 4);
        LAS float* s = scr + kk * 65 + (lane & 15) * 4; s[0] = v[0]; s[1] = v[1]; s[2] = v[2]; s[3] = v[3]; }
    LDS_WAIT(); asm volatile("" ::: "memory");
    const int c = lane & 7;
#pragma unroll
    for (int j = 0; j < 8; ++j) { const int n = (lane >> 3) + 8 * j; const LAS float* s = scr + (8 * c) * 65 + n;
        v4u o; o.x = pk2(s[0 * 65], s[1 * 65]); o.y = pk2(s[2 * 65], s[3 * 65]); o.z = pk2(s[4 * 65], s[5 * 65]); o.w = pk2(s[6 * 65], s[7 * 65]);
        *(v4u*)(WT + (dst_row0 + n) * (size_t)K + k0 + 8 * c) = o; }
    LDS_WAIT(); asm volatile("" ::: "memory");
}
__device__ __forceinline__ bool transpose_group(int& r, const float* src, int cnt, int K, int N, bf16r* dst, bool gu, LAS float* scr, int lane) {
    const int nkb = K / 64, nnb = N / 64, per = nkb * nnb;
    if (r >= cnt * per) { r -= cnt * per; return false; }
    const int mi = r / per, q = r % per, kb = q / nnb, nb = q % nnb, n0 = nb * 64;
    size_t drow = n0;
    if (gu) { drow = (n0 < FF) ? (size_t)(n0 / 128) * 256 + (n0 % 128) : (size_t)((n0 - FF) / 128) * 256 + 128 + ((n0 - FF) % 128); }
    transpose_item(src + (size_t)mi * K * N, K, N, dst + (size_t)mi * K * N, gu ? drow : (size_t)n0, kb * 64, n0, scr, lane);
    return true;
}
__device__ __forceinline__ void norm_row(const float* xrow, const float* gain, bf16r* orow, int lane) {
    const f32x4* xr = (const f32x4*)xrow + lane; f32x4 v[8]; float s = 0.f;
#pragma unroll
    for (int j = 0; j < 8; ++j) { v[j] = xr[64 * j]; s += (v[j][0] * v[j][0] + v[j][1] * v[j][1]) + (v[j][2] * v[j][2] + v[j][3] * v[j][3]); }
    const float rstd = 1.0f / sqrtf(wave_sum(s) * (1.0f / DM) + EPS);
    const f32x4* g4 = (const f32x4*)gain + lane; v2u* o8 = (v2u*)orow + lane;
#pragma unroll
    for (int j = 0; j < 8; ++j) { const f32x4 g = g4[64 * j]; v2u w; w.x = pk2(v[j][0] * rstd * g[0], v[j][1] * rstd * g[1]); w.y = pk2(v[j][2] * rstd * g[2], v[j][3] * rstd * g[3]); o8[64 * j] = w; }
}
__device__ __forceinline__ void norm_phase(const Frame& F, const float* x, const float* gain, bf16r* out, const float* gain2, bf16r* out2) {
    const int gw = F.vcu * NWAVES + F.wave, NGW = F.G * NWAVES;
    for (int m = gw; m < M; m += NGW) { norm_row(x + (size_t)m * DM, gain, out + (size_t)m * DM, F.lane); if (gain2) norm_row(x + (size_t)m * DM, gain2, out2 + (size_t)m * DM, F.lane); }
}
__device__ __forceinline__ void sincos_d(float angf, float& sn, float& cs) {
    const double a = (double)angf; const double k = __builtin_rint(a * 0.15915494309189535); const double r = a - k * 6.283185307179586476925286766559;
    const double r2 = r * r; double ts = r, tc = 1.0, ss = r, cc = 1.0;
#pragma unroll
    for (int n = 1; n <= 14; ++n) { tc = -tc * r2 / (double)((2 * n - 1) * (2 * n)); ts = -ts * r2 / (double)((2 * n) * (2 * n + 1)); cc += tc; ss += ts; }
    sn = (float)ss; cs = (float)cc;
}
__device__ __forceinline__ void head_norm_store(float x1, float x2, const float* g, const float* cosr, const float* sinr, bf16r* dst, int lane) {
    const float ss = wave_sum(x1 * x1 + x2 * x2); const float rstd = 1.0f / sqrtf(ss * (1.0f / HD) + EPS);
    float y1 = x1 * rstd * g[lane], y2 = x2 * rstd * g[lane + 64];
    if (cosr) { const float c = cosr[lane], s = sinr[lane]; const float o1 = y1 * c - y2 * s, o2 = y2 * c + y1 * s; y1 = o1; y2 = o2; }
    dst[lane] = (bf16r)f2bf(y1); dst[lane + 64] = (bf16r)f2bf(y2);
}
__device__ __forceinline__ void qk_prep_phase(const Frame& F, const float* raw, const float* g, const float* cosT, const float* sinT, bf16r* dst) {
    const int gw = F.vcu * NWAVES + F.wave, NGW = F.G * NWAVES, lane = F.lane;
    for (int m = gw; m < M; m += NGW) { const int b = m >> 12, s = m & 4095; const float* r = raw + (size_t)m * 1536;
        float x1[12], x2[12];
#pragma unroll
        for (int h = 0; h < 12; ++h) { x1[h] = r[h * 128 + lane]; x2[h] = r[h * 128 + 64 + lane]; }
#pragma unroll
        for (int h = 0; h < 12; ++h) head_norm_store(x1[h], x2[h], g, cosT + (size_t)s * 64, sinT + (size_t)s * 64, dst + ((size_t)(b * 12 + h) * SEQ + s) * 128, lane);
    }
}
__device__ __forceinline__ void qm_prep_phase(const Frame& F, const float* raw, const float* g, bf16r* dst) {
    const int gw = F.vcu * NWAVES + F.wave, NGW = F.G * NWAVES, lane = F.lane;
    for (int m = gw; m < M; m += NGW) { const int b = m >> 12, s = m & 4095; const float* r = raw + (size_t)m * 512;
        float x1[4], x2[4];
#pragma unroll
        for (int h = 0; h < 4; ++h) { x1[h] = r[h * 128 + lane]; x2[h] = r[h * 128 + 64 + lane]; }
#pragma unroll
        for (int h = 0; h < 4; ++h) head_norm_store(x1[h], x2[h], g, nullptr, nullptr, dst + ((size_t)(b * 4 + h) * SEQ + s) * 128, lane);
    }
}
__device__ __forceinline__ void mem_prep_phase(const Frame& F, const float* raw, const float* gk  , bf16r* mk, bf16r* mv) {
    const int gw = F.vcu * NWAVES + F.wave, NGW = F.G * NWAVES, lane = F.lane;
    for (int r = gw; r < 4096; r += NGW) { const int l = r >> 10, b = (r >> 8) & 3, mm = r & 255; const float* p = raw + (size_t)r * 1024;
#pragma unroll
        for (int h = 0; h < 4; ++h) { const size_t o = ((size_t)((l * 4 + b) * 4 + h) * 256 + mm) * 128;
            head_norm_store(p[h * 128 + lane], p[h * 128 + 64 + lane], gk + l * 128, nullptr, nullptr, mk + o, lane);
            mv[o + lane] = (bf16r)f2bf(p[512 + h * 128 + lane]); mv[o + 64 + lane] = (bf16r)f2bf(p[512 + h * 128 + 64 + lane]); }
    }
}
__device__ __forceinline__ void combine_phase(const Frame& F, const float* oatt, const float* lamp  , const float* subg  , float lam_init, bf16r* cat) {
    const int gw = F.vcu * NWAVES + F.wave, NGW = F.G * NWAVES, lane = F.lane;
    const float d01 = wave_sum(lamp[lane] * lamp[128 + lane] + lamp[64 + lane] * lamp[192 + lane]);
    const float d23 = wave_sum(lamp[256 + lane] * lamp[384 + lane] + lamp[320 + lane] * lamp[448 + lane]);
    const float lam = expf(d01) - expf(d23) + lam_init;
    const int half = lane >> 5, d4 = (lane & 31) * 4; const f32x4 g = *(const f32x4*)(subg + half * 128 + d4); const float post = 1.0f - lam_init;
    for (int it = gw; it < M * DH; it += NGW) { const int m = it / DH, h = it % DH, b = m >> 12, s = m & 4095;
        const size_t vh0 = (size_t)((b * 6 + h) * 2 + 0) * 2 + half, vh1 = (size_t)((b * 6 + h) * 2 + 1) * 2 + half;
        const f32x4 o0 = *(const f32x4*)(oatt + (vh0 * SEQ + s) * 128 + d4), o1 = *(const f32x4*)(oatt + (vh1 * SEQ + s) * 128 + d4);
        const f32x4 o = o0 - o1 * lam;
        const float ss = wave_sum((o[0] * o[0] + o[1] * o[1]) + (o[2] * o[2] + o[3] * o[3])); const float rstd = 1.0f / sqrtf(ss * (1.0f / DV) + EPS);
        v2u w; w.x = pk2(o[0] * rstd * g[0] * post, o[1] * rstd * g[1] * post); w.y = pk2(o[2] * rstd * g[2] * post, o[3] * rstd * g[3] * post);
        *(v2u*)(cat + (size_t)m * DM + h * 256 + half * 128 + d4) = w;
    }
}

constexpr int GM_WL = 0, GM_WLS = 272, GM_VT = 128 * GM_WLS, GM_VTS = 272, GM_RS = GM_VT + 256 * GM_VTS;
static_assert(GM_RS + 512 <= RING_BYTES, "gmlp LDS");
__device__ __forceinline__ void gmlp_phase(const Frame& F, const bf16r* ZA, const float* vstat, const float* w_s  , const float* b_s  , const float* gv  , bf16r* cat) {
    const int tid = F.tid, lane = F.lane, wave = F.wave, fr = lane & 15, fq = lane >> 4;
    LAS unsigned char* lds = F.lds;
    LAS float* rs = (LAS float*)(lds + GM_RS);
    for (int unit = F.vcu; unit < 128 * GG; unit += F.G) {
        const int bc = unit / GG, g = unit % GG, r0 = bc * 128;
        if (tid < 128) { const f32x4* p = (const f32x4*)(vstat + (size_t)(r0 + tid) * 24); float s = 0.f;
#pragma unroll
            for (int i = 0; i < 6; ++i) { const f32x4 v = p[i]; s += (v[0] + v[1]) + (v[2] + v[3]); }
            rs[tid] = 1.0f / sqrtf(s * (1.0f / MIXW) + EPS); }
        { const int s = tid & 127, cb = (tid >> 7) * 8;
#pragma unroll
          for (int it = 0; it < 8; ++it) { const int d8 = (cb + it) * 8; const bf16x8 v = *(const bf16x8*)(ZA + (size_t)(r0 + s) * 3072 + 1536 + g * 256 + d8);
#pragma unroll
              for (int e = 0; e < 8; ++e) *(LAS unsigned short*)(lds + GM_VT + (d8 + e) * GM_VTS + s * 2) = (unsigned short)v[e]; } }
        __syncthreads();
        for (int idx = tid; idx < 128 * 32; idx += 512) { const int t = idx >> 5, s4 = (idx & 31) * 4; const f32x4 w = *(const f32x4*)(w_s + ((size_t)g * 128 + t) * 128 + s4);
            float e[4];
#pragma unroll
            for (int j = 0; j < 4; ++j) e[j] = (s4 + j <= t) ? w[j] * rs[s4 + j] : 0.f;
            v2u o; o.x = pk2(e[0], e[1]); o.y = pk2(e[2], e[3]); *(LAS v2u*)(lds + GM_WL + t * GM_WLS + s4 * 2) = o; }
        __syncthreads();
        f32x4 acc[8][2];
#pragma unroll
        for (int tt = 0; tt < 8; ++tt) { acc[tt][0] = (f32x4){0.f, 0.f, 0.f, 0.f}; acc[tt][1] = (f32x4){0.f, 0.f, 0.f, 0.f}; }
#pragma unroll
        for (int ks = 0; ks < 4; ++ks) {
            bf16x8 bfr[2];
#pragma unroll
            for (int dd = 0; dd < 2; ++dd) bfr[dd] = *(const LAS bf16x8*)(lds + GM_VT + (32 * wave + 16 * dd + fr) * GM_VTS + (32 * ks + 8 * fq) * 2);
#pragma unroll
            for (int tt = 0; tt < 8; ++tt) { if (32 * ks <= 16 * tt + 15) {
                const bf16x8 afr = *(const LAS bf16x8*)(lds + GM_WL + (16 * tt + fr) * GM_WLS + (32 * ks + 8 * fq) * 2);
#pragma unroll
                for (int dd = 0; dd < 2; ++dd) acc[tt][dd] = __builtin_amdgcn_mfma_f32_16x16x32_bf16(bfr[dd], afr, acc[tt][dd], 0, 0, 0); } }
        }
#pragma unroll
        for (int tt = 0; tt < 8; ++tt) { const int t = 16 * tt + fr, row = r0 + t; const float bias = b_s[g * 128 + t];
#pragma unroll
            for (int dd = 0; dd < 2; ++dd) { const int d = 32 * wave + 16 * dd + 4 * fq; const f32x4 gg = *(const f32x4*)(gv + g * 256 + d);
                const v2u uu = *(const v2u*)(ZA + (size_t)row * 3072 + g * 256 + d);
                const float u0 = bf2f((unsigned short)(uu.x & 0xffff)), u1 = bf2f((unsigned short)(uu.x >> 16)), u2 = bf2f((unsigned short)(uu.y & 0xffff)), u3 = bf2f((unsigned short)(uu.y >> 16));
                const f32x4 a = acc[tt][dd]; v2u o; o.x = pk2(u0 * (a[0] * gg[0] + bias), u1 * (a[1] * gg[1] + bias)); o.y = pk2(u2 * (a[2] * gg[2] + bias), u3 * (a[3] * gg[3] + bias));
                *(v2u*)(cat + (size_t)row * DM + g * 256 + d) = o; } }
        __syncthreads();
    }
}
namespace att {
__device__ __forceinline__ BlockRef<bf16, float> diff_ref(int L, int pass, const bf16* Q, const bf16* K, const bf16* V, float* O) {
    const int vh = L >> 3, x = L & 7, qb = pass ? 15 - x : x;
    const int b = vh / 24, r = vh % 24, h = r >> 2, c = (r >> 1) & 1, half = r & 1;
    BlockRef<bf16, float> R;
    R.Q = Q + ((size_t)((b * 2 + c) * 6 + h) * SEQ + (size_t)qb * QB) * D; R.K = K + (size_t)((b * 2 + c) * 6 + h) * SEQ * D; R.V = V + (size_t)((b * 6 + h) * 2 + half) * SEQ * D;
    R.O = O + ((size_t)vh * SEQ + (size_t)qb * QB) * D; R.P0 = qb * QB; R.ldo = D;
    return R;
}
__device__ __forceinline__ void diff_attn_phase(char* lds, const bf16* Q, const bf16* K, const bf16* V, float* O, int G, int c0) {
    constexpr int total = 96 * 8; const int W = 1 << 30;
    int L = c0; if (L >= total) return;
    int pass = 0; BlockRef<bf16, float> cur = diff_ref(L, 0, Q, K, V, O);
    Seam<bf16> S;
    causal_swa_prime<bf16, float>(cur, W, lds, S);
    for (;;) {
        const bool more_pass = pass == 0, more_item = L + G < total, last = !more_pass && !more_item;
        int passn = pass + 1, Ln = L;
        if (!more_pass) { passn = 0; Ln = more_item ? L + G : L; }
        const BlockRef<bf16, float> nxt = last ? cur : diff_ref(Ln, passn, Q, K, V, O);
        causal_swa_block<bf16, float>(cur, nxt, SEQ, W, lds, S);
        if (last) break;
        cur = nxt; pass = passn; L = Ln;
    }
}
__device__ __forceinline__ BlockRef<bf16, bf16> mem_ref(int L, const bf16* Q, const bf16* K, const bf16* V, bf16* cat) {
    const int bh = L >> 4, qb = L & 15, b = bh >> 2, hm = bh & 3;
    BlockRef<bf16, bf16> R;
    R.Q = Q + ((size_t)bh * SEQ + (size_t)qb * QB) * D; R.K = K + (size_t)bh * MEML * D; R.V = V + (size_t)bh * MEML * D;
    R.O = cat + ((size_t)b * SEQ + (size_t)qb * QB) * DM + 1536 + hm * 128; R.P0 = 256; R.ldo = DM;
    return R;
}
__device__ __forceinline__ void mem_attn_phase(char* lds, const bf16* Q, const bf16* K, const bf16* V, bf16* cat, int G, int c0) {
    constexpr int total = 256; const int W = 1 << 30;
    int L = c0; if (L >= total) return;
    BlockRef<bf16, bf16> cur = mem_ref(L, Q, K, V, cat);
    Seam<bf16> S;
    causal_swa_prime<bf16, bf16>(cur, W, lds, S);
    for (;;) {
        const bool last = L + G >= total;
        const BlockRef<bf16, bf16> nxt = last ? cur : mem_ref(L + G, Q, K, V, cat);
        causal_swa_block<bf16, bf16>(cur, nxt, MEML, W, lds, S);
        if (last) break;
        cur = nxt; L += G;
    }
}
}

constexpr int NPL = 12, PH_BASE = 3, NPH = PH_BASE + DEPTH * NPL;
enum { I_X = 0, I_MEM, I_NORMG, I_WGU, I_WDN, I_WOUT, I_MEMNG, I_MEMWKV, I_MEMQG, I_MEMKG, I_AWIN, I_AVG, I_AWS, I_ABS, I_KVG, I_WKV, I_KG, I_BWIN, I_BQG, I_BLAM, I_BSUBG, N_IN };
struct Args { const float* in[N_IN]; float* out; unsigned char* ws; int ph_lo, ph_hi, li, pad; };

#ifndef EN_MASK
#define EN_MASK 0xFFFFFFFFu
#endif
#define SITE(n) (((EN_MASK) >> (n)) & 1u)
#define IN(k) (lo <= (k) && (k) < hi)
#define SEAM(k) do { if (IN((k) + 1)) xcd_barrier(bar); } while (0)
#define CAS __attribute__((address_space(4)))
#define WS_PTRS \
    const CAS Args* ap = (const CAS Args*)__builtin_amdgcn_kernarg_segment_ptr(); asm volatile("" : "+s"(ap)); \
    unsigned char* const ws = ap->ws; \
    bf16r* const Wgu = (bf16r*)(ws + WS_WGU); bf16r* const Wdn = (bf16r*)(ws + WS_WDN); bf16r* const Wout = (bf16r*)(ws + WS_WOUT); bf16r* const Wmem = (bf16r*)(ws + WS_WMEM); \
    bf16r* const Wain = (bf16r*)(ws + WS_WAIN); bf16r* const Wkv = (bf16r*)(ws + WS_WKV); bf16r* const Wbin = (bf16r*)(ws + WS_WBIN); \
    float* const cosT = (float*)(ws + WS_COS); float* const sinT = (float*)(ws + WS_SIN); \
    bf16r* const MEMN = (bf16r*)(ws + WS_MEMN); float* const MKVR = (float*)(ws + WS_MKVR); bf16r* const MK = (bf16r*)(ws + WS_MK); bf16r* const MV = (bf16r*)(ws + WS_MV); \
    bf16r* const HN = (bf16r*)(ws + WS_HN); bf16r* const HKV = (bf16r*)(ws + WS_HKV); bf16r* const HID = (bf16r*)(ws + WS_HID); bf16r* const ZA = (bf16r*)(ws + WS_ZA); \
    float* const VSTAT = (float*)(ws + WS_VSTAT); float* const QMRAW = (float*)(ws + WS_QMRAW); float* const QRAW = (float*)(ws + WS_QRAW); \
    bf16r* const QB_ = (bf16r*)(ws + WS_QB); bf16r* const KSH = (bf16r*)(ws + WS_KSH); bf16r* const VSH = (bf16r*)(ws + WS_VSH); bf16r* const QMB = (bf16r*)(ws + WS_QMB); \
    float* const OATT = (float*)(ws + WS_OATT); bf16r* const CAT = (bf16r*)(ws + WS_CAT); \
    float* const X = ap->out; \
    (void)Wgu; (void)Wdn; (void)Wout; (void)Wmem; (void)Wain; (void)Wkv; (void)Wbin; (void)cosT; (void)sinT; (void)MEMN; (void)MKVR; (void)MK; (void)MV; (void)HN; (void)HKV; (void)HID; (void)ZA; \
    (void)VSTAT; (void)QMRAW; (void)QRAW; (void)QB_; (void)KSH; (void)VSH; (void)QMB; (void)OATT; (void)CAT; (void)X;

template <int L, int S>
__device__ __forceinline__ void ffn_part(const Frame& F, const XcdBarrier& bar, unsigned char* smem, const int lo, const int hi) {
    constexpr int pf = PH_BASE + L * NPL + (S ? 9 : 0);
    if (SITE(3) && IN(pf)) { WS_PTRS
        pg8::Gemm g{HN, Wgu + (size_t)(L * 2 + S) * NGU * DM, M, NGU, DM}; pg8::StaticOrder So; So.init(M, NGU, F.G, (int)blockIdx.x);
        pg8::EpiSwiglu E{HID, FF};
        pg8::gemm_phase<pg8::EpiSwiglu, pg8::StaticOrder, true, true>(F.lds + RING_OFF, g, So, E);
        if constexpr (L == NA && S == 0) {
            pg8::Gemm g2{HKV, Wkv, M, NKV, DM}; pg8::StaticOrder S2; S2.init(M, NKV, F.G, (int)blockIdx.x);
            pg8::EpiKv E2{QRAW, VSH};
            pg8::gemm_phase<pg8::EpiKv, pg8::StaticOrder, true, true>(F.lds + RING_OFF, g2, S2, E2);
        }
        SEAM(pf);
    }
    if (SITE(4) && IN(pf + 1)) { WS_PTRS
        pg8::Gemm g{HID, Wdn + (size_t)(L * 2 + S) * DM * FF, M, DM, FF}; pg8::StaticOrder So; So.init(M, DM, F.G, (int)blockIdx.x);
        pg8::EpiResid E{(L == 0 && S == 0) ? ap->in[I_X] : X, X, DM, 0.5f};
        pg8::gemm_phase<pg8::EpiResid, pg8::StaticOrder, true, true>(F.lds + RING_OFF, g, So, E);
        SEAM(pf + 1);
    }
    if (SITE(5) && IN(pf + 2)) { WS_PTRS
        if constexpr (S == 0) { norm_phase(F, X, ap->in[I_NORMG] + (size_t)(L * 3 + 1) * DM, HN, nullptr, nullptr);
            if constexpr (L == NA) qk_prep_phase(F, QRAW, ap->in[I_KG], cosT, sinT, KSH); }
        else if constexpr (L + 1 < DEPTH) norm_phase(F, X, ap->in[I_NORMG] + (size_t)((L + 1) * 3) * DM, HN, (L + 1 == NA) ? ap->in[I_KVG] : nullptr, HKV);
        SEAM(pf + 2);
    }
}
template <int L>
__device__ __forceinline__ void mixer_part(const Frame& F, const XcdBarrier& bar, unsigned char* smem, const int lo, const int hi) {
    constexpr int pb = PH_BASE + L * NPL;
    if (SITE(6) && IN(pb + 3)) { WS_PTRS
        if constexpr (L < NA) { pg8::Gemm g{HN, Wain + (size_t)L * NAIN * DM, M, NAIN, DM}; pg8::StaticOrder So; So.init(M, NAIN, F.G, (int)blockIdx.x);
            pg8::EpiAin E{ZA, VSTAT, QMRAW};
            pg8::gemm_phase<pg8::EpiAin, pg8::StaticOrder, true, true>(F.lds + RING_OFF, g, So, E); }
        else { pg8::Gemm g{HN, Wbin + (size_t)(L - NA) * NBIN * DM, M, NBIN, DM}; pg8::StaticOrder So; So.init(M, NBIN, F.G, (int)blockIdx.x);
            pg8::EpiF32Split E{QRAW, 1536, 6, QMRAW, 512, 0};
            pg8::gemm_phase<pg8::EpiF32Split, pg8::StaticOrder, true, true>(F.lds + RING_OFF, g, So, E); }
        SEAM(pb + 3);
    }
    if (SITE(7) && IN(pb + 4)) { WS_PTRS
        qm_prep_phase(F, QMRAW, ap->in[I_MEMQG] + L * HD, QMB);
        if constexpr (L >= NA) qk_prep_phase(F, QRAW, ap->in[I_BQG] + (L - NA) * HD, cosT, sinT, QB_);
        SEAM(pb + 4);
    }
    if (SITE(8) && IN(pb + 5)) { WS_PTRS
        if constexpr (L < NA) gmlp_phase(F, ZA, VSTAT, ap->in[I_AWS] + (size_t)L * GG * 128 * 128, ap->in[I_ABS] + (size_t)L * GG * 128, ap->in[I_AVG] + (size_t)L * MIXW, CAT);
        else att::diff_attn_phase((char*)smem, (const att::bf16*)QB_, (const att::bf16*)KSH, (const att::bf16*)VSH, OATT, F.G, F.vcu);
        att::mem_attn_phase((char*)smem, (const att::bf16*)QMB, (const att::bf16*)(MK + (size_t)L * 1024 * 512), (const att::bf16*)(MV + (size_t)L * 1024 * 512), (att::bf16*)CAT, F.G, F.vcu);
        SEAM(pb + 5);
    }
    if constexpr (L >= NA) {
        if (SITE(9) && IN(pb + 6)) { WS_PTRS constexpr float lam_init = (L == 2) ? 0.47071301834358416f : 0.5560582041556405f;
            combine_phase(F, OATT, ap->in[I_BLAM] + (size_t)(L - NA) * 512, ap->in[I_BSUBG] + (size_t)(L - NA) * DV, lam_init, CAT);
            SEAM(pb + 6); }
    }
    if (SITE(10) && IN(pb + 7)) { WS_PTRS
        pg8::Gemm g{CAT, Wout + (size_t)L * DM * DM, M, DM, DM}; pg8::StaticOrder So; So.init(M, DM, F.G, (int)blockIdx.x);
        pg8::EpiResid E{X, X, DM, 1.0f};
        pg8::gemm_phase<pg8::EpiResid, pg8::StaticOrder, true, true>(F.lds + RING_OFF, g, So, E);
        SEAM(pb + 7);
    }
    if (SITE(11) && IN(pb + 8)) { WS_PTRS norm_phase(F, X, ap->in[I_NORMG] + (size_t)(L * 3 + 2) * DM, HN, nullptr, nullptr); SEAM(pb + 8); }
}

__global__ void __launch_bounds__(NWAVES * 64, 2) yoco_fwd(Args args) {
    extern __shared__ __attribute__((aligned(16))) unsigned char smem[];
    Frame F;
    F.lds_g = smem; F.lds = (LAS unsigned char*)smem;
    F.MISC = (volatile LAS unsigned*)(F.lds + MISC_OFF);
    F.tid = threadIdx.x; F.lane = F.tid & 63; F.wave = __builtin_amdgcn_readfirstlane(F.tid >> 6);
    F.G = gridDim.x; { const int bx = blockIdx.x; F.vcu = (F.G % 8 == 0) ? (bx % 8) * (F.G / 8) + bx / 8 : bx; }
    F.ws = args.ws;
    F.ctl = (gu32*)(args.ws + WS_CTL);
    for (int u = F.tid; u < (LDS_BYTES - LDSCTL_OFF) / 4; u += NWAVES * 64) ((LAS unsigned*)(F.lds + LDSCTL_OFF))[u] = 0u;
    __syncthreads();
    XcdBarrier bar = xcd_barrier_post((unsigned*)F.ctl + (size_t)args.li * XCD_BAR_WORDS, F.MISC + 8);
    const int lo = args.ph_lo, hi = args.ph_hi;
    {
    const int gw = F.vcu * NWAVES + F.wave, NGW = F.G * NWAVES;
    if (SITE(0) && IN(0)) { WS_PTRS
        LAS float* scr = (LAS float*)(F.lds + RING_OFF + F.wave * 16640);
        constexpr int NIT = 8 * (DM / 64) * (NGU / 64) + 8 * (FF / 64) * (DM / 64) + 4 * 32 * 32 + 4 * 32 * 16 + 2 * 32 * (NAIN / 64) + 32 * (NKV / 64) + 2 * 32 * 32;
        for (int it = gw; it < NIT; it += NGW) { int r = it;
            if (transpose_group(r, ap->in[I_WGU], 8, DM, NGU, Wgu, true, scr, F.lane)) continue;
            if (transpose_group(r, ap->in[I_WDN], 8, FF, DM, Wdn, false, scr, F.lane)) continue;
            if (transpose_group(r, ap->in[I_WOUT], 4, DM, DM, Wout, false, scr, F.lane)) continue;
            if (transpose_group(r, ap->in[I_MEMWKV], 4, DM, 1024, Wmem, false, scr, F.lane)) continue;
            if (transpose_group(r, ap->in[I_AWIN], 2, DM, NAIN, Wain, false, scr, F.lane)) continue;
            if (transpose_group(r, ap->in[I_WKV], 1, DM, NKV, Wkv, false, scr, F.lane)) continue;
            transpose_group(r, ap->in[I_BWIN], 2, DM, NBIN, Wbin, false, scr, F.lane); }
        for (int i = gw * 64 + F.lane; i < SEQ * 64; i += NGW * 64) { const int pos = i >> 6, k = i & 63; const float inv = (float)pow(10000.0, -(double)k / 64.0); const float ang = (float)pos * inv;
            float sn, cs; sincos_d(ang, sn, cs); cosT[i] = cs; sinT[i] = sn; }
        for (int r = gw; r < 4096; r += NGW) { const int l = r >> 10, mm = r & 1023; norm_row(ap->in[I_MEM] + (size_t)mm * DM, ap->in[I_MEMNG] + l * DM, MEMN + (size_t)r * DM, F.lane); }
        norm_phase(F, ap->in[I_X], ap->in[I_NORMG], HN, nullptr, nullptr);
        SEAM(0);
    }
    if (SITE(1) && IN(1)) { WS_PTRS
        pg8::Gemm g{MEMN, Wmem, 4096, 4096, DM}; pg8::MemKvOrder So{F.G, (int)blockIdx.x};
        pg8::EpiF32Split E{MKVR, 1024, 4, MKVR, 1024, 4};
        pg8::gemm_phase<pg8::EpiF32Split, pg8::MemKvOrder, true, true>(F.lds + RING_OFF, g, So, E);
        SEAM(1);
    }
    if (SITE(2) && IN(2)) { WS_PTRS mem_prep_phase(F, MKVR, ap->in[I_MEMKG], MK, MV); SEAM(2); }
    }
    ffn_part<0, 0>(F, bar, smem, lo, hi); mixer_part<0>(F, bar, smem, lo, hi); ffn_part<0, 1>(F, bar, smem, lo, hi);
    ffn_part<1, 0>(F, bar, smem, lo, hi); mixer_part<1>(F, bar, smem, lo, hi); ffn_part<1, 1>(F, bar, smem, lo, hi);
    ffn_part<2, 0>(F, bar, smem, lo, hi); mixer_part<2>(F, bar, smem, lo, hi); ffn_part<2, 1>(F, bar, smem, lo, hi);
    ffn_part<3, 0>(F, bar, smem, lo, hi); mixer_part<3>(F, bar, smem, lo, hi); ffn_part<3, 1>(F, bar, smem, lo, hi);
}
#undef IN
#undef SEAM

#ifndef MK_MODE
#define MK_MODE 0
#endif
extern "C" void kernel_launch(void* const* d_in, const int* in_sizes, int n_in, void* d_out, int out_size, void* d_ws, size_t ws_size, hipStream_t stream) {
    static int grid = 0;
    if (grid == 0) {
        if (n_in != N_IN || out_size != M * DM || ws_size < WS_END) { fprintf(stderr, "kernel_launch: unexpected shapes: n_in %d out %d ws %zu (need %zu)\n", n_in, out_size, ws_size, (size_t)WS_END); grid = -1; return; }
        int dev = 0, cus = 0, per_cu = 0;
        if (hipGetDevice(&dev) != hipSuccess || hipDeviceGetAttribute(&cus, hipDeviceAttributeMultiprocessorCount, dev) != hipSuccess) { grid = -1; return; }
        if (hipFuncSetAttribute((const void*)yoco_fwd, hipFuncAttributeMaxDynamicSharedMemorySize, LDS_BYTES) != hipSuccess) { fprintf(stderr, "kernel_launch: hipFuncSetAttribute failed\n"); grid = -1; return; }
        if (hipOccupancyMaxActiveBlocksPerMultiprocessor(&per_cu, (const void*)yoco_fwd, NWAVES * 64, LDS_BYTES) != hipSuccess || per_cu < 1) fprintf(stderr, "kernel_launch: occupancy query says %d blocks per CU\n", per_cu);
        (void)hipGetLastError();
        grid = cus;
    }
    if (grid < 0) return;
    (void)in_sizes;
    if (hipMemsetAsync((char*)d_ws + WS_CTL, 0, CTL_ZERO_BYTES, stream) != hipSuccess) return;
    Args a{};
    for (int i = 0; i < N_IN; ++i) a.in[i] = (const float*)d_in[i];
    a.out = (float*)d_out; a.ws = (unsigned char*)d_ws; a.pad = 0;
#if MK_MODE == 1
    a.ph_lo = 0; a.ph_hi = NPH; a.li = 0;
    hipLaunchKernelGGL(yoco_fwd, dim3(grid), dim3(NWAVES * 64), LDS_BYTES, stream, a);
#else
    for (int p = 0; p < NPH; ++p) {
        const int k = (p - PH_BASE) % NPL, l = (p - PH_BASE) / NPL;
        if (p >= PH_BASE && ((k == 6 && l < NA) || (k == 11 && l == DEPTH - 1))) continue;
        a.ph_lo = p; a.ph_hi = p + 1; a.li = 0;
        hipLaunchKernelGGL(yoco_fwd, dim3(grid), dim3(NWAVES * 64), LDS_BYTES, stream, a);
    }
#endif
}
```

```cpp
#include <hip/hip_runtime.h>
#include <hip/hip_bf16.h>
#include <cstdio>
#include <cstdint>

constexpr int BATCH = 4, SEQ = 4096, DM = 2048, DEPTH = 4, NA = 2;
constexpr int M = BATCH * SEQ;
constexpr int MEML = 256, HD = 128, MEMH = 4, MEMW = 512, MIXW = 1536, CHUNK = 128, GG = 6, GW = 256, DH = 6, DV = 256, FF = 5632;
constexpr int NGU = 2 * FF;
constexpr int NAIN = 2 * MIXW + MEMW;
constexpr int NBIN = MIXW + MEMW;
constexpr int NKV = 2 * DH * HD + DH * DV;
constexpr float EPS = 1e-6f;
namespace pg8 {
#define PG8_LAS __attribute__((address_space(3)))
typedef unsigned short bf16_t;
typedef short bf16x8 __attribute__((ext_vector_type(8)));
typedef float f32x4 __attribute__((ext_vector_type(4)));
typedef unsigned u32x4 __attribute__((ext_vector_type(4)));
constexpr int BM = 256, BK = 64, HALF = 128, HTB = HALF * BK * 2  , STAGE_BYTES = 8 * HTB, NXCD = 8, WGM = 8;

__host__ __device__ __forceinline__ int lds_byte(int r, int c) { const int st = (r >> 4) * 2 + (c >> 5), rr = r & 15, cc = c & 31, ob = rr * 64 + cc * 2; return st * 1024 + (ob ^ (((ob >> 9) & 1) << 5)); }
__host__ __device__ __forceinline__ void stage_rc(int b, int& R, int& C) { const int st = b / 1024, sb = b % 1024, swz = sb ^ (((sb >> 9) & 1) << 5); R = (st >> 1) * 16 + swz / 64; C = (st & 1) * 32 + (swz % 64) / 2; }
__host__ __device__ __forceinline__ int perm32(int rho) { const int n = rho >> 4, i = rho & 15; return 8 * (i >> 2) + 4 * n + (i & 3); }

struct Unit { int pm, pn; };
struct Gemm { const bf16_t* A; const bf16_t* Bt; int M, N, K; };

struct StaticOrder {
    int nM, nN, nwg, G, c;
    __host__ __device__ void init(int M, int N, int G_, int c_) { nM = M / BM; nN = N / BM; nwg = nM * nN; G = G_; c = c_; }
    __host__ __device__ bool next(int i, Unit& u) const {
        const long L = (long)i * G + c; if (L >= nwg) return false;
        int wgid = (int)L; { const int q = nwg / NXCD, r = nwg % NXCD, xcd = wgid % NXCD, off = wgid / NXCD; wgid = (xcd < r ? xcd * (q + 1) : r * (q + 1) + (xcd - r) * q) + off; }
        const int nig = WGM * nN, gid = wgid / nig, fm = gid * WGM, gsz = (nM - fm) < WGM ? (nM - fm) : WGM;
        u.pm = fm + ((wgid % nig) % gsz); u.pn = (wgid % nig) / gsz; return true;
    }
    __device__ __forceinline__ void a_ready(const Unit&) const {}
    __device__ __forceinline__ void done(const Unit&) const {}
};
__device__ __forceinline__ unsigned cvt_pk_bf16(float lo, float hi) { unsigned r; asm volatile("v_cvt_pk_bf16_f32 %0, %1, %2" : "=v"(r) : "v"(lo), "v"(hi)); return r; }
typedef float f32x2 __attribute__((ext_vector_type(2)));
__device__ __forceinline__ f32x2 gelu_pk(f32x2 v) {
    const f32x2 av = __builtin_elementwise_abs(v), d = av * 0.2316418882f + 1.0f;
    f32x2 t; t.x = __builtin_amdgcn_rcpf(d.x); t.y = __builtin_amdgcn_rcpf(d.y);
    f32x2 q = t * 0.5307027145f + (-0.7265760135f); q = q * t + 0.7107068705f; q = q * t + (-0.142248368f); q = q * t + 0.127414796f; q = q * t;
    const f32x2 s = (v * v) * (-0.72134752044f);
    f32x2 e; e.x = __builtin_amdgcn_exp2f(s.x); e.y = __builtin_amdgcn_exp2f(s.y);
    const f32x2 m = v * (q * e), r = v - m;
    f32x2 o; o.x = v.x < 0.f ? m.x : r.x; o.y = v.y < 0.f ? m.y : r.y; return o;
}
__device__ __forceinline__ float silu_f(float g) { return g * __builtin_amdgcn_rcpf(1.0f + __builtin_amdgcn_exp2f(-1.4426950408889634f * g)); }
__device__ __forceinline__ u32x4 pack8_bf16(f32x4 a, f32x4 b) { u32x4 w; w.x = cvt_pk_bf16(a[0], a[1]); w.y = cvt_pk_bf16(a[2], a[3]); w.z = cvt_pk_bf16(b[0], b[1]); w.w = cvt_pk_bf16(b[2], b[3]); return w; }

struct EpiSwiglu {
    static constexpr bool PERM = true, AFTER_DRAIN = false;
    bf16_t* H; int ldh;
    __device__ __forceinline__ void operator()(const f32x4 (&acc)[2][2][4][2], const Unit& u, int wr, int wc, int fr, int fq) const {
        const int row0 = u.pm * BM + wr * 64 + fr, col0 = u.pn * HALF + wc * 32 + 8 * fq;
#pragma unroll
        for (int ai = 0; ai < 2; ++ai)
#pragma unroll
            for (int m = 0; m < 4; ++m) {
                const f32x4 g0 = acc[ai][0][m][0], g1 = acc[ai][0][m][1], u0 = acc[ai][1][m][0], u1 = acc[ai][1][m][1];
                f32x4 h0, h1;
#pragma unroll
                for (int j = 0; j < 4; ++j) { h0[j] = silu_f(g0[j]) * u0[j]; h1[j] = silu_f(g1[j]) * u1[j]; }
                *(u32x4*)(H + (size_t)(row0 + ai * HALF + m * 16) * ldh + col0) = pack8_bf16(h0, h1);
            }
    }
};
struct EpiResid {
    static constexpr bool PERM = false, AFTER_DRAIN = false;
    const float* base; float* out; int ld; float scale;
    __device__ __forceinline__ void operator()(const f32x4 (&acc)[2][2][4][2], const Unit& u, int wr, int wc, int fr, int fq) const {
        const int row0 = u.pm * BM + wr * 64 + fr, col0 = u.pn * BM + wc * 32 + 4 * fq;
#pragma unroll
        for (int ai = 0; ai < 2; ++ai)
#pragma unroll
            for (int m = 0; m < 4; ++m) { const size_t off = (size_t)(row0 + ai * HALF + m * 16) * ld + col0;
#pragma unroll
                for (int bj = 0; bj < 2; ++bj)
#pragma unroll
                    for (int n = 0; n < 2; ++n) { const f32x4 b = *(const f32x4*)(base + off + bj * HALF + n * 16); *(f32x4*)(out + off + bj * HALF + n * 16) = b + acc[ai][bj][m][n] * scale; }
                asm volatile("" ::: "memory"); }
    }
};
struct EpiAin {
    static constexpr bool PERM = true, AFTER_DRAIN = false;
    bf16_t* ZA; float* vstat; float* qm;
    __device__ __forceinline__ void operator()(const f32x4 (&acc)[2][2][4][2], const Unit& u, int wr, int wc, int fr, int fq) const {
        const int row0 = u.pm * BM + wr * 64 + fr;
        if (u.pn < 12) {
            const int col0 = u.pn * BM + wc * 32 + 8 * fq; const bool st = u.pn >= 6;
#pragma unroll
            for (int ai = 0; ai < 2; ++ai)
#pragma unroll
                for (int m = 0; m < 4; ++m) { const int row = row0 + ai * HALF + m * 16; float ss = 0.f;
#pragma unroll
                    for (int bj = 0; bj < 2; ++bj) { f32x4 v0 = acc[ai][bj][m][0], v1 = acc[ai][bj][m][1];
                        f32x2 a = gelu_pk((f32x2){v0[0], v0[1]}), b = gelu_pk((f32x2){v0[2], v0[3]}), c = gelu_pk((f32x2){v1[0], v1[1]}), d = gelu_pk((f32x2){v1[2], v1[3]});
                        v0 = (f32x4){a.x, a.y, b.x, b.y}; v1 = (f32x4){c.x, c.y, d.x, d.y};
                        ss += (v0[0] * v0[0] + v0[1] * v0[1]) + (v0[2] * v0[2] + v0[3] * v0[3]) + (v1[0] * v1[0] + v1[1] * v1[1]) + (v1[2] * v1[2] + v1[3] * v1[3]);
                        *(u32x4*)(ZA + (size_t)row * 3072 + col0 + bj * HALF) = pack8_bf16(v0, v1); }
                    if (st) { ss += __shfl_xor(ss, 16); ss += __shfl_xor(ss, 32); if (fq == 0) vstat[(size_t)row * 24 + (u.pn - 6) * 4 + wc] = ss; } }
        } else {
            const int col0 = (u.pn - 12) * BM + wc * 32 + 8 * fq;
#pragma unroll
            for (int ai = 0; ai < 2; ++ai)
#pragma unroll
                for (int m = 0; m < 4; ++m) { float* p = qm + (size_t)(row0 + ai * HALF + m * 16) * 512 + col0;
#pragma unroll
                    for (int bj = 0; bj < 2; ++bj) { *(f32x4*)(p + bj * HALF) = acc[ai][bj][m][0]; *(f32x4*)(p + bj * HALF + 4) = acc[ai][bj][m][1]; } }
        }
    }
};
struct EpiF32Split {
    static constexpr bool PERM = true, AFTER_DRAIN = false;
    float* d0; int ld0; int split; float* d1; int ld1; int pnmod;
    __device__ __forceinline__ void operator()(const f32x4 (&acc)[2][2][4][2], const Unit& u, int wr, int wc, int fr, int fq) const {
        const int row0 = u.pm * BM + wr * 64 + fr; int pn = pnmod ? (u.pn % pnmod) : u.pn; float* d = d0; int ld = ld0;
        if (pn >= split) { d = d1; ld = ld1; pn -= split; }
        const int col0 = pn * BM + wc * 32 + 8 * fq;
#pragma unroll
        for (int ai = 0; ai < 2; ++ai)
#pragma unroll
            for (int m = 0; m < 4; ++m) { float* p = d + (size_t)(row0 + ai * HALF + m * 16) * ld + col0;
#pragma unroll
                for (int bj = 0; bj < 2; ++bj) { *(f32x4*)(p + bj * HALF) = acc[ai][bj][m][0]; *(f32x4*)(p + bj * HALF + 4) = acc[ai][bj][m][1]; } }
    }
};
struct EpiKv {
    static constexpr bool PERM = true, AFTER_DRAIN = false;
    float* kraw; bf16_t* vsh;
    __device__ __forceinline__ void operator()(const f32x4 (&acc)[2][2][4][2], const Unit& u, int wr, int wc, int fr, int fq) const {
        const int row0 = u.pm * BM + wr * 64 + fr;
        if (u.pn < 6) {
            const int col0 = u.pn * BM + wc * 32 + 8 * fq;
#pragma unroll
            for (int ai = 0; ai < 2; ++ai)
#pragma unroll
                for (int m = 0; m < 4; ++m) { float* p = kraw + (size_t)(row0 + ai * HALF + m * 16) * 1536 + col0;
#pragma unroll
                    for (int bj = 0; bj < 2; ++bj) { *(f32x4*)(p + bj * HALF) = acc[ai][bj][m][0]; *(f32x4*)(p + bj * HALF + 4) = acc[ai][bj][m][1]; } }
        } else {
            const int h = u.pn - 6;
#pragma unroll
            for (int ai = 0; ai < 2; ++ai)
#pragma unroll
                for (int m = 0; m < 4; ++m) { const int row = row0 + ai * HALF + m * 16, b = row >> 12, s = row & 4095;
#pragma unroll
                    for (int bj = 0; bj < 2; ++bj) *(u32x4*)(vsh + ((size_t)((b * 6 + h) * 2 + bj) * 4096 + s) * 128 + wc * 32 + 8 * fq) = pack8_bf16(acc[ai][bj][m][0], acc[ai][bj][m][1]); }
        }
    }
};
struct MemKvOrder {
    int G, c;
    __device__ bool next(int i, Unit& u) const { const int L = i * G + c; if (L >= 64) return false; const int layer = L >> 4, r = L & 15; u.pm = layer * 4 + (r >> 2); u.pn = layer * 4 + (r & 3); return true; }
    __device__ __forceinline__ void a_ready(const Unit&) const {}
    __device__ __forceinline__ void done(const Unit&) const {}
};
template <class Epi, class Sched, bool ALIGN_EPI = false, bool SP2 = false>
__device__ __forceinline__ void gemm_phase(PG8_LAS unsigned char* lds, const Gemm g, const Sched& S, const Epi& E) {
    const int tid = threadIdx.x, wid = __builtin_amdgcn_readfirstlane(tid >> 6), lane = tid & 63, wr = wid >> 2, wc = wid & 3, fr = lane & 15, fq = lane >> 4;
    const int K = g.K, nt = K / BK;
    unsigned voffA[2], voffB[2];
#pragma unroll
    for (int i = 0; i < 2; ++i) { int R, C; stage_rc(tid * 16 + i * 8192, R, C); const int Rb = Epi::PERM ? ((R & ~31) + perm32(R & 31)) : R;
        voffA[i] = (unsigned)(R * K + C) * 2u; voffB[i] = (unsigned)(Rb * K + C) * 2u; }
    const size_t kstep = (size_t)(BK * 2);
    const size_t hstep = (size_t)HALF * K * 2;
    const size_t tstep = 2 * hstep;
    const unsigned ldsw = (unsigned)wid * 1024u;
    const int aoff = lds_byte(wr * 64 + fr, fq * 8), boff = lds_byte(wc * 32 + fr, fq * 8);
#define PG8_SA(b, h) (((b) * 2 + (h)) * HTB)
#define PG8_SB(b, h) ((4 + (b) * 2 + (h)) * HTB)
#define PG8_STAGE(bufoff, gbase, voff) do { _Pragma("unroll") for (int _i = 0; _i < 2; ++_i) \
        __builtin_amdgcn_global_load_lds((const unsigned*)((const char*)(gbase) + (voff)[_i]), (PG8_LAS unsigned*)(lds + (bufoff) + ldsw + _i * 8192), 16, 0, 0); } while (0)
#define PG8_LDA(dst, b, h) do { _Pragma("unroll") for (int m = 0; m < 4; ++m) _Pragma("unroll") for (int k = 0; k < 2; ++k) dst[m][k] = *(const PG8_LAS bf16x8*)(lds + PG8_SA(b, h) + aoff + m * 2048 + k * 1024); } while (0)
#define PG8_LDB(dst, b, h) do { _Pragma("unroll") for (int n = 0; n < 2; ++n) _Pragma("unroll") for (int k = 0; k < 2; ++k) dst[n][k] = *(const PG8_LAS bf16x8*)(lds + PG8_SB(b, h) + boff + n * 2048 + k * 1024); } while (0)
#define PG8_MMA(ai, bj, At, Bt) do { __builtin_amdgcn_s_setprio(1); _Pragma("unroll") for (int m = 0; m < 4; ++m) _Pragma("unroll") for (int n = 0; n < 2; ++n) _Pragma("unroll") for (int k = 0; k < 2; ++k) \
        acc[ai][bj][m][n] = __builtin_amdgcn_mfma_f32_16x16x32_bf16(Bt[n][k], At[m][k], acc[ai][bj][m][n], 0, 0, 0); __builtin_amdgcn_s_setprio(0); } while (0)
#define PG8_WAIT_V(n) asm volatile("s_waitcnt vmcnt(" #n ")" ::: "memory")
#define PG8_WAIT_L(n) asm volatile("s_waitcnt lgkmcnt(" #n ")" ::: "memory")
#define PG8_BAR __builtin_amdgcn_s_barrier()
#define PG8_SCHED __builtin_amdgcn_sched_barrier(0)
    Unit cur, nxt; int ui = 0;
    if (!S.next(0, cur)) return;
    f32x4 acc[2][2][4][2];
#pragma unroll
    for (int a = 0; a < 2; ++a)
#pragma unroll
        for (int b = 0; b < 2; ++b)
#pragma unroll
            for (int m = 0; m < 4; ++m)
#pragma unroll
                for (int n = 0; n < 2; ++n) acc[a][b][m][n] = (f32x4){0.f, 0.f, 0.f, 0.f};
    bf16x8 At[4][2], B0[2][2], B1[2][2];
    const char* cA = (const char*)g.A + (size_t)cur.pm * tstep; const char* cB = (const char*)g.Bt + (size_t)cur.pn * tstep;
    S.a_ready(cur);
    if constexpr (SP2) {
        PG8_STAGE(PG8_SB(0, 0), cB, voffB); PG8_STAGE(PG8_SB(0, 1), cB + hstep, voffB); PG8_STAGE(PG8_SA(0, 0), cA, voffA); PG8_STAGE(PG8_SA(0, 1), cA + hstep, voffA);
        if (wr == 1) PG8_BAR;
        PG8_WAIT_V(2); PG8_BAR;
        PG8_STAGE(PG8_SB(1, 0), cB + kstep, voffB); PG8_STAGE(PG8_SA(1, 0), cA + kstep, voffA); PG8_STAGE(PG8_SB(1, 1), cB + hstep + kstep, voffB);
        PG8_WAIT_V(6); PG8_BAR;
    } else {
        PG8_STAGE(PG8_SB(0, 0), cB, voffB); PG8_STAGE(PG8_SA(0, 0), cA, voffA); PG8_STAGE(PG8_SB(0, 1), cB + hstep, voffB); PG8_STAGE(PG8_SA(0, 1), cA + hstep, voffA);
        if (wr == 1) PG8_BAR;
        PG8_WAIT_V(4); PG8_BAR;
        PG8_STAGE(PG8_SB(1, 0), cB + kstep, voffB); PG8_STAGE(PG8_SA(1, 0), cA + kstep, voffA); PG8_STAGE(PG8_SB(1, 1), cB + hstep + kstep, voffB);
        PG8_WAIT_V(6); PG8_BAR;
    }
    for (;;) {
        const bool has_next = S.next(ui + 1, nxt);
        const char* nA = has_next ? (const char*)g.A + (size_t)nxt.pm * tstep : cA; const char* nB = has_next ? (const char*)g.Bt + (size_t)nxt.pn * tstep : cB;
        for (int t = 0; t < nt; t += 2) {
            const bool last = (t == nt - 2);
            const char* a1 = cA + (size_t)(t + 1) * kstep;
            const char* a2 = last ? nA : cA + (size_t)(t + 2) * kstep; const char* b2 = last ? nB : cB + (size_t)(t + 2) * kstep;
            const char* a3 = a2 + kstep; const char* b3 = b2 + kstep;
            if (last && has_next) S.a_ready(nxt);
            if constexpr (SP2) {
            PG8_LDB(B0, 0, 0); PG8_LDB(B1, 0, 1); PG8_SCHED; PG8_LDA(At, 0, 0); PG8_STAGE(PG8_SA(1, 1), a1 + hstep, voffA);
            PG8_WAIT_V(8); PG8_WAIT_L(0); PG8_BAR; PG8_MMA(0, 0, At, B0); PG8_MMA(0, 1, At, B1); PG8_BAR; PG8_SCHED;
            PG8_LDA(At, 0, 1); PG8_STAGE(PG8_SB(0, 0), b2, voffB); PG8_STAGE(PG8_SB(0, 1), b2 + hstep, voffB); PG8_STAGE(PG8_SA(0, 0), a2, voffA);
            PG8_WAIT_V(8); PG8_WAIT_L(0); PG8_BAR; PG8_MMA(1, 0, At, B0); PG8_MMA(1, 1, At, B1); PG8_BAR; PG8_SCHED;
            PG8_LDB(B0, 1, 0); PG8_LDB(B1, 1, 1); PG8_SCHED; PG8_LDA(At, 1, 0); PG8_STAGE(PG8_SA(0, 1), a2 + hstep, voffA);
            PG8_WAIT_V(8); PG8_WAIT_L(0); PG8_BAR; PG8_MMA(0, 0, At, B0); PG8_MMA(0, 1, At, B1); PG8_BAR; PG8_SCHED;
            PG8_LDA(At, 1, 1); PG8_STAGE(PG8_SB(1, 0), b3, voffB); PG8_STAGE(PG8_SB(1, 1), b3 + hstep, voffB); PG8_STAGE(PG8_SA(1, 0), a3, voffA);
            PG8_WAIT_V(8); PG8_WAIT_L(0); PG8_BAR; PG8_MMA(1, 0, At, B0); PG8_MMA(1, 1, At, B1); PG8_BAR; PG8_SCHED;
            } else {
            PG8_LDB(B0, 0, 0); PG8_SCHED; PG8_LDA(At, 0, 0); PG8_STAGE(PG8_SA(1, 1), a1 + hstep, voffA);
            PG8_WAIT_L(8); PG8_BAR; PG8_WAIT_L(0); PG8_MMA(0, 0, At, B0); PG8_BAR; PG8_SCHED;
            PG8_LDB(B1, 0, 1); PG8_STAGE(PG8_SB(0, 0), b2, voffB);
            PG8_BAR; PG8_WAIT_L(0); PG8_MMA(0, 1, At, B1); PG8_BAR;
            PG8_LDA(At, 0, 1); PG8_STAGE(PG8_SA(0, 0), a2, voffA);
            PG8_BAR; PG8_WAIT_L(0); PG8_MMA(1, 0, At, B0); PG8_BAR; PG8_SCHED;
            PG8_STAGE(PG8_SB(0, 1), b2 + hstep, voffB);
            PG8_WAIT_V(6); PG8_BAR; PG8_MMA(1, 1, At, B1); PG8_BAR;
            PG8_LDB(B0, 1, 0); PG8_SCHED; PG8_LDA(At, 1, 0); PG8_STAGE(PG8_SA(0, 1), a2 + hstep, voffA);
            PG8_WAIT_L(8); PG8_BAR; PG8_WAIT_L(0); PG8_MMA(0, 0, At, B0); PG8_BAR; PG8_SCHED;
            PG8_LDB(B1, 1, 1); PG8_STAGE(PG8_SB(1, 0), b3, voffB);
            PG8_BAR; PG8_WAIT_L(0); PG8_MMA(0, 1, At, B1); PG8_BAR;
            PG8_LDA(At, 1, 1); PG8_STAGE(PG8_SA(1, 0), a3, voffA);
            PG8_BAR; PG8_WAIT_L(0); PG8_MMA(1, 0, At, B0); PG8_BAR; PG8_SCHED;
            PG8_STAGE(PG8_SB(1, 1), b3 + hstep, voffB);
            PG8_WAIT_V(6); PG8_BAR; PG8_MMA(1, 1, At, B1); PG8_BAR;
            }
        }
        if constexpr (ALIGN_EPI) { if (wr == 0) PG8_BAR; }
        if constexpr (!Epi::AFTER_DRAIN) { E(acc, cur, wr, wc, fr, fq); S.done(cur); }
        if (!has_next) break;
#pragma unroll
        for (int a = 0; a < 2; ++a)
#pragma unroll
            for (int b = 0; b < 2; ++b)
#pragma unroll
                for (int m = 0; m < 4; ++m)
#pragma unroll
                    for (int n = 0; n < 2; ++n) acc[a][b][m][n] = (f32x4){0.f, 0.f, 0.f, 0.f};
        cur = nxt; cA = nA; cB = nB; ++ui;
        if constexpr (ALIGN_EPI) { if (wr == 1) PG8_BAR; }
    }
    PG8_WAIT_V(0);
    if constexpr (!ALIGN_EPI) { if (wr == 0) PG8_BAR; }
    PG8_BAR;
    if constexpr (Epi::AFTER_DRAIN) { E.fused(acc, cur, wr, wc, fr, fq, lds, wid, lane); S.done(cur); }
#undef PG8_SA
#undef PG8_SB
#undef PG8_STAGE
#undef PG8_LDA
#undef PG8_LDB
#undef PG8_MMA
#undef PG8_WAIT_V
#undef PG8_WAIT_L
#undef PG8_BAR
#undef PG8_SCHED
}
}
namespace att {
constexpr int D = 128; constexpr float THR = 8.f; constexpr bool WSKIP = false;
constexpr float SCALE = 0.08838834764831845f;
constexpr int NW = 8, QBLK = 32, KVBLK = 64, QB = NW * QBLK;
constexpr int SHM_V = KVBLK * D * 2, SHM_K = KVBLK * D * 2;
constexpr int LDS_BYTES = 2 * SHM_V + 2 * SHM_K + NW * 64 * 4;

using bf16 = __hip_bfloat16;
typedef short bf16x8 __attribute__((ext_vector_type(8)));
typedef short s16x4 __attribute__((ext_vector_type(4)));
typedef float f32x16 __attribute__((ext_vector_type(16)));
typedef float f32x4 __attribute__((ext_vector_type(4)));
typedef unsigned u32x4 __attribute__((ext_vector_type(4)));
template <class A, class Bt> struct same_t { static constexpr bool v = false; };
template <class A> struct same_t<A, A> { static constexpr bool v = true; };

#define KSWZ(row, colB) ((row) * 256 + ((colB) ^ (((row) & 7) << 4)))
#define SBAR() __builtin_amdgcn_sched_barrier(0)
__device__ __forceinline__ int v_st(int k, int c) { const int kk = (k & ~0xC) | ((k & 4) << 1) | ((k & 8) >> 1); return ((kk >> 3) * 4 + (c >> 5)) * 512 + ((kk & 7) * 32 + (c & 31)) * 2; }
__device__ __forceinline__ int v_rd_base(int lane) { return ((lane & 3) << 3) | (((lane >> 2) & 3) << 6) | (((lane >> 4) & 1) << 5) | (((lane >> 5) & 1) << 8); }
constexpr int v_rd_off(int d0, int ks, int half) { return d0 * 512 + ks * 4096 + half * 2048; }
__device__ __forceinline__ int crow(int r, int hi) { return (r & 3) + 8 * (r >> 2) + 4 * hi; }
__device__ __forceinline__ unsigned cvtpk(float lo, float hi) {
    unsigned r; asm volatile("v_cvt_pk_bf16_f32 %0, %1, %2" : "=v"(r) : "v"(lo), "v"(hi)); return r;
}
__device__ __forceinline__ bf16x8 pack8(f32x4 a, f32x4 b) {
    u32x4 w = {cvtpk(a[0], a[1]), cvtpk(a[2], a[3]), cvtpk(b[0], b[1]), cvtpk(b[2], b[3])};
    return *reinterpret_cast<bf16x8*>(&w);
}
template <class T> __device__ __forceinline__ bf16x8 load8(const T* p) {
    if constexpr (same_t<T, float>::v) { return pack8(*(const f32x4*)p, *(const f32x4*)(p + 4)); }
    else { return *reinterpret_cast<const bf16x8*>(p); }
}
__device__ __forceinline__ void mask_tile(f32x16& p0, f32x16& p1, int dq, unsigned W) {
    const float NEG = -__builtin_inff();
#pragma unroll
    for (int r = 0; r < 16; ++r) {
        const int c = (r & 3) + 8 * (r >> 2);
        if ((unsigned)(dq - c) >= W) p0[r] = NEG;
        if ((unsigned)(dq - c - 32) >= W) p1[r] = NEG;
    }
}
__device__ __forceinline__ void partialSM(f32x16& p0, f32x16& p1, float& m_reg, float& mn, float& alpha) {
    float pmax = p0[0]; for (int r = 1; r < 16; ++r) pmax = fmaxf(pmax, p0[r]); for (int r = 0; r < 16; ++r) pmax = fmaxf(pmax, p1[r]);
    { auto rr = __builtin_amdgcn_permlane32_swap(__float_as_uint(pmax), __float_as_uint(pmax), false, false);
      pmax = fmaxf(__uint_as_float(rr[0]), __uint_as_float(rr[1])); }
    constexpr float C2 = 1.4426950408889634f * SCALE;
    if (__builtin_expect(__all((pmax - m_reg) * SCALE <= THR), 1)) { mn = m_reg; alpha = 1.f; }
    else { mn = fmaxf(m_reg, pmax); alpha = __builtin_amdgcn_exp2f((m_reg - mn) * C2); m_reg = mn; }
    const float mnL = -mn * C2;
    for (int r = 0; r < 16; ++r) p0[r] = fmaf(p0[r], C2, mnL); for (int r = 0; r < 16; ++r) p1[r] = fmaf(p1[r], C2, mnL);
    for (int r = 0; r < 16; ++r) p0[r] = __builtin_amdgcn_exp2f(p0[r]);
}
__device__ __forceinline__ void finishSM(f32x16& p0, f32x16& p1, float alpha, float& l_reg, bf16x8& pa0, bf16x8& pa1, bf16x8& pa2, bf16x8& pa3) {
    for (int r = 0; r < 16; ++r) p1[r] = __builtin_amdgcn_exp2f(p1[r]);
    float ps = 0; for (int r = 0; r < 16; ++r) ps += p0[r]; for (int r = 0; r < 16; ++r) ps += p1[r];
    { auto rr = __builtin_amdgcn_permlane32_swap(__float_as_uint(ps), __float_as_uint(ps), false, false);
      ps = __uint_as_float(rr[0]) + __uint_as_float(rr[1]); }
    l_reg = l_reg * alpha + ps;
#define PK4(P, B_, OUT) do { unsigned a0 = cvtpk(P[B_+0], P[B_+1]), a1 = cvtpk(P[B_+2], P[B_+3]);                          \
        unsigned b0 = cvtpk(P[B_+4], P[B_+5]), b1 = cvtpk(P[B_+6], P[B_+7]);                                             \
        auto r0 = __builtin_amdgcn_permlane32_swap(a0, b0, false, false); auto r1 = __builtin_amdgcn_permlane32_swap(a1, b1, false, false); \
        u32x4 w = {r0[0], r1[0], r0[1], r1[1]}; OUT = *reinterpret_cast<bf16x8*>(&w); } while (0)
    PK4(p0, 0, pa0); PK4(p0, 8, pa1); PK4(p1, 0, pa2); PK4(p1, 8, pa3);
#undef PK4
}
template <int KB, bool SK>
__device__ __forceinline__ void qkt(f32x16& p0, f32x16& p1, const char* K_lds, int r32, int hi, const bf16x8* qr, bool act) {
    if (SK && !act) { const float NEG = -__builtin_inff();
#pragma unroll
        for (int r = 0; r < 16; ++r) { p0[r] = NEG; p1[r] = NEG; } return; }
    p0 = f32x16{}; p1 = f32x16{};
    const char* kb[4];
#pragma unroll
    for (int dd = 0; dd < 4; ++dd) kb[dd] = K_lds + KB * SHM_K + KSWZ(r32, (dd * 16 + hi * 8) * 2);
#pragma unroll
    for (int d0 = 0; d0 < 8; ++d0) { const char* a = kb[d0 & 3] + (d0 >> 2) * 128;
        bf16x8 b0 = *reinterpret_cast<const bf16x8*>(a);
        bf16x8 b1 = *reinterpret_cast<const bf16x8*>(a + 32 * 256);
        p0 = __builtin_amdgcn_mfma_f32_32x32x16_bf16(b0, qr[d0], p0, 0, 0, 0);
        p1 = __builtin_amdgcn_mfma_f32_32x32x16_bf16(b1, qr[d0], p1, 0, 0, 0); }
}
template <int VB, bool SK>
__device__ __forceinline__ void pv_tile(f32x16* o, int vb0, bf16x8 pa0, bf16x8 pa1, bf16x8 pa2, bf16x8 pa3, bool act) {
    if (SK && !act) return;
#define TRRD(dst, off) asm volatile("ds_read_b64_tr_b16 %0, %1 offset:%2" : "=&v"(dst) : "v"(vb0), "i"(off) : "memory")
#define PV_D0(d0) do { s16x4 l0, l1, l2, l3, h0, h1, h2, h3; constexpr int b_ = VB * SHM_V + v_rd_off(d0, 0, 0);     \
        TRRD(l0, b_); TRRD(h0, b_ + 2048); TRRD(l1, b_ + 4096); TRRD(h1, b_ + 6144); TRRD(l2, b_ + 8192); TRRD(h2, b_ + 10240); TRRD(l3, b_ + 12288); TRRD(h3, b_ + 14336); \
        asm volatile("s_waitcnt lgkmcnt(0)" ::: "memory"); SBAR();                 \
        o[d0] = __builtin_amdgcn_mfma_f32_32x32x16_bf16(pa0, (bf16x8){l0[0], l0[1], l0[2], l0[3], h0[0], h0[1], h0[2], h0[3]}, o[d0], 0, 0, 0);   \
        o[d0] = __builtin_amdgcn_mfma_f32_32x32x16_bf16(pa1, (bf16x8){l1[0], l1[1], l1[2], l1[3], h1[0], h1[1], h1[2], h1[3]}, o[d0], 0, 0, 0);   \
        o[d0] = __builtin_amdgcn_mfma_f32_32x32x16_bf16(pa2, (bf16x8){l2[0], l2[1], l2[2], l2[3], h2[0], h2[1], h2[2], h2[3]}, o[d0], 0, 0, 0);   \
        o[d0] = __builtin_amdgcn_mfma_f32_32x32x16_bf16(pa3, (bf16x8){l3[0], l3[1], l3[2], l3[3], h3[0], h3[1], h3[2], h3[3]}, o[d0], 0, 0, 0); } while (0)
    PV_D0(0); PV_D0(1); PV_D0(2); PV_D0(3);
#undef PV_D0
#undef TRRD
}

template <class TIn, class TOut> struct BlockRef { const TIn* Q; const TIn* K; const TIn* V; TOut* O; int P0; int ldo; };
template <class TIn> struct Seam {
    bf16x8 qr[8];
    bf16x8 st_v0, st_v1, st_k0, st_k1; f32x4 sf0, sf1, sf2, sf3;
    f32x4 tq[16];
};
__device__ __forceinline__ int swa_jlo(int P0, int W) { const int lowk = P0 - W + 1; return lowk > 0 ? lowk / KVBLK : 0; }
#define ROW(p, k0, rr) ((p) + (size_t)((k0) + (rr)) * D + sc)
#define VMW() asm volatile("s_waitcnt vmcnt(0)" ::: "memory")
#define VMWN(n) asm volatile("s_waitcnt vmcnt(%0)" :: "i"(n) : "memory")
#define SLOAD_H(Kp, Vp, k0) do { S.st_v0 = load8<TIn>(ROW(Vp, k0, sr)); S.st_v1 = load8<TIn>(ROW(Vp, k0, 32 + sr));              \
                         S.st_k0 = load8<TIn>(ROW(Kp, k0, sr)); S.st_k1 = load8<TIn>(ROW(Kp, k0, 32 + sr)); } while (0)
#define SWRITE_HK(bf) do { *(bf16x8*)(K_lds + (bf) * SHM_K + kws) = S.st_k0; *(bf16x8*)(K_lds + (bf) * SHM_K + kws + 32 * 256) = S.st_k1; } while (0)
#define SWRITE_HV(bf) do { *(bf16x8*)(V_lds + (bf) * SHM_V + vst0) = S.st_v0; *(bf16x8*)(V_lds + (bf) * SHM_V + vst1) = S.st_v1; } while (0)
#define SWRITE_H(bf) do { SWRITE_HV(bf); SWRITE_HK(bf); } while (0)
#define SLOAD_F(p, k0) do { S.sf0 = *(const f32x4*)ROW(p, k0, sr); S.sf1 = *(const f32x4*)(ROW(p, k0, sr) + 4);                \
                            S.sf2 = *(const f32x4*)ROW(p, k0, 32 + sr); S.sf3 = *(const f32x4*)(ROW(p, k0, 32 + sr) + 4); } while (0)
#define SWRITE_KF(bf) do { *(bf16x8*)(K_lds + (bf) * SHM_K + kws) = pack8(S.sf0, S.sf1); *(bf16x8*)(K_lds + (bf) * SHM_K + kws + 32 * 256) = pack8(S.sf2, S.sf3); } while (0)
#define SWRITE_VF(bf) do { *(bf16x8*)(V_lds + (bf) * SHM_V + vst0) = pack8(S.sf0, S.sf1); *(bf16x8*)(V_lds + (bf) * SHM_V + vst1) = pack8(S.sf2, S.sf3); } while (0)
template <class TIn, class TOut>
__device__ __forceinline__ void causal_swa_prime(const BlockRef<TIn, TOut>& cur, int W, char* lds, Seam<TIn>& S) {
    constexpr bool F32 = same_t<TIn, float>::v;
    const int tid = threadIdx.x, wid = __builtin_amdgcn_readfirstlane(tid >> 6), lane = tid & 63, r32 = lane & 31, hi = lane >> 5;
    const int sr = tid >> 4, sc = (tid & 15) * 8, kws = KSWZ(sr, sc * 2); char* K_lds = lds + 2 * SHM_V;
    const int kb0 = swa_jlo(cur.P0, W) * KVBLK;
    for (int d0 = 0; d0 < 8; ++d0) S.qr[d0] = load8<TIn>(cur.Q + (size_t)(wid * QBLK + r32) * D + d0 * 16 + hi * 8);
    if constexpr (F32) { SLOAD_F((const float*)cur.K, kb0); VMW(); SWRITE_KF(0); SBAR(); SLOAD_F((const float*)cur.V, kb0); }
    else { SLOAD_H(cur.K, cur.V, kb0); VMW(); SWRITE_HK(0); }
    __syncthreads();
}
template <class TIn, class TOut>
__device__ __forceinline__ void causal_swa_block(const BlockRef<TIn, TOut>& cur, const BlockRef<TIn, TOut>& nxt, int skv, int W, char* lds, Seam<TIn>& S) {
    constexpr bool F32 = same_t<TIn, float>::v;
    const int tid = threadIdx.x, wid = __builtin_amdgcn_readfirstlane(tid >> 6), lane = tid & 63, r32 = lane & 31, hi = lane >> 5;
    const int j_lo = swa_jlo(cur.P0, W);
    int j_hi = (cur.P0 + QB - 1) / KVBLK + 1; if (j_hi > skv / KVBLK) j_hi = skv / KVBLK;
    const int NT = j_hi - j_lo;
    const int kbn = swa_jlo(nxt.P0, W) * KVBLK;
    const int qlo = cur.P0 + wid * QBLK, qm = qlo + r32 - 4 * hi;
    char* V_lds = lds; char* K_lds = lds + 2 * SHM_V;
    float* ws = (float*)(lds + 2 * SHM_V + 2 * SHM_K) + wid * 64; float* li_l = ws, * al_l = ws + 32;
    float m_reg = -1e30f, l_reg = 0; f32x16 o[4] = {};
    const int sr = tid >> 4, sc = (tid & 15) * 8, vst0 = v_st(sr, sc), vst1 = v_st(32 + sr, sc), kws = KSWZ(sr, sc * 2);
    const int vb0 = (int)(uintptr_t)V_lds + v_rd_base(lane);
    const TIn* Kh = cur.K; const TIn* Vh = cur.V;
#define RESC(a) do { if (__any((a) < 1.f)) { if (hi == 0) al_l[r32] = (a); asm volatile("s_waitcnt lgkmcnt(0)" ::: "memory");              \
                     for (int d_ = 0; d_ < 4; ++d_) for (int r = 0; r < 16; ++r) o[d_][r] *= al_l[crow(r, hi)]; } } while (0)
#define KBASE(t) ((j_lo + (t)) * KVBLK)
#define ACT(t) (KBASE(t) <= qlo + QBLK - 1 && KBASE(t) + KVBLK - 1 >= qlo - W + 1)
#define MASKT(P0_, P1_, t) do { const int kb_ = KBASE(t); if ((!SK || ACT(t)) && (kb_ + KVBLK - 1 > qlo || kb_ <= qlo + QBLK - 1 - W)) mask_tile(P0_, P1_, qm - kb_, (unsigned)W); } while (0)
    constexpr int NQL = F32 ? 16 : 8;
    constexpr bool SK = WSKIP && !F32;
#define SEAM_K0() do { VMWN(NQL); if constexpr (F32) { SWRITE_KF(0); SBAR(); SLOAD_F((const float*)nxt.V, kbn); } else { SWRITE_HK(0); } SBAR(); } while (0)
    f32x16 pA0, pA1, pB0, pB1; float mnA, mnB, alA, alB; bf16x8 pa0, pa1, pa2, pa3;
    if constexpr (F32) { VMW(); SWRITE_VF(0); SBAR(); } else { SWRITE_HV(0); SBAR(); }
    if (NT > 1) { if constexpr (F32) SLOAD_F((const float*)Kh, KBASE(1)); else SLOAD_H(Kh, Vh, KBASE(1)); }
    SBAR(); qkt<0, SK>(pA0, pA1, K_lds, r32, hi, S.qr, ACT(0));
    if constexpr (F32) { if (NT > 1) { VMW(); SWRITE_KF(1); SBAR(); SLOAD_F((const float*)Vh, KBASE(1)); } }
    MASKT(pA0, pA1, 0); partialSM(pA0, pA1, m_reg, mnA, alA);
    if (NT > 1) { VMW(); if constexpr (F32) { SWRITE_VF(1); SBAR(); if (NT > 2) SLOAD_F((const float*)Kh, KBASE(2)); } else SWRITE_H(1); }
    __syncthreads();
#define HALF_STEP(PX0, PX1, mnX, alX, PY0, PY1, alY, t, KB, VB, SB) do {                                                      \
        SBAR(); qkt<KB, SK>(PX0, PX1, K_lds, r32, hi, S.qr, ACT(t));                                             \
        finishSM(PY0, PY1, alY, l_reg, pa0, pa1, pa2, pa3); SBAR();                                                           \
        if ((t) + 1 < NT) { if constexpr (F32) { VMW(); SWRITE_KF(SB); SBAR(); SLOAD_F((const float*)Vh, KBASE((t) + 1)); }  \
                            else { SLOAD_H(Kh, Vh, KBASE((t) + 1)); } SBAR(); }                                               \
        pv_tile<VB, SK>(o, vb0, pa0, pa1, pa2, pa3, ACT((t) - 1)); MASKT(PX0, PX1, (t)); partialSM(PX0, PX1, m_reg, mnX, alX);                                        \
        __syncthreads();                                                                                                      \
        if ((t) + 1 < NT) { VMW(); if constexpr (F32) { SWRITE_VF(SB); SBAR(); if ((t) + 2 < NT) SLOAD_F((const float*)Kh, KBASE((t) + 2)); } \
                            else { SWRITE_H(SB); } }                                                                          \
        RESC(alX); __syncthreads(); } while (0)
    for (int t = 1; t + 1 < NT; t += 2) {
        HALF_STEP(pB0, pB1, mnB, alB, pA0, pA1, alA, t, 1, 0, 0);
        HALF_STEP(pA0, pA1, mnA, alA, pB0, pB1, alB, t + 1, 0, 1, 1);
    }
    const bool even = (NT & 1) == 0;
    if (even) { SBAR(); qkt<1, SK>(pB0, pB1, K_lds, r32, hi, S.qr, ACT(NT - 1)); SBAR(); }
#define QROW(e) (nxt.Q + (size_t)(wid * QBLK + r32) * D + ((e) >> 1) * 16 + hi * 8 + ((e) & 1) * 4)
    if constexpr (F32) { SLOAD_F((const float*)nxt.K, kbn); SBAR();
#pragma unroll
        for (int e = 0; e < 8; ++e) S.tq[e] = *(const f32x4*)QROW(e); }
    else { SLOAD_H(nxt.K, nxt.V, kbn); SBAR();
#pragma unroll
        for (int d0 = 0; d0 < 8; ++d0) S.qr[d0] = load8<TIn>(nxt.Q + (size_t)(wid * QBLK + r32) * D + d0 * 16 + hi * 8); }
    SBAR();
    finishSM(pA0, pA1, alA, l_reg, pa0, pa1, pa2, pa3); SBAR();
    if constexpr (F32) {
#pragma unroll
        for (int e = 8; e < 16; ++e) S.tq[e] = *(const f32x4*)QROW(e); SBAR(); }
#undef QROW
    pv_tile<0, SK>(o, vb0, pa0, pa1, pa2, pa3, ACT(even ? NT - 2 : NT - 1));
    if (even) { MASKT(pB0, pB1, NT - 1); partialSM(pB0, pB1, m_reg, mnB, alB); __syncthreads(); RESC(alB);
        finishSM(pB0, pB1, alB, l_reg, pa0, pa1, pa2, pa3); SBAR(); pv_tile<1, SK>(o, vb0, pa0, pa1, pa2, pa3, ACT(NT - 1)); }
    SBAR(); SEAM_K0();
    if (hi == 0) li_l[r32] = l_reg; asm volatile("s_waitcnt lgkmcnt(0)" ::: "memory");
    float rli[16];
#pragma unroll
    for (int r = 0; r < 16; ++r) rli[r] = __builtin_amdgcn_rcpf(li_l[crow(r, hi)]);
    const int LDO = cur.ldo; TOut* Ow = cur.O + (size_t)(wid * QBLK) * LDO;
#pragma unroll
    for (int r = 0; r < 16; ++r) { const int orow = crow(r, hi);
#pragma unroll
        for (int d0 = 0; d0 < 4; ++d0) { const float v = o[d0][r] * rli[r];
            if constexpr (same_t<TOut, float>::v) { Ow[(size_t)orow * LDO + d0 * 32 + r32] = v; }
            else { const float vn = __shfl_xor(v, 1);
                   if ((r32 & 1) == 0) *(unsigned*)(Ow + (size_t)orow * LDO + d0 * 32 + r32) = cvtpk(v, vn); } } }
    if constexpr (F32) {
#pragma unroll
        for (int d0 = 0; d0 < 8; ++d0) S.qr[d0] = pack8(S.tq[2 * d0], S.tq[2 * d0 + 1]); }
    __syncthreads();
#undef RESC
#undef KBASE
#undef ACT
#undef MASKT
#undef SEAM_K0
#undef HALF_STEP
}
#undef ROW
#undef VMW
#undef VMWN
#undef SLOAD_H
#undef SWRITE_HK
#undef SWRITE_HV
#undef SWRITE_H
#undef SLOAD_F
#undef SWRITE_KF
#undef SWRITE_VF

}
constexpr size_t al256(size_t x) { return (x + 255) & ~(size_t)255; }
constexpr size_t WS_CTL = 0, CTL_ZERO_BYTES = 1u << 20;
constexpr size_t WS_WGU   = CTL_ZERO_BYTES;
constexpr size_t WS_WDN   = WS_WGU  + (size_t)8 * NGU * DM * 2;
constexpr size_t WS_WOUT  = WS_WDN  + (size_t)8 * DM * FF * 2;
constexpr size_t WS_WMEM  = WS_WOUT + (size_t)4 * DM * DM * 2;
constexpr size_t WS_WAIN  = WS_WMEM + (size_t)4 * 1024 * DM * 2;
constexpr size_t WS_WKV   = WS_WAIN + (size_t)2 * NAIN * DM * 2;
constexpr size_t WS_WBIN  = WS_WKV  + (size_t)NKV * DM * 2;
constexpr size_t WS_COS   = WS_WBIN + (size_t)2 * NBIN * DM * 2;
constexpr size_t WS_SIN   = WS_COS  + (size_t)SEQ * 64 * 4;
constexpr size_t WS_MEMN  = WS_SIN  + (size_t)SEQ * 64 * 4;
constexpr size_t WS_MKVR  = WS_MEMN + (size_t)4 * 1024 * DM * 2;
constexpr size_t WS_MK    = WS_MKVR + (size_t)4 * 1024 * 1024 * 4;
constexpr size_t WS_MV    = WS_MK   + (size_t)4 * 1024 * 512 * 2;
constexpr size_t WS_HN    = WS_MV   + (size_t)4 * 1024 * 512 * 2;
constexpr size_t WS_HKV   = WS_HN   + (size_t)M * DM * 2;
constexpr size_t WS_HID   = WS_HKV  + (size_t)M * DM * 2;
constexpr size_t WS_ZA    = WS_HID  + (size_t)M * FF * 2;
constexpr size_t WS_VSTAT = WS_ZA   + (size_t)M * 3072 * 2;
constexpr size_t WS_QMRAW = WS_VSTAT + (size_t)M * 24 * 4;
constexpr size_t WS_QRAW  = WS_QMRAW + (size_t)M * 512 * 4;
constexpr size_t WS_QB    = WS_QRAW + (size_t)M * 1536 * 4;
constexpr size_t WS_KSH   = WS_QB   + (size_t)M * 1536 * 2;
constexpr size_t WS_VSH   = WS_KSH  + (size_t)M * 1536 * 2;
constexpr size_t WS_QMB   = WS_VSH  + (size_t)M * 1536 * 2;
constexpr size_t WS_OATT  = WS_QMB  + (size_t)M * 512 * 2;
constexpr size_t WS_CAT   = WS_OATT + (size_t)96 * SEQ * 128 * 4;
constexpr size_t WS_END   = WS_CAT  + (size_t)M * DM * 2;
static_assert(WS_WGU % 256 == 0 && WS_COS % 256 == 0 && WS_VSTAT % 256 == 0 && WS_QMRAW % 256 == 0 && WS_END % 256 == 0, "ws alignment");

constexpr int RING_OFF = 0, RING_BYTES = 131072;
constexpr int LDSCTL_OFF = 139264, MISC_OFF = LDSCTL_OFF + 320;
constexpr int LDS_BYTES = 147456;
constexpr int NWAVES = 8;

#define GAS __attribute__((address_space(1)))
#define LAS __attribute__((address_space(3)))
typedef unsigned short bf16r;
typedef unsigned v4u __attribute__((ext_vector_type(4)));
typedef unsigned v2u __attribute__((ext_vector_type(2)));
typedef float f32x4 __attribute__((ext_vector_type(4)));
typedef short bf16x8 __attribute__((ext_vector_type(8)));
typedef GAS unsigned gu32;
#define LDS_WAIT() asm volatile("s_waitcnt lgkmcnt(0)" ::: "memory")
#define VM_WAIT() asm volatile("s_waitcnt vmcnt(0)" ::: "memory")
__device__ __forceinline__ unsigned f2bf(float f) { unsigned u = __builtin_bit_cast(unsigned, f); return (u + 0x7fffu + ((u >> 16) & 1u)) >> 16; }
__device__ __forceinline__ unsigned pk2(float lo, float hi) { return f2bf(lo) | (f2bf(hi) << 16); }
__device__ __forceinline__ float bf2f(unsigned short b) { return __builtin_bit_cast(float, ((unsigned)b) << 16); }
__device__ __forceinline__ float wave_sum(float v) {
#pragma unroll
    for (int o = 1; o < 64; o <<= 1) v += __shfl_xor(v, o);
    return v;
}
#define XB_TMO      128
#define XB_XCNT(j)  (256  + 64 * (j))
#define XB_XSUB(j)  (1280 + 64 * (j))
#define XB_XGEN(j)  (2304 + 64 * (j))
#define XB_TOP      3328
#define XB_TOPGEN   3392
#define XCD_BAR_WORDS 3456
#define XB_SPIN_CAP (1u << 18)

__device__ __forceinline__ unsigned xb_ld(unsigned* p)              { return __hip_atomic_load(p, __ATOMIC_RELAXED, __HIP_MEMORY_SCOPE_AGENT); }
__device__ __forceinline__ unsigned xb_add(unsigned* p, unsigned v) { return __hip_atomic_fetch_add(p, v, __ATOMIC_RELAXED, __HIP_MEMORY_SCOPE_AGENT); }
__device__ __forceinline__ unsigned xb_xcc_id() { return (unsigned)__builtin_amdgcn_s_getreg((3 << 11) | 20) & 0xFu; }
#define XB_SPIN(cond, bar) do { unsigned _sp = 0; while (cond) { __builtin_amdgcn_s_sleep(1); \
    if ((++_sp & 255u) == 0u) { if (xb_ld(&(bar)[XB_TMO])) break; if (_sp > XB_SPIN_CAP) { atomicAdd(&(bar)[XB_TMO], 1u); break; } } } } while (0)

struct XcdBarrier {
    unsigned* bar; unsigned x;
    volatile LAS unsigned* st;
};

__device__ __forceinline__ XcdBarrier xcd_barrier_post(unsigned* bar, volatile LAS unsigned* st) {
    XcdBarrier b; b.bar = bar; b.x = xb_xcc_id(); b.st = st;
    if (threadIdx.x == 0) (void)xb_add(&bar[XB_XCNT(b.x)], 1u);
    return b;
}
__device__ __forceinline__ void xcd_barrier_complete(unsigned* bar, unsigned x, unsigned& nloc, unsigned& nx) {
    const unsigned G = gridDim.x * gridDim.y * gridDim.z;
    unsigned sum, cnt, mine, sp = 0u;
    for (;;) {
        sum = 0u; cnt = 0u; mine = 0u;
#pragma unroll
        for (unsigned j = 0; j < 16; ++j) { const unsigned c = xb_ld(&bar[XB_XCNT(j)]); sum += c; cnt += (c > 0u) ? 1u : 0u; mine = (j == x) ? c : mine; }
        if (sum == G) break;
        __builtin_amdgcn_s_sleep(1);
        if ((++sp & 255u) == 0u) { if (xb_ld(&bar[XB_TMO])) break; if (sp > XB_SPIN_CAP) { atomicAdd(&bar[XB_TMO], 1u); break; } }
    }
    nloc = mine > 0u ? mine : 1u; nx = cnt > 0u ? cnt : 1u;
}

__device__ __forceinline__ void xcd_barrier(const XcdBarrier& b) {
    asm volatile("s_waitcnt vmcnt(0)" ::: "memory");
    __syncthreads();
    if (threadIdx.x == 0) {
        unsigned* bar = b.bar;
        __builtin_amdgcn_s_waitcnt(0);
        unsigned nloc = b.st[0], nx = b.st[1];
        if (nloc == 0u) { xcd_barrier_complete(bar, b.x, nloc, nx); b.st[0] = nloc; b.st[1] = nx; }
        const unsigned old = xb_add(&bar[XB_XSUB(b.x)], 1u);
        const unsigned gen = old / nloc;
        if (old + 1u == (gen + 1u) * nloc) {
            __builtin_amdgcn_fence(__ATOMIC_RELEASE, "agent");
            asm volatile("s_waitcnt vmcnt(0)" ::: "memory");
            const unsigned og = xb_add(&bar[XB_TOP], 1u);
            const unsigned tg = og / nx;
            if (og + 1u == (tg + 1u) * nx) xb_add(&bar[XB_TOPGEN], 1u);
            else XB_SPIN(xb_ld(&bar[XB_TOPGEN]) == tg, bar);
            __builtin_amdgcn_fence(__ATOMIC_ACQUIRE, "agent");
            xb_add(&bar[XB_XGEN(b.x)], 1u);
            asm volatile("s_waitcnt vmcnt(0)" ::: "memory");
        } else {
            XB_SPIN(xb_ld(&bar[XB_XGEN(b.x)]) == gen, bar);
            __builtin_amdgcn_fence(__ATOMIC_ACQUIRE, "agent");
            asm volatile("s_waitcnt vmcnt(0)" ::: "memory");
        }
    }
    __syncthreads();
}
struct Frame {
    unsigned char* lds_g;
    LAS unsigned char* lds;
    volatile LAS unsigned* MISC;
    gu32* ctl;
    int tid, lane, wave;
    int vcu, G;
    unsigned char* ws;
};

__device__ __forceinline__ void transpose_item(const float* W, int K, int N, bf16r* WT, size_t dst_row0, int k0, int n0, LAS float* scr, int lane) {
#pragma unroll 4
    for (int i = 0; i < 16; ++i) { const int kk = 4 * i + (lane >> 4); const f32x4 v = *(const f32x4*)(W + (size_t)(k0 + kk) * N + n0 + (lane & 15) * 4);
        LAS float* s = scr + kk * 65 + (lane & 15) * 4; s[0] = v[0]; s[1] = v[1]; s[2] = v[2]; s[3] = v[3]; }
    LDS_WAIT(); asm volatile("" ::: "memory");
    const int c = lane & 7;
#pragma unroll
    for (int j = 0; j < 8; ++j) { const int n = (lane >> 3) + 8 * j; const LAS float* s = scr + (8 * c) * 65 + n;
        v4u o; o.x = pk2(s[0 * 65], s[1 * 65]); o.y = pk2(s[2 * 65], s[3 * 65]); o.z = pk2(s[4 * 65], s[5 * 65]); o.w = pk2(s[6 * 65], s[7 * 65]);
        *(v4u*)(WT + (dst_row0 + n) * (size_t)K + k0 + 8 * c) = o; }
    LDS_WAIT(); asm volatile("" ::: "memory");
}
__device__ __forceinline__ bool transpose_group(int& r, const float* src, int cnt, int K, int N, bf16r* dst, bool gu, LAS float* scr, int lane) {
    const int nkb = K / 64, nnb = N / 64, per = nkb * nnb;
    if (r >= cnt * per) { r -= cnt * per; return false; }
    const int mi = r / per, q = r % per, kb = q / nnb, nb = q % nnb, n0 = nb * 64;
    size_t drow = n0;
    if (gu) { drow = (n0 < FF) ? (size_t)(n0 / 128) * 256 + (n0 % 128) : (size_t)((n0 - FF) / 128) * 256 + 128 + ((n0 - FF) % 128); }
    transpose_item(src + (size_t)mi * K * N, K, N, dst + (size_t)mi * K * N, gu ? drow : (size_t)n0, kb * 64, n0, scr, lane);
    return true;
}
__device__ __forceinline__ void norm_row(const float* xrow, const float* gain, bf16r* orow, int lane) {
    const f32x4* xr = (const f32x4*)xrow + lane; f32x4 v[8]; float s = 0.f;
#pragma unroll
    for (int j = 0; j < 8; ++j) { v[j] = xr[64 * j]; s += (v[j][0] * v[j][0] + v[j][1] * v[j][1]) + (v[j][2] * v[j][2] + v[j][3] * v[j][3]); }
    const float rstd = 1.0f / sqrtf(wave_sum(s) * (1.0f / DM) + EPS);
    const f32x4* g4 = (const f32x4*)gain + lane; v2u* o8 = (v2u*)orow + lane;
#pragma unroll
    for (int j = 0; j < 8; ++j) { const f32x4 g = g4[64 * j]; v2u w; w.x = pk2(v[j][0] * rstd * g[0], v[j][1] * rstd * g[1]); w.y = pk2(v[j][2] * rstd * g[2], v[j][3] * rstd * g[3]); o8[64 * j] = w; }
}
__device__ __forceinline__ void norm_phase(const Frame& F, const float* x, const float* gain, bf16r* out, const float* gain2, bf16r* out2) {
    const int gw = F.vcu * NWAVES + F.wave, NGW = F.G * NWAVES;
    for (int m = gw; m < M; m += NGW) { norm_row(x + (size_t)m * DM, gain, out + (size_t)m * DM, F.lane); if (gain2) norm_row(x + (size_t)m * DM, gain2, out2 + (size_t)m * DM, F.lane); }
}
__device__ __forceinline__ void sincos_d(float angf, float& sn, float& cs) {
    const double a = (double)angf; const double k = __builtin_rint(a * 0.15915494309189535); const double r = a - k * 6.283185307179586476925286766559;
    const double r2 = r * r; double ts = r, tc = 1.0, ss = r, cc = 1.0;
#pragma unroll
    for (int n = 1; n <= 14; ++n) { tc = -tc * r2 / (double)((2 * n - 1) * (2 * n)); ts = -ts * r2 / (double)((2 * n) * (2 * n + 1)); cc += tc; ss += ts; }
    sn = (float)ss; cs = (float)cc;
}
__device__ __forceinline__ void head_norm_store(float x1, float x2, const float* g, const float* cosr, const float* sinr, bf16r* dst, int lane) {
    const float ss = wave_sum(x1 * x1 + x2 * x2); const float rstd = 1.0f / sqrtf(ss * (1.0f / HD) + EPS);
    float y1 = x1 * rstd * g[lane], y2 = x2 * rstd * g[lane + 64];
    if (cosr) { const float c = cosr[lane], s = sinr[lane]; const float o1 = y1 * c - y2 * s, o2 = y2 * c + y1 * s; y1 = o1; y2 = o2; }
    dst[lane] = (bf16r)f2bf(y1); dst[lane + 64] = (bf16r)f2bf(y2);
}
__device__ __forceinline__ void qk_prep_phase(const Frame& F, const float* raw, const float* g, const float* cosT, const float* sinT, bf16r* dst) {
    const int gw = F.vcu * NWAVES + F.wave, NGW = F.G * NWAVES, lane = F.lane;
    for (int m = gw; m < M; m += NGW) { const int b = m >> 12, s = m & 4095; const float* r = raw + (size_t)m * 1536;
        float x1[12], x2[12];
#pragma unroll
        for (int h = 0; h < 12; ++h) { x1[h] = r[h * 128 + lane]; x2[h] = r[h * 128 + 64 + lane]; }
#pragma unroll
        for (int h = 0; h < 12; ++h) head_norm_store(x1[h], x2[h], g, cosT + (size_t)s * 64, sinT + (size_t)s * 64, dst + ((size_t)(b * 12 + h) * SEQ + s) * 128, lane);
    }
}
__device__ __forceinline__ void qm_prep_phase(const Frame& F, const float* raw, const float* g, bf16r* dst) {
    const int gw = F.vcu * NWAVES + F.wave, NGW = F.G * NWAVES, lane = F.lane;
    for (int m = gw; m < M; m += NGW) { const int b = m >> 12, s = m & 4095; const float* r = raw + (size_t)m * 512;
        float x1[4], x2[4];
#pragma unroll
        for (int h = 0; h < 4; ++h) { x1[h] = r[h * 128 + lane]; x2[h] = r[h * 128 + 64 + lane]; }
#pragma unroll
        for (int h = 0; h < 4; ++h) head_norm_store(x1[h], x2[h], g, nullptr, nullptr, dst + ((size_t)(b * 4 + h) * SEQ + s) * 128, lane);
    }
}
__device__ __forceinline__ void mem_prep_phase(const Frame& F, const float* raw, const float* gk  , bf16r* mk, bf16r* mv) {
    const int gw = F.vcu * NWAVES + F.wave, NGW = F.G * NWAVES, lane = F.lane;
    for (int r = gw; r < 4096; r += NGW) { const int l = r >> 10, b = (r >> 8) & 3, mm = r & 255; const float* p = raw + (size_t)r * 1024;
#pragma unroll
        for (int h = 0; h < 4; ++h) { const size_t o = ((size_t)((l * 4 + b) * 4 + h) * 256 + mm) * 128;
            head_norm_store(p[h * 128 + lane], p[h * 128 + 64 + lane], gk + l * 128, nullptr, nullptr, mk + o, lane);
            mv[o + lane] = (bf16r)f2bf(p[512 + h * 128 + lane]); mv[o + 64 + lane] = (bf16r)f2bf(p[512 + h * 128 + 64 + lane]); }
    }
}
__device__ __forceinline__ void combine_phase(const Frame& F, const float* oatt, const float* lamp  , const float* subg  , float lam_init, bf16r* cat) {
    const int gw = F.vcu * NWAVES + F.wave, NGW = F.G * NWAVES, lane = F.lane;
    const float d01 = wave_sum(lamp[lane] * lamp[128 + lane] + lamp[64 + lane] * lamp[192 + lane]);
    const float d23 = wave_sum(lamp[256 + lane] * lamp[384 + lane] + lamp[320 + lane] * lamp[448 + lane]);
    const float lam = expf(d01) - expf(d23) + lam_init;
    const int half = lane >> 5, d4 = (lane & 31) * 4; const f32x4 g = *(const f32x4*)(subg + half * 128 + d4); const float post = 1.0f - lam_init;
    for (int it = gw; it < M * DH; it += NGW) { const int m = it / DH, h = it % DH, b = m >> 12, s = m & 4095;
        const size_t vh0 = (size_t)((b * 6 + h) * 2 + 0) * 2 + half, vh1 = (size_t)((b * 6 + h) * 2 + 1) * 2 + half;
        const f32x4 o0 = *(const f32x4*)(oatt + (vh0 * SEQ + s) * 128 + d4), o1 = *(const f32x4*)(oatt + (vh1 * SEQ + s) * 128 + d4);
        const f32x4 o = o0 - o1 * lam;
        const float ss = wave_sum((o[0] * o[0] + o[1] * o[1]) + (o[2] * o[2] + o[3] * o[3])); const float rstd = 1.0f / sqrtf(ss * (1.0f / DV) + EPS);
        v2u w; w.x = pk2(o[0] * rstd * g[0] * post, o[1] * rstd * g[1] * post); w.y = pk2(o[2] * rstd * g[2] * post, o[3] * rstd * g[3] * post);
        *(v2u*)(cat + (size_t)m * DM + h * 256 + half * 128 + d4) = w;
    }
}

constexpr int GM_WL = 0, GM_WLS = 272, GM_VT = 128 * GM_WLS, GM_VTS = 272, GM_RS = GM_VT + 256 * GM_VTS;
static_assert(GM_RS + 512 <= RING_BYTES, "gmlp LDS");
__device__ __forceinline__ void gmlp_phase(const Frame& F, const bf16r* ZA, const float* vstat, const float* w_s  , const float* b_s  , const float* gv  , bf16r* cat) {
    const int tid = F.tid, lane = F.lane, wave = F.wave, fr = lane & 15, fq = lane >> 4;
    LAS unsigned char* lds = F.lds;
    LAS float* rs = (LAS float*)(lds + GM_RS);
    for (int unit = F.vcu; unit < 128 * GG; unit += F.G) {
        const int bc = unit / GG, g = unit % GG, r0 = bc * 128;
        if (tid < 128) { const f32x4* p = (const f32x4*)(vstat + (size_t)(r0 + tid) * 24); float s = 0.f;
#pragma unroll
            for (int i = 0; i < 6; ++i) { const f32x4 v = p[i]; s += (v[0] + v[1]) + (v[2] + v[3]); }
            rs[tid] = 1.0f / sqrtf(s * (1.0f / MIXW) + EPS); }
        { const int s = tid & 127, cb = (tid >> 7) * 8;
#pragma unroll
          for (int it = 0; it < 8; ++it) { const int d8 = (cb + it) * 8; const bf16x8 v = *(const bf16x8*)(ZA + (size_t)(r0 + s) * 3072 + 1536 + g * 256 + d8);
#pragma unroll
              for (int e = 0; e < 8; ++e) *(LAS unsigned short*)(lds + GM_VT + (d8 + e) * GM_VTS + s * 2) = (unsigned short)v[e]; } }
        __syncthreads();
        for (int idx = tid; idx < 128 * 32; idx += 512) { const int t = idx >> 5, s4 = (idx & 31) * 4; const f32x4 w = *(const f32x4*)(w_s + ((size_t)g * 128 + t) * 128 + s4);
            float e[4];
#pragma unroll
            for (int j = 0; j < 4; ++j) e[j] = (s4 + j <= t) ? w[j] * rs[s4 + j] : 0.f;
            v2u o; o.x = pk2(e[0], e[1]); o.y = pk2(e[2], e[3]); *(LAS v2u*)(lds + GM_WL + t * GM_WLS + s4 * 2) = o; }
        __syncthreads();
        f32x4 acc[8][2];
#pragma unroll
        for (int tt = 0; tt < 8; ++tt) { acc[tt][0] = (f32x4){0.f, 0.f, 0.f, 0.f}; acc[tt][1] = (f32x4){0.f, 0.f, 0.f, 0.f}; }
#pragma unroll
        for (int ks = 0; ks < 4; ++ks) {
            bf16x8 bfr[2];
#pragma unroll
            for (int dd = 0; dd < 2; ++dd) bfr[dd] = *(const LAS bf16x8*)(lds + GM_VT + (32 * wave + 16 * dd + fr) * GM_VTS + (32 * ks + 8 * fq) * 2);
#pragma unroll
            for (int tt = 0; tt < 8; ++tt) { if (32 * ks <= 16 * tt + 15) {
                const bf16x8 afr = *(const LAS bf16x8*)(lds + GM_WL + (16 * tt + fr) * GM_WLS + (32 * ks + 8 * fq) * 2);
#pragma unroll
                for (int dd = 0; dd < 2; ++dd) acc[tt][dd] = __builtin_amdgcn_mfma_f32_16x16x32_bf16(bfr[dd], afr, acc[tt][dd], 0, 0, 0); } }
        }
#pragma unroll
        for (int tt = 0; tt < 8; ++tt) { const int t = 16 * tt + fr, row = r0 + t; const float bias = b_s[g * 128 + t];
#pragma unroll
            for (int dd = 0; dd < 2; ++dd) { const int d = 32 * wave + 16 * dd + 4 * fq; const f32x4 gg = *(const f32x4*)(gv + g * 256 + d);
                const v2u uu = *(const v2u*)(ZA + (size_t)row * 3072 + g * 256 + d);
                const float u0 = bf2f((unsigned short)(uu.x & 0xffff)), u1 = bf2f((unsigned short)(uu.x >> 16)), u2 = bf2f((unsigned short)(uu.y & 0xffff)), u3 = bf2f((unsigned short)(uu.y >> 16));
                const f32x4 a = acc[tt][dd]; v2u o; o.x = pk2(u0 * (a[0] * gg[0] + bias), u1 * (a[1] * gg[1] + bias)); o.y = pk2(u2 * (a[2] * gg[2] + bias), u3 * (a[3] * gg[3] + bias));
                *(v2u*)(cat + (size_t)row * DM + g * 256 + d) = o; } }
        __syncthreads();
    }
}
namespace att {
__device__ __forceinline__ BlockRef<bf16, float> diff_ref(int L, int pass, const bf16* Q, const bf16* K, const bf16* V, float* O) {
    const int vh = L >> 3, x = L & 7, qb = pass ? 15 - x : x;
    const int b = vh / 24, r = vh % 24, h = r >> 2, c = (r >> 1) & 1, half = r & 1;
    BlockRef<bf16, float> R;
    R.Q = Q + ((size_t)((b * 2 + c) * 6 + h) * SEQ + (size_t)qb * QB) * D; R.K = K + (size_t)((b * 2 + c) * 6 + h) * SEQ * D; R.V = V + (size_t)((b * 6 + h) * 2 + half) * SEQ * D;
    R.O = O + ((size_t)vh * SEQ + (size_t)qb * QB) * D; R.P0 = qb * QB; R.ldo = D;
    return R;
}
__device__ __forceinline__ void diff_attn_phase(char* lds, const bf16* Q, const bf16* K, const bf16* V, float* O, int G, int c0) {
    constexpr int total = 96 * 8; const int W = 1 << 30;
    int L = c0; if (L >= total) return;
    int pass = 0; BlockRef<bf16, float> cur = diff_ref(L, 0, Q, K, V, O);
    Seam<bf16> S;
    causal_swa_prime<bf16, float>(cur, W, lds, S);
    for (;;) {
        const bool more_pass = pass == 0, more_item = L + G < total, last = !more_pass && !more_item;
        int passn = pass + 1, Ln = L;
        if (!more_pass) { passn = 0; Ln = more_item ? L + G : L; }
        const BlockRef<bf16, float> nxt = last ? cur : diff_ref(Ln, passn, Q, K, V, O);
        causal_swa_block<bf16, float>(cur, nxt, SEQ, W, lds, S);
        if (last) break;
        cur = nxt; pass = passn; L = Ln;
    }
}
__device__ __forceinline__ BlockRef<bf16, bf16> mem_ref(int L, const bf16* Q, const bf16* K, const bf16* V, bf16* cat) {
    const int bh = L >> 4, qb = L & 15, b = bh >> 2, hm = bh & 3;
    BlockRef<bf16, bf16> R;
    R.Q = Q + ((size_t)bh * SEQ + (size_t)qb * QB) * D; R.K = K + (size_t)bh * MEML * D; R.V = V + (size_t)bh * MEML * D;
    R.O = cat + ((size_t)b * SEQ + (size_t)qb * QB) * DM + 1536 + hm * 128; R.P0 = 256; R.ldo = DM;
    return R;
}
__device__ __forceinline__ void mem_attn_phase(char* lds, const bf16* Q, const bf16* K, const bf16* V, bf16* cat, int G, int c0) {
    constexpr int total = 256; const int W = 1 << 30;
    int L = c0; if (L >= total) return;
    BlockRef<bf16, bf16> cur = mem_ref(L, Q, K, V, cat);
    Seam<bf16> S;
    causal_swa_prime<bf16, bf16>(cur, W, lds, S);
    for (;;) {
        const bool last = L + G >= total;
        const BlockRef<bf16, bf16> nxt = last ? cur : mem_ref(L + G, Q, K, V, cat);
        causal_swa_block<bf16, bf16>(cur, nxt, MEML, W, lds, S);
        if (last) break;
        cur = nxt; L += G;
    }
}
}

constexpr int NPL = 12, PH_BASE = 3, NPH = PH_BASE + DEPTH * NPL;
enum { I_X = 0, I_MEM, I_NORMG, I_WGU, I_WDN, I_WOUT, I_MEMNG, I_MEMWKV, I_MEMQG, I_MEMKG, I_AWIN, I_AVG, I_AWS, I_ABS, I_KVG, I_WKV, I_KG, I_BWIN, I_BQG, I_BLAM, I_BSUBG, N_IN };
struct Args { const float* in[N_IN]; float* out; unsigned char* ws; int ph_lo, ph_hi, li, pad; };

#ifndef EN_MASK
#define EN_MASK 0xFFFFFFFFu
#endif
#define SITE(n) (((EN_MASK) >> (n)) & 1u)
#define IN(k) (lo <= (k) && (k) < hi)
#define SEAM(k) do { if (IN((k) + 1)) xcd_barrier(bar); } while (0)
#define CAS __attribute__((address_space(4)))
#define WS_PTRS \
    const CAS Args* ap = (const CAS Args*)__builtin_amdgcn_kernarg_segment_ptr(); asm volatile("" : "+s"(ap)); \
    unsigned char* const ws = ap->ws; \
    bf16r* const Wgu = (bf16r*)(ws + WS_WGU); bf16r* const Wdn = (bf16r*)(ws + WS_WDN); bf16r* const Wout = (bf16r*)(ws + WS_WOUT); bf16r* const Wmem = (bf16r*)(ws + WS_WMEM); \
    bf16r* const Wain = (bf16r*)(ws + WS_WAIN); bf16r* const Wkv = (bf16r*)(ws + WS_WKV); bf16r* const Wbin = (bf16r*)(ws + WS_WBIN); \
    float* const cosT = (float*)(ws + WS_COS); float* const sinT = (float*)(ws + WS_SIN); \
    bf16r* const MEMN = (bf16r*)(ws + WS_MEMN); float* const MKVR = (float*)(ws + WS_MKVR); bf16r* const MK = (bf16r*)(ws + WS_MK); bf16r* const MV = (bf16r*)(ws + WS_MV); \
    bf16r* const HN = (bf16r*)(ws + WS_HN); bf16r* const HKV = (bf16r*)(ws + WS_HKV); bf16r* const HID = (bf16r*)(ws + WS_HID); bf16r* const ZA = (bf16r*)(ws + WS_ZA); \
    float* const VSTAT = (float*)(ws + WS_VSTAT); float* const QMRAW = (float*)(ws + WS_QMRAW); float* const QRAW = (float*)(ws + WS_QRAW); \
    bf16r* const QB_ = (bf16r*)(ws + WS_QB); bf16r* const KSH = (bf16r*)(ws + WS_KSH); bf16r* const VSH = (bf16r*)(ws + WS_VSH); bf16r* const QMB = (bf16r*)(ws + WS_QMB); \
    float* const OATT = (float*)(ws + WS_OATT); bf16r* const CAT = (bf16r*)(ws + WS_CAT); \
    float* const X = ap->out; \
    (void)Wgu; (void)Wdn; (void)Wout; (void)Wmem; (void)Wain; (void)Wkv; (void)Wbin; (void)cosT; (void)sinT; (void)MEMN; (void)MKVR; (void)MK; (void)MV; (void)HN; (void)HKV; (void)HID; (void)ZA; \
    (void)VSTAT; (void)QMRAW; (void)QRAW; (void)QB_; (void)KSH; (void)VSH; (void)QMB; (void)OATT; (void)CAT; (void)X;

template <int L, int S>
__device__ __forceinline__ void ffn_part(const Frame& F, const XcdBarrier& bar, unsigned char* smem, const int lo, const int hi) {
    constexpr int pf = PH_BASE + L * NPL + (S ? 9 : 0);
    if (SITE(3) && IN(pf)) { WS_PTRS
        pg8::Gemm g{HN, Wgu + (size_t)(L * 2 + S) * NGU * DM, M, NGU, DM}; pg8::StaticOrder So; So.init(M, NGU, F.G, (int)blockIdx.x);
        pg8::EpiSwiglu E{HID, FF};
        pg8::gemm_phase<pg8::EpiSwiglu, pg8::StaticOrder, true, true>(F.lds + RING_OFF, g, So, E);
        if constexpr (L == NA && S == 0) {
            pg8::Gemm g2{HKV, Wkv, M, NKV, DM}; pg8::StaticOrder S2; S2.init(M, NKV, F.G, (int)blockIdx.x);
            pg8::EpiKv E2{QRAW, VSH};
            pg8::gemm_phase<pg8::EpiKv, pg8::StaticOrder, true, true>(F.lds + RING_OFF, g2, S2, E2);
        }
        SEAM(pf);
    }
    if (SITE(4) && IN(pf + 1)) { WS_PTRS
        pg8::Gemm g{HID, Wdn + (size_t)(L * 2 + S) * DM * FF, M, DM, FF}; pg8::StaticOrder So; So.init(M, DM, F.G, (int)blockIdx.x);
        pg8::EpiResid E{(L == 0 && S == 0) ? ap->in[I_X] : X, X, DM, 0.5f};
        pg8::gemm_phase<pg8::EpiResid, pg8::StaticOrder, true, true>(F.lds + RING_OFF, g, So, E);
        SEAM(pf + 1);
    }
    if (SITE(5) && IN(pf + 2)) { WS_PTRS
        if constexpr (S == 0) { norm_phase(F, X, ap->in[I_NORMG] + (size_t)(L * 3 + 1) * DM, HN, nullptr, nullptr);
            if constexpr (L == NA) qk_prep_phase(F, QRAW, ap->in[I_KG], cosT, sinT, KSH); }
        else if constexpr (L + 1 < DEPTH) norm_phase(F, X, ap->in[I_NORMG] + (size_t)((L + 1) * 3) * DM, HN, (L + 1 == NA) ? ap->in[I_KVG] : nullptr, HKV);
        SEAM(pf + 2);
    }
}
template <int L>
__device__ __forceinline__ void mixer_part(const Frame& F, const XcdBarrier& bar, unsigned char* smem, const int lo, const int hi) {
    constexpr int pb = PH_BASE + L * NPL;
    if (SITE(6) && IN(pb + 3)) { WS_PTRS
        if constexpr (L < NA) { pg8::Gemm g{HN, Wain + (size_t)L * NAIN * DM, M, NAIN, DM}; pg8::StaticOrder So; So.init(M, NAIN, F.G, (int)blockIdx.x);
            pg8::EpiAin E{ZA, VSTAT, QMRAW};
            pg8::gemm_phase<pg8::EpiAin, pg8::StaticOrder, true, true>(F.lds + RING_OFF, g, So, E); }
        else { pg8::Gemm g{HN, Wbin + (size_t)(L - NA) * NBIN * DM, M, NBIN, DM}; pg8::StaticOrder So; So.init(M, NBIN, F.G, (int)blockIdx.x);
            pg8::EpiF32Split E{QRAW, 1536, 6, QMRAW, 512, 0};
            pg8::gemm_phase<pg8::EpiF32Split, pg8::StaticOrder, true, true>(F.lds + RING_OFF, g, So, E); }
        SEAM(pb + 3);
    }
    if (SITE(7) && IN(pb + 4)) { WS_PTRS
        qm_prep_phase(F, QMRAW, ap->in[I_MEMQG] + L * HD, QMB);
        if constexpr (L >= NA) qk_prep_phase(F, QRAW, ap->in[I_BQG] + (L - NA) * HD, cosT, sinT, QB_);
        SEAM(pb + 4);
    }
    if (SITE(8) && IN(pb + 5)) { WS_PTRS
        if constexpr (L < NA) gmlp_phase(F, ZA, VSTAT, ap->in[I_AWS] + (size_t)L * GG * 128 * 128, ap->in[I_ABS] + (size_t)L * GG * 128, ap->in[I_AVG] + (size_t)L * MIXW, CAT);
        else att::diff_attn_phase((char*)smem, (const att::bf16*)QB_, (const att::bf16*)KSH, (const att::bf16*)VSH, OATT, F.G, F.vcu);
        att::mem_attn_phase((char*)smem, (const att::bf16*)QMB, (const att::bf16*)(MK + (size_t)L * 1024 * 512), (const att::bf16*)(MV + (size_t)L * 1024 * 512), (att::bf16*)CAT, F.G, F.vcu);
        SEAM(pb + 5);
    }
    if constexpr (L >= NA) {
        if (SITE(9) && IN(pb + 6)) { WS_PTRS constexpr float lam_init = (L == 2) ? 0.47071301834358416f : 0.5560582041556405f;
            combine_phase(F, OATT, ap->in[I_BLAM] + (size_t)(L - NA) * 512, ap->in[I_BSUBG] + (size_t)(L - NA) * DV, lam_init, CAT);
            SEAM(pb + 6); }
    }
    if (SITE(10) && IN(pb + 7)) { WS_PTRS
        pg8::Gemm g{CAT, Wout + (size_t)L * DM * DM, M, DM, DM}; pg8::StaticOrder So; So.init(M, DM, F.G, (int)blockIdx.x);
        pg8::EpiResid E{X, X, DM, 1.0f};
        pg8::gemm_phase<pg8::EpiResid, pg8::StaticOrder, true, true>(F.lds + RING_OFF, g, So, E);
        SEAM(pb + 7);
    }
    if (SITE(11) && IN(pb + 8)) { WS_PTRS norm_phase(F, X, ap->in[I_NORMG] + (size_t)(L * 3 + 2) * DM, HN, nullptr, nullptr); SEAM(pb + 8); }
}

__global__ void __launch_bounds__(NWAVES * 64, 2) yoco_fwd(Args args) {
    extern __shared__ __attribute__((aligned(16))) unsigned char smem[];
    Frame F;
    F.lds_g = smem; F.lds = (LAS unsigned char*)smem;
    F.MISC = (volatile LAS unsigned*)(F.lds + MISC_OFF);
    F.tid = threadIdx.x; F.lane = F.tid & 63; F.wave = __builtin_amdgcn_readfirstlane(F.tid >> 6);
    F.G = gridDim.x; { const int bx = blockIdx.x; F.vcu = (F.G % 8 == 0) ? (bx % 8) * (F.G / 8) + bx / 8 : bx; }
    F.ws = args.ws;
    F.ctl = (gu32*)(args.ws + WS_CTL);
    for (int u = F.tid; u < (LDS_BYTES - LDSCTL_OFF) / 4; u += NWAVES * 64) ((LAS unsigned*)(F.lds + LDSCTL_OFF))[u] = 0u;
    __syncthreads();
    XcdBarrier bar = xcd_barrier_post((unsigned*)F.ctl + (size_t)args.li * XCD_BAR_WORDS, F.MISC + 8);
    const int lo = args.ph_lo, hi = args.ph_hi;
    {
    const int gw = F.vcu * NWAVES + F.wave, NGW = F.G * NWAVES;
    if (SITE(0) && IN(0)) { WS_PTRS
        LAS float* scr = (LAS float*)(F.lds + RING_OFF + F.wave * 16640);
        constexpr int NIT = 8 * (DM / 64) * (NGU / 64) + 8 * (FF / 64) * (DM / 64) + 4 * 32 * 32 + 4 * 32 * 16 + 2 * 32 * (NAIN / 64) + 32 * (NKV / 64) + 2 * 32 * 32;
        for (int it = gw; it < NIT; it += NGW) { int r = it;
            if (transpose_group(r, ap->in[I_WGU], 8, DM, NGU, Wgu, true, scr, F.lane)) continue;
            if (transpose_group(r, ap->in[I_WDN], 8, FF, DM, Wdn, false, scr, F.lane)) continue;
            if (transpose_group(r, ap->in[I_WOUT], 4, DM, DM, Wout, false, scr, F.lane)) continue;
            if (transpose_group(r, ap->in[I_MEMWKV], 4, DM, 1024, Wmem, false, scr, F.lane)) continue;
            if (transpose_group(r, ap->in[I_AWIN], 2, DM, NAIN, Wain, false, scr, F.lane)) continue;
            if (transpose_group(r, ap->in[I_WKV], 1, DM, NKV, Wkv, false, scr, F.lane)) continue;
            transpose_group(r, ap->in[I_BWIN], 2, DM, NBIN, Wbin, false, scr, F.lane); }
        for (int i = gw * 64 + F.lane; i < SEQ * 64; i += NGW * 64) { const int pos = i >> 6, k = i & 63; const float inv = (float)pow(10000.0, -(double)k / 64.0); const float ang = (float)pos * inv;
            float sn, cs; sincos_d(ang, sn, cs); cosT[i] = cs; sinT[i] = sn; }
        for (int r = gw; r < 4096; r += NGW) { const int l = r >> 10, mm = r & 1023; norm_row(ap->in[I_MEM] + (size_t)mm * DM, ap->in[I_MEMNG] + l * DM, MEMN + (size_t)r * DM, F.lane); }
        norm_phase(F, ap->in[I_X], ap->in[I_NORMG], HN, nullptr, nullptr);
        SEAM(0);
    }
    if (SITE(1) && IN(1)) { WS_PTRS
        pg8::Gemm g{MEMN, Wmem, 4096, 4096, DM}; pg8::MemKvOrder So{F.G, (int)blockIdx.x};
        pg8::EpiF32Split E{MKVR, 1024, 4, MKVR, 1024, 4};
        pg8::gemm_phase<pg8::EpiF32Split, pg8::MemKvOrder, true, true>(F.lds + RING_OFF, g, So, E);
        SEAM(1);
    }
    if (SITE(2) && IN(2)) { WS_PTRS mem_prep_phase(F, MKVR, ap->in[I_MEMKG], MK, MV); SEAM(2); }
    }
    ffn_part<0, 0>(F, bar, smem, lo, hi); mixer_part<0>(F, bar, smem, lo, hi); ffn_part<0, 1>(F, bar, smem, lo, hi);
    ffn_part<1, 0>(F, bar, smem, lo, hi); mixer_part<1>(F, bar, smem, lo, hi); ffn_part<1, 1>(F, bar, smem, lo, hi);
    ffn_part<2, 0>(F, bar, smem, lo, hi); mixer_part<2>(F, bar, smem, lo, hi); ffn_part<2, 1>(F, bar, smem, lo, hi);
    ffn_part<3, 0>(F, bar, smem, lo, hi); mixer_part<3>(F, bar, smem, lo, hi); ffn_part<3, 1>(F, bar, smem, lo, hi);
}
#undef IN
#undef SEAM

#ifndef MK_MODE
#define MK_MODE 1
#endif
extern "C" void kernel_launch(void* const* d_in, const int* in_sizes, int n_in, void* d_out, int out_size, void* d_ws, size_t ws_size, hipStream_t stream) {
    static int grid = 0;
    if (grid == 0) {
        if (n_in != N_IN || out_size != M * DM || ws_size < WS_END) { fprintf(stderr, "kernel_launch: unexpected shapes: n_in %d out %d ws %zu (need %zu)\n", n_in, out_size, ws_size, (size_t)WS_END); grid = -1; return; }
        int dev = 0, cus = 0, per_cu = 0;
        if (hipGetDevice(&dev) != hipSuccess || hipDeviceGetAttribute(&cus, hipDeviceAttributeMultiprocessorCount, dev) != hipSuccess) { grid = -1; return; }
        if (hipFuncSetAttribute((const void*)yoco_fwd, hipFuncAttributeMaxDynamicSharedMemorySize, LDS_BYTES) != hipSuccess) { fprintf(stderr, "kernel_launch: hipFuncSetAttribute failed\n"); grid = -1; return; }
        if (hipOccupancyMaxActiveBlocksPerMultiprocessor(&per_cu, (const void*)yoco_fwd, NWAVES * 64, LDS_BYTES) != hipSuccess || per_cu < 1) fprintf(stderr, "kernel_launch: occupancy query says %d blocks per CU\n", per_cu);
        (void)hipGetLastError();
        grid = cus;
    }
    if (grid < 0) return;
    (void)in_sizes;
    if (hipMemsetAsync((char*)d_ws + WS_CTL, 0, CTL_ZERO_BYTES, stream) != hipSuccess) return;
    Args a{};
    for (int i = 0; i < N_IN; ++i) a.in[i] = (const float*)d_in[i];
    a.out = (float*)d_out; a.ws = (unsigned char*)d_ws; a.pad = 0;
#if MK_MODE == 1
    a.ph_lo = 0; a.ph_hi = NPH; a.li = 0;
    hipLaunchKernelGGL(yoco_fwd, dim3(grid), dim3(NWAVES * 64), LDS_BYTES, stream, a);
#else
    for (int p = 0; p < NPH; ++p) {
        const int k = (p - PH_BASE) % NPL, l = (p - PH_BASE) / NPL;
        if (p >= PH_BASE && ((k == 6 && l < NA) || (k == 11 && l == DEPTH - 1))) continue;
        a.ph_lo = p; a.ph_hi = p + 1; a.li = 0;
        hipLaunchKernelGGL(yoco_fwd, dim3(grid), dim3(NWAVES * 64), LDS_BYTES, stream, a);
    }
#endif
}
```

```cpp
#include <hip/hip_runtime.h>
#include <hip/hip_bf16.h>
#include <cstdio>
#include <cstdint>

constexpr int BATCH = 4, SEQ = 4096, DM = 2048, DEPTH = 4, NA = 2;
constexpr int M = BATCH * SEQ;
constexpr int MEML = 256, HD = 128, MEMH = 4, MEMW = 512, MIXW = 1536, CHUNK = 128, GG = 6, GW = 256, DH = 6, DV = 256, FF = 5632;
constexpr int NGU = 2 * FF;
constexpr int NAIN = 2 * MIXW + MEMW;
constexpr int NBIN = MIXW + MEMW;
constexpr int NKV = 2 * DH * HD + DH * DV;
constexpr float EPS = 1e-6f;
namespace pg8 {
#define PG8_LAS __attribute__((address_space(3)))
typedef unsigned short bf16_t;
typedef short bf16x8 __attribute__((ext_vector_type(8)));
typedef float f32x4 __attribute__((ext_vector_type(4)));
typedef unsigned u32x4 __attribute__((ext_vector_type(4)));
constexpr int BM = 256, BK = 64, HALF = 128, HTB = HALF * BK * 2  , STAGE_BYTES = 8 * HTB, NXCD = 8, WGM = 8;

__host__ __device__ __forceinline__ int lds_byte(int r, int c) { const int st = (r >> 4) * 2 + (c >> 5), rr = r & 15, cc = c & 31, ob = rr * 64 + cc * 2; return st * 1024 + (ob ^ (((ob >> 9) & 1) << 5)); }
__host__ __device__ __forceinline__ void stage_rc(int b, int& R, int& C) { const int st = b / 1024, sb = b % 1024, swz = sb ^ (((sb >> 9) & 1) << 5); R = (st >> 1) * 16 + swz / 64; C = (st & 1) * 32 + (swz % 64) / 2; }
__host__ __device__ __forceinline__ int perm32(int rho) { const int n = rho >> 4, i = rho & 15; return 8 * (i >> 2) + 4 * n + (i & 3); }

struct Unit { int pm, pn; };
struct Gemm { const bf16_t* A; const bf16_t* Bt; int M, N, K; };

struct StaticOrder {
    int nM, nN, nwg, G, c;
    __host__ __device__ void init(int M, int N, int G_, int c_) { nM = M / BM; nN = N / BM; nwg = nM * nN; G = G_; c = c_; }
    __host__ __device__ bool next(int i, Unit& u) const {
        const long L = (long)i * G + c; if (L >= nwg) return false;
        int wgid = (int)L; { const int q = nwg / NXCD, r = nwg % NXCD, xcd = wgid % NXCD, off = wgid / NXCD; wgid = (xcd < r ? xcd * (q + 1) : r * (q + 1) + (xcd - r) * q) + off; }
        const int nig = WGM * nN, gid = wgid / nig, fm = gid * WGM, gsz = (nM - fm) < WGM ? (nM - fm) : WGM;
        u.pm = fm + ((wgid % nig) % gsz); u.pn = (wgid % nig) / gsz; return true;
    }
    __device__ __forceinline__ void a_ready(const Unit&) const {}
    __device__ __forceinline__ void done(const Unit&) const {}
};
__device__ __forceinline__ unsigned cvt_pk_bf16(float lo, float hi) { unsigned r; asm volatile("v_cvt_pk_bf16_f32 %0, %1, %2" : "=v"(r) : "v"(lo), "v"(hi)); return r; }
typedef float f32x2 __attribute__((ext_vector_type(2)));
typedef unsigned u32x2 __attribute__((ext_vector_type(2)));
__device__ __forceinline__ f32x2 gelu_pk(f32x2 v) {
    const f32x2 av = __builtin_elementwise_abs(v), d = av * 0.2316418882f + 1.0f;
    f32x2 t; t.x = __builtin_amdgcn_rcpf(d.x); t.y = __builtin_amdgcn_rcpf(d.y);
    f32x2 q = t * 0.5307027145f + (-0.7265760135f); q = q * t + 0.7107068705f; q = q * t + (-0.142248368f); q = q * t + 0.127414796f; q = q * t;
    const f32x2 s = (v * v) * (-0.72134752044f);
    f32x2 e; e.x = __builtin_amdgcn_exp2f(s.x); e.y = __builtin_amdgcn_exp2f(s.y);
    const f32x2 m = v * (q * e), r = v - m;
    f32x2 o; o.x = v.x < 0.f ? m.x : r.x; o.y = v.y < 0.f ? m.y : r.y; return o;
}
__device__ __forceinline__ float silu_f(float g) { return g * __builtin_amdgcn_rcpf(1.0f + __builtin_amdgcn_exp2f(-1.4426950408889634f * g)); }
__device__ __forceinline__ u32x4 pack8_bf16(f32x4 a, f32x4 b) { u32x4 w; w.x = cvt_pk_bf16(a[0], a[1]); w.y = cvt_pk_bf16(a[2], a[3]); w.z = cvt_pk_bf16(b[0], b[1]); w.w = cvt_pk_bf16(b[2], b[3]); return w; }

__host__ __device__ __forceinline__ size_t blk_off(int row, int col, int kt) { return ((size_t)((row >> 8) * kt + (col >> 6)) << 14) + ((row & 255) << 6) + (col & 63); }
struct RowScale { const PG8_LAS float* rtab; };
__device__ __forceinline__ void get_rstd(float (&rs)[2][4], const RowScale& R, int wr, int fr) {
#pragma unroll
    for (int ai = 0; ai < 2; ++ai)
#pragma unroll
        for (int m = 0; m < 4; ++m) rs[ai][m] = R.rtab ? R.rtab[2 * (ai * HALF + wr * 64 + m * 16 + fr)] : 1.0f;
}
struct EpiSwiglu {
    static constexpr bool PERM = true, AFTER_DRAIN = false;
    static __host__ __device__ __forceinline__ int bmap(int R) { return (R & ~31) + perm32(R & 31); }
    bf16_t* H; int ldh; RowScale R;
    __device__ __forceinline__ void operator()(const f32x4 (&acc)[2][2][4][2], const Unit& u, int wr, int wc, int fr, int fq) const {
        const int row0 = u.pm * BM + wr * 64 + fr, col0 = u.pn * HALF + wc * 32 + 8 * fq;
#pragma unroll
        for (int ai = 0; ai < 2; ++ai)
#pragma unroll
            for (int m = 0; m < 4; ++m) { const f32x2 rv = *(const PG8_LAS f32x2*)(R.rtab + 2 * (ai * HALF + wr * 64 + m * 16 + fr)); const float c1 = -1.4426950408889634f * rv.x, v = rv.y;
                const f32x4 g0 = acc[ai][0][m][0], g1 = acc[ai][0][m][1], u0 = acc[ai][1][m][0], u1 = acc[ai][1][m][1];
                f32x4 h0, h1;
#pragma unroll
                for (int j = 0; j < 4; ++j) { const float e0 = __builtin_amdgcn_exp2f(g0[j] * c1), e1 = __builtin_amdgcn_exp2f(g1[j] * c1);
                    h0[j] = (g0[j] * u0[j]) * __builtin_amdgcn_rcpf(__builtin_fmaf(e0, v, v)); h1[j] = (g1[j] * u1[j]) * __builtin_amdgcn_rcpf(__builtin_fmaf(e1, v, v)); }
                *(u32x4*)(H + blk_off(row0 + ai * HALF + m * 16, col0, ldh >> 6)) = pack8_bf16(h0, h1);
            }
    }
};
struct EpiResid {
    static constexpr bool PERM = true, AFTER_DRAIN = false;
    static __host__ __device__ __forceinline__ int bmap(int R) { return (R & ~31) + perm32(R & 31); }
    const float* base_f32; float* out_f32; int ld; float scale; bf16_t* xb; float* ss; _Float16* xh;
    typedef _Float16 h8 __attribute__((ext_vector_type(8)));
    static __device__ __forceinline__ void one(const f32x4 b0, const f32x4 b1, const f32x4 a0, const f32x4 a1, int row, int col, size_t off, float& s, float scale, float* out_f32, _Float16* xh, bf16_t* xb, int ld) {
        const f32x4 o0 = b0 + a0 * scale, o1 = b1 + a1 * scale;
        if (out_f32) { *(f32x4*)(out_f32 + off) = o0; *(f32x4*)(out_f32 + off + 4) = o1; }
        else { h8 w; w[0] = (_Float16)o0[0]; w[1] = (_Float16)o0[1]; w[2] = (_Float16)o0[2]; w[3] = (_Float16)o0[3]; w[4] = (_Float16)o1[0]; w[5] = (_Float16)o1[1]; w[6] = (_Float16)o1[2]; w[7] = (_Float16)o1[3];
            *(h8*)(xh + off) = w;
            *(u32x4*)(xb + blk_off(row, col, ld >> 6)) = pack8_bf16(o0, o1);
            s += ((o0[0] * o0[0] + o0[1] * o0[1]) + (o0[2] * o0[2] + o0[3] * o0[3])) + ((o1[0] * o1[0] + o1[1] * o1[1]) + (o1[2] * o1[2] + o1[3] * o1[3])); }
    }
    __device__ __forceinline__ void operator()(const f32x4 (&acc)[2][2][4][2], const Unit& u, int wr, int wc, int fr, int fq) const {
        const int row0 = u.pm * BM + wr * 64 + fr, col0 = u.pn * BM + wc * 32 + 8 * fq;
        const float scale_ = scale; float* const out_ = out_f32; _Float16* const xh_ = xh; bf16_t* const xb_ = xb; const int ld_ = ld;
        if (base_f32) {
#pragma unroll
            for (int ai = 0; ai < 2; ++ai)
#pragma unroll
                for (int m = 0; m < 4; ++m) { const int row = row0 + ai * HALF + m * 16; const size_t off = (size_t)row * ld + col0; float s = 0.f;
#pragma unroll
                    for (int bj = 0; bj < 2; ++bj) one(*(const f32x4*)(base_f32 + off + bj * HALF), *(const f32x4*)(base_f32 + off + bj * HALF + 4), acc[ai][bj][m][0], acc[ai][bj][m][1], row, col0 + bj * HALF, off + bj * HALF, s, scale_, out_, xh_, xb_, ld_);
                    if (!out_f32) { s += __shfl_xor(s, 16); s += __shfl_xor(s, 32); if (fq == 0) ss[(size_t)row * 32 + u.pn * 4 + wc] = s; }
                    asm volatile("" ::: "memory"); }
            return;
        }
#pragma unroll
        for (int ai = 0; ai < 2; ++ai) {
            h8 w[4][2];
#pragma unroll
            for (int m = 0; m < 4; ++m)
#pragma unroll
                for (int bj = 0; bj < 2; ++bj) w[m][bj] = *(const h8*)(xh + (size_t)(row0 + ai * HALF + m * 16) * ld + col0 + bj * HALF);
#pragma unroll
            for (int m = 0; m < 4; ++m) { const int row = row0 + ai * HALF + m * 16; const size_t off = (size_t)row * ld + col0; float s = 0.f;
#pragma unroll
                for (int bj = 0; bj < 2; ++bj) { const h8 v = w[m][bj];
                    one((f32x4){(float)v[0], (float)v[1], (float)v[2], (float)v[3]}, (f32x4){(float)v[4], (float)v[5], (float)v[6], (float)v[7]}, acc[ai][bj][m][0], acc[ai][bj][m][1], row, col0 + bj * HALF, off + bj * HALF, s, scale_, out_, xh_, xb_, ld_); }
                if (!out_f32) { s += __shfl_xor(s, 16); s += __shfl_xor(s, 32); if (fq == 0) ss[(size_t)row * 32 + u.pn * 4 + wc] = s; } }
            asm volatile("" ::: "memory");
        }
    }
};
__device__ __forceinline__ void head_ss_put(PG8_LAS float* ex, int rl, int bj, int wc, int fq, float s) { s += __shfl_xor(s, 16); s += __shfl_xor(s, 32); if (fq == 0) ex[(rl * 2 + bj) * 4 + wc] = s; }
__device__ __forceinline__ float head_rstd_get(const PG8_LAS float* ex, int rl, int bj) { const f32x4 p = *(const PG8_LAS f32x4*)(ex + (rl * 2 + bj) * 4); return 1.0f / sqrtf(((p[0] + p[1]) + (p[2] + p[3])) * (1.0f / 128.0f) + 1e-6f); }
#define PG8_EPI_BARRIER() do { asm volatile("s_waitcnt lgkmcnt(0)" ::: "memory"); __builtin_amdgcn_s_barrier(); asm volatile("" ::: "memory"); } while (0)
struct EpiAin {
    static constexpr bool PERM = true, AFTER_DRAIN = false;
    static __host__ __device__ __forceinline__ int bmap(int R) { return (R & ~31) + perm32(R & 31); }
    bf16_t* ZA; float* vstat; bf16_t* qmb; const float* gq; PG8_LAS float* ex; RowScale R;
    __device__ __forceinline__ void operator()(const f32x4 (&acc)[2][2][4][2], const Unit& u, int wr, int wc, int fr, int fq) const {
        const int row0 = u.pm * BM + wr * 64 + fr;
        float rs[2][4]; get_rstd(rs, R, wr, fr);
        if (u.pn < 12) {
            const int col0 = u.pn * BM + wc * 32 + 8 * fq; const bool st = u.pn >= 6;
#pragma unroll
            for (int ai = 0; ai < 2; ++ai)
#pragma unroll
                for (int m = 0; m < 4; ++m) { const int row = row0 + ai * HALF + m * 16; float sq = 0.f;
#pragma unroll
                    for (int bj = 0; bj < 2; ++bj) { f32x4 v0 = acc[ai][bj][m][0] * rs[ai][m], v1 = acc[ai][bj][m][1] * rs[ai][m];
                        f32x2 a = gelu_pk((f32x2){v0[0], v0[1]}), b = gelu_pk((f32x2){v0[2], v0[3]}), c = gelu_pk((f32x2){v1[0], v1[1]}), d = gelu_pk((f32x2){v1[2], v1[3]});
                        v0 = (f32x4){a.x, a.y, b.x, b.y}; v1 = (f32x4){c.x, c.y, d.x, d.y};
                        sq += (v0[0] * v0[0] + v0[1] * v0[1]) + (v0[2] * v0[2] + v0[3] * v0[3]) + (v1[0] * v1[0] + v1[1] * v1[1]) + (v1[2] * v1[2] + v1[3] * v1[3]);
                        *(u32x4*)(ZA + (size_t)row * 3072 + col0 + bj * HALF) = pack8_bf16(v0, v1); }
                    if (st) { sq += __shfl_xor(sq, 16); sq += __shfl_xor(sq, 32); if (fq == 0) vstat[(size_t)row * 24 + (u.pn - 6) * 4 + wc] = sq; } }
        } else {
            const int d0 = wc * 32 + 8 * fq; const f32x4 g0 = *(const f32x4*)(gq + d0), g1 = *(const f32x4*)(gq + d0 + 4);
#pragma unroll
            for (int ai = 0; ai < 2; ++ai)
#pragma unroll
                for (int m = 0; m < 4; ++m) { const int rl = ai * HALF + wr * 64 + m * 16 + fr;
#pragma unroll
                    for (int bj = 0; bj < 2; ++bj) { const f32x4 v0 = acc[ai][bj][m][0], v1 = acc[ai][bj][m][1];
                        head_ss_put(ex, rl, bj, wc, fq, (((v0[0] * v0[0] + v0[1] * v0[1]) + (v0[2] * v0[2] + v0[3] * v0[3])) + ((v1[0] * v1[0] + v1[1] * v1[1]) + (v1[2] * v1[2] + v1[3] * v1[3]))) * (rs[ai][m] * rs[ai][m])); } }
            PG8_EPI_BARRIER();
#pragma unroll
            for (int ai = 0; ai < 2; ++ai)
#pragma unroll
                for (int m = 0; m < 4; ++m) { const int rl = ai * HALF + wr * 64 + m * 16 + fr, row = u.pm * BM + rl, b = row >> 12, s = row & 4095;
#pragma unroll
                    for (int bj = 0; bj < 2; ++bj) { const float sc = rs[ai][m] * head_rstd_get(ex, rl, bj); const int hm = (u.pn - 12) * 2 + bj;
                        *(u32x4*)(qmb + ((size_t)(b * 4 + hm) * 4096 + s) * 128 + d0) = pack8_bf16(acc[ai][bj][m][0] * sc * g0, acc[ai][bj][m][1] * sc * g1); } }
        }
    }
};
struct EpiF32Split {
    static constexpr bool PERM = true, AFTER_DRAIN = false;
    static __host__ __device__ __forceinline__ int bmap(int R) { return (R & ~31) + perm32(R & 31); }
    float* d0; int ld0; int split; float* d1; int ld1; int pnmod; RowScale R;
    __device__ __forceinline__ void operator()(const f32x4 (&acc)[2][2][4][2], const Unit& u, int wr, int wc, int fr, int fq) const {
        const int row0 = u.pm * BM + wr * 64 + fr; int pn = pnmod ? (u.pn % pnmod) : u.pn; float* d = d0; int ld = ld0;
        if (pn >= split) { d = d1; ld = ld1; pn -= split; }
        const int col0 = pn * BM + wc * 32 + 8 * fq;
        float rs[2][4]; get_rstd(rs, R, wr, fr);
#pragma unroll
        for (int ai = 0; ai < 2; ++ai)
#pragma unroll
            for (int m = 0; m < 4; ++m) { float* p = d + (size_t)(row0 + ai * HALF + m * 16) * ld + col0;
#pragma unroll
                for (int bj = 0; bj < 2; ++bj) { *(f32x4*)(p + bj * HALF) = acc[ai][bj][m][0] * rs[ai][m]; *(f32x4*)(p + bj * HALF + 4) = acc[ai][bj][m][1] * rs[ai][m]; } }
    }
};
struct EpiQKRope {
    static constexpr bool PERM = true, AFTER_DRAIN = false;
    static __host__ __device__ __forceinline__ int bmap(int R) { return 64 * ((R >> 4) & 1) + 16 * (R >> 5) + (R & 15); }
    int kind; bf16_t* qk; bf16_t* other; const float* gr; const float* gn; const unsigned* cs; PG8_LAS float* ex; RowScale R;
    __device__ __forceinline__ void operator()(const f32x4 (&acc)[2][2][4][2], const Unit& u, int wr, int wc, int fr, int fq) const {
        typedef _Float16 h2 __attribute__((ext_vector_type(2)));
        float rs[2][4]; get_rstd(rs, R, wr, fr);
        const int d0 = 16 * wc + 4 * fq;
        const bool rope = u.pn < 6;
        if (!rope && kind == 1) {
            const int h = u.pn - 6;
#pragma unroll
            for (int ai = 0; ai < 2; ++ai)
#pragma unroll
                for (int m = 0; m < 4; ++m) { const int row = u.pm * BM + ai * HALF + wr * 64 + m * 16 + fr, b = row >> 12, s = row & 4095;
#pragma unroll
                    for (int bj = 0; bj < 2; ++bj) { bf16_t* p = other + ((size_t)((b * 6 + h) * 2 + bj) * 4096 + s) * 128 + d0;
#pragma unroll
                        for (int n = 0; n < 2; ++n) { const f32x4 v = acc[ai][bj][m][n] * rs[ai][m]; u32x2 w; w.x = cvt_pk_bf16(v[0], v[1]); w.y = cvt_pk_bf16(v[2], v[3]); *(u32x2*)(p + 64 * n) = w; } } }
            return;
        }
        const float* g = rope ? gr : gn; const f32x4 ga = *(const f32x4*)(g + d0), gb = *(const f32x4*)(g + 64 + d0);
        u32x4 cst[2][4];
        if (rope) {
#pragma unroll
            for (int ai = 0; ai < 2; ++ai)
#pragma unroll
                for (int m = 0; m < 4; ++m) { const int s = (u.pm * BM + ai * HALF + wr * 64 + m * 16 + fr) & 4095; cst[ai][m] = *(const u32x4*)(cs + (size_t)s * 64 + d0); }
        }
#pragma unroll
        for (int ai = 0; ai < 2; ++ai)
#pragma unroll
            for (int m = 0; m < 4; ++m) { const int rl = ai * HALF + wr * 64 + m * 16 + fr;
#pragma unroll
                for (int bj = 0; bj < 2; ++bj) { const f32x4 v0 = acc[ai][bj][m][0], v1 = acc[ai][bj][m][1];
                    head_ss_put(ex, rl, bj, wc, fq, (((v0[0] * v0[0] + v0[1] * v0[1]) + (v0[2] * v0[2] + v0[3] * v0[3])) + ((v1[0] * v1[0] + v1[1] * v1[1]) + (v1[2] * v1[2] + v1[3] * v1[3]))) * (rs[ai][m] * rs[ai][m])); } }
        PG8_EPI_BARRIER();
#pragma unroll
        for (int ai = 0; ai < 2; ++ai)
#pragma unroll
            for (int m = 0; m < 4; ++m) { const int rl = ai * HALF + wr * 64 + m * 16 + fr, row = u.pm * BM + rl, b = row >> 12, s = row & 4095;
#pragma unroll
                for (int bj = 0; bj < 2; ++bj) { const float sc = rs[ai][m] * head_rstd_get(ex, rl, bj);
                    f32x4 y0 = acc[ai][bj][m][0] * sc * ga, y1 = acc[ai][bj][m][1] * sc * gb; bf16_t* p;
                    if (rope) { f32x4 o0, o1;
#pragma unroll
                        for (int j = 0; j < 4; ++j) { const unsigned cw = cst[ai][m][j]; const h2 t = __builtin_bit_cast(h2, cw); const float c = (float)t.x, sn = (float)t.y; o0[j] = y0[j] * c - y1[j] * sn; o1[j] = y1[j] * c + y0[j] * sn; }
                        y0 = o0; y1 = o1; p = qk + ((size_t)(b * 12 + u.pn * 2 + bj) * 4096 + s) * 128 + d0; }
                    else p = other + ((size_t)(b * 4 + (u.pn - 6) * 2 + bj) * 4096 + s) * 128 + d0;
                    u32x2 w0, w1; w0.x = cvt_pk_bf16(y0[0], y0[1]); w0.y = cvt_pk_bf16(y0[2], y0[3]); w1.x = cvt_pk_bf16(y1[0], y1[1]); w1.y = cvt_pk_bf16(y1[2], y1[3]);
                    *(u32x2*)p = w0; *(u32x2*)(p + 64) = w1; } }
    }
};
struct ColSweepOrder {
    int c;
    __device__ bool next(int i, Unit& u) const { if (i >= 2) return false; const int xcd = c & 7, j = c >> 3; u.pm = 8 * xcd + 4 * i + (j & 3); u.pn = j >> 2; return true; }
    __device__ __forceinline__ void a_ready(const Unit&) const {}
    __device__ __forceinline__ void done(const Unit&) const {}
};
struct EpiMemKv {
    static constexpr bool PERM = true, AFTER_DRAIN = false;
    static __host__ __device__ __forceinline__ int bmap(int R) { return (R & ~31) + perm32(R & 31); }
    bf16_t* mk; bf16_t* mv; const float* gk; PG8_LAS float* ex;
    __device__ __forceinline__ void operator()(const f32x4 (&acc)[2][2][4][2], const Unit& u, int wr, int wc, int fr, int fq) const {
        const int t = u.pn & 3, d0 = wc * 32 + 8 * fq; const size_t base = (size_t)u.pm * 4;
        if (t < 2) {
            const f32x4 g0 = *(const f32x4*)(gk + (u.pm >> 2) * 128 + d0), g1 = *(const f32x4*)(gk + (u.pm >> 2) * 128 + d0 + 4);
#pragma unroll
            for (int ai = 0; ai < 2; ++ai)
#pragma unroll
                for (int m = 0; m < 4; ++m) { const int rl = ai * HALF + wr * 64 + m * 16 + fr;
#pragma unroll
                    for (int bj = 0; bj < 2; ++bj) { const f32x4 v0 = acc[ai][bj][m][0], v1 = acc[ai][bj][m][1];
                        head_ss_put(ex, rl, bj, wc, fq, ((v0[0] * v0[0] + v0[1] * v0[1]) + (v0[2] * v0[2] + v0[3] * v0[3])) + ((v1[0] * v1[0] + v1[1] * v1[1]) + (v1[2] * v1[2] + v1[3] * v1[3]))); } }
            PG8_EPI_BARRIER();
#pragma unroll
            for (int ai = 0; ai < 2; ++ai)
#pragma unroll
                for (int m = 0; m < 4; ++m) { const int rl = ai * HALF + wr * 64 + m * 16 + fr;
#pragma unroll
                    for (int bj = 0; bj < 2; ++bj) { const float sc = head_rstd_get(ex, rl, bj);
                        *(u32x4*)(mk + ((base + t * 2 + bj) * 256 + rl) * 128 + d0) = pack8_bf16(acc[ai][bj][m][0] * sc * g0, acc[ai][bj][m][1] * sc * g1); } }
        } else {
#pragma unroll
            for (int ai = 0; ai < 2; ++ai)
#pragma unroll
                for (int m = 0; m < 4; ++m) { const int rl = ai * HALF + wr * 64 + m * 16 + fr;
#pragma unroll
                    for (int bj = 0; bj < 2; ++bj) *(u32x4*)(mv + ((base + (t - 2) * 2 + bj) * 256 + rl) * 128 + d0) = pack8_bf16(acc[ai][bj][m][0], acc[ai][bj][m][1]); }
        }
    }
};
struct MemKvOrder {
    int G, c;
    __device__ bool next(int i, Unit& u) const { const int L = i * G + c; if (L >= 64) return false; const int layer = L >> 4, r = L & 15; u.pm = layer * 4 + (r >> 2); u.pn = layer * 4 + (r & 3); return true; }
    __device__ __forceinline__ void a_ready(const Unit&) const {}
    __device__ __forceinline__ void done(const Unit&) const {}
};
template <class Epi, class Sched, bool ALIGN_EPI = false, bool SP2 = false, bool ABLK = false, bool BBLK = false>
__device__ __forceinline__ void gemm_phase(PG8_LAS unsigned char* lds, const Gemm g, const Sched& S, const Epi& E) {
    int tid_ = threadIdx.x; asm volatile("" : "+v"(tid_));
    const int tid = tid_, wid = __builtin_amdgcn_readfirstlane(tid >> 6), lane = tid & 63, wr = wid >> 2, wc = wid & 3, fr = lane & 15, fq = lane >> 4;
    const int K = g.K, nt = K / BK;
    unsigned voffA[2], voffB[2];
#pragma unroll
    for (int i = 0; i < 2; ++i) { int R, C; stage_rc(tid * 16 + i * 8192, R, C); const int Rb = Epi::bmap(R);
        voffA[i] = ABLK ? (unsigned)(R * BK + C) * 2u : (unsigned)(R * K + C) * 2u; voffB[i] = BBLK ? (unsigned)(Rb * BK + C) * 2u : (unsigned)(Rb * K + C) * 2u; }
    const size_t kstepA = ABLK ? (size_t)(BM * BK * 2) : (size_t)(BK * 2), kstepB = BBLK ? (size_t)(BM * BK * 2) : (size_t)(BK * 2);
    const size_t hstepA = ABLK ? (size_t)(HALF * BK * 2) : (size_t)HALF * K * 2, hstepB = BBLK ? (size_t)(HALF * BK * 2) : (size_t)HALF * K * 2;
    const size_t tstep = (size_t)BM * K * 2;
#ifndef PG8_PF
#define PG8_PF 0
#endif
    PG8_LAS unsigned* const pfjunk = (PG8_LAS unsigned*)(lds + 143360 + wid * 256);
    const unsigned ldsw = (unsigned)wid * 1024u;
    const int aoff = lds_byte(wr * 64 + fr, fq * 8), boff = lds_byte(wc * 32 + fr, fq * 8);
#define PG8_SA(b, h) (((b) * 2 + (h)) * HTB)
#define PG8_SB(b, h) ((4 + (b) * 2 + (h)) * HTB)
#define PG8_STAGE(bufoff, gbase, voff) do { _Pragma("unroll") for (int _i = 0; _i < 2; ++_i) \
        __builtin_amdgcn_global_load_lds((const unsigned*)((const char*)(gbase) + (voff)[_i]), (PG8_LAS unsigned*)(lds + (bufoff) + ldsw + _i * 8192), 16, 0, 0); } while (0)
#define PG8_LDA(dst, b, h) do { _Pragma("unroll") for (int m = 0; m < 4; ++m) _Pragma("unroll") for (int k = 0; k < 2; ++k) dst[m][k] = *(const PG8_LAS bf16x8*)(lds + PG8_SA(b, h) + aoff + m * 2048 + k * 1024); } while (0)
#define PG8_LDB(dst, b, h) do { _Pragma("unroll") for (int n = 0; n < 2; ++n) _Pragma("unroll") for (int k = 0; k < 2; ++k) dst[n][k] = *(const PG8_LAS bf16x8*)(lds + PG8_SB(b, h) + boff + n * 2048 + k * 1024); } while (0)
#define PG8_MMA(ai, bj, At, Bt) do { __builtin_amdgcn_s_setprio(1); _Pragma("unroll") for (int m = 0; m < 4; ++m) _Pragma("unroll") for (int n = 0; n < 2; ++n) _Pragma("unroll") for (int k = 0; k < 2; ++k) \
        acc[ai][bj][m][n] = __builtin_amdgcn_mfma_f32_16x16x32_bf16(Bt[n][k], At[m][k], acc[ai][bj][m][n], 0, 0, 0); __builtin_amdgcn_s_setprio(0); } while (0)
#define PG8_WAIT_V(n) asm volatile("s_waitcnt vmcnt(" #n ")" ::: "memory")
#define PG8_WAIT_LOOP() do { if (PG8_PF) asm volatile("s_waitcnt vmcnt(9)" ::: "memory"); else asm volatile("s_waitcnt vmcnt(8)" ::: "memory"); } while (0)
#define PG8_PREFETCH(tp) do { if (PG8_PF) { const int tp_ = (tp); const char* pb_ = (wid < 4) ? (tp_ < nt ? cA + (size_t)tp_ * kstepA : nA + (size_t)(tp_ - nt) * kstepA) : (tp_ < nt ? cB + (size_t)tp_ * kstepB : nB + (size_t)(tp_ - nt) * kstepB); \
        const unsigned ln_ = __builtin_amdgcn_mbcnt_hi(~0u, __builtin_amdgcn_mbcnt_lo(~0u, 0u)) + (unsigned)(wid & 3) * 64u; const unsigned pfl_ = ln_ * ((wid < 4) ? (ABLK ? 128u : (unsigned)K * 2u) : (BBLK ? 128u : (unsigned)K * 2u)); \
        __builtin_amdgcn_global_load_lds((const unsigned*)(pb_ + pfl_), pfjunk, 4, 0, 0); } } while (0)
#define PG8_WAIT_L(n) asm volatile("s_waitcnt lgkmcnt(" #n ")" ::: "memory")
#define PG8_BAR __builtin_amdgcn_s_barrier()
#define PG8_SCHED __builtin_amdgcn_sched_barrier(0)
    Unit cur, nxt; int ui = 0;
    if (!S.next(0, cur)) return;
    f32x4 acc[2][2][4][2];
#pragma unroll
    for (int a = 0; a < 2; ++a)
#pragma unroll
        for (int b = 0; b < 2; ++b)
#pragma unroll
            for (int m = 0; m < 4; ++m)
#pragma unroll
                for (int n = 0; n < 2; ++n) acc[a][b][m][n] = (f32x4){0.f, 0.f, 0.f, 0.f};
    bf16x8 At[4][2], B0[2][2], B1[2][2];
    const char* cA = (const char*)g.A + (size_t)cur.pm * tstep; const char* cB = (const char*)g.Bt + (size_t)cur.pn * tstep;
    S.a_ready(cur);
    if constexpr (SP2) {
        PG8_STAGE(PG8_SB(0, 0), cB, voffB); PG8_STAGE(PG8_SB(0, 1), cB + hstepB, voffB); PG8_STAGE(PG8_SA(0, 0), cA, voffA); PG8_STAGE(PG8_SA(0, 1), cA + hstepA, voffA);
        if (wr == 1) PG8_BAR;
        PG8_WAIT_V(2); PG8_BAR;
        PG8_STAGE(PG8_SB(1, 0), cB + kstepB, voffB); PG8_STAGE(PG8_SA(1, 0), cA + kstepA, voffA); PG8_STAGE(PG8_SB(1, 1), cB + hstepB + kstepB, voffB);
        PG8_WAIT_V(6); PG8_BAR;
    } else {
        PG8_STAGE(PG8_SB(0, 0), cB, voffB); PG8_STAGE(PG8_SA(0, 0), cA, voffA); PG8_STAGE(PG8_SB(0, 1), cB + hstepB, voffB); PG8_STAGE(PG8_SA(0, 1), cA + hstepA, voffA);
        if (wr == 1) PG8_BAR;
        PG8_WAIT_V(4); PG8_BAR;
        PG8_STAGE(PG8_SB(1, 0), cB + kstepB, voffB); PG8_STAGE(PG8_SA(1, 0), cA + kstepA, voffA); PG8_STAGE(PG8_SB(1, 1), cB + hstepB + kstepB, voffB);
        PG8_WAIT_V(6); PG8_BAR;
    }
    for (;;) {
        const bool has_next = S.next(ui + 1, nxt);
        const char* nA = has_next ? (const char*)g.A + (size_t)nxt.pm * tstep : cA; const char* nB = has_next ? (const char*)g.Bt + (size_t)nxt.pn * tstep : cB;
        for (int t = 0; t < nt; t += 2) {
            const bool last = (t == nt - 2);
            const char* a1 = cA + (size_t)(t + 1) * kstepA;
            const char* a2 = last ? nA : cA + (size_t)(t + 2) * kstepA; const char* b2 = last ? nB : cB + (size_t)(t + 2) * kstepB;
            const char* a3 = a2 + kstepA; const char* b3 = b2 + kstepB;
            if (last && has_next) S.a_ready(nxt);
            if constexpr (SP2) {
            PG8_LDB(B0, 0, 0); PG8_LDB(B1, 0, 1); PG8_SCHED; PG8_LDA(At, 0, 0); PG8_STAGE(PG8_SA(1, 1), a1 + hstepA, voffA); PG8_PREFETCH(t + PG8_PF);
            PG8_WAIT_LOOP(); PG8_WAIT_L(0); PG8_BAR; PG8_MMA(0, 0, At, B0); PG8_MMA(0, 1, At, B1); PG8_BAR; PG8_SCHED;
            PG8_LDA(At, 0, 1); PG8_STAGE(PG8_SB(0, 0), b2, voffB); PG8_STAGE(PG8_SB(0, 1), b2 + hstepB, voffB); PG8_STAGE(PG8_SA(0, 0), a2, voffA);
            PG8_WAIT_LOOP(); PG8_WAIT_L(0); PG8_BAR; PG8_MMA(1, 0, At, B0); PG8_MMA(1, 1, At, B1); PG8_BAR; PG8_SCHED;
            PG8_LDB(B0, 1, 0); PG8_LDB(B1, 1, 1); PG8_SCHED; PG8_LDA(At, 1, 0); PG8_STAGE(PG8_SA(0, 1), a2 + hstepA, voffA); PG8_PREFETCH(t + 1 + PG8_PF);
            PG8_WAIT_LOOP(); PG8_WAIT_L(0); PG8_BAR; PG8_MMA(0, 0, At, B0); PG8_MMA(0, 1, At, B1); PG8_BAR; PG8_SCHED;
            PG8_LDA(At, 1, 1); PG8_STAGE(PG8_SB(1, 0), b3, voffB); PG8_STAGE(PG8_SB(1, 1), b3 + hstepB, voffB); PG8_STAGE(PG8_SA(1, 0), a3, voffA);
            PG8_WAIT_LOOP(); PG8_WAIT_L(0); PG8_BAR; PG8_MMA(1, 0, At, B0); PG8_MMA(1, 1, At, B1); PG8_BAR; PG8_SCHED;
            } else {
            PG8_LDB(B0, 0, 0); PG8_SCHED; PG8_LDA(At, 0, 0); PG8_STAGE(PG8_SA(1, 1), a1 + hstepA, voffA);
            PG8_WAIT_L(8); PG8_BAR; PG8_WAIT_L(0); PG8_MMA(0, 0, At, B0); PG8_BAR; PG8_SCHED;
            PG8_LDB(B1, 0, 1); PG8_STAGE(PG8_SB(0, 0), b2, voffB);
            PG8_BAR; PG8_WAIT_L(0); PG8_MMA(0, 1, At, B1); PG8_BAR;
            PG8_LDA(At, 0, 1); PG8_STAGE(PG8_SA(0, 0), a2, voffA);
            PG8_BAR; PG8_WAIT_L(0); PG8_MMA(1, 0, At, B0); PG8_BAR; PG8_SCHED;
            PG8_STAGE(PG8_SB(0, 1), b2 + hstepB, voffB);
            PG8_WAIT_V(6); PG8_BAR; PG8_MMA(1, 1, At, B1); PG8_BAR;
            PG8_LDB(B0, 1, 0); PG8_SCHED; PG8_LDA(At, 1, 0); PG8_STAGE(PG8_SA(0, 1), a2 + hstepA, voffA);
            PG8_WAIT_L(8); PG8_BAR; PG8_WAIT_L(0); PG8_MMA(0, 0, At, B0); PG8_BAR; PG8_SCHED;
            PG8_LDB(B1, 1, 1); PG8_STAGE(PG8_SB(1, 0), b3, voffB);
            PG8_BAR; PG8_WAIT_L(0); PG8_MMA(0, 1, At, B1); PG8_BAR;
            PG8_LDA(At, 1, 1); PG8_STAGE(PG8_SA(1, 0), a3, voffA);
            PG8_BAR; PG8_WAIT_L(0); PG8_MMA(1, 0, At, B0); PG8_BAR; PG8_SCHED;
            PG8_STAGE(PG8_SB(1, 1), b3 + hstepB, voffB);
            PG8_WAIT_V(6); PG8_BAR; PG8_MMA(1, 1, At, B1); PG8_BAR;
            }
        }
        if constexpr (ALIGN_EPI) { if (wr == 0) PG8_BAR; }
        if constexpr (!Epi::AFTER_DRAIN) { int fr_e = fr, fq_e = fq; asm volatile("" : "+v"(fr_e), "+v"(fq_e));
            E(acc, cur, wr, wc, fr_e, fq_e); S.done(cur); }
        if (!has_next) break;
#pragma unroll
        for (int a = 0; a < 2; ++a)
#pragma unroll
            for (int b = 0; b < 2; ++b)
#pragma unroll
                for (int m = 0; m < 4; ++m)
#pragma unroll
                    for (int n = 0; n < 2; ++n) acc[a][b][m][n] = (f32x4){0.f, 0.f, 0.f, 0.f};
        cur = nxt; cA = nA; cB = nB; ++ui;
        if constexpr (ALIGN_EPI) { if (wr == 1) PG8_BAR; }
    }
    PG8_WAIT_V(0);
    if constexpr (!ALIGN_EPI) { if (wr == 0) PG8_BAR; }
    PG8_BAR;
    if constexpr (Epi::AFTER_DRAIN) { E.fused(acc, cur, wr, wc, fr, fq, lds, wid, lane); S.done(cur); }
#undef PG8_SA
#undef PG8_SB
#undef PG8_STAGE
#undef PG8_LDA
#undef PG8_LDB
#undef PG8_MMA
#undef PG8_WAIT_V
#undef PG8_WAIT_L
#undef PG8_WAIT_LOOP
#undef PG8_PREFETCH
#undef PG8_BAR
#undef PG8_SCHED
}
}
namespace att {
constexpr int D = 128; constexpr float THR = 8.f; constexpr bool WSKIP = false;
constexpr float SCALE = 0.08838834764831845f;
constexpr int NW = 8, QBLK = 32, KVBLK = 64, QB = NW * QBLK;
constexpr int SHM_V = KVBLK * D * 2, SHM_K = KVBLK * D * 2;
constexpr int LDS_BYTES = 2 * SHM_V + 2 * SHM_K + NW * 64 * 4;

using bf16 = __hip_bfloat16;
typedef short bf16x8 __attribute__((ext_vector_type(8)));
typedef short s16x4 __attribute__((ext_vector_type(4)));
typedef float f32x16 __attribute__((ext_vector_type(16)));
typedef float f32x4 __attribute__((ext_vector_type(4)));
typedef unsigned u32x4 __attribute__((ext_vector_type(4)));
template <class A, class Bt> struct same_t { static constexpr bool v = false; };
template <class A> struct same_t<A, A> { static constexpr bool v = true; };

#define KSWZ(row, colB) ((row) * 256 + ((colB) ^ (((row) & 7) << 4)))
#define SBAR() __builtin_amdgcn_sched_barrier(0)
__device__ __forceinline__ int v_st(int k, int c) { const int kk = (k & ~0xC) | ((k & 4) << 1) | ((k & 8) >> 1); return ((kk >> 3) * 4 + (c >> 5)) * 512 + ((kk & 7) * 32 + (c & 31)) * 2; }
__device__ __forceinline__ int v_rd_base(int lane) { return ((lane & 3) << 3) | (((lane >> 2) & 3) << 6) | (((lane >> 4) & 1) << 5) | (((lane >> 5) & 1) << 8); }
constexpr int v_rd_off(int d0, int ks, int half) { return d0 * 512 + ks * 4096 + half * 2048; }
__device__ __forceinline__ int crow(int r, int hi) { return (r & 3) + 8 * (r >> 2) + 4 * hi; }
__device__ __forceinline__ unsigned cvtpk(float lo, float hi) {
    unsigned r; asm volatile("v_cvt_pk_bf16_f32 %0, %1, %2" : "=v"(r) : "v"(lo), "v"(hi)); return r;
}
__device__ __forceinline__ bf16x8 pack8(f32x4 a, f32x4 b) {
    u32x4 w = {cvtpk(a[0], a[1]), cvtpk(a[2], a[3]), cvtpk(b[0], b[1]), cvtpk(b[2], b[3])};
    return *reinterpret_cast<bf16x8*>(&w);
}
template <class T> __device__ __forceinline__ bf16x8 load8(const T* p) {
    if constexpr (same_t<T, float>::v) { return pack8(*(const f32x4*)p, *(const f32x4*)(p + 4)); }
    else { return *reinterpret_cast<const bf16x8*>(p); }
}
__device__ __forceinline__ void mask_tile(f32x16& p0, f32x16& p1, int dq, unsigned W) {
    const float NEG = -__builtin_inff();
#pragma unroll
    for (int r = 0; r < 16; ++r) {
        const int c = (r & 3) + 8 * (r >> 2);
        if ((unsigned)(dq - c) >= W) p0[r] = NEG;
        if ((unsigned)(dq - c - 32) >= W) p1[r] = NEG;
    }
}
__device__ __forceinline__ void partialSM(f32x16& p0, f32x16& p1, float& m_reg, float& mn, float& alpha) {
    float pmax = p0[0]; for (int r = 1; r < 16; ++r) pmax = fmaxf(pmax, p0[r]); for (int r = 0; r < 16; ++r) pmax = fmaxf(pmax, p1[r]);
    { auto rr = __builtin_amdgcn_permlane32_swap(__float_as_uint(pmax), __float_as_uint(pmax), false, false);
      pmax = fmaxf(__uint_as_float(rr[0]), __uint_as_float(rr[1])); }
    constexpr float C2 = 1.4426950408889634f * SCALE;
    if (__builtin_expect(__all((pmax - m_reg) * SCALE <= THR), 1)) { mn = m_reg; alpha = 1.f; }
    else { mn = fmaxf(m_reg, pmax); alpha = __builtin_amdgcn_exp2f((m_reg - mn) * C2); m_reg = mn; }
    const float mnL = -mn * C2;
    for (int r = 0; r < 16; ++r) p0[r] = fmaf(p0[r], C2, mnL); for (int r = 0; r < 16; ++r) p1[r] = fmaf(p1[r], C2, mnL);
    for (int r = 0; r < 16; ++r) p0[r] = __builtin_amdgcn_exp2f(p0[r]);
}
__device__ __forceinline__ void finishSM(f32x16& p0, f32x16& p1, float alpha, float& l_reg, bf16x8& pa0, bf16x8& pa1, bf16x8& pa2, bf16x8& pa3) {
    for (int r = 0; r < 16; ++r) p1[r] = __builtin_amdgcn_exp2f(p1[r]);
    float ps = 0; for (int r = 0; r < 16; ++r) ps += p0[r]; for (int r = 0; r < 16; ++r) ps += p1[r];
    { auto rr = __builtin_amdgcn_permlane32_swap(__float_as_uint(ps), __float_as_uint(ps), false, false);
      ps = __uint_as_float(rr[0]) + __uint_as_float(rr[1]); }
    l_reg = l_reg * alpha + ps;
#define PK4(P, B_, OUT) do { unsigned a0 = cvtpk(P[B_+0], P[B_+1]), a1 = cvtpk(P[B_+2], P[B_+3]);                          \
        unsigned b0 = cvtpk(P[B_+4], P[B_+5]), b1 = cvtpk(P[B_+6], P[B_+7]);                                             \
        auto r0 = __builtin_amdgcn_permlane32_swap(a0, b0, false, false); auto r1 = __builtin_amdgcn_permlane32_swap(a1, b1, false, false); \
        u32x4 w = {r0[0], r1[0], r0[1], r1[1]}; OUT = *reinterpret_cast<bf16x8*>(&w); } while (0)
    PK4(p0, 0, pa0); PK4(p0, 8, pa1); PK4(p1, 0, pa2); PK4(p1, 8, pa3);
#undef PK4
}
template <int KB, bool SK>
__device__ __forceinline__ void qkt(f32x16& p0, f32x16& p1, const char* K_lds, int r32, int hi, const bf16x8* qr, bool act) {
    if (SK && !act) { const float NEG = -__builtin_inff();
#pragma unroll
        for (int r = 0; r < 16; ++r) { p0[r] = NEG; p1[r] = NEG; } return; }
    p0 = f32x16{}; p1 = f32x16{};
    const char* kb[4];
#pragma unroll
    for (int dd = 0; dd < 4; ++dd) kb[dd] = K_lds + KB * SHM_K + KSWZ(r32, (dd * 16 + hi * 8) * 2);
#pragma unroll
    for (int d0 = 0; d0 < 8; ++d0) { const char* a = kb[d0 & 3] + (d0 >> 2) * 128;
        bf16x8 b0 = *reinterpret_cast<const bf16x8*>(a);
        bf16x8 b1 = *reinterpret_cast<const bf16x8*>(a + 32 * 256);
        p0 = __builtin_amdgcn_mfma_f32_32x32x16_bf16(b0, qr[d0], p0, 0, 0, 0);
        p1 = __builtin_amdgcn_mfma_f32_32x32x16_bf16(b1, qr[d0], p1, 0, 0, 0); }
}
template <int VB, bool SK>
__device__ __forceinline__ void pv_tile(f32x16* o, int vb0, bf16x8 pa0, bf16x8 pa1, bf16x8 pa2, bf16x8 pa3, bool act) {
    if (SK && !act) return;
#define TRRD(dst, off) asm volatile("ds_read_b64_tr_b16 %0, %1 offset:%2" : "=&v"(dst) : "v"(vb0), "i"(off) : "memory")
#define PV_D0(d0) do { s16x4 l0, l1, l2, l3, h0, h1, h2, h3; constexpr int b_ = VB * SHM_V + v_rd_off(d0, 0, 0);     \
        TRRD(l0, b_); TRRD(h0, b_ + 2048); TRRD(l1, b_ + 4096); TRRD(h1, b_ + 6144); TRRD(l2, b_ + 8192); TRRD(h2, b_ + 10240); TRRD(l3, b_ + 12288); TRRD(h3, b_ + 14336); \
        asm volatile("s_waitcnt lgkmcnt(0)" ::: "memory"); SBAR();                 \
        o[d0] = __builtin_amdgcn_mfma_f32_32x32x16_bf16(pa0, (bf16x8){l0[0], l0[1], l0[2], l0[3], h0[0], h0[1], h0[2], h0[3]}, o[d0], 0, 0, 0);   \
        o[d0] = __builtin_amdgcn_mfma_f32_32x32x16_bf16(pa1, (bf16x8){l1[0], l1[1], l1[2], l1[3], h1[0], h1[1], h1[2], h1[3]}, o[d0], 0, 0, 0);   \
        o[d0] = __builtin_amdgcn_mfma_f32_32x32x16_bf16(pa2, (bf16x8){l2[0], l2[1], l2[2], l2[3], h2[0], h2[1], h2[2], h2[3]}, o[d0], 0, 0, 0);   \
        o[d0] = __builtin_amdgcn_mfma_f32_32x32x16_bf16(pa3, (bf16x8){l3[0], l3[1], l3[2], l3[3], h3[0], h3[1], h3[2], h3[3]}, o[d0], 0, 0, 0); } while (0)
    PV_D0(0); PV_D0(1); PV_D0(2); PV_D0(3);
#undef PV_D0
#undef TRRD
}

template <class TIn, class TOut> struct BlockRef { const TIn* Q; const TIn* K; const TIn* V; TOut* O; int P0; int ldo; };
template <class TIn> struct Seam {
    bf16x8 qr[8];
    bf16x8 st_v0, st_v1, st_k0, st_k1; f32x4 sf0, sf1, sf2, sf3;
    f32x4 tq[16];
};
__device__ __forceinline__ int swa_jlo(int P0, int W) { const int lowk = P0 - W + 1; return lowk > 0 ? lowk / KVBLK : 0; }
#define ROW(p, k0, rr) ((p) + (size_t)((k0) + (rr)) * D + sc)
#define VMW() asm volatile("s_waitcnt vmcnt(0)" ::: "memory")
#define VMWN(n) asm volatile("s_waitcnt vmcnt(%0)" :: "i"(n) : "memory")
#define SLOAD_H(Kp, Vp, k0) do { S.st_v0 = load8<TIn>(ROW(Vp, k0, sr)); S.st_v1 = load8<TIn>(ROW(Vp, k0, 32 + sr));              \
                         S.st_k0 = load8<TIn>(ROW(Kp, k0, sr)); S.st_k1 = load8<TIn>(ROW(Kp, k0, 32 + sr)); } while (0)
#define SWRITE_HK(bf) do { *(bf16x8*)(K_lds + (bf) * SHM_K + kws) = S.st_k0; *(bf16x8*)(K_lds + (bf) * SHM_K + kws + 32 * 256) = S.st_k1; } while (0)
#define SWRITE_HV(bf) do { *(bf16x8*)(V_lds + (bf) * SHM_V + vst0) = S.st_v0; *(bf16x8*)(V_lds + (bf) * SHM_V + vst1) = S.st_v1; } while (0)
#define SWRITE_H(bf) do { SWRITE_HV(bf); SWRITE_HK(bf); } while (0)
#define SLOAD_F(p, k0) do { S.sf0 = *(const f32x4*)ROW(p, k0, sr); S.sf1 = *(const f32x4*)(ROW(p, k0, sr) + 4);                \
                            S.sf2 = *(const f32x4*)ROW(p, k0, 32 + sr); S.sf3 = *(const f32x4*)(ROW(p, k0, 32 + sr) + 4); } while (0)
#define SWRITE_KF(bf) do { *(bf16x8*)(K_lds + (bf) * SHM_K + kws) = pack8(S.sf0, S.sf1); *(bf16x8*)(K_lds + (bf) * SHM_K + kws + 32 * 256) = pack8(S.sf2, S.sf3); } while (0)
#define SWRITE_VF(bf) do { *(bf16x8*)(V_lds + (bf) * SHM_V + vst0) = pack8(S.sf0, S.sf1); *(bf16x8*)(V_lds + (bf) * SHM_V + vst1) = pack8(S.sf2, S.sf3); } while (0)
template <class TIn, class TOut>
__device__ __forceinline__ void causal_swa_prime(const BlockRef<TIn, TOut>& cur, int W, char* lds, Seam<TIn>& S) {
    constexpr bool F32 = same_t<TIn, float>::v;
    int tid_ = threadIdx.x; asm volatile("" : "+v"(tid_));
    const int tid = tid_, wid = __builtin_amdgcn_readfirstlane(tid >> 6), lane = tid & 63, r32 = lane & 31, hi = lane >> 5;
    const int sr = tid >> 4, sc = (tid & 15) * 8, kws = KSWZ(sr, sc * 2); char* K_lds = lds + 2 * SHM_V;
    const int kb0 = swa_jlo(cur.P0, W) * KVBLK;
    for (int d0 = 0; d0 < 8; ++d0) S.qr[d0] = load8<TIn>(cur.Q + (size_t)(wid * QBLK + r32) * D + d0 * 16 + hi * 8);
    if constexpr (F32) { SLOAD_F((const float*)cur.K, kb0); VMW(); SWRITE_KF(0); SBAR(); SLOAD_F((const float*)cur.V, kb0); }
    else { SLOAD_H(cur.K, cur.V, kb0); VMW(); SWRITE_HK(0); }
    __syncthreads();
}
template <class TIn, class TOut>
__device__ __forceinline__ void causal_swa_block(const BlockRef<TIn, TOut>& cur, const BlockRef<TIn, TOut>& nxt, int skv, int W, char* lds, Seam<TIn>& S) {
    constexpr bool F32 = same_t<TIn, float>::v;
    int tid_ = threadIdx.x; asm volatile("" : "+v"(tid_));
    const int tid = tid_, wid = __builtin_amdgcn_readfirstlane(tid >> 6), lane = tid & 63, r32 = lane & 31, hi = lane >> 5;
    const int j_lo = swa_jlo(cur.P0, W);
    int j_hi = (cur.P0 + QB - 1) / KVBLK + 1; if (j_hi > skv / KVBLK) j_hi = skv / KVBLK;
    const int NT = j_hi - j_lo;
    const int kbn = swa_jlo(nxt.P0, W) * KVBLK;
    const int qlo = cur.P0 + wid * QBLK, qm = qlo + r32 - 4 * hi;
    char* V_lds = lds; char* K_lds = lds + 2 * SHM_V;
    float* ws = (float*)(lds + 2 * SHM_V + 2 * SHM_K) + wid * 64; float* li_l = ws, * al_l = ws + 32;
    float m_reg = -1e30f, l_reg = 0; f32x16 o[4] = {};
    const int sr = tid >> 4, sc = (tid & 15) * 8, vst0 = v_st(sr, sc), vst1 = v_st(32 + sr, sc), kws = KSWZ(sr, sc * 2);
    const int vb0 = (int)(uintptr_t)V_lds + v_rd_base(lane);
    const TIn* Kh = cur.K; const TIn* Vh = cur.V;
#define RESC(a) do { if (__any((a) < 1.f)) { if (hi == 0) al_l[r32] = (a); asm volatile("s_waitcnt lgkmcnt(0)" ::: "memory");              \
                     for (int d_ = 0; d_ < 4; ++d_) for (int r = 0; r < 16; ++r) o[d_][r] *= al_l[crow(r, hi)]; } } while (0)
#define KBASE(t) ((j_lo + (t)) * KVBLK)
#define ACT(t) (KBASE(t) <= qlo + QBLK - 1 && KBASE(t) + KVBLK - 1 >= qlo - W + 1)
#define MASKT(P0_, P1_, t) do { const int kb_ = KBASE(t); if ((!SK || ACT(t)) && (kb_ + KVBLK - 1 > qlo || kb_ <= qlo + QBLK - 1 - W)) mask_tile(P0_, P1_, qm - kb_, (unsigned)W); } while (0)
    constexpr int NQL = F32 ? 16 : 8;
    constexpr bool SK = WSKIP && !F32;
#define SEAM_K0() do { VMWN(NQL); if constexpr (F32) { SWRITE_KF(0); SBAR(); SLOAD_F((const float*)nxt.V, kbn); } else { SWRITE_HK(0); } SBAR(); } while (0)
    f32x16 pA0, pA1, pB0, pB1; float mnA, mnB, alA, alB; bf16x8 pa0, pa1, pa2, pa3;
    if constexpr (F32) { VMW(); SWRITE_VF(0); SBAR(); } else { SWRITE_HV(0); SBAR(); }
    if (NT > 1) { if constexpr (F32) SLOAD_F((const float*)Kh, KBASE(1)); else SLOAD_H(Kh, Vh, KBASE(1)); }
    SBAR(); qkt<0, SK>(pA0, pA1, K_lds, r32, hi, S.qr, ACT(0));
    if constexpr (F32) { if (NT > 1) { VMW(); SWRITE_KF(1); SBAR(); SLOAD_F((const float*)Vh, KBASE(1)); } }
    MASKT(pA0, pA1, 0); partialSM(pA0, pA1, m_reg, mnA, alA);
    if (NT > 1) { VMW(); if constexpr (F32) { SWRITE_VF(1); SBAR(); if (NT > 2) SLOAD_F((const float*)Kh, KBASE(2)); } else SWRITE_H(1); }
    __syncthreads();
#define HALF_STEP(PX0, PX1, mnX, alX, PY0, PY1, alY, t, KB, VB, SB) do {                                                      \
        SBAR(); qkt<KB, SK>(PX0, PX1, K_lds, r32, hi, S.qr, ACT(t));                                             \
        finishSM(PY0, PY1, alY, l_reg, pa0, pa1, pa2, pa3); SBAR();                                                           \
        if ((t) + 1 < NT) { if constexpr (F32) { VMW(); SWRITE_KF(SB); SBAR(); SLOAD_F((const float*)Vh, KBASE((t) + 1)); }  \
                            else { SLOAD_H(Kh, Vh, KBASE((t) + 1)); } SBAR(); }                                               \
        pv_tile<VB, SK>(o, vb0, pa0, pa1, pa2, pa3, ACT((t) - 1)); MASKT(PX0, PX1, (t)); partialSM(PX0, PX1, m_reg, mnX, alX);                                        \
        __syncthreads();                                                                                                      \
        if ((t) + 1 < NT) { VMW(); if constexpr (F32) { SWRITE_VF(SB); SBAR(); if ((t) + 2 < NT) SLOAD_F((const float*)Kh, KBASE((t) + 2)); } \
                            else { SWRITE_H(SB); } }                                                                          \
        RESC(alX); __syncthreads(); } while (0)
    for (int t = 1; t + 1 < NT; t += 2) {
        HALF_STEP(pB0, pB1, mnB, alB, pA0, pA1, alA, t, 1, 0, 0);
        HALF_STEP(pA0, pA1, mnA, alA, pB0, pB1, alB, t + 1, 0, 1, 1);
    }
    const bool even = (NT & 1) == 0;
    if (even) { SBAR(); qkt<1, SK>(pB0, pB1, K_lds, r32, hi, S.qr, ACT(NT - 1)); SBAR(); }
#define QROW(e) (nxt.Q + (size_t)(wid * QBLK + r32) * D + ((e) >> 1) * 16 + hi * 8 + ((e) & 1) * 4)
    if constexpr (F32) { SLOAD_F((const float*)nxt.K, kbn); SBAR();
#pragma unroll
        for (int e = 0; e < 8; ++e) S.tq[e] = *(const f32x4*)QROW(e); }
    else { SLOAD_H(nxt.K, nxt.V, kbn); SBAR();
#pragma unroll
        for (int d0 = 0; d0 < 8; ++d0) S.qr[d0] = load8<TIn>(nxt.Q + (size_t)(wid * QBLK + r32) * D + d0 * 16 + hi * 8); }
    SBAR();
    finishSM(pA0, pA1, alA, l_reg, pa0, pa1, pa2, pa3); SBAR();
    if constexpr (F32) {
#pragma unroll
        for (int e = 8; e < 16; ++e) S.tq[e] = *(const f32x4*)QROW(e); SBAR(); }
#undef QROW
    pv_tile<0, SK>(o, vb0, pa0, pa1, pa2, pa3, ACT(even ? NT - 2 : NT - 1));
    if (even) { MASKT(pB0, pB1, NT - 1); partialSM(pB0, pB1, m_reg, mnB, alB); __syncthreads(); RESC(alB);
        finishSM(pB0, pB1, alB, l_reg, pa0, pa1, pa2, pa3); SBAR(); pv_tile<1, SK>(o, vb0, pa0, pa1, pa2, pa3, ACT(NT - 1)); }
    SBAR(); SEAM_K0();
    if (hi == 0) li_l[r32] = l_reg; asm volatile("s_waitcnt lgkmcnt(0)" ::: "memory");
    float rli[16];
#pragma unroll
    for (int r = 0; r < 16; ++r) rli[r] = __builtin_amdgcn_rcpf(li_l[crow(r, hi)]);
    const int LDO = cur.ldo; TOut* Ow = cur.O + (size_t)(wid * QBLK) * LDO;
#pragma unroll
    for (int r = 0; r < 16; ++r) { const int orow = crow(r, hi);
#pragma unroll
        for (int d0 = 0; d0 < 4; ++d0) { const float v = o[d0][r] * rli[r];
            if constexpr (same_t<TOut, float>::v) { Ow[(size_t)orow * LDO + d0 * 32 + r32] = v; }
            else { const float vn = __shfl_xor(v, 1);
                   if ((r32 & 1) == 0) *(unsigned*)(Ow + (size_t)orow * LDO + d0 * 32 + r32) = cvtpk(v, vn); } } }
    if constexpr (F32) {
#pragma unroll
        for (int d0 = 0; d0 < 8; ++d0) S.qr[d0] = pack8(S.tq[2 * d0], S.tq[2 * d0 + 1]); }
    __syncthreads();
#undef RESC
#undef KBASE
#undef ACT
#undef MASKT
#undef SEAM_K0
#undef HALF_STEP
}
#undef ROW
#undef VMW
#undef VMWN
#undef SLOAD_H
#undef SWRITE_HK
#undef SWRITE_HV
#undef SWRITE_H
#undef SLOAD_F
#undef SWRITE_KF
#undef SWRITE_VF


constexpr int QB2 = 128, L2_K = 0, L2_V0 = 32768, L2_V1 = 65536, L2_P = 98304;
struct Ref2 { const bf16* Q; const bf16* K; const bf16* V0; const bf16* V1; float* O0; float* O1; int P0; };
struct Seam2 { bf16x8 qr[8]; bf16x8 sk0, sk1, sa0, sa1, sb0, sb1; };
#define LD8(p) (*reinterpret_cast<const bf16x8*>(p))
#define VMW2() asm volatile("s_waitcnt vmcnt(0)" ::: "memory")
__device__ __forceinline__ void pv3_tile(f32x16* o, int vb, bf16x8 pa0, bf16x8 pa1, bf16x8 pa2, bf16x8 pa3, bf16x8 pb0, bf16x8 pb1, bf16x8 pb2, bf16x8 pb3) {
#define TRRD(dst, off) asm volatile("ds_read_b64_tr_b16 %0, %1 offset:%2" : "=&v"(dst) : "v"(vb), "i"(off) : "memory")
#define RD8(X, g) do { constexpr int b_ = v_rd_off((g), 0, 0); TRRD(X##0, b_); TRRD(X##1, b_ + 2048); TRRD(X##2, b_ + 4096); TRRD(X##3, b_ + 6144); \
        TRRD(X##4, b_ + 8192); TRRD(X##5, b_ + 10240); TRRD(X##6, b_ + 12288); TRRD(X##7, b_ + 14336); } while (0)
#define VF(X, a, b) (bf16x8){X##a[0], X##a[1], X##a[2], X##a[3], X##b[0], X##b[1], X##b[2], X##b[3]}
#define MM8(X, g) do { \
        o[g] = __builtin_amdgcn_mfma_f32_32x32x16_bf16(pa0, VF(X, 0, 1), o[g], 0, 0, 0); o[4 + g] = __builtin_amdgcn_mfma_f32_32x32x16_bf16(pb0, VF(X, 0, 1), o[4 + g], 0, 0, 0); \
        o[g] = __builtin_amdgcn_mfma_f32_32x32x16_bf16(pa1, VF(X, 2, 3), o[g], 0, 0, 0); o[4 + g] = __builtin_amdgcn_mfma_f32_32x32x16_bf16(pb1, VF(X, 2, 3), o[4 + g], 0, 0, 0); \
        o[g] = __builtin_amdgcn_mfma_f32_32x32x16_bf16(pa2, VF(X, 4, 5), o[g], 0, 0, 0); o[4 + g] = __builtin_amdgcn_mfma_f32_32x32x16_bf16(pb2, VF(X, 4, 5), o[4 + g], 0, 0, 0); \
        o[g] = __builtin_amdgcn_mfma_f32_32x32x16_bf16(pa3, VF(X, 6, 7), o[g], 0, 0, 0); o[4 + g] = __builtin_amdgcn_mfma_f32_32x32x16_bf16(pb3, VF(X, 6, 7), o[4 + g], 0, 0, 0); } while (0)
#define LGK8() do { asm volatile("s_waitcnt lgkmcnt(8)" ::: "memory"); SBAR(); } while (0)
    s16x4 A0, A1, A2, A3, A4, A5, A6, A7, B0, B1, B2, B3, B4, B5, B6, B7;
    RD8(A, 0); RD8(B, 1); LGK8(); MM8(A, 0); SBAR();
    RD8(A, 2); LGK8(); MM8(B, 1); SBAR();
    RD8(B, 3); LGK8(); MM8(A, 2); SBAR();
    asm volatile("s_waitcnt lgkmcnt(0)" ::: "memory"); SBAR(); MM8(B, 3);
#undef TRRD
#undef RD8
#undef VF
#undef MM8
#undef LGK8
}
template <bool RS>
__device__ __forceinline__ void diff2_prime(const Ref2& cur, char* lds, Seam2& S) {
    int tid_ = threadIdx.x; asm volatile("" : "+v"(tid_));
    const int tid = tid_, wid = __builtin_amdgcn_readfirstlane(tid >> 6), lane = tid & 63, r32 = lane & 31, hi = lane >> 5;
    const int sr = tid >> 4, sc = (tid & 15) * 8, kws = KSWZ(sr, sc * 2);
    if constexpr (RS) {
#pragma unroll
        for (int d0 = 0; d0 < 8; ++d0) S.qr[d0] = LD8(cur.Q + (size_t)(wid * QBLK + r32) * D + d0 * 16 + hi * 8); }
    S.sk0 = LD8(cur.K + (size_t)sr * D + sc); S.sk1 = LD8(cur.K + (size_t)(32 + sr) * D + sc);
    S.sa0 = LD8(cur.V0 + (size_t)sr * D + sc); S.sa1 = LD8(cur.V0 + (size_t)(32 + sr) * D + sc);
    S.sb0 = LD8(cur.V1 + (size_t)sr * D + sc); S.sb1 = LD8(cur.V1 + (size_t)(32 + sr) * D + sc);
    VMW2();
    *(bf16x8*)(lds + L2_K + kws) = S.sk0; *(bf16x8*)(lds + L2_K + kws + 32 * 256) = S.sk1;
    __syncthreads();
}
template <bool RS>
__device__ __forceinline__ void diff2_block(const Ref2& cur, const Ref2& nxt, char* lds, float* xl, Seam2& S) {
    int tid_ = threadIdx.x; asm volatile("" : "+v"(tid_));
    const int tid = tid_, wid = __builtin_amdgcn_readfirstlane(tid >> 6), lane = tid & 63, r32 = lane & 31, hi = lane >> 5;
    const int w4 = wid & 3;
    const int NT = (cur.P0 + QB2 - 1) / KVBLK + 1;
    const int qlo = cur.P0 + w4 * QBLK, qm = qlo + r32 - 4 * hi;
    char* K_lds = lds + L2_K; char* V0_lds = lds + L2_V0; char* V1_lds = lds + L2_V1; char* P_lds = lds + L2_P + w4 * 4096;
    float* alp = xl + w4 * 32; float* li = xl + 256 + (RS ? w4 : (w4 >> 1) * 2) * 32; float* flg = xl + 384 + w4;
    const int sr = tid >> 4, sc = (tid & 15) * 8, vst0 = v_st(sr, sc), vst1 = v_st(32 + sr, sc), kws = KSWZ(sr, sc * 2);
    const int vbase = (int)(uintptr_t)V0_lds + v_rd_base(lane);
    float m_reg = -1e30f, l_reg = 0.f; f32x16 o[RS ? 1 : 8] = {};
#pragma unroll 1
    for (int t = 0; t <= NT; ++t) {
        const int par = t & 1;
        if (t < NT) { *(bf16x8*)(V0_lds + par * SHM_V + vst0) = S.sa0; *(bf16x8*)(V0_lds + par * SHM_V + vst1) = S.sa1;
                      *(bf16x8*)(V1_lds + par * SHM_V + vst0) = S.sb0; *(bf16x8*)(V1_lds + par * SHM_V + vst1) = S.sb1; }
        const bool ld_cur = t + 1 < NT, ld_nxt = t == NT;
        if (ld_cur || ld_nxt) {
            const bf16* Kp = ld_cur ? cur.K : nxt.K; const bf16* Ap = ld_cur ? cur.V0 : nxt.V0; const bf16* Bp = ld_cur ? cur.V1 : nxt.V1; const int k0 = ld_cur ? (t + 1) * KVBLK : 0;
            S.sk0 = LD8(Kp + (size_t)(k0 + sr) * D + sc); S.sk1 = LD8(Kp + (size_t)(k0 + 32 + sr) * D + sc);
            S.sa0 = LD8(Ap + (size_t)(k0 + sr) * D + sc); S.sa1 = LD8(Ap + (size_t)(k0 + 32 + sr) * D + sc);
            S.sb0 = LD8(Bp + (size_t)(k0 + sr) * D + sc); S.sb1 = LD8(Bp + (size_t)(k0 + 32 + sr) * D + sc); }
        if constexpr (RS) { if (ld_nxt) {
#pragma unroll
            for (int d0 = 0; d0 < 8; ++d0) S.qr[d0] = LD8(nxt.Q + (size_t)(w4 * QBLK + r32) * D + d0 * 16 + hi * 8); } }
        SBAR();
        if constexpr (RS) {
            if (t < NT) {
                f32x16 p0, p1; float mn, alpha; bf16x8 pa0, pa1, pa2, pa3;
                qkt<0, false>(p0, p1, K_lds + par * SHM_K, r32, hi, S.qr, true);
                { const int kb = t * KVBLK; if (kb + KVBLK - 1 > qlo) mask_tile(p0, p1, qm - kb, 1u << 30); }
                partialSM(p0, p1, m_reg, mn, alpha); finishSM(p0, p1, alpha, l_reg, pa0, pa1, pa2, pa3);
                { bf16x8* pw = (bf16x8*)(P_lds + par * 16384) + lane; pw[0] = pa0; pw[64] = pa1; pw[128] = pa2; pw[192] = pa3; }
                const bool need = __any(alpha < 1.f);
                if (hi == 0) { alp[par * 128 + r32] = alpha; if (t == NT - 1) li[r32] = l_reg; if (r32 == 0) flg[par * 4] = need ? 1.f : 0.f; }
            }
        } else if (t >= 1) {
            const int pp = (t - 1) & 1, rg = w4 >> 1, hf = w4 & 1;
            char* PA = lds + L2_P + (2 * rg) * 4096 + pp * 16384; float* alA = xl + (2 * rg) * 32 + pp * 128; float* flA = xl + 384 + 2 * rg + pp * 4;
            if (__builtin_amdgcn_readfirstlane(__float_as_int(flA[0])) != 0) {
                const f32x4* a4p = (const f32x4*)alA + hi; const f32x4 a0 = a4p[0], a1 = a4p[2], a2 = a4p[4], a3 = a4p[6];
#pragma unroll
                for (int d_ = 0; d_ < 4; ++d_)
#pragma unroll
                    for (int j = 0; j < 4; ++j) { o[d_][j] *= a0[j]; o[d_][4 + j] *= a1[j]; o[d_][8 + j] *= a2[j]; o[d_][12 + j] *= a3[j]; } }
            if (__builtin_amdgcn_readfirstlane(__float_as_int(flA[1])) != 0) {
                const f32x4* a4p = (const f32x4*)(alA + 32) + hi; const f32x4 a0 = a4p[0], a1 = a4p[2], a2 = a4p[4], a3 = a4p[6];
#pragma unroll
                for (int d_ = 4; d_ < 8; ++d_)
#pragma unroll
                    for (int j = 0; j < 4; ++j) { o[d_][j] *= a0[j]; o[d_][4 + j] *= a1[j]; o[d_][8 + j] *= a2[j]; o[d_][12 + j] *= a3[j]; } }
            bf16x8 pa0, pa1, pa2, pa3, pb0, pb1, pb2, pb3;
            { const bf16x8* pr = (const bf16x8*)PA + lane; pa0 = pr[0]; pa1 = pr[64]; pa2 = pr[128]; pa3 = pr[192]; pb0 = pr[256]; pb1 = pr[320]; pb2 = pr[384]; pb3 = pr[448]; }
            pv3_tile(o, vbase + hf * (L2_V1 - L2_V0) + pp * SHM_V, pa0, pa1, pa2, pa3, pb0, pb1, pb2, pb3);
        }
        SBAR();
        if (t == NT) VMW2(); else asm volatile("s_waitcnt vmcnt(4)" ::: "memory");
        if (ld_cur || ld_nxt) { const int wb = ld_cur ? ((t + 1) & 1) : 0;
            *(bf16x8*)(K_lds + wb * SHM_K + kws) = S.sk0; *(bf16x8*)(K_lds + wb * SHM_K + kws + 32 * 256) = S.sk1; }
        if constexpr (!RS) { if (t == NT) {
            int r32e = r32, hie = hi; asm volatile("" : "+v"(r32e), "+v"(hie));
            const f32x4* l4p = (const f32x4*)li + hie; const f32x4 l0 = l4p[0], l1 = l4p[2], l2 = l4p[4], l3 = l4p[6];
            float rli[16];
#pragma unroll
            for (int j = 0; j < 4; ++j) { rli[j] = __builtin_amdgcn_rcpf(l0[j]); rli[4 + j] = __builtin_amdgcn_rcpf(l1[j]); rli[8 + j] = __builtin_amdgcn_rcpf(l2[j]); rli[12 + j] = __builtin_amdgcn_rcpf(l3[j]); }
            const f32x4* m4p = (const f32x4*)(li + 32) + hie; const f32x4 n0 = m4p[0], n1 = m4p[2], n2 = m4p[4], n3 = m4p[6];
            float rlj[16];
#pragma unroll
            for (int j = 0; j < 4; ++j) { rlj[j] = __builtin_amdgcn_rcpf(n0[j]); rlj[4 + j] = __builtin_amdgcn_rcpf(n1[j]); rlj[8 + j] = __builtin_amdgcn_rcpf(n2[j]); rlj[12 + j] = __builtin_amdgcn_rcpf(n3[j]); }
            float* Ow = ((w4 & 1) ? cur.O1 : cur.O0) + (size_t)((w4 >> 1) * 2 * QBLK) * D;
#pragma unroll
            for (int r = 0; r < 16; ++r) { const int orow = crow(r, hie);
#pragma unroll
                for (int d0 = 0; d0 < 4; ++d0) { Ow[(size_t)orow * D + d0 * 32 + r32e] = o[d0][r] * rli[r]; Ow[(size_t)(QBLK + orow) * D + d0 * 32 + r32e] = o[4 + d0][r] * rlj[r]; } }
        } }
        __syncthreads();
    }
}
#undef LD8
#undef VMW2
}
constexpr size_t al256(size_t x) { return (x + 255) & ~(size_t)255; }
constexpr size_t WS_CTL = 0, CTL_ZERO_BYTES = 1u << 20;
constexpr size_t WS_WGU   = CTL_ZERO_BYTES;
constexpr size_t WS_WDN   = WS_WGU  + (size_t)8 * NGU * DM * 2;
constexpr size_t WS_WOUT  = WS_WDN  + (size_t)8 * DM * FF * 2;
constexpr size_t WS_WMEM  = WS_WOUT + (size_t)4 * DM * DM * 2;
constexpr size_t WS_WAIN  = WS_WMEM + (size_t)4 * 1024 * DM * 2;
constexpr size_t WS_WKV   = WS_WAIN + (size_t)2 * NAIN * DM * 2;
constexpr size_t WS_WBIN  = WS_WKV  + (size_t)NKV * DM * 2;
constexpr size_t WS_COS   = WS_WBIN + (size_t)2 * NBIN * DM * 2;
constexpr size_t WS_MEMN  = WS_COS  + (size_t)SEQ * 64 * 4;
constexpr size_t WS_MK    = WS_MEMN + (size_t)4 * 1024 * DM * 2;
constexpr size_t WS_MV    = WS_MK   + (size_t)4 * 1024 * 512 * 2;
constexpr size_t WS_XB    = WS_MV   + (size_t)4 * 1024 * 512 * 2;
constexpr size_t WS_SS    = WS_XB   + (size_t)M * DM * 2;
constexpr size_t WS_XH    = WS_SS   + (size_t)M * 32 * 4;
constexpr size_t WS_HID   = WS_XH   + (size_t)M * DM * 2;
constexpr size_t WS_ZA    = WS_HID  + (size_t)M * FF * 2;
constexpr size_t WS_VSTAT = WS_ZA   + (size_t)M * 3072 * 2;
constexpr size_t WS_QB    = WS_VSTAT + (size_t)M * 24 * 4;
constexpr size_t WS_KSH   = WS_QB   + (size_t)M * 1536 * 2;
constexpr size_t WS_VSH   = WS_KSH  + (size_t)M * 1536 * 2;
constexpr size_t WS_QMB   = WS_VSH  + (size_t)M * 1536 * 2;
constexpr size_t WS_OATT  = WS_QMB  + (size_t)M * 512 * 2;
constexpr size_t WS_CAT   = WS_OATT + (size_t)2 * 96 * SEQ * 128 * 4;
constexpr size_t WS_END   = WS_CAT  + (size_t)M * DM * 2;
static_assert(WS_WGU % 256 == 0 && WS_COS % 256 == 0 && WS_VSTAT % 256 == 0 && WS_QB % 256 == 0 && WS_END % 256 == 0, "ws alignment");

constexpr int RING_OFF = 0, RING_BYTES = 131072;
constexpr int LDSCTL_OFF = 141312, MISC_OFF = LDSCTL_OFF + 320;
constexpr int LDS_BYTES = 147456;
constexpr int NWAVES = 8;

#define GAS __attribute__((address_space(1)))
#define LAS __attribute__((address_space(3)))
typedef unsigned short bf16r;
typedef unsigned v4u __attribute__((ext_vector_type(4)));
typedef unsigned v2u __attribute__((ext_vector_type(2)));
typedef float f32x4 __attribute__((ext_vector_type(4)));
typedef short bf16x8 __attribute__((ext_vector_type(8)));
typedef GAS unsigned gu32;
#define LDS_WAIT() asm volatile("s_waitcnt lgkmcnt(0)" ::: "memory")
#define VM_WAIT() asm volatile("s_waitcnt vmcnt(0)" ::: "memory")
__device__ __forceinline__ unsigned f2bf(float f) { unsigned u = __builtin_bit_cast(unsigned, f); return (u + 0x7fffu + ((u >> 16) & 1u)) >> 16; }
__device__ __forceinline__ unsigned pk2(float lo, float hi) { return f2bf(lo) | (f2bf(hi) << 16); }
__device__ __forceinline__ float bf2f(unsigned short b) { return __builtin_bit_cast(float, ((unsigned)b) << 16); }
__device__ __forceinline__ float wave_sum(float v) {
#pragma unroll
    for (int o = 1; o < 64; o <<= 1) v += __shfl_xor(v, o);
    return v;
}
#define XB_TMO      128
#define XB_XCNT(j)  (256  + 64 * (j))
#define XB_XSUB(j)  (1280 + 64 * (j))
#define XB_XGEN(j)  (2304 + 64 * (j))
#define XB_TOP      3328
#define XB_TOPGEN   3392
#define XCD_BAR_WORDS 3456
#define XB_SPIN_CAP (1u << 18)

__device__ __forceinline__ unsigned xb_ld(unsigned* p)              { return __hip_atomic_load(p, __ATOMIC_RELAXED, __HIP_MEMORY_SCOPE_AGENT); }
__device__ __forceinline__ unsigned xb_add(unsigned* p, unsigned v) { return __hip_atomic_fetch_add(p, v, __ATOMIC_RELAXED, __HIP_MEMORY_SCOPE_AGENT); }
__device__ __forceinline__ unsigned xb_xcc_id() { return (unsigned)__builtin_amdgcn_s_getreg((3 << 11) | 20) & 0xFu; }
#define XB_SPIN(cond, bar) do { unsigned _sp = 0; while (cond) { __builtin_amdgcn_s_sleep(1); \
    if ((++_sp & 255u) == 0u) { if (xb_ld(&(bar)[XB_TMO])) break; if (_sp > XB_SPIN_CAP) { atomicAdd(&(bar)[XB_TMO], 1u); break; } } } } while (0)

struct XcdBarrier {
    unsigned* bar; unsigned x;
    volatile LAS unsigned* st;
};

__device__ __forceinline__ XcdBarrier xcd_barrier_post(unsigned* bar, volatile LAS unsigned* st) {
    XcdBarrier b; b.bar = bar; b.x = xb_xcc_id(); b.st = st;
    if (threadIdx.x == 0) (void)xb_add(&bar[XB_XCNT(b.x)], 1u);
    return b;
}
__device__ __forceinline__ void xcd_barrier_complete(unsigned* bar, unsigned x, unsigned& nloc, unsigned& nx) {
    const unsigned G = gridDim.x * gridDim.y * gridDim.z;
    unsigned sum, cnt, mine, sp = 0u;
    for (;;) {
        sum = 0u; cnt = 0u; mine = 0u;
#pragma unroll
        for (unsigned j = 0; j < 16; ++j) { const unsigned c = xb_ld(&bar[XB_XCNT(j)]); sum += c; cnt += (c > 0u) ? 1u : 0u; mine = (j == x) ? c : mine; }
        if (sum == G) break;
        __builtin_amdgcn_s_sleep(1);
        if ((++sp & 255u) == 0u) { if (xb_ld(&bar[XB_TMO])) break; if (sp > XB_SPIN_CAP) { atomicAdd(&bar[XB_TMO], 1u); break; } }
    }
    nloc = mine > 0u ? mine : 1u; nx = cnt > 0u ? cnt : 1u;
}

__device__ __forceinline__ void xcd_barrier(const XcdBarrier& b) {
    asm volatile("s_waitcnt vmcnt(0)" ::: "memory");
    __syncthreads();
    if (threadIdx.x == 0) {
        unsigned* bar = b.bar;
        __builtin_amdgcn_s_waitcnt(0);
        unsigned nloc = b.st[0], nx = b.st[1];
        if (nloc == 0u) { xcd_barrier_complete(bar, b.x, nloc, nx); b.st[0] = nloc; b.st[1] = nx; }
        const unsigned old = xb_add(&bar[XB_XSUB(b.x)], 1u);
        const unsigned gen = old / nloc;
        if (old + 1u == (gen + 1u) * nloc) {
            __builtin_amdgcn_fence(__ATOMIC_RELEASE, "agent");
            asm volatile("s_waitcnt vmcnt(0)" ::: "memory");
            const unsigned og = xb_add(&bar[XB_TOP], 1u);
            const unsigned tg = og / nx;
            if (og + 1u == (tg + 1u) * nx) xb_add(&bar[XB_TOPGEN], 1u);
            else XB_SPIN(xb_ld(&bar[XB_TOPGEN]) == tg, bar);
            __builtin_amdgcn_fence(__ATOMIC_ACQUIRE, "agent");
            xb_add(&bar[XB_XGEN(b.x)], 1u);
            asm volatile("s_waitcnt vmcnt(0)" ::: "memory");
        } else {
            XB_SPIN(xb_ld(&bar[XB_XGEN(b.x)]) == gen, bar);
            __builtin_amdgcn_fence(__ATOMIC_ACQUIRE, "agent");
            asm volatile("s_waitcnt vmcnt(0)" ::: "memory");
        }
    }
    __syncthreads();
}

#define XB_LSUB(j)  (4096 + 64 * (j))
#define XB_LGEN(j)  (5120 + 64 * (j))
#define XB_XCCTAB   6144
__device__ __forceinline__ void xcd_local_barrier(const XcdBarrier& b) {
    asm volatile("s_waitcnt vmcnt(0)" ::: "memory");
    __syncthreads();
    if (threadIdx.x == 0) {
        unsigned* bar = b.bar;
        __builtin_amdgcn_s_waitcnt(0);
        const unsigned nloc = b.st[0] ? b.st[0] : 1u;
        const unsigned old = xb_add(&bar[XB_LSUB(b.x)], 1u);
        const unsigned gen = old / nloc;
        if (old + 1u == (gen + 1u) * nloc) {
#ifndef LOCAL_BAR_RELEASE
#define LOCAL_BAR_RELEASE 0
#endif
            if (LOCAL_BAR_RELEASE) { __builtin_amdgcn_fence(__ATOMIC_RELEASE, "agent"); asm volatile("s_waitcnt vmcnt(0)" ::: "memory"); }
            __builtin_amdgcn_fence(__ATOMIC_ACQUIRE, "agent");
            xb_add(&bar[XB_LGEN(b.x)], 1u);
            asm volatile("s_waitcnt vmcnt(0)" ::: "memory");
        } else {
            XB_SPIN(xb_ld(&bar[XB_LGEN(b.x)]) == gen, bar);
            __builtin_amdgcn_fence(__ATOMIC_ACQUIRE, "agent");
            asm volatile("s_waitcnt vmcnt(0)" ::: "memory");
        }
    }
    __syncthreads();
}
struct Frame {
    unsigned char* lds_g;
    LAS unsigned char* lds;
    volatile LAS unsigned* MISC;
    gu32* ctl;
    int tid, lane, wave;
    int vcu, G;
    unsigned char* ws;
};

__device__ __forceinline__ void transpose_item(const float* W, int K, int N, bf16r* WT, size_t dst_row0, int k0, int n0, LAS float* scr, int lane, const float* gain) {
    f32x4 v[16]; float gk[16];
#pragma unroll
    for (int i = 0; i < 16; ++i) { const int kk = 4 * i + (lane >> 4); v[i] = *(const f32x4*)(W + (size_t)(k0 + kk) * N + n0 + (lane & 15) * 4); gk[i] = gain ? gain[k0 + kk] : 1.0f; }
#pragma unroll
    for (int i = 0; i < 16; ++i) { const int kk = 4 * i + (lane >> 4); const f32x4 w = v[i] * gk[i];
        LAS float* s = scr + kk * 65 + (lane & 15) * 4; s[0] = w[0]; s[1] = w[1]; s[2] = w[2]; s[3] = w[3]; }
    LDS_WAIT(); asm volatile("" ::: "memory");
    const int c = lane & 7;
#pragma unroll
    for (int j = 0; j < 8; ++j) { const int n = (lane >> 3) + 8 * j; const LAS float* s = scr + (8 * c) * 65 + n;
        v4u o; o.x = pk2(s[0 * 65], s[1 * 65]); o.y = pk2(s[2 * 65], s[3 * 65]); o.z = pk2(s[4 * 65], s[5 * 65]); o.w = pk2(s[6 * 65], s[7 * 65]);
        const size_t row = dst_row0 + n;
        *(v4u*)(WT + (((row >> 8) * (size_t)(K >> 6) + (k0 >> 6)) << 14) + ((row & 255) << 6) + 8 * c) = o; }
    LDS_WAIT(); asm volatile("" ::: "memory");
}
__device__ __forceinline__ bool transpose_group(int& r, const float* src, int cnt, int K, int N, bf16r* dst, bool gu, LAS float* scr, int lane, const float* gain, int gmode) {
    const int nkb = K / 64, nnb = N / 64, per = nkb * nnb;
    if (r >= cnt * per) { r -= cnt * per; return false; }
    const int mi = r / per, q = r % per, kb = q / nnb, nb = q % nnb, n0 = nb * 64;
    size_t drow = n0;
    if (gu) { drow = (n0 < FF) ? (size_t)(n0 / 128) * 256 + (n0 % 128) : (size_t)((n0 - FF) / 128) * 256 + 128 + ((n0 - FF) % 128); }
    const float* gp = gain;
    if (gain) { if (gmode == 1) gp = gain + (size_t)((mi >> 1) * 3 + (mi & 1) * 2) * K; else if (gmode >= 2) gp = gain + (size_t)((mi + (gmode - 2)) * 3 + 1) * K; }
    transpose_item(src + (size_t)mi * K * N, K, N, dst + (size_t)mi * K * N, gu ? drow : (size_t)n0, kb * 64, n0, scr, lane, gp);
    return true;
}
__device__ __forceinline__ void norm_row(const float* xrow, const float* gain, bf16r* orow, int lane) {
    const f32x4* xr = (const f32x4*)xrow + lane; f32x4 v[8]; float s = 0.f;
#pragma unroll
    for (int j = 0; j < 8; ++j) { v[j] = xr[64 * j]; s += (v[j][0] * v[j][0] + v[j][1] * v[j][1]) + (v[j][2] * v[j][2] + v[j][3] * v[j][3]); }
    const float rstd = 1.0f / sqrtf(wave_sum(s) * (1.0f / DM) + EPS);
    const f32x4* g4 = (const f32x4*)gain + lane; v2u* o8 = (v2u*)orow + lane;
#pragma unroll
    for (int j = 0; j < 8; ++j) { const f32x4 g = g4[64 * j]; v2u w; w.x = pk2(v[j][0] * rstd * g[0], v[j][1] * rstd * g[1]); w.y = pk2(v[j][2] * rstd * g[2], v[j][3] * rstd * g[3]); o8[64 * j] = w; }
}
__device__ __forceinline__ void xb_ss_phase(const Frame& F, const float* x, bf16r* xb, float* ss) {
    const int gw = F.vcu * NWAVES + F.wave, NGW = F.G * NWAVES, lane = F.lane;
    for (int m = gw; m < M; m += NGW) { const f32x4* xr = (const f32x4*)(x + (size_t)m * DM) + lane; float s = 0.f;
#pragma unroll
        for (int j = 0; j < 8; ++j) { const f32x4 v = xr[64 * j]; s += (v[0] * v[0] + v[1] * v[1]) + (v[2] * v[2] + v[3] * v[3]); v2u w; w.x = pk2(v[0], v[1]); w.y = pk2(v[2], v[3]); const int col = 4 * lane + 256 * j; *(v2u*)(xb + (((size_t)((m >> 8) * (DM >> 6) + (col >> 6))) << 14) + ((m & 255) << 6) + (col & 63)) = w; }
        s = wave_sum(s); if (lane < 32) ss[(size_t)m * 32 + lane] = (lane == 0) ? s : 0.f; }
}
__device__ __forceinline__ void sincos_d(float angf, float& sn, float& cs) {
    const double a = (double)angf; const double k = __builtin_rint(a * 0.15915494309189535); const double r = a - k * 6.283185307179586476925286766559;
    const double r2 = r * r; double ts = r, tc = 1.0, ss = r, cc = 1.0;
#pragma unroll
    for (int n = 1; n <= 14; ++n) { tc = -tc * r2 / (double)((2 * n - 1) * (2 * n)); ts = -ts * r2 / (double)((2 * n) * (2 * n + 1)); cc += tc; ss += ts; }
    sn = (float)ss; cs = (float)cc;
}
__device__ __forceinline__ void combine_phase(const Frame& F, const float* oatt, const float* lamp  , const float* subg  , float lam_init, bf16r* cat) {
    const int gw = F.vcu * NWAVES + F.wave, NGW = F.G * NWAVES, lane = F.lane;
    const float d01 = wave_sum(lamp[lane] * lamp[128 + lane] + lamp[64 + lane] * lamp[192 + lane]);
    const float d23 = wave_sum(lamp[256 + lane] * lamp[384 + lane] + lamp[320 + lane] * lamp[448 + lane]);
    const float lam = expf(d01) - expf(d23) + lam_init;
    const int half = lane >> 5, d4 = (lane & 31) * 4; const f32x4 g = *(const f32x4*)(subg + half * 128 + d4) * (1.0f - lam_init);
    const bool own = F.G == 256; const int m0 = own ? 2048 * ((int)blockIdx.x & 7) + ((int)blockIdx.x >> 3) * NWAVES + F.wave : gw, mstep = own ? 256 : NGW, mend = own ? 2048 * ((int)blockIdx.x & 7) + 2048 : M;
    for (int m = m0; m < mend; m += mstep) { const int b = m >> 12, s = m & 4095;
        f32x4 o[DH]; float ss[DH];
#pragma unroll
        for (int h = 0; h < DH; ++h) { const size_t vh0 = (size_t)((b * 6 + h) * 2 + 0) * 2 + half, vh1 = (size_t)((b * 6 + h) * 2 + 1) * 2 + half;
            const f32x4 o0 = *(const f32x4*)(oatt + (vh0 * SEQ + s) * 128 + d4), o1 = *(const f32x4*)(oatt + (vh1 * SEQ + s) * 128 + d4);
            o[h] = o0 - o1 * lam; ss[h] = (o[h][0] * o[h][0] + o[h][1] * o[h][1]) + (o[h][2] * o[h][2] + o[h][3] * o[h][3]); }
#pragma unroll
        for (int sh = 1; sh < 64; sh <<= 1) {
#pragma unroll
            for (int h = 0; h < DH; ++h) ss[h] += __shfl_xor(ss[h], sh); }
#pragma unroll
        for (int h = 0; h < DH; ++h) { const float rstd = 1.0f / sqrtf(ss[h] * (1.0f / DV) + EPS);
            v2u w; w.x = pk2(o[h][0] * rstd * g[0], o[h][1] * rstd * g[1]); w.y = pk2(o[h][2] * rstd * g[2], o[h][3] * rstd * g[3]);
            *(v2u*)(cat + (size_t)m * DM + h * 256 + half * 128 + d4) = w; }
    }
}

constexpr int GM_WL = 0, GM_WLS = 272, GM_VT = 128 * GM_WLS, GM_VTS = 272, GM_RS = GM_VT + 256 * GM_VTS;
static_assert(GM_RS + 512 <= RING_BYTES, "gmlp LDS");
__device__ __forceinline__ void gmlp_phase(const Frame& F, const bf16r* ZA, const float* vstat, const float* w_s  , const float* b_s  , const float* gv  , bf16r* cat) {
    const int tid = F.tid, lane = F.lane, wave = F.wave, fr = lane & 15, fq = lane >> 4;
    LAS unsigned char* lds = F.lds;
    LAS float* rs = (LAS float*)(lds + GM_RS);
    const bool own = F.G == 256; const int xg = (int)blockIdx.x & 7, jg = (int)blockIdx.x >> 3;
    for (int unit = own ? jg : F.vcu; unit < (own ? 96 : 128 * GG); unit += own ? 32 : F.G) {
        const int bc = own ? 16 * xg + unit / GG : unit / GG, g = unit % GG, r0 = bc * 128;
        if (tid < 128) { const f32x4* p = (const f32x4*)(vstat + (size_t)(r0 + tid) * 24); float s = 0.f;
#pragma unroll
            for (int i = 0; i < 6; ++i) { const f32x4 v = p[i]; s += (v[0] + v[1]) + (v[2] + v[3]); }
            rs[tid] = 1.0f / sqrtf(s * (1.0f / MIXW) + EPS); }
        { const int s = tid & 127, cb = (tid >> 7) * 8;
#pragma unroll
          for (int it = 0; it < 8; ++it) { const int d8 = (cb + it) * 8; const bf16x8 v = *(const bf16x8*)(ZA + (size_t)(r0 + s) * 3072 + 1536 + g * 256 + d8);
#pragma unroll
              for (int e = 0; e < 8; ++e) *(LAS unsigned short*)(lds + GM_VT + (d8 + e) * GM_VTS + s * 2) = (unsigned short)v[e]; } }
        __syncthreads();
        for (int idx = tid; idx < 128 * 32; idx += 512) { const int t = idx >> 5, s4 = (idx & 31) * 4; const f32x4 w = *(const f32x4*)(w_s + ((size_t)g * 128 + t) * 128 + s4);
            float e[4];
#pragma unroll
            for (int j = 0; j < 4; ++j) e[j] = (s4 + j <= t) ? w[j] * rs[s4 + j] : 0.f;
            v2u o; o.x = pk2(e[0], e[1]); o.y = pk2(e[2], e[3]); *(LAS v2u*)(lds + GM_WL + t * GM_WLS + s4 * 2) = o; }
        __syncthreads();
        f32x4 acc[8][2];
#pragma unroll
        for (int tt = 0; tt < 8; ++tt) { acc[tt][0] = (f32x4){0.f, 0.f, 0.f, 0.f}; acc[tt][1] = (f32x4){0.f, 0.f, 0.f, 0.f}; }
#pragma unroll
        for (int ks = 0; ks < 4; ++ks) {
            bf16x8 bfr[2];
#pragma unroll
            for (int dd = 0; dd < 2; ++dd) bfr[dd] = *(const LAS bf16x8*)(lds + GM_VT + (32 * wave + 16 * dd + fr) * GM_VTS + (32 * ks + 8 * fq) * 2);
#pragma unroll
            for (int tt = 0; tt < 8; ++tt) { if (32 * ks <= 16 * tt + 15) {
                const bf16x8 afr = *(const LAS bf16x8*)(lds + GM_WL + (16 * tt + fr) * GM_WLS + (32 * ks + 8 * fq) * 2);
#pragma unroll
                for (int dd = 0; dd < 2; ++dd) acc[tt][dd] = __builtin_amdgcn_mfma_f32_16x16x32_bf16(bfr[dd], afr, acc[tt][dd], 0, 0, 0); } }
        }
#pragma unroll
        for (int tt = 0; tt < 8; ++tt) { const int t = 16 * tt + fr, row = r0 + t; const float bias = b_s[g * 128 + t];
#pragma unroll
            for (int dd = 0; dd < 2; ++dd) { const int d = 32 * wave + 16 * dd + 4 * fq; const f32x4 gg = *(const f32x4*)(gv + g * 256 + d);
                const v2u uu = *(const v2u*)(ZA + (size_t)row * 3072 + g * 256 + d);
                const float u0 = bf2f((unsigned short)(uu.x & 0xffff)), u1 = bf2f((unsigned short)(uu.x >> 16)), u2 = bf2f((unsigned short)(uu.y & 0xffff)), u3 = bf2f((unsigned short)(uu.y >> 16));
                const f32x4 a = acc[tt][dd]; v2u o; o.x = pk2(u0 * (a[0] * gg[0] + bias), u1 * (a[1] * gg[1] + bias)); o.y = pk2(u2 * (a[2] * gg[2] + bias), u3 * (a[3] * gg[3] + bias));
                *(v2u*)(cat + (size_t)row * DM + g * 256 + d) = o; } }
        __syncthreads();
    }
}
namespace att {
__device__ __forceinline__ BlockRef<bf16, float> diff_ref(int L, int pass, const bf16* Q, const bf16* K, const bf16* V, float* O) {
    const int vh = L >> 3, x = L & 7, qb = pass ? 15 - x : x;
    const int b = vh / 24, r = vh % 24, h = r >> 2, c = (r >> 1) & 1, half = r & 1;
    BlockRef<bf16, float> R;
    R.Q = Q + ((size_t)((b * 2 + c) * 6 + h) * SEQ + (size_t)qb * QB) * D; R.K = K + (size_t)((b * 2 + c) * 6 + h) * SEQ * D; R.V = V + (size_t)((b * 6 + h) * 2 + half) * SEQ * D;
    R.O = O + ((size_t)vh * SEQ + (size_t)qb * QB) * D; R.P0 = qb * QB; R.ldo = D;
    return R;
}
__device__ __forceinline__ void diff_attn_phase(char* lds, const bf16* Q, const bf16* K, const bf16* V, float* O, int G, int c0) {
    constexpr int total = 96 * 8; const int W = 1 << 30;
    int L = c0; if (L >= total) return;
    int pass = 0; BlockRef<bf16, float> cur = diff_ref(L, 0, Q, K, V, O);
    Seam<bf16> S;
    causal_swa_prime<bf16, float>(cur, W, lds, S);
    for (;;) {
        const bool more_pass = pass == 0, more_item = L + G < total, last = !more_pass && !more_item;
        int passn = pass + 1, Ln = L;
        if (!more_pass) { passn = 0; Ln = more_item ? L + G : L; }
        const BlockRef<bf16, float> nxt = last ? cur : diff_ref(Ln, passn, Q, K, V, O);
        causal_swa_block<bf16, float>(cur, nxt, SEQ, W, lds, S);
        if (last) break;
        cur = nxt; pass = passn; L = Ln;
    }
}
__device__ __forceinline__ Ref2 diff_ref2(int L, int pass, const bf16* Q, const bf16* K, const bf16* V, float* O) {
    const int bhc = L >> 4, x = L & 15, qb = pass ? 31 - x : x;
    const int b = bhc / 12, r = bhc % 12, h = r >> 1, c = r & 1;
    Ref2 R; const size_t qk = (size_t)((b * 2 + c) * 6 + h) * SEQ;
    R.Q = Q + (qk + (size_t)qb * QB2) * D; R.K = K + qk * D;
    R.V0 = V + (size_t)((b * 6 + h) * 2) * SEQ * D; R.V1 = R.V0 + (size_t)SEQ * D;
    const size_t vh = (size_t)b * 24 + h * 4 + c * 2;
    R.O0 = O + (vh * SEQ + (size_t)qb * QB2) * D; R.O1 = R.O0 + (size_t)SEQ * D; R.P0 = qb * QB2;
    return R;
}
template <bool RS>
__device__ __forceinline__ void diff_attn2_role(char* lds, float* xl, const bf16* Q, const bf16* K, const bf16* V, float* O, int G, int c0) {
    constexpr int total = 48 * 16;
    int L = c0; if (L >= total) return;
    int pass = 0; Ref2 cur = diff_ref2(L, 0, Q, K, V, O);
    Seam2 S;
    diff2_prime<RS>(cur, lds, S);
    for (;;) {
        const bool more_pass = pass == 0, more_item = L + G < total, last = !more_pass && !more_item;
        int passn = pass + 1, Ln = L;
        if (!more_pass) { passn = 0; Ln = more_item ? L + G : L; }
        const Ref2 nxt = last ? cur : diff_ref2(Ln, passn, Q, K, V, O);
        diff2_block<RS>(cur, nxt, lds, xl, S);
        if (last) break;
        cur = nxt; pass = passn; L = Ln;
    }
}
__device__ __forceinline__ void diff_attn2_phase(char* lds, float* xl, const bf16* Q, const bf16* K, const bf16* V, float* O, int G, int c0) {
    if (__builtin_amdgcn_readfirstlane((int)threadIdx.x >> 6) < 4) diff_attn2_role<true>(lds, xl, Q, K, V, O, G, c0);
    else diff_attn2_role<false>(lds, xl, Q, K, V, O, G, c0);
}
__device__ __forceinline__ BlockRef<bf16, bf16> mem_ref(int L, const bf16* Q, const bf16* K, const bf16* V, bf16* cat) {
    const int bh = L >> 4, qb = L & 15, b = bh >> 2, hm = bh & 3;
    BlockRef<bf16, bf16> R;
    R.Q = Q + ((size_t)bh * SEQ + (size_t)qb * QB) * D; R.K = K + (size_t)bh * MEML * D; R.V = V + (size_t)bh * MEML * D;
    R.O = cat + ((size_t)b * SEQ + (size_t)qb * QB) * DM + 1536 + hm * 128; R.P0 = 256; R.ldo = DM;
    return R;
}
__device__ __forceinline__ void mem_attn_phase(char* lds, const bf16* Q, const bf16* K, const bf16* V, bf16* cat, int G, int c0) {
    constexpr int total = 256; const int W = 1 << 30;
    int L = c0; if (L >= total) return;
    BlockRef<bf16, bf16> cur = mem_ref(L, Q, K, V, cat);
    Seam<bf16> S;
    causal_swa_prime<bf16, bf16>(cur, W, lds, S);
    for (;;) {
        const bool last = L + G >= total;
        const BlockRef<bf16, bf16> nxt = last ? cur : mem_ref(L + G, Q, K, V, cat);
        causal_swa_block<bf16, bf16>(cur, nxt, MEML, W, lds, S);
        if (last) break;
        cur = nxt; L += G;
    }
}

struct DynAttn { unsigned* qcnt; const unsigned* rq; const unsigned* rkv; unsigned tag; unsigned* tmo; volatile __attribute__((address_space(3))) unsigned* bc; };
__device__ __forceinline__ unsigned dyn_pull(const DynAttn& C, int bpref) {
    if (threadIdx.x == 0) {
        unsigned code = 0xffffffffu;
        for (unsigned spins = 0;; ++spins) {
            bool any_left = false;
#pragma unroll 1
            for (int k = 0; k < 4 && code == 0xffffffffu; ++k) { const int b = (bpref + k) & 3;
                if (__hip_atomic_load(C.qcnt + 64 * b, __ATOMIC_RELAXED, __HIP_MEMORY_SCOPE_AGENT) >= 384u) continue;
                any_left = true;
                const bool ready = __hip_atomic_load(C.rq + 64 * (2 * b), __ATOMIC_RELAXED, __HIP_MEMORY_SCOPE_AGENT) == C.tag && __hip_atomic_load(C.rq + 64 * (2 * b + 1), __ATOMIC_RELAXED, __HIP_MEMORY_SCOPE_AGENT) == C.tag &&
                                   __hip_atomic_load(C.rkv + 64 * (2 * b), __ATOMIC_RELAXED, __HIP_MEMORY_SCOPE_AGENT) != 0u && __hip_atomic_load(C.rkv + 64 * (2 * b + 1), __ATOMIC_RELAXED, __HIP_MEMORY_SCOPE_AGENT) != 0u;
                if (!ready) continue;
                const unsigned n = __hip_atomic_fetch_add(C.qcnt + 64 * b, 1u, __ATOMIC_RELAXED, __HIP_MEMORY_SCOPE_AGENT);
                if (n < 384u) code = ((unsigned)b << 16) | n;
            }
            if (code != 0xffffffffu || !any_left) break;
            __builtin_amdgcn_s_sleep(8);
            if ((spins & 255u) == 255u) { if (__hip_atomic_load(C.tmo, __ATOMIC_RELAXED, __HIP_MEMORY_SCOPE_AGENT)) break; if (spins > (1u << 20)) { __hip_atomic_store(C.tmo, 1u, __ATOMIC_RELAXED, __HIP_MEMORY_SCOPE_AGENT); break; } }
        }
        __builtin_amdgcn_fence(__ATOMIC_ACQUIRE, "agent");
        asm volatile("s_waitcnt vmcnt(0)" ::: "memory");
        C.bc[0] = code;
    }
    __syncthreads();
    const unsigned code = C.bc[0];
    __syncthreads();
    return code;
}
__device__ __forceinline__ BlockRef<bf16, float> dyn_ref(unsigned code, const bf16* Q, const bf16* K, const bf16* V, float* O) {
    const int b = (int)(code >> 16), n = (int)(code & 0xffffu), qb = 15 - (n & 15), r = n >> 4, h = r >> 2, c = (r >> 1) & 1, half = r & 1, vh = b * 24 + r;
    BlockRef<bf16, float> R;
    R.Q = Q + ((size_t)((b * 2 + c) * 6 + h) * SEQ + (size_t)qb * QB) * D; R.K = K + (size_t)((b * 2 + c) * 6 + h) * SEQ * D; R.V = V + (size_t)((b * 6 + h) * 2 + half) * SEQ * D;
    R.O = O + ((size_t)vh * SEQ + (size_t)qb * QB) * D; R.P0 = qb * QB; R.ldo = D;
    return R;
}
__device__ __forceinline__ void diff_attn_dyn_phase(char* lds, const bf16* Q, const bf16* K, const bf16* V, float* O, const DynAttn& C, int bpref) {
    const int W = 1 << 30;
    unsigned code = dyn_pull(C, bpref); if (code == 0xffffffffu) return;
    BlockRef<bf16, float> cur = dyn_ref(code, Q, K, V, O);
    Seam<bf16> S;
    causal_swa_prime<bf16, float>(cur, W, lds, S);
    for (;;) {
        const unsigned nc = dyn_pull(C, bpref); const bool last = nc == 0xffffffffu;
        const BlockRef<bf16, float> nxt = last ? cur : dyn_ref(nc, Q, K, V, O);
        causal_swa_block<bf16, float>(cur, nxt, SEQ, W, lds, S);
        if (last) break;
        cur = nxt;
    }
}
}

constexpr int NPL = 8, PH_BASE = 1, NPH = PH_BASE + DEPTH * NPL;
enum { I_X = 0, I_MEM, I_NORMG, I_WGU, I_WDN, I_WOUT, I_MEMNG, I_MEMWKV, I_MEMQG, I_MEMKG, I_AWIN, I_AVG, I_AWS, I_ABS, I_KVG, I_WKV, I_KG, I_BWIN, I_BQG, I_BLAM, I_BSUBG, N_IN };
struct Args { const float* in[N_IN]; float* out; unsigned char* ws; int ph_lo, ph_hi, li, pad; };

#ifndef EN_MASK
#define EN_MASK 0xFFFFFFFFu
#endif
#define SITE(n) (((EN_MASK) >> (n)) & 1u)
#define IN(k) (lo <= (k) && (k) < hi)
#ifndef PROBE_WAIT
#define PROBE_WAIT 0
#endif
#ifndef PROBE_PHASE
#define PROBE_PHASE 0
#endif
#ifndef LOCAL_SEAMS
#define LOCAL_SEAMS 1
#endif
#define SEAM_X(k, local) do { if (IN((k) + 1)) { unsigned long long t0_ = 0; if (PROBE_WAIT) t0_ = __builtin_amdgcn_s_memrealtime(); \
    if (LOCAL_SEAMS && (local) && F.MISC[24] != 0u) xcd_local_barrier(bar); else xcd_barrier(bar); \
    if (PROBE_WAIT && ((PROBE_WAIT >> CUR_SITE) & 1) && F.tid == 0) F.MISC[16] += (unsigned)(__builtin_amdgcn_s_memrealtime() - t0_); \
    } \
    if (PROBE_PHASE && ((PROBE_PHASE >> CUR_SITE) & 1) && F.tid == 0) F.MISC[17] += (unsigned)(__builtin_amdgcn_s_memrealtime() - tsite_); } while (0)
#define SEAM(k) SEAM_X(k, false)
#define SEAM_L(k) SEAM_X(k, true)
constexpr int CW_RQ = 70016, CW_RKV = 70656, CW_QCNT = 71296;
#define PUBLISH_FLAG(word, val) do { if (blockIdx.x < 8 && F.tid == 0) { __builtin_amdgcn_fence(__ATOMIC_RELEASE, "agent"); asm volatile("s_waitcnt vmcnt(0)" ::: "memory"); \
    __hip_atomic_store((unsigned*)F.ctl + (word) + 64 * (blockIdx.x & 7), (unsigned)(val), __ATOMIC_RELAXED, __HIP_MEMORY_SCOPE_AGENT); } } while (0)
#define SITE_T0 unsigned long long tsite_ = 0; if (PROBE_PHASE) tsite_ = __builtin_amdgcn_s_memrealtime(); (void)tsite_;
#define CAS __attribute__((address_space(4)))
#define WS_PTRS \
    const CAS Args* ap = (const CAS Args*)__builtin_amdgcn_kernarg_segment_ptr(); asm volatile("" : "+s"(ap)); \
    unsigned char* const ws = ap->ws; \
    bf16r* const Wgu = (bf16r*)(ws + WS_WGU); bf16r* const Wdn = (bf16r*)(ws + WS_WDN); bf16r* const Wout = (bf16r*)(ws + WS_WOUT); bf16r* const Wmem = (bf16r*)(ws + WS_WMEM); \
    bf16r* const Wain = (bf16r*)(ws + WS_WAIN); bf16r* const Wkv = (bf16r*)(ws + WS_WKV); bf16r* const Wbin = (bf16r*)(ws + WS_WBIN); \
    unsigned* const CS = (unsigned*)(ws + WS_COS); \
    bf16r* const MEMN = (bf16r*)(ws + WS_MEMN); bf16r* const MK = (bf16r*)(ws + WS_MK); bf16r* const MV = (bf16r*)(ws + WS_MV); \
    bf16r* const XB = (bf16r*)(ws + WS_XB); float* const SS = (float*)(ws + WS_SS); _Float16* const XH = (_Float16*)(ws + WS_XH); bf16r* const HID = (bf16r*)(ws + WS_HID); bf16r* const ZA = (bf16r*)(ws + WS_ZA); \
    float* const VSTAT = (float*)(ws + WS_VSTAT); \
    bf16r* const QB_ = (bf16r*)(ws + WS_QB); bf16r* const KSH = (bf16r*)(ws + WS_KSH); bf16r* const VSH = (bf16r*)(ws + WS_VSH); bf16r* const QMB = (bf16r*)(ws + WS_QMB); \
    float* const OATT = (float*)(ws + WS_OATT); bf16r* const CAT = (bf16r*)(ws + WS_CAT); \
    float* const X = ap->out; \
    (void)Wgu; (void)Wdn; (void)Wout; (void)Wmem; (void)Wain; (void)Wkv; (void)Wbin; (void)CS; (void)MEMN; (void)MK; (void)MV; (void)XB; (void)SS; (void)XH; (void)HID; (void)ZA; \
    (void)VSTAT; (void)QB_; (void)KSH; (void)VSH; (void)QMB; (void)OATT; (void)CAT; (void)X;

constexpr int EX_OFF = RING_BYTES + 2048;
constexpr int RTAB_OFF = RING_BYTES;
__device__ __forceinline__ pg8::RowScale fill_rstd(const Frame& F, const float* ss, const pg8::StaticOrder& So) {
    pg8::Unit u0; const int pm0 = So.next(0, u0) ? u0.pm : -1;
    { pg8::Unit ui; bool same = true; for (int i = 1; So.next(i, ui); ++i) same &= (ui.pm == pm0); if (!same && F.tid == 0) __hip_atomic_store((unsigned*)F.ctl + XB_TMO, 1u, __ATOMIC_RELAXED, __HIP_MEMORY_SCOPE_AGENT); }
    LAS float* tab = (LAS float*)(F.lds + RTAB_OFF);
    __syncthreads();
    if (pm0 >= 0 && F.tid < 256) { const f32x4* p = (const f32x4*)(ss + (size_t)(pm0 * 256 + F.tid) * 32); float s = 0.f;
#pragma unroll
        for (int i = 0; i < 8; ++i) { const f32x4 v = p[i]; s += (v[0] + v[1]) + (v[2] + v[3]); }
        const float v = s * (1.0f / DM) + EPS; tab[2 * F.tid] = 1.0f / sqrtf(v); tab[2 * F.tid + 1] = v; }
    __syncthreads();
    return pg8::RowScale{(const LAS float*)tab};
}
#ifndef ATTN2
#define ATTN2 1
#endif
#ifndef DYN_ATTN
#define DYN_ATTN 0
#endif
template <int L, int S>
__device__ __forceinline__ void ffn_part(const Frame& F, const XcdBarrier& bar, unsigned char* smem, const int lo, const int hi) {
    constexpr int pf = PH_BASE + L * NPL + (S ? 6 : 0);
    if (SITE(3) && IN(pf)) { constexpr int CUR_SITE = 3; (void)CUR_SITE; SITE_T0 WS_PTRS
        pg8::Gemm g{XB, Wgu + (size_t)(L * 2 + S) * NGU * DM, M, NGU, DM}; pg8::StaticOrder So; So.init(M, NGU, F.G, (int)blockIdx.x);
        pg8::EpiSwiglu E{HID, FF, fill_rstd(F, SS, So)};
        pg8::gemm_phase<pg8::EpiSwiglu, pg8::StaticOrder, true, true, true, true>(F.lds + RING_OFF, g, So, E);
        if constexpr (L == NA && S == 0) {
            pg8::Gemm g2{XB, Wkv, M, NKV, DM}; pg8::StaticOrder S2; S2.init(M, NKV, F.G, (int)blockIdx.x);
            pg8::EpiQKRope E2{1, KSH, VSH, ap->in[I_KG], nullptr, CS, (LAS float*)(F.lds + EX_OFF), fill_rstd(F, SS, S2)};
            pg8::gemm_phase<pg8::EpiQKRope, pg8::StaticOrder, true, true, true, true>(F.lds + RING_OFF, g2, S2, E2);
        }
        SEAM_L(pf);
        if constexpr (L == NA && S == 0) { if (DYN_ATTN && IN(pf + 1)) PUBLISH_FLAG(CW_RKV, 1u); }
    }
    if (SITE(4) && IN(pf + 1)) { constexpr int CUR_SITE = 4; (void)CUR_SITE; SITE_T0 WS_PTRS
        pg8::Gemm g{HID, Wdn + (size_t)(L * 2 + S) * DM * FF, M, DM, FF}; pg8::ColSweepOrder So{(int)blockIdx.x};
        pg8::EpiResid E{(L == 0 && S == 0) ? ap->in[I_X] : nullptr, (L == DEPTH - 1 && S == 1) ? X : nullptr, DM, 0.5f, XB, SS, XH};
        pg8::gemm_phase<pg8::EpiResid, pg8::ColSweepOrder, true, true, true, true>(F.lds + RING_OFF, g, So, E);
        SEAM_L(pf + 1);
    }
}
template <int L>
__device__ __forceinline__ void mixer_part(const Frame& F, const XcdBarrier& bar, unsigned char* smem, const int lo, const int hi) {
    constexpr int pb = PH_BASE + L * NPL;
    if (SITE(6) && IN(pb + 2)) { constexpr int CUR_SITE = 6; (void)CUR_SITE; SITE_T0 WS_PTRS
        if constexpr (L < NA) { pg8::Gemm g{XB, Wain + (size_t)L * NAIN * DM, M, NAIN, DM}; pg8::StaticOrder So; So.init(M, NAIN, F.G, (int)blockIdx.x);
            pg8::EpiAin E{ZA, VSTAT, QMB, ap->in[I_MEMQG] + L * HD, (LAS float*)(F.lds + EX_OFF), fill_rstd(F, SS, So)};
            pg8::gemm_phase<pg8::EpiAin, pg8::StaticOrder, true, true, true, true>(F.lds + RING_OFF, g, So, E);
            if constexpr (L == 0) {
                if ((int)blockIdx.x >= 128) { pg8::Gemm gm{MEMN, Wmem, 4096, 4096, DM}; pg8::MemKvOrder Sm{F.G, (int)blockIdx.x - 128};
                    pg8::EpiMemKv Em{MK, MV, ap->in[I_MEMKG], (LAS float*)(F.lds + EX_OFF)};
                    pg8::gemm_phase<pg8::EpiMemKv, pg8::MemKvOrder, true, true, false, true>(F.lds + RING_OFF, gm, Sm, Em); } } }
        else { pg8::Gemm g{XB, Wbin + (size_t)(L - NA) * NBIN * DM, M, NBIN, DM}; pg8::StaticOrder So; So.init(M, NBIN, F.G, (int)blockIdx.x);
            pg8::EpiQKRope E{0, QB_, QMB, ap->in[I_BQG] + (L - NA) * HD, ap->in[I_MEMQG] + L * HD, CS, (LAS float*)(F.lds + EX_OFF), fill_rstd(F, SS, So)};
            pg8::gemm_phase<pg8::EpiQKRope, pg8::StaticOrder, true, true, true, true>(F.lds + RING_OFF, g, So, E); }
        if constexpr (L == 1 || (L >= NA && DYN_ATTN)) SEAM_L(pb + 2); else SEAM(pb + 2);
        if constexpr (L >= NA) { if (DYN_ATTN && IN(pb + 3)) PUBLISH_FLAG(CW_RQ, (unsigned)L); }
    }
    if (SITE(8) && IN(pb + 3)) { constexpr int CUR_SITE = 8; (void)CUR_SITE; SITE_T0 WS_PTRS
        if constexpr (L < NA) gmlp_phase(F, ZA, VSTAT, ap->in[I_AWS] + (size_t)L * GG * 128 * 128, ap->in[I_ABS] + (size_t)L * GG * 128, ap->in[I_AVG] + (size_t)L * MIXW, CAT);
        { const int xg = (int)blockIdx.x & 7, jg = (int)blockIdx.x >> 3, pnl = 8 * xg + (jg >> 2);
          const int c0 = ((L < NA || DYN_ATTN) && F.G == 256) ? (((pnl >> 4) * 4 + (jg & 3)) * 16 + (pnl & 15)) : F.vcu;
          att::mem_attn_phase((char*)smem, (const att::bf16*)QMB, (const att::bf16*)(MK + (size_t)L * 1024 * 512), (const att::bf16*)(MV + (size_t)L * 1024 * 512), (att::bf16*)CAT, F.G, c0); }
        if constexpr (L >= NA) {
            float* const Ol = OATT + (size_t)(L - NA) * 96 * SEQ * 128;
            if (DYN_ATTN) { const att::DynAttn C{(unsigned*)F.ctl + CW_QCNT + 64 * 4 * (L - NA), (const unsigned*)F.ctl + CW_RQ, (const unsigned*)F.ctl + CW_RKV, (unsigned)L, (unsigned*)F.ctl + XB_TMO, F.MISC + 28};
                att::diff_attn_dyn_phase((char*)smem, (const att::bf16*)QB_, (const att::bf16*)KSH, (const att::bf16*)VSH, Ol, C, ((int)blockIdx.x & 7) >> 1); }
            else if (ATTN2) att::diff_attn2_phase((char*)smem, (float*)(smem + 133120), (const att::bf16*)QB_, (const att::bf16*)KSH, (const att::bf16*)VSH, Ol, F.G, F.vcu);
            else att::diff_attn_phase((char*)smem, (const att::bf16*)QB_, (const att::bf16*)KSH, (const att::bf16*)VSH, Ol, F.G, F.vcu);
        }
        if constexpr (L < NA) SEAM_L(pb + 3); else SEAM(pb + 3);
    }
    if constexpr (L >= NA) {
        if (SITE(9) && IN(pb + 4)) { constexpr int CUR_SITE = 9; (void)CUR_SITE; SITE_T0 WS_PTRS constexpr float lam_init = (L == 2) ? 0.47071301834358416f : 0.5560582041556405f;
            combine_phase(F, OATT + (size_t)(L - NA) * 96 * SEQ * 128, ap->in[I_BLAM] + (size_t)(L - NA) * 512, ap->in[I_BSUBG] + (size_t)(L - NA) * DV, lam_init, CAT);
            SEAM_L(pb + 4); }
    }
    if (SITE(10) && IN(pb + 5)) { constexpr int CUR_SITE = 10; (void)CUR_SITE; SITE_T0 WS_PTRS
        pg8::Gemm g{CAT, Wout + (size_t)L * DM * DM, M, DM, DM}; pg8::ColSweepOrder So{(int)blockIdx.x};
        pg8::EpiResid E{nullptr, nullptr, DM, 1.0f, XB, SS, XH};
        pg8::gemm_phase<pg8::EpiResid, pg8::ColSweepOrder, true, true, false, true>(F.lds + RING_OFF, g, So, E);
        SEAM_L(pb + 5);
    }
}

__global__ void __launch_bounds__(NWAVES * 64, 2) yoco_fwd(Args args) {
    extern __shared__ __attribute__((aligned(16))) unsigned char smem[];
    Frame F;
    F.lds_g = smem; F.lds = (LAS unsigned char*)smem;
    F.MISC = (volatile LAS unsigned*)(F.lds + MISC_OFF);
    F.tid = threadIdx.x; F.lane = F.tid & 63; F.wave = __builtin_amdgcn_readfirstlane(F.tid >> 6);
    F.G = gridDim.x; { const int bx = blockIdx.x; F.vcu = (F.G % 8 == 0) ? (bx % 8) * (F.G / 8) + bx / 8 : bx; }
    F.ws = args.ws;
    F.ctl = (gu32*)(args.ws + WS_CTL);
    for (int u = F.tid; u < (LDS_BYTES - LDSCTL_OFF) / 4; u += NWAVES * 64) ((LAS unsigned*)(F.lds + LDSCTL_OFF))[u] = 0u;
    __syncthreads();
    XcdBarrier bar = xcd_barrier_post((unsigned*)F.ctl + (size_t)args.li * XCD_BAR_WORDS, F.MISC + 8);
    if (F.tid == 0) __hip_atomic_store((unsigned*)F.ctl + XB_XCCTAB + blockIdx.x, bar.x + 1u, __ATOMIC_RELAXED, __HIP_MEMORY_SCOPE_AGENT);
    const int lo = args.ph_lo, hi = args.ph_hi;
    {
    const int gw = F.vcu * NWAVES + F.wave, NGW = F.G * NWAVES;
    if (SITE(0) && IN(0)) { constexpr int CUR_SITE = 0; (void)CUR_SITE; SITE_T0 WS_PTRS
        LAS float* scr = (LAS float*)(F.lds + RING_OFF + F.wave * 16640);
        constexpr int NIT = 8 * (DM / 64) * (NGU / 64) + 8 * (FF / 64) * (DM / 64) + 4 * 32 * 32 + 4 * 32 * 16 + 2 * 32 * (NAIN / 64) + 32 * (NKV / 64) + 2 * 32 * 32;
        for (int it = gw; it < NIT; it += NGW) { int r = it;
            if (transpose_group(r, ap->in[I_WGU], 8, DM, NGU, Wgu, true, scr, F.lane, ap->in[I_NORMG], 1)) continue;
            if (transpose_group(r, ap->in[I_WDN], 8, FF, DM, Wdn, false, scr, F.lane, nullptr, 0)) continue;
            if (transpose_group(r, ap->in[I_WOUT], 4, DM, DM, Wout, false, scr, F.lane, nullptr, 0)) continue;
            if (transpose_group(r, ap->in[I_MEMWKV], 4, DM, 1024, Wmem, false, scr, F.lane, nullptr, 0)) continue;
            if (transpose_group(r, ap->in[I_AWIN], 2, DM, NAIN, Wain, false, scr, F.lane, ap->in[I_NORMG], 2)) continue;
            if (transpose_group(r, ap->in[I_WKV], 1, DM, NKV, Wkv, false, scr, F.lane, ap->in[I_KVG], 0)) continue;
            transpose_group(r, ap->in[I_BWIN], 2, DM, NBIN, Wbin, false, scr, F.lane, ap->in[I_NORMG], 4); }
        for (int i = gw * 64 + F.lane; i < SEQ * 64; i += NGW * 64) { const int pos = i >> 6, k = i & 63; const float inv = (float)pow(10000.0, -(double)k / 64.0); const float ang = (float)pos * inv;
            float sn, cs; sincos_d(ang, sn, cs); typedef _Float16 h2 __attribute__((ext_vector_type(2))); h2 t; t.x = (_Float16)cs; t.y = (_Float16)sn; CS[i] = __builtin_bit_cast(unsigned, t); }
        for (int r = gw; r < 4096; r += NGW) { const int l = r >> 10, mm = r & 1023; norm_row(ap->in[I_MEM] + (size_t)mm * DM, ap->in[I_MEMNG] + l * DM, MEMN + (size_t)r * DM, F.lane); }
        xb_ss_phase(F, ap->in[I_X], XB, SS);
        SEAM(0);
        if (LOCAL_SEAMS && IN(1)) { if (F.tid < 64) { bool ok = F.G == 256; unsigned mine[4];
#pragma unroll
                for (int q = 0; q < 4; ++q) { const unsigned i = F.tid + 64 * q; mine[q] = __hip_atomic_load((unsigned*)F.ctl + XB_XCCTAB + i, __ATOMIC_RELAXED, __HIP_MEMORY_SCOPE_AGENT);
                    const unsigned rep = __hip_atomic_load((unsigned*)F.ctl + XB_XCCTAB + (i & 7u), __ATOMIC_RELAXED, __HIP_MEMORY_SCOPE_AGENT); ok = ok && mine[q] != 0u && mine[q] == rep; }
                if (F.tid < 8) { for (unsigned o = 0; o < 8; ++o) { const unsigned other = __hip_atomic_load((unsigned*)F.ctl + XB_XCCTAB + o, __ATOMIC_RELAXED, __HIP_MEMORY_SCOPE_AGENT); ok = ok && (o == (unsigned)F.tid || other != mine[0]); } }
                ok = __all(ok); if (F.tid == 0) F.MISC[24] = ok ? 1u : 0u; }
            __syncthreads(); }
    }
    }
    ffn_part<0, 0>(F, bar, smem, lo, hi); mixer_part<0>(F, bar, smem, lo, hi); ffn_part<0, 1>(F, bar, smem, lo, hi);
    ffn_part<1, 0>(F, bar, smem, lo, hi); mixer_part<1>(F, bar, smem, lo, hi); ffn_part<1, 1>(F, bar, smem, lo, hi);
    ffn_part<2, 0>(F, bar, smem, lo, hi); mixer_part<2>(F, bar, smem, lo, hi); ffn_part<2, 1>(F, bar, smem, lo, hi);
    ffn_part<3, 0>(F, bar, smem, lo, hi); mixer_part<3>(F, bar, smem, lo, hi); ffn_part<3, 1>(F, bar, smem, lo, hi);
    if (PROBE_PHASE) { if (blockIdx.x == 0 && F.tid == 0) { const unsigned long long tot = F.MISC[17], t0 = __builtin_amdgcn_s_memrealtime(); while (__builtin_amdgcn_s_memrealtime() - t0 < tot) __builtin_amdgcn_s_sleep(8); } }
#ifdef PROBE_LOCALOK
    if (blockIdx.x == 0 && F.tid == 0 && F.MISC[24] != 0u) { const unsigned long long t0 = __builtin_amdgcn_s_memrealtime(); while (__builtin_amdgcn_s_memrealtime() - t0 < 50000ull) __builtin_amdgcn_s_sleep(8); }
#endif
    if (PROBE_WAIT) {
        unsigned* sumw = (unsigned*)F.ctl + 65536;
        if (F.tid == 0) __hip_atomic_fetch_add(sumw, F.MISC[16], __ATOMIC_RELAXED, __HIP_MEMORY_SCOPE_AGENT);
        xcd_barrier(bar);
        if (blockIdx.x == 0 && F.tid == 0) { const unsigned tot = __hip_atomic_load(sumw, __ATOMIC_RELAXED, __HIP_MEMORY_SCOPE_AGENT); const unsigned long long avg = tot / gridDim.x, t0 = __builtin_amdgcn_s_memrealtime();
            while (__builtin_amdgcn_s_memrealtime() - t0 < avg) __builtin_amdgcn_s_sleep(8); }
    }
}
#undef IN
#undef SEAM

#ifndef MK_MODE
#define MK_MODE 1
#endif
extern "C" void kernel_launch(void* const* d_in, const int* in_sizes, int n_in, void* d_out, int out_size, void* d_ws, size_t ws_size, hipStream_t stream) {
    static int grid = 0;
    if (grid == 0) {
        if (n_in != N_IN || out_size != M * DM || ws_size < WS_END) { fprintf(stderr, "kernel_launch: unexpected shapes: n_in %d out %d ws %zu (need %zu)\n", n_in, out_size, ws_size, (size_t)WS_END); grid = -1; return; }
        int dev = 0, cus = 0, per_cu = 0;
        if (hipGetDevice(&dev) != hipSuccess || hipDeviceGetAttribute(&cus, hipDeviceAttributeMultiprocessorCount, dev) != hipSuccess) { grid = -1; return; }
        if (hipFuncSetAttribute((const void*)yoco_fwd, hipFuncAttributeMaxDynamicSharedMemorySize, LDS_BYTES) != hipSuccess) { fprintf(stderr, "kernel_launch: hipFuncSetAttribute failed\n"); grid = -1; return; }
        if (hipOccupancyMaxActiveBlocksPerMultiprocessor(&per_cu, (const void*)yoco_fwd, NWAVES * 64, LDS_BYTES) != hipSuccess || per_cu < 1) fprintf(stderr, "kernel_launch: occupancy query says %d blocks per CU\n", per_cu);
        (void)hipGetLastError();
        grid = cus;
        if (cus != 256) { fprintf(stderr, "kernel_launch: built for a 256-CU device (got %d)\n", cus); grid = -1; return; }
    }
    if (grid < 0) return;
    (void)in_sizes;
    if (hipMemsetAsync((char*)d_ws + WS_CTL, 0, CTL_ZERO_BYTES, stream) != hipSuccess) return;
    Args a{};
    for (int i = 0; i < N_IN; ++i) a.in[i] = (const float*)d_in[i];
    a.out = (float*)d_out; a.ws = (unsigned char*)d_ws; a.pad = 0;
#if MK_MODE == 1
    a.ph_lo = 0; a.ph_hi = NPH; a.li = 0;
    hipLaunchKernelGGL(yoco_fwd, dim3(grid), dim3(NWAVES * 64), LDS_BYTES, stream, a);
#else
    for (int p = 0; p < NPH; ++p) {
        const int k = (p - PH_BASE) % NPL, l = (p - PH_BASE) / NPL;
        if (p >= PH_BASE && (k == 4 && l < NA)) continue;
        a.ph_lo = p; a.ph_hi = p + 1; a.li = 0;
        hipLaunchKernelGGL(yoco_fwd, dim3(grid), dim3(NWAVES * 64), LDS_BYTES, stream, a);
    }
#endif
}
```

```cpp
#include <hip/hip_runtime.h>
#include <hip/hip_bf16.h>
#include <cstdio>
#include <cstdint>

constexpr int BATCH = 4, SEQ = 4096, DM = 2048, DEPTH = 4, NA = 2;
constexpr int M = BATCH * SEQ;
constexpr int MEML = 256, HD = 128, MEMH = 4, MEMW = 512, MIXW = 1536, CHUNK = 128, GG = 6, GW = 256, DH = 6, DV = 256, FF = 5632;
constexpr int NGU = 2 * FF;
constexpr int NAIN = 2 * MIXW + MEMW;
constexpr int NBIN = MIXW + MEMW;
constexpr int NKV = 2 * DH * HD + DH * DV;
constexpr float EPS = 1e-6f;
namespace pg8 {
#define PG8_LAS __attribute__((address_space(3)))
typedef unsigned short bf16_t;
typedef short bf16x8 __attribute__((ext_vector_type(8)));
typedef float f32x4 __attribute__((ext_vector_type(4)));
typedef unsigned u32x4 __attribute__((ext_vector_type(4)));
constexpr int BM = 256, BK = 64, HALF = 128, HTB = HALF * BK * 2  , STAGE_BYTES = 8 * HTB, NXCD = 8, WGM = 8;

__host__ __device__ __forceinline__ int lds_byte(int r, int c) { const int st = (r >> 4) * 2 + (c >> 5), rr = r & 15, cc = c & 31, ob = rr * 64 + cc * 2; return st * 1024 + (ob ^ (((ob >> 9) & 1) << 5)); }
__host__ __device__ __forceinline__ void stage_rc(int b, int& R, int& C) { const int st = b / 1024, sb = b % 1024, swz = sb ^ (((sb >> 9) & 1) << 5); R = (st >> 1) * 16 + swz / 64; C = (st & 1) * 32 + (swz % 64) / 2; }
__host__ __device__ __forceinline__ int perm32(int rho) { const int n = rho >> 4, i = rho & 15; return 8 * (i >> 2) + 4 * n + (i & 3); }

struct Unit { int pm, pn; };
struct Gemm { const bf16_t* A; const bf16_t* Bt; int M, N, K; };

struct StaticOrder {
    int nM, nN, nwg, G, c;
    __host__ __device__ void init(int M, int N, int G_, int c_) { nM = M / BM; nN = N / BM; nwg = nM * nN; G = G_; c = c_; }
    __host__ __device__ bool next(int i, Unit& u) const {
        const long L = (long)i * G + c; if (L >= nwg) return false;
        int wgid = (int)L; { const int q = nwg / NXCD, r = nwg % NXCD, xcd = wgid % NXCD, off = wgid / NXCD; wgid = (xcd < r ? xcd * (q + 1) : r * (q + 1) + (xcd - r) * q) + off; }
        const int nig = WGM * nN, gid = wgid / nig, fm = gid * WGM, gsz = (nM - fm) < WGM ? (nM - fm) : WGM;
        u.pm = fm + ((wgid % nig) % gsz); u.pn = (wgid % nig) / gsz; return true;
    }
    __device__ __forceinline__ void a_ready(const Unit&) const {}
    __device__ __forceinline__ void done(const Unit&) const {}
};
__device__ __forceinline__ unsigned cvt_pk_bf16(float lo, float hi) { unsigned r; asm volatile("v_cvt_pk_bf16_f32 %0, %1, %2" : "=v"(r) : "v"(lo), "v"(hi)); return r; }
typedef float f32x2 __attribute__((ext_vector_type(2)));
typedef unsigned u32x2 __attribute__((ext_vector_type(2)));
__device__ __forceinline__ f32x2 gelu_pk(f32x2 v) {
    const f32x2 av = __builtin_elementwise_abs(v), d = av * 0.2316418882f + 1.0f;
    f32x2 t; t.x = __builtin_amdgcn_rcpf(d.x); t.y = __builtin_amdgcn_rcpf(d.y);
    f32x2 q = t * 0.5307027145f + (-0.7265760135f); q = q * t + 0.7107068705f; q = q * t + (-0.142248368f); q = q * t + 0.127414796f; q = q * t;
    const f32x2 s = (v * v) * (-0.72134752044f);
    f32x2 e; e.x = __builtin_amdgcn_exp2f(s.x); e.y = __builtin_amdgcn_exp2f(s.y);
    const f32x2 m = v * (q * e), r = v - m;
    f32x2 o; o.x = v.x < 0.f ? m.x : r.x; o.y = v.y < 0.f ? m.y : r.y; return o;
}
__device__ __forceinline__ float silu_f(float g) { return g * __builtin_amdgcn_rcpf(1.0f + __builtin_amdgcn_exp2f(-1.4426950408889634f * g)); }
__device__ __forceinline__ u32x4 pack8_bf16(f32x4 a, f32x4 b) { u32x4 w; w.x = cvt_pk_bf16(a[0], a[1]); w.y = cvt_pk_bf16(a[2], a[3]); w.z = cvt_pk_bf16(b[0], b[1]); w.w = cvt_pk_bf16(b[2], b[3]); return w; }

__host__ __device__ __forceinline__ size_t blk_off(int row, int col, int kt) { return ((size_t)((row >> 8) * kt + (col >> 6)) << 14) + ((row & 255) << 6) + (col & 63); }
struct RowScale { const PG8_LAS float* rtab; };
__device__ __forceinline__ void get_rstd(float (&rs)[2][4], const RowScale& R, int wr, int fr) {
#pragma unroll
    for (int ai = 0; ai < 2; ++ai)
#pragma unroll
        for (int m = 0; m < 4; ++m) rs[ai][m] = R.rtab ? R.rtab[2 * (ai * HALF + wr * 64 + m * 16 + fr)] : 1.0f;
}
struct EpiSwiglu {
    static constexpr bool PERM = true, AFTER_DRAIN = false;
    static __host__ __device__ __forceinline__ int bmap(int R) { return (R & ~31) + perm32(R & 31); }
    bf16_t* H; int ldh; RowScale R;
    __device__ __forceinline__ void operator()(const f32x4 (&acc)[2][2][4][2], const Unit& u, int wr, int wc, int fr, int fq) const {
        const int row0 = u.pm * BM + wr * 64 + fr, col0 = u.pn * HALF + wc * 32 + 8 * fq;
#pragma unroll
        for (int ai = 0; ai < 2; ++ai)
#pragma unroll
            for (int m = 0; m < 4; ++m) { const f32x2 rv = *(const PG8_LAS f32x2*)(R.rtab + 2 * (ai * HALF + wr * 64 + m * 16 + fr)); const float c1 = -1.4426950408889634f * rv.x, v = rv.y;
                const f32x4 g0 = acc[ai][0][m][0], g1 = acc[ai][0][m][1], u0 = acc[ai][1][m][0], u1 = acc[ai][1][m][1];
                f32x4 h0, h1;
#pragma unroll
                for (int j = 0; j < 4; ++j) { const float e0 = __builtin_amdgcn_exp2f(g0[j] * c1), e1 = __builtin_amdgcn_exp2f(g1[j] * c1);
                    h0[j] = (g0[j] * u0[j]) * __builtin_amdgcn_rcpf(__builtin_fmaf(e0, v, v)); h1[j] = (g1[j] * u1[j]) * __builtin_amdgcn_rcpf(__builtin_fmaf(e1, v, v)); }
                *(u32x4*)(H + blk_off(row0 + ai * HALF + m * 16, col0, ldh >> 6)) = pack8_bf16(h0, h1);
            }
    }
};
struct EpiResid {
    static constexpr bool PERM = true, AFTER_DRAIN = false;
    static __host__ __device__ __forceinline__ int bmap(int R) { return (R & ~31) + perm32(R & 31); }
    const float* base_f32; float* out_f32; int ld; float scale; bf16_t* xb; float* ss; _Float16* xh;
    typedef _Float16 h8 __attribute__((ext_vector_type(8)));
    static __device__ __forceinline__ void one(const f32x4 b0, const f32x4 b1, const f32x4 a0, const f32x4 a1, int row, int col, size_t off, float& s, float scale, float* out_f32, _Float16* xh, bf16_t* xb, int ld) {
        const f32x4 o0 = b0 + a0 * scale, o1 = b1 + a1 * scale;
        if (out_f32) { *(f32x4*)(out_f32 + off) = o0; *(f32x4*)(out_f32 + off + 4) = o1; }
        else { h8 w; w[0] = (_Float16)o0[0]; w[1] = (_Float16)o0[1]; w[2] = (_Float16)o0[2]; w[3] = (_Float16)o0[3]; w[4] = (_Float16)o1[0]; w[5] = (_Float16)o1[1]; w[6] = (_Float16)o1[2]; w[7] = (_Float16)o1[3];
            *(h8*)(xh + off) = w;
            *(u32x4*)(xb + blk_off(row, col, ld >> 6)) = pack8_bf16(o0, o1);
            s += ((o0[0] * o0[0] + o0[1] * o0[1]) + (o0[2] * o0[2] + o0[3] * o0[3])) + ((o1[0] * o1[0] + o1[1] * o1[1]) + (o1[2] * o1[2] + o1[3] * o1[3])); }
    }
    __device__ __forceinline__ void operator()(const f32x4 (&acc)[2][2][4][2], const Unit& u, int wr, int wc, int fr, int fq) const {
        const int row0 = u.pm * BM + wr * 64 + fr, col0 = u.pn * BM + wc * 32 + 8 * fq;
        const float scale_ = scale; float* const out_ = out_f32; _Float16* const xh_ = xh; bf16_t* const xb_ = xb; const int ld_ = ld;
        if (base_f32) {
#pragma unroll
            for (int ai = 0; ai < 2; ++ai)
#pragma unroll
                for (int m = 0; m < 4; ++m) { const int row = row0 + ai * HALF + m * 16; const size_t off = (size_t)row * ld + col0; float s = 0.f;
#pragma unroll
                    for (int bj = 0; bj < 2; ++bj) one(*(const f32x4*)(base_f32 + off + bj * HALF), *(const f32x4*)(base_f32 + off + bj * HALF + 4), acc[ai][bj][m][0], acc[ai][bj][m][1], row, col0 + bj * HALF, off + bj * HALF, s, scale_, out_, xh_, xb_, ld_);
                    if (!out_f32) { s += __shfl_xor(s, 16); s += __shfl_xor(s, 32); if (fq == 0) ss[(size_t)row * 32 + u.pn * 4 + wc] = s; }
                    asm volatile("" ::: "memory"); }
            return;
        }
#pragma unroll
        for (int ai = 0; ai < 2; ++ai) {
            h8 w[4][2];
#pragma unroll
            for (int m = 0; m < 4; ++m)
#pragma unroll
                for (int bj = 0; bj < 2; ++bj) w[m][bj] = *(const h8*)(xh + (size_t)(row0 + ai * HALF + m * 16) * ld + col0 + bj * HALF);
#pragma unroll
            for (int m = 0; m < 4; ++m) { const int row = row0 + ai * HALF + m * 16; const size_t off = (size_t)row * ld + col0; float s = 0.f;
#pragma unroll
                for (int bj = 0; bj < 2; ++bj) { const h8 v = w[m][bj];
                    one((f32x4){(float)v[0], (float)v[1], (float)v[2], (float)v[3]}, (f32x4){(float)v[4], (float)v[5], (float)v[6], (float)v[7]}, acc[ai][bj][m][0], acc[ai][bj][m][1], row, col0 + bj * HALF, off + bj * HALF, s, scale_, out_, xh_, xb_, ld_); }
                if (!out_f32) { s += __shfl_xor(s, 16); s += __shfl_xor(s, 32); if (fq == 0) ss[(size_t)row * 32 + u.pn * 4 + wc] = s; } }
            asm volatile("" ::: "memory");
        }
    }
};
__device__ __forceinline__ void head_ss_put(PG8_LAS float* ex, int rl, int bj, int wc, int fq, float s) { s += __shfl_xor(s, 16); s += __shfl_xor(s, 32); if (fq == 0) ex[(rl * 2 + bj) * 4 + wc] = s; }
__device__ __forceinline__ float head_rstd_get(const PG8_LAS float* ex, int rl, int bj) { const f32x4 p = *(const PG8_LAS f32x4*)(ex + (rl * 2 + bj) * 4); return 1.0f / sqrtf(((p[0] + p[1]) + (p[2] + p[3])) * (1.0f / 128.0f) + 1e-6f); }
#define PG8_EPI_BARRIER() do { asm volatile("s_waitcnt lgkmcnt(0)" ::: "memory"); __builtin_amdgcn_s_barrier(); asm volatile("" ::: "memory"); } while (0)
struct EpiAin {
    static constexpr bool PERM = true, AFTER_DRAIN = false;
    static __host__ __device__ __forceinline__ int bmap(int R) { return (R & ~31) + perm32(R & 31); }
    bf16_t* ZA; float* vstat; bf16_t* qmb; const float* gq; PG8_LAS float* ex; RowScale R;
    __device__ __forceinline__ void operator()(const f32x4 (&acc)[2][2][4][2], const Unit& u, int wr, int wc, int fr, int fq) const {
        const int row0 = u.pm * BM + wr * 64 + fr;
        float rs[2][4]; get_rstd(rs, R, wr, fr);
        if (u.pn < 12) {
            const int col0 = u.pn * BM + wc * 32 + 8 * fq; const bool st = u.pn >= 6;
#pragma unroll
            for (int ai = 0; ai < 2; ++ai)
#pragma unroll
                for (int m = 0; m < 4; ++m) { const int row = row0 + ai * HALF + m * 16; float sq = 0.f;
#pragma unroll
                    for (int bj = 0; bj < 2; ++bj) { f32x4 v0 = acc[ai][bj][m][0] * rs[ai][m], v1 = acc[ai][bj][m][1] * rs[ai][m];
                        f32x2 a = gelu_pk((f32x2){v0[0], v0[1]}), b = gelu_pk((f32x2){v0[2], v0[3]}), c = gelu_pk((f32x2){v1[0], v1[1]}), d = gelu_pk((f32x2){v1[2], v1[3]});
                        v0 = (f32x4){a.x, a.y, b.x, b.y}; v1 = (f32x4){c.x, c.y, d.x, d.y};
                        sq += (v0[0] * v0[0] + v0[1] * v0[1]) + (v0[2] * v0[2] + v0[3] * v0[3]) + (v1[0] * v1[0] + v1[1] * v1[1]) + (v1[2] * v1[2] + v1[3] * v1[3]);
                        *(u32x4*)(ZA + (size_t)row * 3072 + col0 + bj * HALF) = pack8_bf16(v0, v1); }
                    if (st) { sq += __shfl_xor(sq, 16); sq += __shfl_xor(sq, 32); if (fq == 0) vstat[(size_t)row * 24 + (u.pn - 6) * 4 + wc] = sq; } }
        } else {
            const int d0 = wc * 32 + 8 * fq; const f32x4 g0 = *(const f32x4*)(gq + d0), g1 = *(const f32x4*)(gq + d0 + 4);
#pragma unroll
            for (int ai = 0; ai < 2; ++ai)
#pragma unroll
                for (int m = 0; m < 4; ++m) { const int rl = ai * HALF + wr * 64 + m * 16 + fr;
#pragma unroll
                    for (int bj = 0; bj < 2; ++bj) { const f32x4 v0 = acc[ai][bj][m][0], v1 = acc[ai][bj][m][1];
                        head_ss_put(ex, rl, bj, wc, fq, (((v0[0] * v0[0] + v0[1] * v0[1]) + (v0[2] * v0[2] + v0[3] * v0[3])) + ((v1[0] * v1[0] + v1[1] * v1[1]) + (v1[2] * v1[2] + v1[3] * v1[3]))) * (rs[ai][m] * rs[ai][m])); } }
            PG8_EPI_BARRIER();
#pragma unroll
            for (int ai = 0; ai < 2; ++ai)
#pragma unroll
                for (int m = 0; m < 4; ++m) { const int rl = ai * HALF + wr * 64 + m * 16 + fr, row = u.pm * BM + rl, b = row >> 12, s = row & 4095;
#pragma unroll
                    for (int bj = 0; bj < 2; ++bj) { const float sc = rs[ai][m] * head_rstd_get(ex, rl, bj); const int hm = (u.pn - 12) * 2 + bj;
                        *(u32x4*)(qmb + ((size_t)(b * 4 + hm) * 4096 + s) * 128 + d0) = pack8_bf16(acc[ai][bj][m][0] * sc * g0, acc[ai][bj][m][1] * sc * g1); } }
        }
    }
};
struct EpiF32Split {
    static constexpr bool PERM = true, AFTER_DRAIN = false;
    static __host__ __device__ __forceinline__ int bmap(int R) { return (R & ~31) + perm32(R & 31); }
    float* d0; int ld0; int split; float* d1; int ld1; int pnmod; RowScale R;
    __device__ __forceinline__ void operator()(const f32x4 (&acc)[2][2][4][2], const Unit& u, int wr, int wc, int fr, int fq) const {
        const int row0 = u.pm * BM + wr * 64 + fr; int pn = pnmod ? (u.pn % pnmod) : u.pn; float* d = d0; int ld = ld0;
        if (pn >= split) { d = d1; ld = ld1; pn -= split; }
        const int col0 = pn * BM + wc * 32 + 8 * fq;
        float rs[2][4]; get_rstd(rs, R, wr, fr);
#pragma unroll
        for (int ai = 0; ai < 2; ++ai)
#pragma unroll
            for (int m = 0; m < 4; ++m) { float* p = d + (size_t)(row0 + ai * HALF + m * 16) * ld + col0;
#pragma unroll
                for (int bj = 0; bj < 2; ++bj) { *(f32x4*)(p + bj * HALF) = acc[ai][bj][m][0] * rs[ai][m]; *(f32x4*)(p + bj * HALF + 4) = acc[ai][bj][m][1] * rs[ai][m]; } }
    }
};
struct EpiQKRope {
    static constexpr bool PERM = true, AFTER_DRAIN = false;
    static __host__ __device__ __forceinline__ int bmap(int R) { return 64 * ((R >> 4) & 1) + 16 * (R >> 5) + (R & 15); }
    int kind; bf16_t* qk; bf16_t* other; const float* gr; const float* gn; const unsigned* cs; PG8_LAS float* ex; RowScale R;
    __device__ __forceinline__ void operator()(const f32x4 (&acc)[2][2][4][2], const Unit& u, int wr, int wc, int fr, int fq) const {
        typedef _Float16 h2 __attribute__((ext_vector_type(2)));
        float rs[2][4]; get_rstd(rs, R, wr, fr);
        const int d0 = 16 * wc + 4 * fq;
        const bool rope = u.pn < 6;
        if (!rope && kind == 1) {
            const int h = u.pn - 6;
#pragma unroll
            for (int ai = 0; ai < 2; ++ai)
#pragma unroll
                for (int m = 0; m < 4; ++m) { const int row = u.pm * BM + ai * HALF + wr * 64 + m * 16 + fr, b = row >> 12, s = row & 4095;
#pragma unroll
                    for (int bj = 0; bj < 2; ++bj) { bf16_t* p = other + ((size_t)((b * 6 + h) * 2 + bj) * 4096 + s) * 128 + d0;
#pragma unroll
                        for (int n = 0; n < 2; ++n) { const f32x4 v = acc[ai][bj][m][n] * rs[ai][m]; u32x2 w; w.x = cvt_pk_bf16(v[0], v[1]); w.y = cvt_pk_bf16(v[2], v[3]); *(u32x2*)(p + 64 * n) = w; } } }
            return;
        }
        const float* g = rope ? gr : gn; const f32x4 ga = *(const f32x4*)(g + d0), gb = *(const f32x4*)(g + 64 + d0);
        u32x4 cst[2][4];
        if (rope) {
#pragma unroll
            for (int ai = 0; ai < 2; ++ai)
#pragma unroll
                for (int m = 0; m < 4; ++m) { const int s = (u.pm * BM + ai * HALF + wr * 64 + m * 16 + fr) & 4095; cst[ai][m] = *(const u32x4*)(cs + (size_t)s * 64 + d0); }
        }
#pragma unroll
        for (int ai = 0; ai < 2; ++ai)
#pragma unroll
            for (int m = 0; m < 4; ++m) { const int rl = ai * HALF + wr * 64 + m * 16 + fr;
#pragma unroll
                for (int bj = 0; bj < 2; ++bj) { const f32x4 v0 = acc[ai][bj][m][0], v1 = acc[ai][bj][m][1];
                    head_ss_put(ex, rl, bj, wc, fq, (((v0[0] * v0[0] + v0[1] * v0[1]) + (v0[2] * v0[2] + v0[3] * v0[3])) + ((v1[0] * v1[0] + v1[1] * v1[1]) + (v1[2] * v1[2] + v1[3] * v1[3]))) * (rs[ai][m] * rs[ai][m])); } }
        PG8_EPI_BARRIER();
#pragma unroll
        for (int ai = 0; ai < 2; ++ai)
#pragma unroll
            for (int m = 0; m < 4; ++m) { const int rl = ai * HALF + wr * 64 + m * 16 + fr, row = u.pm * BM + rl, b = row >> 12, s = row & 4095;
#pragma unroll
                for (int bj = 0; bj < 2; ++bj) { const float sc = rs[ai][m] * head_rstd_get(ex, rl, bj);
                    f32x4 y0 = acc[ai][bj][m][0] * sc * ga, y1 = acc[ai][bj][m][1] * sc * gb; bf16_t* p;
                    if (rope) { f32x4 o0, o1;
#pragma unroll
                        for (int j = 0; j < 4; ++j) { const unsigned cw = cst[ai][m][j]; const h2 t = __builtin_bit_cast(h2, cw); const float c = (float)t.x, sn = (float)t.y; o0[j] = y0[j] * c - y1[j] * sn; o1[j] = y1[j] * c + y0[j] * sn; }
                        y0 = o0; y1 = o1; p = qk + ((size_t)(b * 12 + u.pn * 2 + bj) * 4096 + s) * 128 + d0; }
                    else p = other + ((size_t)(b * 4 + (u.pn - 6) * 2 + bj) * 4096 + s) * 128 + d0;
                    u32x2 w0, w1; w0.x = cvt_pk_bf16(y0[0], y0[1]); w0.y = cvt_pk_bf16(y0[2], y0[3]); w1.x = cvt_pk_bf16(y1[0], y1[1]); w1.y = cvt_pk_bf16(y1[2], y1[3]);
                    *(u32x2*)p = w0; *(u32x2*)(p + 64) = w1; } }
    }
};
struct ColSweepOrder {
    int c;
    __device__ bool next(int i, Unit& u) const { if (i >= 2) return false; const int xcd = c & 7, j = c >> 3; u.pm = 8 * xcd + 4 * i + (j & 3); u.pn = j >> 2; return true; }
    __device__ __forceinline__ void a_ready(const Unit&) const {}
    __device__ __forceinline__ void done(const Unit&) const {}
};
struct EpiMemKv {
    static constexpr bool PERM = true, AFTER_DRAIN = false;
    static __host__ __device__ __forceinline__ int bmap(int R) { return (R & ~31) + perm32(R & 31); }
    bf16_t* mk; bf16_t* mv; const float* gk; PG8_LAS float* ex;
    __device__ __forceinline__ void operator()(const f32x4 (&acc)[2][2][4][2], const Unit& u, int wr, int wc, int fr, int fq) const {
        const int t = u.pn & 3, d0 = wc * 32 + 8 * fq; const size_t base = (size_t)u.pm * 4;
        if (t < 2) {
            const f32x4 g0 = *(const f32x4*)(gk + (u.pm >> 2) * 128 + d0), g1 = *(const f32x4*)(gk + (u.pm >> 2) * 128 + d0 + 4);
#pragma unroll
            for (int ai = 0; ai < 2; ++ai)
#pragma unroll
                for (int m = 0; m < 4; ++m) { const int rl = ai * HALF + wr * 64 + m * 16 + fr;
#pragma unroll
                    for (int bj = 0; bj < 2; ++bj) { const f32x4 v0 = acc[ai][bj][m][0], v1 = acc[ai][bj][m][1];
                        head_ss_put(ex, rl, bj, wc, fq, ((v0[0] * v0[0] + v0[1] * v0[1]) + (v0[2] * v0[2] + v0[3] * v0[3])) + ((v1[0] * v1[0] + v1[1] * v1[1]) + (v1[2] * v1[2] + v1[3] * v1[3]))); } }
            PG8_EPI_BARRIER();
#pragma unroll
            for (int ai = 0; ai < 2; ++ai)
#pragma unroll
                for (int m = 0; m < 4; ++m) { const int rl = ai * HALF + wr * 64 + m * 16 + fr;
#pragma unroll
                    for (int bj = 0; bj < 2; ++bj) { const float sc = head_rstd_get(ex, rl, bj);
                        *(u32x4*)(mk + ((base + t * 2 + bj) * 256 + rl) * 128 + d0) = pack8_bf16(acc[ai][bj][m][0] * sc * g0, acc[ai][bj][m][1] * sc * g1); } }
        } else {
#pragma unroll
            for (int ai = 0; ai < 2; ++ai)
#pragma unroll
                for (int m = 0; m < 4; ++m) { const int rl = ai * HALF + wr * 64 + m * 16 + fr;
#pragma unroll
                    for (int bj = 0; bj < 2; ++bj) *(u32x4*)(mv + ((base + (t - 2) * 2 + bj) * 256 + rl) * 128 + d0) = pack8_bf16(acc[ai][bj][m][0], acc[ai][bj][m][1]); }
        }
    }
};
struct MemKvOrder {
    int G, c;
    __device__ bool next(int i, Unit& u) const { const int L = i * G + c; if (L >= 64) return false; const int layer = L >> 4, r = L & 15; u.pm = layer * 4 + (r >> 2); u.pn = layer * 4 + (r & 3); return true; }
    __device__ __forceinline__ void a_ready(const Unit&) const {}
    __device__ __forceinline__ void done(const Unit&) const {}
};
template <class Epi, class Sched, bool ALIGN_EPI = false, bool SP2 = false, bool ABLK = false, bool BBLK = false>
__device__ __forceinline__ void gemm_phase(PG8_LAS unsigned char* lds, const Gemm g, const Sched& S, const Epi& E) {
    int tid_ = threadIdx.x; asm volatile("" : "+v"(tid_));
    const int tid = tid_, wid = __builtin_amdgcn_readfirstlane(tid >> 6), lane = tid & 63, wr = wid >> 2, wc = wid & 3, fr = lane & 15, fq = lane >> 4;
    const int K = g.K, nt = K / BK;
    unsigned voffA[2], voffB[2];
#pragma unroll
    for (int i = 0; i < 2; ++i) { int R, C; stage_rc(tid * 16 + i * 8192, R, C); const int Rb = Epi::bmap(R);
        voffA[i] = ABLK ? (unsigned)(R * BK + C) * 2u : (unsigned)(R * K + C) * 2u; voffB[i] = BBLK ? (unsigned)(Rb * BK + C) * 2u : (unsigned)(Rb * K + C) * 2u; }
    const size_t kstepA = ABLK ? (size_t)(BM * BK * 2) : (size_t)(BK * 2), kstepB = BBLK ? (size_t)(BM * BK * 2) : (size_t)(BK * 2);
    const size_t hstepA = ABLK ? (size_t)(HALF * BK * 2) : (size_t)HALF * K * 2, hstepB = BBLK ? (size_t)(HALF * BK * 2) : (size_t)HALF * K * 2;
    const size_t tstep = (size_t)BM * K * 2;
#ifndef PG8_PF
#define PG8_PF 0
#endif
    PG8_LAS unsigned* const pfjunk = (PG8_LAS unsigned*)(lds + 143360 + wid * 256);
    const unsigned ldsw = (unsigned)wid * 1024u;
    const int aoff = lds_byte(wr * 64 + fr, fq * 8), boff = lds_byte(wc * 32 + fr, fq * 8);
#define PG8_SA(b, h) (((b) * 2 + (h)) * HTB)
#define PG8_SB(b, h) ((4 + (b) * 2 + (h)) * HTB)
#define PG8_STAGE(bufoff, gbase, voff) do { _Pragma("unroll") for (int _i = 0; _i < 2; ++_i) \
        __builtin_amdgcn_global_load_lds((const unsigned*)((const char*)(gbase) + (voff)[_i]), (PG8_LAS unsigned*)(lds + (bufoff) + ldsw + _i * 8192), 16, 0, 0); } while (0)
#define PG8_LDA(dst, b, h) do { _Pragma("unroll") for (int m = 0; m < 4; ++m) _Pragma("unroll") for (int k = 0; k < 2; ++k) dst[m][k] = *(const PG8_LAS bf16x8*)(lds + PG8_SA(b, h) + aoff + m * 2048 + k * 1024); } while (0)
#define PG8_LDB(dst, b, h) do { _Pragma("unroll") for (int n = 0; n < 2; ++n) _Pragma("unroll") for (int k = 0; k < 2; ++k) dst[n][k] = *(const PG8_LAS bf16x8*)(lds + PG8_SB(b, h) + boff + n * 2048 + k * 1024); } while (0)
#define PG8_MMA(ai, bj, At, Bt) do { __builtin_amdgcn_s_setprio(1); _Pragma("unroll") for (int m = 0; m < 4; ++m) _Pragma("unroll") for (int n = 0; n < 2; ++n) _Pragma("unroll") for (int k = 0; k < 2; ++k) \
        acc[ai][bj][m][n] = __builtin_amdgcn_mfma_f32_16x16x32_bf16(Bt[n][k], At[m][k], acc[ai][bj][m][n], 0, 0, 0); __builtin_amdgcn_s_setprio(0); } while (0)
#define PG8_WAIT_V(n) asm volatile("s_waitcnt vmcnt(" #n ")" ::: "memory")
#define PG8_WAIT_LOOP() do { if (PG8_PF) asm volatile("s_waitcnt vmcnt(9)" ::: "memory"); else asm volatile("s_waitcnt vmcnt(8)" ::: "memory"); } while (0)
#define PG8_PREFETCH(tp) do { if (PG8_PF) { const int tp_ = (tp); const char* pb_ = (wid < 4) ? (tp_ < nt ? cA + (size_t)tp_ * kstepA : nA + (size_t)(tp_ - nt) * kstepA) : (tp_ < nt ? cB + (size_t)tp_ * kstepB : nB + (size_t)(tp_ - nt) * kstepB); \
        const unsigned ln_ = __builtin_amdgcn_mbcnt_hi(~0u, __builtin_amdgcn_mbcnt_lo(~0u, 0u)) + (unsigned)(wid & 3) * 64u; const unsigned pfl_ = ln_ * ((wid < 4) ? (ABLK ? 128u : (unsigned)K * 2u) : (BBLK ? 128u : (unsigned)K * 2u)); \
        __builtin_amdgcn_global_load_lds((const unsigned*)(pb_ + pfl_), pfjunk, 4, 0, 0); } } while (0)
#define PG8_WAIT_L(n) asm volatile("s_waitcnt lgkmcnt(" #n ")" ::: "memory")
#define PG8_BAR __builtin_amdgcn_s_barrier()
#define PG8_SCHED __builtin_amdgcn_sched_barrier(0)
    Unit cur, nxt; int ui = 0;
    if (!S.next(0, cur)) return;
    f32x4 acc[2][2][4][2];
#pragma unroll
    for (int a = 0; a < 2; ++a)
#pragma unroll
        for (int b = 0; b < 2; ++b)
#pragma unroll
            for (int m = 0; m < 4; ++m)
#pragma unroll
                for (int n = 0; n < 2; ++n) acc[a][b][m][n] = (f32x4){0.f, 0.f, 0.f, 0.f};
    bf16x8 At[4][2], B0[2][2], B1[2][2];
    const char* cA = (const char*)g.A + (size_t)cur.pm * tstep; const char* cB = (const char*)g.Bt + (size_t)cur.pn * tstep;
    S.a_ready(cur);
    if constexpr (SP2) {
        PG8_STAGE(PG8_SB(0, 0), cB, voffB); PG8_STAGE(PG8_SB(0, 1), cB + hstepB, voffB); PG8_STAGE(PG8_SA(0, 0), cA, voffA); PG8_STAGE(PG8_SA(0, 1), cA + hstepA, voffA);
        if (wr == 1) PG8_BAR;
        PG8_WAIT_V(2); PG8_BAR;
        PG8_STAGE(PG8_SB(1, 0), cB + kstepB, voffB); PG8_STAGE(PG8_SA(1, 0), cA + kstepA, voffA); PG8_STAGE(PG8_SB(1, 1), cB + hstepB + kstepB, voffB);
        PG8_WAIT_V(6); PG8_BAR;
    } else {
        PG8_STAGE(PG8_SB(0, 0), cB, voffB); PG8_STAGE(PG8_SA(0, 0), cA, voffA); PG8_STAGE(PG8_SB(0, 1), cB + hstepB, voffB); PG8_STAGE(PG8_SA(0, 1), cA + hstepA, voffA);
        if (wr == 1) PG8_BAR;
        PG8_WAIT_V(4); PG8_BAR;
        PG8_STAGE(PG8_SB(1, 0), cB + kstepB, voffB); PG8_STAGE(PG8_SA(1, 0), cA + kstepA, voffA); PG8_STAGE(PG8_SB(1, 1), cB + hstepB + kstepB, voffB);
        PG8_WAIT_V(6); PG8_BAR;
    }
    for (;;) {
        const bool has_next = S.next(ui + 1, nxt);
        const char* nA = has_next ? (const char*)g.A + (size_t)nxt.pm * tstep : cA; const char* nB = has_next ? (const char*)g.Bt + (size_t)nxt.pn * tstep : cB;
        for (int t = 0; t < nt; t += 2) {
            const bool last = (t == nt - 2);
            const char* a1 = cA + (size_t)(t + 1) * kstepA;
            const char* a2 = last ? nA : cA + (size_t)(t + 2) * kstepA; const char* b2 = last ? nB : cB + (size_t)(t + 2) * kstepB;
            const char* a3 = a2 + kstepA; const char* b3 = b2 + kstepB;
            if (last && has_next) S.a_ready(nxt);
            if constexpr (SP2) {
            PG8_LDB(B0, 0, 0); PG8_LDB(B1, 0, 1); PG8_SCHED; PG8_LDA(At, 0, 0); PG8_STAGE(PG8_SA(1, 1), a1 + hstepA, voffA); PG8_PREFETCH(t + PG8_PF);
            PG8_WAIT_LOOP(); PG8_WAIT_L(0); PG8_BAR; PG8_MMA(0, 0, At, B0); PG8_MMA(0, 1, At, B1); PG8_BAR; PG8_SCHED;
            PG8_LDA(At, 0, 1); PG8_STAGE(PG8_SB(0, 0), b2, voffB); PG8_STAGE(PG8_SB(0, 1), b2 + hstepB, voffB); PG8_STAGE(PG8_SA(0, 0), a2, voffA);
            PG8_WAIT_LOOP(); PG8_WAIT_L(0); PG8_BAR; PG8_MMA(1, 0, At, B0); PG8_MMA(1, 1, At, B1); PG8_BAR; PG8_SCHED;
            PG8_LDB(B0, 1, 0); PG8_LDB(B1, 1, 1); PG8_SCHED; PG8_LDA(At, 1, 0); PG8_STAGE(PG8_SA(0, 1), a2 + hstepA, voffA); PG8_PREFETCH(t + 1 + PG8_PF);
            PG8_WAIT_LOOP(); PG8_WAIT_L(0); PG8_BAR; PG8_MMA(0, 0, At, B0); PG8_MMA(0, 1, At, B1); PG8_BAR; PG8_SCHED;
            PG8_LDA(At, 1, 1); PG8_STAGE(PG8_SB(1, 0), b3, voffB); PG8_STAGE(PG8_SB(1, 1), b3 + hstepB, voffB); PG8_STAGE(PG8_SA(1, 0), a3, voffA);
            PG8_WAIT_LOOP(); PG8_WAIT_L(0); PG8_BAR; PG8_MMA(1, 0, At, B0); PG8_MMA(1, 1, At, B1); PG8_BAR; PG8_SCHED;
            } else {
            PG8_LDB(B0, 0, 0); PG8_SCHED; PG8_LDA(At, 0, 0); PG8_STAGE(PG8_SA(1, 1), a1 + hstepA, voffA);
            PG8_WAIT_L(8); PG8_BAR; PG8_WAIT_L(0); PG8_MMA(0, 0, At, B0); PG8_BAR; PG8_SCHED;
            PG8_LDB(B1, 0, 1); PG8_STAGE(PG8_SB(0, 0), b2, voffB);
            PG8_BAR; PG8_WAIT_L(0); PG8_MMA(0, 1, At, B1); PG8_BAR;
            PG8_LDA(At, 0, 1); PG8_STAGE(PG8_SA(0, 0), a2, voffA);
            PG8_BAR; PG8_WAIT_L(0); PG8_MMA(1, 0, At, B0); PG8_BAR; PG8_SCHED;
            PG8_STAGE(PG8_SB(0, 1), b2 + hstepB, voffB);
            PG8_WAIT_V(6); PG8_BAR; PG8_MMA(1, 1, At, B1); PG8_BAR;
            PG8_LDB(B0, 1, 0); PG8_SCHED; PG8_LDA(At, 1, 0); PG8_STAGE(PG8_SA(0, 1), a2 + hstepA, voffA);
            PG8_WAIT_L(8); PG8_BAR; PG8_WAIT_L(0); PG8_MMA(0, 0, At, B0); PG8_BAR; PG8_SCHED;
            PG8_LDB(B1, 1, 1); PG8_STAGE(PG8_SB(1, 0), b3, voffB);
            PG8_BAR; PG8_WAIT_L(0); PG8_MMA(0, 1, At, B1); PG8_BAR;
            PG8_LDA(At, 1, 1); PG8_STAGE(PG8_SA(1, 0), a3, voffA);
            PG8_BAR; PG8_WAIT_L(0); PG8_MMA(1, 0, At, B0); PG8_BAR; PG8_SCHED;
            PG8_STAGE(PG8_SB(1, 1), b3 + hstepB, voffB);
            PG8_WAIT_V(6); PG8_BAR; PG8_MMA(1, 1, At, B1); PG8_BAR;
            }
        }
        if constexpr (ALIGN_EPI) { if (wr == 0) PG8_BAR; }
        if constexpr (!Epi::AFTER_DRAIN) { int fr_e = fr, fq_e = fq; asm volatile("" : "+v"(fr_e), "+v"(fq_e));
            E(acc, cur, wr, wc, fr_e, fq_e); S.done(cur); }
        if (!has_next) break;
#pragma unroll
        for (int a = 0; a < 2; ++a)
#pragma unroll
            for (int b = 0; b < 2; ++b)
#pragma unroll
                for (int m = 0; m < 4; ++m)
#pragma unroll
                    for (int n = 0; n < 2; ++n) acc[a][b][m][n] = (f32x4){0.f, 0.f, 0.f, 0.f};
        cur = nxt; cA = nA; cB = nB; ++ui;
        if constexpr (ALIGN_EPI) { if (wr == 1) PG8_BAR; }
    }
    PG8_WAIT_V(0);
    if constexpr (!ALIGN_EPI) { if (wr == 0) PG8_BAR; }
    PG8_BAR;
    if constexpr (Epi::AFTER_DRAIN) { E.fused(acc, cur, wr, wc, fr, fq, lds, wid, lane); S.done(cur); }
#undef PG8_SA
#undef PG8_SB
#undef PG8_STAGE
#undef PG8_LDA
#undef PG8_LDB
#undef PG8_MMA
#undef PG8_WAIT_V
#undef PG8_WAIT_L
#undef PG8_WAIT_LOOP
#undef PG8_PREFETCH
#undef PG8_BAR
#undef PG8_SCHED
}
}
namespace att {
constexpr int D = 128; constexpr float THR = 8.f; constexpr bool WSKIP = false;
constexpr float SCALE = 0.08838834764831845f;
constexpr int NW = 8, QBLK = 32, KVBLK = 64, QB = NW * QBLK;
constexpr int SHM_V = KVBLK * D * 2, SHM_K = KVBLK * D * 2;
constexpr int LDS_BYTES = 2 * SHM_V + 2 * SHM_K + NW * 64 * 4;

using bf16 = __hip_bfloat16;
typedef short bf16x8 __attribute__((ext_vector_type(8)));
typedef short s16x4 __attribute__((ext_vector_type(4)));
typedef float f32x16 __attribute__((ext_vector_type(16)));
typedef float f32x4 __attribute__((ext_vector_type(4)));
typedef unsigned u32x4 __attribute__((ext_vector_type(4)));
template <class A, class Bt> struct same_t { static constexpr bool v = false; };
template <class A> struct same_t<A, A> { static constexpr bool v = true; };

#define KSWZ(row, colB) ((row) * 256 + ((colB) ^ (((row) & 7) << 4)))
#define SBAR() __builtin_amdgcn_sched_barrier(0)
__device__ __forceinline__ int v_st(int k, int c) { const int kk = (k & ~0xC) | ((k & 4) << 1) | ((k & 8) >> 1); return ((kk >> 3) * 4 + (c >> 5)) * 512 + ((kk & 7) * 32 + (c & 31)) * 2; }
__device__ __forceinline__ int v_rd_base(int lane) { return ((lane & 3) << 3) | (((lane >> 2) & 3) << 6) | (((lane >> 4) & 1) << 5) | (((lane >> 5) & 1) << 8); }
constexpr int v_rd_off(int d0, int ks, int half) { return d0 * 512 + ks * 4096 + half * 2048; }
__device__ __forceinline__ int crow(int r, int hi) { return (r & 3) + 8 * (r >> 2) + 4 * hi; }
__device__ __forceinline__ unsigned cvtpk(float lo, float hi) {
    unsigned r; asm volatile("v_cvt_pk_bf16_f32 %0, %1, %2" : "=v"(r) : "v"(lo), "v"(hi)); return r;
}
__device__ __forceinline__ bf16x8 pack8(f32x4 a, f32x4 b) {
    u32x4 w = {cvtpk(a[0], a[1]), cvtpk(a[2], a[3]), cvtpk(b[0], b[1]), cvtpk(b[2], b[3])};
    return *reinterpret_cast<bf16x8*>(&w);
}
template <class T> __device__ __forceinline__ bf16x8 load8(const T* p) {
    if constexpr (same_t<T, float>::v) { return pack8(*(const f32x4*)p, *(const f32x4*)(p + 4)); }
    else { return *reinterpret_cast<const bf16x8*>(p); }
}
__device__ __forceinline__ void mask_tile(f32x16& p0, f32x16& p1, int dq, unsigned W) {
    const float NEG = -__builtin_inff();
#pragma unroll
    for (int r = 0; r < 16; ++r) {
        const int c = (r & 3) + 8 * (r >> 2);
        if ((unsigned)(dq - c) >= W) p0[r] = NEG;
        if ((unsigned)(dq - c - 32) >= W) p1[r] = NEG;
    }
}
__device__ __forceinline__ void partialSM(f32x16& p0, f32x16& p1, float& m_reg, float& mn, float& alpha) {
    float pmax = p0[0]; for (int r = 1; r < 16; ++r) pmax = fmaxf(pmax, p0[r]); for (int r = 0; r < 16; ++r) pmax = fmaxf(pmax, p1[r]);
    { auto rr = __builtin_amdgcn_permlane32_swap(__float_as_uint(pmax), __float_as_uint(pmax), false, false);
      pmax = fmaxf(__uint_as_float(rr[0]), __uint_as_float(rr[1])); }
    constexpr float C2 = 1.4426950408889634f * SCALE;
    if (__builtin_expect(__all((pmax - m_reg) * SCALE <= THR), 1)) { mn = m_reg; alpha = 1.f; }
    else { mn = fmaxf(m_reg, pmax); alpha = __builtin_amdgcn_exp2f((m_reg - mn) * C2); m_reg = mn; }
    const float mnL = -mn * C2;
    for (int r = 0; r < 16; ++r) p0[r] = fmaf(p0[r], C2, mnL); for (int r = 0; r < 16; ++r) p1[r] = fmaf(p1[r], C2, mnL);
    for (int r = 0; r < 16; ++r) p0[r] = __builtin_amdgcn_exp2f(p0[r]);
}
__device__ __forceinline__ void finishSM(f32x16& p0, f32x16& p1, float alpha, float& l_reg, bf16x8& pa0, bf16x8& pa1, bf16x8& pa2, bf16x8& pa3) {
    for (int r = 0; r < 16; ++r) p1[r] = __builtin_amdgcn_exp2f(p1[r]);
    float ps = 0; for (int r = 0; r < 16; ++r) ps += p0[r]; for (int r = 0; r < 16; ++r) ps += p1[r];
    { auto rr = __builtin_amdgcn_permlane32_swap(__float_as_uint(ps), __float_as_uint(ps), false, false);
      ps = __uint_as_float(rr[0]) + __uint_as_float(rr[1]); }
    l_reg = l_reg * alpha + ps;
#define PK4(P, B_, OUT) do { unsigned a0 = cvtpk(P[B_+0], P[B_+1]), a1 = cvtpk(P[B_+2], P[B_+3]);                          \
        unsigned b0 = cvtpk(P[B_+4], P[B_+5]), b1 = cvtpk(P[B_+6], P[B_+7]);                                             \
        auto r0 = __builtin_amdgcn_permlane32_swap(a0, b0, false, false); auto r1 = __builtin_amdgcn_permlane32_swap(a1, b1, false, false); \
        u32x4 w = {r0[0], r1[0], r0[1], r1[1]}; OUT = *reinterpret_cast<bf16x8*>(&w); } while (0)
    PK4(p0, 0, pa0); PK4(p0, 8, pa1); PK4(p1, 0, pa2); PK4(p1, 8, pa3);
#undef PK4
}
template <int KB, bool SK>
__device__ __forceinline__ void qkt(f32x16& p0, f32x16& p1, const char* K_lds, int r32, int hi, const bf16x8* qr, bool act) {
    if (SK && !act) { const float NEG = -__builtin_inff();
#pragma unroll
        for (int r = 0; r < 16; ++r) { p0[r] = NEG; p1[r] = NEG; } return; }
    p0 = f32x16{}; p1 = f32x16{};
    const char* kb[4];
#pragma unroll
    for (int dd = 0; dd < 4; ++dd) kb[dd] = K_lds + KB * SHM_K + KSWZ(r32, (dd * 16 + hi * 8) * 2);
#pragma unroll
    for (int d0 = 0; d0 < 8; ++d0) { const char* a = kb[d0 & 3] + (d0 >> 2) * 128;
        bf16x8 b0 = *reinterpret_cast<const bf16x8*>(a);
        bf16x8 b1 = *reinterpret_cast<const bf16x8*>(a + 32 * 256);
        p0 = __builtin_amdgcn_mfma_f32_32x32x16_bf16(b0, qr[d0], p0, 0, 0, 0);
        p1 = __builtin_amdgcn_mfma_f32_32x32x16_bf16(b1, qr[d0], p1, 0, 0, 0); }
}
template <int VB, bool SK>
__device__ __forceinline__ void pv_tile(f32x16* o, int vb0, bf16x8 pa0, bf16x8 pa1, bf16x8 pa2, bf16x8 pa3, bool act) {
    if (SK && !act) return;
#define TRRD(dst, off) asm volatile("ds_read_b64_tr_b16 %0, %1 offset:%2" : "=&v"(dst) : "v"(vb0), "i"(off) : "memory")
#define PV_D0(d0) do { s16x4 l0, l1, l2, l3, h0, h1, h2, h3; constexpr int b_ = VB * SHM_V + v_rd_off(d0, 0, 0);     \
        TRRD(l0, b_); TRRD(h0, b_ + 2048); TRRD(l1, b_ + 4096); TRRD(h1, b_ + 6144); TRRD(l2, b_ + 8192); TRRD(h2, b_ + 10240); TRRD(l3, b_ + 12288); TRRD(h3, b_ + 14336); \
        asm volatile("s_waitcnt lgkmcnt(0)" ::: "memory"); SBAR();                 \
        o[d0] = __builtin_amdgcn_mfma_f32_32x32x16_bf16(pa0, (bf16x8){l0[0], l0[1], l0[2], l0[3], h0[0], h0[1], h0[2], h0[3]}, o[d0], 0, 0, 0);   \
        o[d0] = __builtin_amdgcn_mfma_f32_32x32x16_bf16(pa1, (bf16x8){l1[0], l1[1], l1[2], l1[3], h1[0], h1[1], h1[2], h1[3]}, o[d0], 0, 0, 0);   \
        o[d0] = __builtin_amdgcn_mfma_f32_32x32x16_bf16(pa2, (bf16x8){l2[0], l2[1], l2[2], l2[3], h2[0], h2[1], h2[2], h2[3]}, o[d0], 0, 0, 0);   \
        o[d0] = __builtin_amdgcn_mfma_f32_32x32x16_bf16(pa3, (bf16x8){l3[0], l3[1], l3[2], l3[3], h3[0], h3[1], h3[2], h3[3]}, o[d0], 0, 0, 0); } while (0)
    PV_D0(0); PV_D0(1); PV_D0(2); PV_D0(3);
#undef PV_D0
#undef TRRD
}

template <class TIn, class TOut> struct BlockRef { const TIn* Q; const TIn* K; const TIn* V; TOut* O; int P0; int ldo; };
template <class TIn> struct Seam {
    bf16x8 qr[8];
    bf16x8 st_v0, st_v1, st_k0, st_k1; f32x4 sf0, sf1, sf2, sf3;
    f32x4 tq[16];
};
__device__ __forceinline__ int swa_jlo(int P0, int W) { const int lowk = P0 - W + 1; return lowk > 0 ? lowk / KVBLK : 0; }
#define ROW(p, k0, rr) ((p) + (size_t)((k0) + (rr)) * D + sc)
#define VMW() asm volatile("s_waitcnt vmcnt(0)" ::: "memory")
#define VMWN(n) asm volatile("s_waitcnt vmcnt(%0)" :: "i"(n) : "memory")
#define SLOAD_H(Kp, Vp, k0) do { S.st_v0 = load8<TIn>(ROW(Vp, k0, sr)); S.st_v1 = load8<TIn>(ROW(Vp, k0, 32 + sr));              \
                         S.st_k0 = load8<TIn>(ROW(Kp, k0, sr)); S.st_k1 = load8<TIn>(ROW(Kp, k0, 32 + sr)); } while (0)
#define SWRITE_HK(bf) do { *(bf16x8*)(K_lds + (bf) * SHM_K + kws) = S.st_k0; *(bf16x8*)(K_lds + (bf) * SHM_K + kws + 32 * 256) = S.st_k1; } while (0)
#define SWRITE_HV(bf) do { *(bf16x8*)(V_lds + (bf) * SHM_V + vst0) = S.st_v0; *(bf16x8*)(V_lds + (bf) * SHM_V + vst1) = S.st_v1; } while (0)
#define SWRITE_H(bf) do { SWRITE_HV(bf); SWRITE_HK(bf); } while (0)
#define SLOAD_F(p, k0) do { S.sf0 = *(const f32x4*)ROW(p, k0, sr); S.sf1 = *(const f32x4*)(ROW(p, k0, sr) + 4);                \
                            S.sf2 = *(const f32x4*)ROW(p, k0, 32 + sr); S.sf3 = *(const f32x4*)(ROW(p, k0, 32 + sr) + 4); } while (0)
#define SWRITE_KF(bf) do { *(bf16x8*)(K_lds + (bf) * SHM_K + kws) = pack8(S.sf0, S.sf1); *(bf16x8*)(K_lds + (bf) * SHM_K + kws + 32 * 256) = pack8(S.sf2, S.sf3); } while (0)
#define SWRITE_VF(bf) do { *(bf16x8*)(V_lds + (bf) * SHM_V + vst0) = pack8(S.sf0, S.sf1); *(bf16x8*)(V_lds + (bf) * SHM_V + vst1) = pack8(S.sf2, S.sf3); } while (0)
template <class TIn, class TOut>
__device__ __forceinline__ void causal_swa_prime(const BlockRef<TIn, TOut>& cur, int W, char* lds, Seam<TIn>& S) {
    constexpr bool F32 = same_t<TIn, float>::v;
    int tid_ = threadIdx.x; asm volatile("" : "+v"(tid_));
    const int tid = tid_, wid = __builtin_amdgcn_readfirstlane(tid >> 6), lane = tid & 63, r32 = lane & 31, hi = lane >> 5;
    const int sr = tid >> 4, sc = (tid & 15) * 8, kws = KSWZ(sr, sc * 2); char* K_lds = lds + 2 * SHM_V;
    const int kb0 = swa_jlo(cur.P0, W) * KVBLK;
    for (int d0 = 0; d0 < 8; ++d0) S.qr[d0] = load8<TIn>(cur.Q + (size_t)(wid * QBLK + r32) * D + d0 * 16 + hi * 8);
    if constexpr (F32) { SLOAD_F((const float*)cur.K, kb0); VMW(); SWRITE_KF(0); SBAR(); SLOAD_F((const float*)cur.V, kb0); }
    else { SLOAD_H(cur.K, cur.V, kb0); VMW(); SWRITE_HK(0); }
    __syncthreads();
}
template <class TIn, class TOut>
__device__ __forceinline__ void causal_swa_block(const BlockRef<TIn, TOut>& cur, const BlockRef<TIn, TOut>& nxt, int skv, int W, char* lds, Seam<TIn>& S) {
    constexpr bool F32 = same_t<TIn, float>::v;
    int tid_ = threadIdx.x; asm volatile("" : "+v"(tid_));
    const int tid = tid_, wid = __builtin_amdgcn_readfirstlane(tid >> 6), lane = tid & 63, r32 = lane & 31, hi = lane >> 5;
    const int j_lo = swa_jlo(cur.P0, W);
    int j_hi = (cur.P0 + QB - 1) / KVBLK + 1; if (j_hi > skv / KVBLK) j_hi = skv / KVBLK;
    const int NT = j_hi - j_lo;
    const int kbn = swa_jlo(nxt.P0, W) * KVBLK;
    const int qlo = cur.P0 + wid * QBLK, qm = qlo + r32 - 4 * hi;
    char* V_lds = lds; char* K_lds = lds + 2 * SHM_V;
    float* ws = (float*)(lds + 2 * SHM_V + 2 * SHM_K) + wid * 64; float* li_l = ws, * al_l = ws + 32;
    float m_reg = -1e30f, l_reg = 0; f32x16 o[4] = {};
    const int sr = tid >> 4, sc = (tid & 15) * 8, vst0 = v_st(sr, sc), vst1 = v_st(32 + sr, sc), kws = KSWZ(sr, sc * 2);
    const int vb0 = (int)(uintptr_t)V_lds + v_rd_base(lane);
    const TIn* Kh = cur.K; const TIn* Vh = cur.V;
#define RESC(a) do { if (__any((a) < 1.f)) { if (hi == 0) al_l[r32] = (a); asm volatile("s_waitcnt lgkmcnt(0)" ::: "memory");              \
                     for (int d_ = 0; d_ < 4; ++d_) for (int r = 0; r < 16; ++r) o[d_][r] *= al_l[crow(r, hi)]; } } while (0)
#define KBASE(t) ((j_lo + (t)) * KVBLK)
#define ACT(t) (KBASE(t) <= qlo + QBLK - 1 && KBASE(t) + KVBLK - 1 >= qlo - W + 1)
#define MASKT(P0_, P1_, t) do { const int kb_ = KBASE(t); if ((!SK || ACT(t)) && (kb_ + KVBLK - 1 > qlo || kb_ <= qlo + QBLK - 1 - W)) mask_tile(P0_, P1_, qm - kb_, (unsigned)W); } while (0)
    constexpr int NQL = F32 ? 16 : 8;
    constexpr bool SK = WSKIP && !F32;
#define SEAM_K0() do { VMWN(NQL); if constexpr (F32) { SWRITE_KF(0); SBAR(); SLOAD_F((const float*)nxt.V, kbn); } else { SWRITE_HK(0); } SBAR(); } while (0)
    f32x16 pA0, pA1, pB0, pB1; float mnA, mnB, alA, alB; bf16x8 pa0, pa1, pa2, pa3;
    if constexpr (F32) { VMW(); SWRITE_VF(0); SBAR(); } else { SWRITE_HV(0); SBAR(); }
    if (NT > 1) { if constexpr (F32) SLOAD_F((const float*)Kh, KBASE(1)); else SLOAD_H(Kh, Vh, KBASE(1)); }
    SBAR(); qkt<0, SK>(pA0, pA1, K_lds, r32, hi, S.qr, ACT(0));
    if constexpr (F32) { if (NT > 1) { VMW(); SWRITE_KF(1); SBAR(); SLOAD_F((const float*)Vh, KBASE(1)); } }
    MASKT(pA0, pA1, 0); partialSM(pA0, pA1, m_reg, mnA, alA);
    if (NT > 1) { VMW(); if constexpr (F32) { SWRITE_VF(1); SBAR(); if (NT > 2) SLOAD_F((const float*)Kh, KBASE(2)); } else SWRITE_H(1); }
    __syncthreads();
#define HALF_STEP(PX0, PX1, mnX, alX, PY0, PY1, alY, t, KB, VB, SB) do {                                                      \
        SBAR(); qkt<KB, SK>(PX0, PX1, K_lds, r32, hi, S.qr, ACT(t));                                             \
        finishSM(PY0, PY1, alY, l_reg, pa0, pa1, pa2, pa3); SBAR();                                                           \
        if ((t) + 1 < NT) { if constexpr (F32) { VMW(); SWRITE_KF(SB); SBAR(); SLOAD_F((const float*)Vh, KBASE((t) + 1)); }  \
                            else { SLOAD_H(Kh, Vh, KBASE((t) + 1)); } SBAR(); }                                               \
        pv_tile<VB, SK>(o, vb0, pa0, pa1, pa2, pa3, ACT((t) - 1)); MASKT(PX0, PX1, (t)); partialSM(PX0, PX1, m_reg, mnX, alX);                                        \
        __syncthreads();                                                                                                      \
        if ((t) + 1 < NT) { VMW(); if constexpr (F32) { SWRITE_VF(SB); SBAR(); if ((t) + 2 < NT) SLOAD_F((const float*)Kh, KBASE((t) + 2)); } \
                            else { SWRITE_H(SB); } }                                                                          \
        RESC(alX); __syncthreads(); } while (0)
    for (int t = 1; t + 1 < NT; t += 2) {
        HALF_STEP(pB0, pB1, mnB, alB, pA0, pA1, alA, t, 1, 0, 0);
        HALF_STEP(pA0, pA1, mnA, alA, pB0, pB1, alB, t + 1, 0, 1, 1);
    }
    const bool even = (NT & 1) == 0;
    if (even) { SBAR(); qkt<1, SK>(pB0, pB1, K_lds, r32, hi, S.qr, ACT(NT - 1)); SBAR(); }
#define QROW(e) (nxt.Q + (size_t)(wid * QBLK + r32) * D + ((e) >> 1) * 16 + hi * 8 + ((e) & 1) * 4)
    if constexpr (F32) { SLOAD_F((const float*)nxt.K, kbn); SBAR();
#pragma unroll
        for (int e = 0; e < 8; ++e) S.tq[e] = *(const f32x4*)QROW(e); }
    else { SLOAD_H(nxt.K, nxt.V, kbn); SBAR();
#pragma unroll
        for (int d0 = 0; d0 < 8; ++d0) S.qr[d0] = load8<TIn>(nxt.Q + (size_t)(wid * QBLK + r32) * D + d0 * 16 + hi * 8); }
    SBAR();
    finishSM(pA0, pA1, alA, l_reg, pa0, pa1, pa2, pa3); SBAR();
    if constexpr (F32) {
#pragma unroll
        for (int e = 8; e < 16; ++e) S.tq[e] = *(const f32x4*)QROW(e); SBAR(); }
#undef QROW
    pv_tile<0, SK>(o, vb0, pa0, pa1, pa2, pa3, ACT(even ? NT - 2 : NT - 1));
    if (even) { MASKT(pB0, pB1, NT - 1); partialSM(pB0, pB1, m_reg, mnB, alB); __syncthreads(); RESC(alB);
        finishSM(pB0, pB1, alB, l_reg, pa0, pa1, pa2, pa3); SBAR(); pv_tile<1, SK>(o, vb0, pa0, pa1, pa2, pa3, ACT(NT - 1)); }
    SBAR(); SEAM_K0();
    if (hi == 0) li_l[r32] = l_reg; asm volatile("s_waitcnt lgkmcnt(0)" ::: "memory");
    float rli[16];
#pragma unroll
    for (int r = 0; r < 16; ++r) rli[r] = __builtin_amdgcn_rcpf(li_l[crow(r, hi)]);
    const int LDO = cur.ldo; TOut* Ow = cur.O + (size_t)(wid * QBLK) * LDO;
#pragma unroll
    for (int r = 0; r < 16; ++r) { const int orow = crow(r, hi);
#pragma unroll
        for (int d0 = 0; d0 < 4; ++d0) { const float v = o[d0][r] * rli[r];
            if constexpr (same_t<TOut, float>::v) { Ow[(size_t)orow * LDO + d0 * 32 + r32] = v; }
            else { const float vn = __shfl_xor(v, 1);
                   if ((r32 & 1) == 0) *(unsigned*)(Ow + (size_t)orow * LDO + d0 * 32 + r32) = cvtpk(v, vn); } } }
    if constexpr (F32) {
#pragma unroll
        for (int d0 = 0; d0 < 8; ++d0) S.qr[d0] = pack8(S.tq[2 * d0], S.tq[2 * d0 + 1]); }
    __syncthreads();
#undef RESC
#undef KBASE
#undef ACT
#undef MASKT
#undef SEAM_K0
#undef HALF_STEP
}
#undef ROW
#undef VMW
#undef VMWN
#undef SLOAD_H
#undef SWRITE_HK
#undef SWRITE_HV
#undef SWRITE_H
#undef SLOAD_F
#undef SWRITE_KF
#undef SWRITE_VF


constexpr int QB2 = 128, L2_K = 0, L2_V0 = 32768, L2_V1 = 65536, L2_P = 98304;
struct Ref2 { const bf16* Q; const bf16* K; const bf16* V0; const bf16* V1; float* O0; float* O1; int P0; };
struct Seam2 { bf16x8 qr[8]; bf16x8 sk0, sk1, sa0, sa1, sb0, sb1; f32x16 pA0, pA1; };
#define LD8(p) (*reinterpret_cast<const bf16x8*>(p))
#define VMW2() asm volatile("s_waitcnt vmcnt(0)" ::: "memory")
__device__ __forceinline__ void pv3_tile(f32x16* o, int vb, bf16x8 pa0, bf16x8 pa1, bf16x8 pa2, bf16x8 pa3, bf16x8 pb0, bf16x8 pb1, bf16x8 pb2, bf16x8 pb3, float fA, float fB, const float* alA, int hi) {
#define TRRD(dst, off) asm volatile("ds_read_b64_tr_b16 %0, %1 offset:%2" : "=&v"(dst) : "v"(vb), "i"(off) : "memory")
#define RD8(X, g) do { constexpr int b_ = v_rd_off((g), 0, 0); TRRD(X##0, b_); TRRD(X##1, b_ + 2048); TRRD(X##2, b_ + 4096); TRRD(X##3, b_ + 6144); \
        TRRD(X##4, b_ + 8192); TRRD(X##5, b_ + 10240); TRRD(X##6, b_ + 12288); TRRD(X##7, b_ + 14336); } while (0)
#define VF(X, a, b) (bf16x8){X##a[0], X##a[1], X##a[2], X##a[3], X##b[0], X##b[1], X##b[2], X##b[3]}
#define MM8(X, g) do { \
        o[g] = __builtin_amdgcn_mfma_f32_32x32x16_bf16(pa0, VF(X, 0, 1), o[g], 0, 0, 0); o[4 + g] = __builtin_amdgcn_mfma_f32_32x32x16_bf16(pb0, VF(X, 0, 1), o[4 + g], 0, 0, 0); \
        o[g] = __builtin_amdgcn_mfma_f32_32x32x16_bf16(pa1, VF(X, 2, 3), o[g], 0, 0, 0); o[4 + g] = __builtin_amdgcn_mfma_f32_32x32x16_bf16(pb1, VF(X, 2, 3), o[4 + g], 0, 0, 0); \
        o[g] = __builtin_amdgcn_mfma_f32_32x32x16_bf16(pa2, VF(X, 4, 5), o[g], 0, 0, 0); o[4 + g] = __builtin_amdgcn_mfma_f32_32x32x16_bf16(pb2, VF(X, 4, 5), o[4 + g], 0, 0, 0); \
        o[g] = __builtin_amdgcn_mfma_f32_32x32x16_bf16(pa3, VF(X, 6, 7), o[g], 0, 0, 0); o[4 + g] = __builtin_amdgcn_mfma_f32_32x32x16_bf16(pb3, VF(X, 6, 7), o[4 + g], 0, 0, 0); } while (0)
#define LGK8() do { asm volatile("s_waitcnt lgkmcnt(8)" ::: "memory"); SBAR(); } while (0)
    s16x4 A0, A1, A2, A3, A4, A5, A6, A7, B0, B1, B2, B3, B4, B5, B6, B7;
    RD8(A, 0); RD8(B, 1);
    if (__builtin_amdgcn_readfirstlane(__float_as_int(fA)) != 0) {
        const f32x4* a4p = (const f32x4*)alA + hi; const f32x4 a0 = a4p[0], a1 = a4p[2], a2 = a4p[4], a3 = a4p[6];
#pragma unroll
        for (int d_ = 0; d_ < 4; ++d_)
#pragma unroll
            for (int j = 0; j < 4; ++j) { o[d_][j] *= a0[j]; o[d_][4 + j] *= a1[j]; o[d_][8 + j] *= a2[j]; o[d_][12 + j] *= a3[j]; } }
    if (__builtin_amdgcn_readfirstlane(__float_as_int(fB)) != 0) {
        const f32x4* a4p = (const f32x4*)(alA + 32) + hi; const f32x4 a0 = a4p[0], a1 = a4p[2], a2 = a4p[4], a3 = a4p[6];
#pragma unroll
        for (int d_ = 4; d_ < 8; ++d_)
#pragma unroll
            for (int j = 0; j < 4; ++j) { o[d_][j] *= a0[j]; o[d_][4 + j] *= a1[j]; o[d_][8 + j] *= a2[j]; o[d_][12 + j] *= a3[j]; } }
    asm volatile("s_waitcnt lgkmcnt(0)" ::: "memory"); SBAR(); MM8(A, 0); SBAR();
    RD8(A, 2); LGK8(); MM8(B, 1); SBAR();
    RD8(B, 3); LGK8(); MM8(A, 2); SBAR();
    asm volatile("s_waitcnt lgkmcnt(0)" ::: "memory"); SBAR(); MM8(B, 3);
#undef TRRD
#undef RD8
#undef VF
#undef MM8
#undef LGK8
}
template <bool RS>
__device__ __forceinline__ void diff2_prime(const Ref2& cur, char* lds, Seam2& S) {
    int tid_ = threadIdx.x; asm volatile("" : "+v"(tid_));
    const int tid = tid_, wid = __builtin_amdgcn_readfirstlane(tid >> 6), lane = tid & 63, r32 = lane & 31, hi = lane >> 5;
    const int sr = tid >> 4, sc = (tid & 15) * 8, kws = KSWZ(sr, sc * 2);
    if constexpr (RS) {
#pragma unroll
        for (int d0 = 0; d0 < 8; ++d0) S.qr[d0] = LD8(cur.Q + (size_t)(wid * QBLK + r32) * D + d0 * 16 + hi * 8); }
    S.sk0 = LD8(cur.K + (size_t)sr * D + sc); S.sk1 = LD8(cur.K + (size_t)(32 + sr) * D + sc);
    VMW2();
    *(bf16x8*)(lds + L2_K + kws) = S.sk0; *(bf16x8*)(lds + L2_K + kws + 32 * 256) = S.sk1;
    S.sk0 = LD8(cur.K + (size_t)(KVBLK + sr) * D + sc); S.sk1 = LD8(cur.K + (size_t)(KVBLK + 32 + sr) * D + sc);
    S.sa0 = LD8(cur.V0 + (size_t)sr * D + sc); S.sa1 = LD8(cur.V0 + (size_t)(32 + sr) * D + sc);
    S.sb0 = LD8(cur.V1 + (size_t)sr * D + sc); S.sb1 = LD8(cur.V1 + (size_t)(32 + sr) * D + sc);
    VMW2();
    *(bf16x8*)(lds + L2_K + SHM_K + kws) = S.sk0; *(bf16x8*)(lds + L2_K + SHM_K + kws + 32 * 256) = S.sk1;
    __syncthreads();
    if constexpr (RS) qkt<0, false>(S.pA0, S.pA1, lds + L2_K, r32, hi, S.qr, true);
}
template <bool RS>
__device__ __forceinline__ void diff2_block(const Ref2& cur, const Ref2& nxt, char* lds, float* xl, Seam2& S) {
    int tid_ = threadIdx.x; asm volatile("" : "+v"(tid_));
    const int tid = tid_, wid = __builtin_amdgcn_readfirstlane(tid >> 6), lane = tid & 63, r32 = lane & 31, hi = lane >> 5;
    const int w4 = wid & 3;
    const int NT = (cur.P0 + QB2 - 1) / KVBLK + 1;
    const int qlo = cur.P0 + w4 * QBLK, qm = qlo + r32 - 4 * hi;
    char* K_lds = lds + L2_K; char* V0_lds = lds + L2_V0; char* V1_lds = lds + L2_V1; char* P_lds = lds + L2_P + w4 * 4096;
    float* alp = xl + w4 * 32; float* li = xl + 256 + (RS ? w4 : (w4 >> 1) * 2) * 32; float* flg = xl + 384 + w4;
    const int sr = tid >> 4, sc = (tid & 15) * 8, vst0 = v_st(sr, sc), vst1 = v_st(32 + sr, sc), kws = KSWZ(sr, sc * 2);
    const int vbase = (int)(uintptr_t)V0_lds + v_rd_base(lane);
    float m_reg = -1e30f, l_reg = 0.f; f32x16 o[RS ? 1 : 8] = {};
    auto stage_top = [&](const int t, const bool drain) __attribute__((always_inline)) {
        const int par = t & 1;
        if (!drain) { *(bf16x8*)(V0_lds + par * SHM_V + vst0) = S.sa0; *(bf16x8*)(V0_lds + par * SHM_V + vst1) = S.sa1;
                      *(bf16x8*)(V1_lds + par * SHM_V + vst0) = S.sb0; *(bf16x8*)(V1_lds + par * SHM_V + vst1) = S.sb1; }
        const bool kc = !drain && t + 2 < NT, kn = drain || t == NT - 1;
        if (kc || kn) { const bf16* Kp = kc ? cur.K : nxt.K; const int k0 = kc ? (t + 2) * KVBLK : (drain ? KVBLK : 0);
            S.sk0 = LD8(Kp + (size_t)(k0 + sr) * D + sc); S.sk1 = LD8(Kp + (size_t)(k0 + 32 + sr) * D + sc); }
        const bool vc = !drain && t + 1 < NT;
        if (vc || drain) { const bf16* Ap = vc ? cur.V0 : nxt.V0; const bf16* Bp = vc ? cur.V1 : nxt.V1; const int k0 = vc ? (t + 1) * KVBLK : 0;
            S.sa0 = LD8(Ap + (size_t)(k0 + sr) * D + sc); S.sa1 = LD8(Ap + (size_t)(k0 + 32 + sr) * D + sc);
            S.sb0 = LD8(Bp + (size_t)(k0 + sr) * D + sc); S.sb1 = LD8(Bp + (size_t)(k0 + 32 + sr) * D + sc); }
    };
    auto stage_end = [&](const int t, const bool drain, const int nyoung) __attribute__((always_inline)) {
        const bool kc = !drain && t + 2 < NT, kn = drain || t == NT - 1;
        if (kc || kn) { const int wb = kc ? (t & 1) : (drain ? 1 : 0);
            (void)nyoung;
            *(bf16x8*)(K_lds + wb * SHM_K + kws) = S.sk0; *(bf16x8*)(K_lds + wb * SHM_K + kws + 32 * 256) = S.sk1; }
    };
    if constexpr (RS) {
        f32x16 pB0, pB1;
        auto siter = [&](f32x16& pX0, f32x16& pX1, f32x16& pY0, f32x16& pY1, const int t) __attribute__((always_inline)) {
            const int par = t & 1;
            stage_top(t, false);
            if (t == NT - 1) {
#pragma unroll
                for (int d0 = 0; d0 < 8; ++d0) S.qr[d0] = LD8(nxt.Q + (size_t)(w4 * QBLK + r32) * D + d0 * 16 + hi * 8); }
            SBAR();
            if (t + 1 < NT) qkt<0, false>(pY0, pY1, K_lds + ((t + 1) & 1) * SHM_K, r32, hi, S.qr, true);
            float mn, alpha; bf16x8 pa0, pa1, pa2, pa3;
            { const int kb = t * KVBLK; if (kb + KVBLK - 1 > qlo) mask_tile(pX0, pX1, qm - kb, 1u << 30); }
            partialSM(pX0, pX1, m_reg, mn, alpha); finishSM(pX0, pX1, alpha, l_reg, pa0, pa1, pa2, pa3);
            { bf16x8* pw = (bf16x8*)(P_lds + par * 16384) + lane; pw[0] = pa0; pw[64] = pa1; pw[128] = pa2; pw[192] = pa3; }
            const bool need = __any(alpha < 1.f);
            if (hi == 0) { alp[par * 128 + r32] = alpha; if (t == NT - 1) li[r32] = l_reg; if (r32 == 0) flg[par * 4] = need ? 1.f : 0.f; }
            SBAR();
            stage_end(t, false, t == NT - 1 ? 12 : 4);
            __syncthreads();
        };
#pragma unroll 1
        for (int t = 0; t < NT; t += 2) { siter(S.pA0, S.pA1, pB0, pB1, t); siter(pB0, pB1, S.pA0, S.pA1, t + 1); }
        stage_top(NT, true);
        SBAR();
        qkt<0, false>(S.pA0, S.pA1, K_lds, r32, hi, S.qr, true);
        SBAR();
        stage_end(NT, true, 4);
        __syncthreads();
    } else {
#pragma unroll 1
        for (int t = 0; t <= NT; ++t) {
            const bool drain = t == NT;
            stage_top(t, drain);
            SBAR();
            if (t >= 1) {
                const int pp = (t - 1) & 1, rg = w4 >> 1, hf = w4 & 1;
                char* PA = lds + L2_P + (2 * rg) * 4096 + pp * 16384; float* alA = xl + (2 * rg) * 32 + pp * 128; float* flA = xl + 384 + 2 * rg + pp * 4;
                bf16x8 pa0, pa1, pa2, pa3, pb0, pb1, pb2, pb3;
                { const bf16x8* pr = (const bf16x8*)PA + lane; pa0 = pr[0]; pa1 = pr[64]; pa2 = pr[128]; pa3 = pr[192]; pb0 = pr[256]; pb1 = pr[320]; pb2 = pr[384]; pb3 = pr[448]; }
                const float fA = flA[0], fB = flA[1];
                pv3_tile(o, vbase + hf * (L2_V1 - L2_V0) + pp * SHM_V, pa0, pa1, pa2, pa3, pb0, pb1, pb2, pb3, fA, fB, alA, hi);
            }
            SBAR();
            stage_end(t, drain, 4);
            if (drain) {
                int r32e = r32, hie = hi; asm volatile("" : "+v"(r32e), "+v"(hie));
                const f32x4* l4p = (const f32x4*)li + hie; const f32x4 l0 = l4p[0], l1 = l4p[2], l2 = l4p[4], l3 = l4p[6];
                float rli[16];
#pragma unroll
                for (int j = 0; j < 4; ++j) { rli[j] = __builtin_amdgcn_rcpf(l0[j]); rli[4 + j] = __builtin_amdgcn_rcpf(l1[j]); rli[8 + j] = __builtin_amdgcn_rcpf(l2[j]); rli[12 + j] = __builtin_amdgcn_rcpf(l3[j]); }
                const f32x4* m4p = (const f32x4*)(li + 32) + hie; const f32x4 n0 = m4p[0], n1 = m4p[2], n2 = m4p[4], n3 = m4p[6];
                float rlj[16];
#pragma unroll
                for (int j = 0; j < 4; ++j) { rlj[j] = __builtin_amdgcn_rcpf(n0[j]); rlj[4 + j] = __builtin_amdgcn_rcpf(n1[j]); rlj[8 + j] = __builtin_amdgcn_rcpf(n2[j]); rlj[12 + j] = __builtin_amdgcn_rcpf(n3[j]); }
                float* Ow = ((w4 & 1) ? cur.O1 : cur.O0) + (size_t)((w4 >> 1) * 2 * QBLK) * D;
#pragma unroll
                for (int r = 0; r < 16; ++r) { const int orow = crow(r, hie);
#pragma unroll
                    for (int d0 = 0; d0 < 4; ++d0) { Ow[(size_t)orow * D + d0 * 32 + r32e] = o[d0][r] * rli[r]; Ow[(size_t)(QBLK + orow) * D + d0 * 32 + r32e] = o[4 + d0][r] * rlj[r]; } }
            }
            __syncthreads();
        }
    }
}
#undef LD8
#undef VMW2
}
constexpr size_t al256(size_t x) { return (x + 255) & ~(size_t)255; }
constexpr size_t WS_CTL = 0, CTL_ZERO_BYTES = 1u << 20;
constexpr size_t WS_WGU   = CTL_ZERO_BYTES;
constexpr size_t WS_WDN   = WS_WGU  + (size_t)8 * NGU * DM * 2;
constexpr size_t WS_WOUT  = WS_WDN  + (size_t)8 * DM * FF * 2;
constexpr size_t WS_WMEM  = WS_WOUT + (size_t)4 * DM * DM * 2;
constexpr size_t WS_WAIN  = WS_WMEM + (size_t)4 * 1024 * DM * 2;
constexpr size_t WS_WKV   = WS_WAIN + (size_t)2 * NAIN * DM * 2;
constexpr size_t WS_WBIN  = WS_WKV  + (size_t)NKV * DM * 2;
constexpr size_t WS_COS   = WS_WBIN + (size_t)2 * NBIN * DM * 2;
constexpr size_t WS_MEMN  = WS_COS  + (size_t)SEQ * 64 * 4;
constexpr size_t WS_MK    = WS_MEMN + (size_t)4 * 1024 * DM * 2;
constexpr size_t WS_MV    = WS_MK   + (size_t)4 * 1024 * 512 * 2;
constexpr size_t WS_XB    = WS_MV   + (size_t)4 * 1024 * 512 * 2;
constexpr size_t WS_SS    = WS_XB   + (size_t)M * DM * 2;
constexpr size_t WS_XH    = WS_SS   + (size_t)M * 32 * 4;
constexpr size_t WS_HID   = WS_XH   + (size_t)M * DM * 2;
constexpr size_t WS_ZA    = WS_HID  + (size_t)M * FF * 2;
constexpr size_t WS_VSTAT = WS_ZA   + (size_t)M * 3072 * 2;
constexpr size_t WS_QB    = WS_VSTAT + (size_t)M * 24 * 4;
constexpr size_t WS_KSH   = WS_QB   + (size_t)M * 1536 * 2;
constexpr size_t WS_VSH   = WS_KSH  + (size_t)M * 1536 * 2;
constexpr size_t WS_QMB   = WS_VSH  + (size_t)M * 1536 * 2;
constexpr size_t WS_OATT  = WS_QMB  + (size_t)M * 512 * 2;
constexpr size_t WS_CAT   = WS_OATT + (size_t)2 * 96 * SEQ * 128 * 4;
constexpr size_t WS_END   = WS_CAT  + (size_t)M * DM * 2;
static_assert(WS_WGU % 256 == 0 && WS_COS % 256 == 0 && WS_VSTAT % 256 == 0 && WS_QB % 256 == 0 && WS_END % 256 == 0, "ws alignment");

constexpr int RING_OFF = 0, RING_BYTES = 131072;
constexpr int LDSCTL_OFF = 141312, MISC_OFF = LDSCTL_OFF + 320;
constexpr int LDS_BYTES = 147456;
constexpr int NWAVES = 8;

#define GAS __attribute__((address_space(1)))
#define LAS __attribute__((address_space(3)))
typedef unsigned short bf16r;
typedef unsigned v4u __attribute__((ext_vector_type(4)));
typedef unsigned v2u __attribute__((ext_vector_type(2)));
typedef float f32x4 __attribute__((ext_vector_type(4)));
typedef short bf16x8 __attribute__((ext_vector_type(8)));
typedef GAS unsigned gu32;
#define LDS_WAIT() asm volatile("s_waitcnt lgkmcnt(0)" ::: "memory")
#define VM_WAIT() asm volatile("s_waitcnt vmcnt(0)" ::: "memory")
__device__ __forceinline__ unsigned f2bf(float f) { unsigned u = __builtin_bit_cast(unsigned, f); return (u + 0x7fffu + ((u >> 16) & 1u)) >> 16; }
__device__ __forceinline__ unsigned pk2(float lo, float hi) { return f2bf(lo) | (f2bf(hi) << 16); }
__device__ __forceinline__ float bf2f(unsigned short b) { return __builtin_bit_cast(float, ((unsigned)b) << 16); }
__device__ __forceinline__ float wave_sum(float v) {
#pragma unroll
    for (int o = 1; o < 64; o <<= 1) v += __shfl_xor(v, o);
    return v;
}
#define XB_TMO      128
#define XB_XCNT(j)  (256  + 64 * (j))
#define XB_XSUB(j)  (1280 + 64 * (j))
#define XB_XGEN(j)  (2304 + 64 * (j))
#define XB_TOP      3328
#define XB_TOPGEN   3392
#define XCD_BAR_WORDS 3456
#define XB_SPIN_CAP (1u << 18)

__device__ __forceinline__ unsigned xb_ld(unsigned* p)              { return __hip_atomic_load(p, __ATOMIC_RELAXED, __HIP_MEMORY_SCOPE_AGENT); }
__device__ __forceinline__ unsigned xb_add(unsigned* p, unsigned v) { return __hip_atomic_fetch_add(p, v, __ATOMIC_RELAXED, __HIP_MEMORY_SCOPE_AGENT); }
__device__ __forceinline__ unsigned xb_xcc_id() { return (unsigned)__builtin_amdgcn_s_getreg((3 << 11) | 20) & 0xFu; }
#define XB_SPIN(cond, bar) do { unsigned _sp = 0; while (cond) { __builtin_amdgcn_s_sleep(1); \
    if ((++_sp & 255u) == 0u) { if (xb_ld(&(bar)[XB_TMO])) break; if (_sp > XB_SPIN_CAP) { atomicAdd(&(bar)[XB_TMO], 1u); break; } } } } while (0)

struct XcdBarrier {
    unsigned* bar; unsigned x;
    volatile LAS unsigned* st;
};

__device__ __forceinline__ XcdBarrier xcd_barrier_post(unsigned* bar, volatile LAS unsigned* st) {
    XcdBarrier b; b.bar = bar; b.x = xb_xcc_id(); b.st = st;
    if (threadIdx.x == 0) (void)xb_add(&bar[XB_XCNT(b.x)], 1u);
    return b;
}
__device__ __forceinline__ void xcd_barrier_complete(unsigned* bar, unsigned x, unsigned& nloc, unsigned& nx) {
    const unsigned G = gridDim.x * gridDim.y * gridDim.z;
    unsigned sum, cnt, mine, sp = 0u;
    for (;;) {
        sum = 0u; cnt = 0u; mine = 0u;
#pragma unroll
        for (unsigned j = 0; j < 16; ++j) { const unsigned c = xb_ld(&bar[XB_XCNT(j)]); sum += c; cnt += (c > 0u) ? 1u : 0u; mine = (j == x) ? c : mine; }
        if (sum == G) break;
        __builtin_amdgcn_s_sleep(1);
        if ((++sp & 255u) == 0u) { if (xb_ld(&bar[XB_TMO])) break; if (sp > XB_SPIN_CAP) { atomicAdd(&bar[XB_TMO], 1u); break; } }
    }
    nloc = mine > 0u ? mine : 1u; nx = cnt > 0u ? cnt : 1u;
}

__device__ __forceinline__ void xcd_barrier(const XcdBarrier& b) {
    asm volatile("s_waitcnt vmcnt(0)" ::: "memory");
    __syncthreads();
    if (threadIdx.x == 0) {
        unsigned* bar = b.bar;
        __builtin_amdgcn_s_waitcnt(0);
        unsigned nloc = b.st[0], nx = b.st[1];
        if (nloc == 0u) { xcd_barrier_complete(bar, b.x, nloc, nx); b.st[0] = nloc; b.st[1] = nx; }
        const unsigned old = xb_add(&bar[XB_XSUB(b.x)], 1u);
        const unsigned gen = old / nloc;
        if (old + 1u == (gen + 1u) * nloc) {
            __builtin_amdgcn_fence(__ATOMIC_RELEASE, "agent");
            asm volatile("s_waitcnt vmcnt(0)" ::: "memory");
            const unsigned og = xb_add(&bar[XB_TOP], 1u);
            const unsigned tg = og / nx;
            if (og + 1u == (tg + 1u) * nx) xb_add(&bar[XB_TOPGEN], 1u);
            else XB_SPIN(xb_ld(&bar[XB_TOPGEN]) == tg, bar);
            __builtin_amdgcn_fence(__ATOMIC_ACQUIRE, "agent");
            xb_add(&bar[XB_XGEN(b.x)], 1u);
            asm volatile("s_waitcnt vmcnt(0)" ::: "memory");
        } else {
            XB_SPIN(xb_ld(&bar[XB_XGEN(b.x)]) == gen, bar);
            __builtin_amdgcn_fence(__ATOMIC_ACQUIRE, "agent");
            asm volatile("s_waitcnt vmcnt(0)" ::: "memory");
        }
    }
    __syncthreads();
}

#define XB_LSUB(j)  (4096 + 64 * (j))
#define XB_LGEN(j)  (5120 + 64 * (j))
#define XB_XCCTAB   6144
__device__ __forceinline__ void xcd_local_barrier(const XcdBarrier& b) {
    asm volatile("s_waitcnt vmcnt(0)" ::: "memory");
    __syncthreads();
    if (threadIdx.x == 0) {
        unsigned* bar = b.bar;
        __builtin_amdgcn_s_waitcnt(0);
        const unsigned nloc = b.st[0] ? b.st[0] : 1u;
        const unsigned old = xb_add(&bar[XB_LSUB(b.x)], 1u);
        const unsigned gen = old / nloc;
        if (old + 1u == (gen + 1u) * nloc) {
#ifndef LOCAL_BAR_RELEASE
#define LOCAL_BAR_RELEASE 0
#endif
            if (LOCAL_BAR_RELEASE) { __builtin_amdgcn_fence(__ATOMIC_RELEASE, "agent"); asm volatile("s_waitcnt vmcnt(0)" ::: "memory"); }
            __builtin_amdgcn_fence(__ATOMIC_ACQUIRE, "agent");
            xb_add(&bar[XB_LGEN(b.x)], 1u);
            asm volatile("s_waitcnt vmcnt(0)" ::: "memory");
        } else {
            XB_SPIN(xb_ld(&bar[XB_LGEN(b.x)]) == gen, bar);
            __builtin_amdgcn_fence(__ATOMIC_ACQUIRE, "agent");
            asm volatile("s_waitcnt vmcnt(0)" ::: "memory");
        }
    }
    __syncthreads();
}
struct Frame {
    unsigned char* lds_g;
    LAS unsigned char* lds;
    volatile LAS unsigned* MISC;
    gu32* ctl;
    int tid, lane, wave;
    int vcu, G;
    unsigned char* ws;
};

__device__ __forceinline__ void transpose_item(const float* W, int K, int N, bf16r* WT, size_t dst_row0, int k0, int n0, LAS float* scr, int lane, const float* gain) {
    f32x4 v[16]; float gk[16];
#pragma unroll
    for (int i = 0; i < 16; ++i) { const int kk = 4 * i + (lane >> 4); v[i] = *(const f32x4*)(W + (size_t)(k0 + kk) * N + n0 + (lane & 15) * 4); gk[i] = gain ? gain[k0 + kk] : 1.0f; }
#pragma unroll
    for (int i = 0; i < 16; ++i) { const int kk = 4 * i + (lane >> 4); const f32x4 w = v[i] * gk[i];
        LAS float* s = scr + kk * 65 + (lane & 15) * 4; s[0] = w[0]; s[1] = w[1]; s[2] = w[2]; s[3] = w[3]; }
    LDS_WAIT(); asm volatile("" ::: "memory");
    const int c = lane & 7;
#pragma unroll
    for (int j = 0; j < 8; ++j) { const int n = (lane >> 3) + 8 * j; const LAS float* s = scr + (8 * c) * 65 + n;
        v4u o; o.x = pk2(s[0 * 65], s[1 * 65]); o.y = pk2(s[2 * 65], s[3 * 65]); o.z = pk2(s[4 * 65], s[5 * 65]); o.w = pk2(s[6 * 65], s[7 * 65]);
        const size_t row = dst_row0 + n;
        *(v4u*)(WT + (((row >> 8) * (size_t)(K >> 6) + (k0 >> 6)) << 14) + ((row & 255) << 6) + 8 * c) = o; }
    LDS_WAIT(); asm volatile("" ::: "memory");
}
__device__ __forceinline__ bool transpose_group(int& r, const float* src, int cnt, int K, int N, bf16r* dst, bool gu, LAS float* scr, int lane, const float* gain, int gmode) {
    const int nkb = K / 64, nnb = N / 64, per = nkb * nnb;
    if (r >= cnt * per) { r -= cnt * per; return false; }
    const int mi = r / per, q = r % per, kb = q / nnb, nb = q % nnb, n0 = nb * 64;
    size_t drow = n0;
    if (gu) { drow = (n0 < FF) ? (size_t)(n0 / 128) * 256 + (n0 % 128) : (size_t)((n0 - FF) / 128) * 256 + 128 + ((n0 - FF) % 128); }
    const float* gp = gain;
    if (gain) { if (gmode == 1) gp = gain + (size_t)((mi >> 1) * 3 + (mi & 1) * 2) * K; else if (gmode >= 2) gp = gain + (size_t)((mi + (gmode - 2)) * 3 + 1) * K; }
    transpose_item(src + (size_t)mi * K * N, K, N, dst + (size_t)mi * K * N, gu ? drow : (size_t)n0, kb * 64, n0, scr, lane, gp);
    return true;
}
__device__ __forceinline__ void norm_row(const float* xrow, const float* gain, bf16r* orow, int lane) {
    const f32x4* xr = (const f32x4*)xrow + lane; f32x4 v[8]; float s = 0.f;
#pragma unroll
    for (int j = 0; j < 8; ++j) { v[j] = xr[64 * j]; s += (v[j][0] * v[j][0] + v[j][1] * v[j][1]) + (v[j][2] * v[j][2] + v[j][3] * v[j][3]); }
    const float rstd = 1.0f / sqrtf(wave_sum(s) * (1.0f / DM) + EPS);
    const f32x4* g4 = (const f32x4*)gain + lane; v2u* o8 = (v2u*)orow + lane;
#pragma unroll
    for (int j = 0; j < 8; ++j) { const f32x4 g = g4[64 * j]; v2u w; w.x = pk2(v[j][0] * rstd * g[0], v[j][1] * rstd * g[1]); w.y = pk2(v[j][2] * rstd * g[2], v[j][3] * rstd * g[3]); o8[64 * j] = w; }
}
__device__ __forceinline__ void xb_ss_phase(const Frame& F, const float* x, bf16r* xb, float* ss) {
    const int gw = F.vcu * NWAVES + F.wave, NGW = F.G * NWAVES, lane = F.lane;
    for (int m = gw; m < M; m += NGW) { const f32x4* xr = (const f32x4*)(x + (size_t)m * DM) + lane; float s = 0.f;
#pragma unroll
        for (int j = 0; j < 8; ++j) { const f32x4 v = xr[64 * j]; s += (v[0] * v[0] + v[1] * v[1]) + (v[2] * v[2] + v[3] * v[3]); v2u w; w.x = pk2(v[0], v[1]); w.y = pk2(v[2], v[3]); const int col = 4 * lane + 256 * j; *(v2u*)(xb + (((size_t)((m >> 8) * (DM >> 6) + (col >> 6))) << 14) + ((m & 255) << 6) + (col & 63)) = w; }
        s = wave_sum(s); if (lane < 32) ss[(size_t)m * 32 + lane] = (lane == 0) ? s : 0.f; }
}
__device__ __forceinline__ void sincos_d(float angf, float& sn, float& cs) {
    const double a = (double)angf; const double k = __builtin_rint(a * 0.15915494309189535); const double r = a - k * 6.283185307179586476925286766559;
    const double r2 = r * r; double ts = r, tc = 1.0, ss = r, cc = 1.0;
#pragma unroll
    for (int n = 1; n <= 14; ++n) { tc = -tc * r2 / (double)((2 * n - 1) * (2 * n)); ts = -ts * r2 / (double)((2 * n) * (2 * n + 1)); cc += tc; ss += ts; }
    sn = (float)ss; cs = (float)cc;
}
__device__ __forceinline__ void combine_phase(const Frame& F, const float* oatt, const float* lamp  , const float* subg  , float lam_init, bf16r* cat) {
    const int gw = F.vcu * NWAVES + F.wave, NGW = F.G * NWAVES, lane = F.lane;
    const float d01 = wave_sum(lamp[lane] * lamp[128 + lane] + lamp[64 + lane] * lamp[192 + lane]);
    const float d23 = wave_sum(lamp[256 + lane] * lamp[384 + lane] + lamp[320 + lane] * lamp[448 + lane]);
    const float lam = expf(d01) - expf(d23) + lam_init;
    const int half = lane >> 5, d4 = (lane & 31) * 4; const f32x4 g = *(const f32x4*)(subg + half * 128 + d4) * (1.0f - lam_init);
    const bool own = F.G == 256; const int m0 = own ? 2048 * ((int)blockIdx.x & 7) + ((int)blockIdx.x >> 3) * NWAVES + F.wave : gw, mstep = own ? 256 : NGW, mend = own ? 2048 * ((int)blockIdx.x & 7) + 2048 : M;
    for (int m = m0; m < mend; m += mstep) { const int b = m >> 12, s = m & 4095;
        f32x4 o[DH]; float ss[DH];
#pragma unroll
        for (int h = 0; h < DH; ++h) { const size_t vh0 = (size_t)((b * 6 + h) * 2 + 0) * 2 + half, vh1 = (size_t)((b * 6 + h) * 2 + 1) * 2 + half;
            const f32x4 o0 = *(const f32x4*)(oatt + (vh0 * SEQ + s) * 128 + d4), o1 = *(const f32x4*)(oatt + (vh1 * SEQ + s) * 128 + d4);
            o[h] = o0 - o1 * lam; ss[h] = (o[h][0] * o[h][0] + o[h][1] * o[h][1]) + (o[h][2] * o[h][2] + o[h][3] * o[h][3]); }
#pragma unroll
        for (int sh = 1; sh < 64; sh <<= 1) {
#pragma unroll
            for (int h = 0; h < DH; ++h) ss[h] += __shfl_xor(ss[h], sh); }
#pragma unroll
        for (int h = 0; h < DH; ++h) { const float rstd = 1.0f / sqrtf(ss[h] * (1.0f / DV) + EPS);
            v2u w; w.x = pk2(o[h][0] * rstd * g[0], o[h][1] * rstd * g[1]); w.y = pk2(o[h][2] * rstd * g[2], o[h][3] * rstd * g[3]);
            *(v2u*)(cat + (size_t)m * DM + h * 256 + half * 128 + d4) = w; }
    }
}

constexpr int GM_WL = 0, GM_WLS = 272, GM_VT = 128 * GM_WLS, GM_VTS = 272, GM_RS = GM_VT + 256 * GM_VTS;
static_assert(GM_RS + 512 <= RING_BYTES, "gmlp LDS");
__device__ __forceinline__ void gmlp_phase(const Frame& F, const bf16r* ZA, const float* vstat, const float* w_s  , const float* b_s  , const float* gv  , bf16r* cat) {
    const int tid = F.tid, lane = F.lane, wave = F.wave, fr = lane & 15, fq = lane >> 4;
    LAS unsigned char* lds = F.lds;
    LAS float* rs = (LAS float*)(lds + GM_RS);
    const bool own = F.G == 256; const int xg = (int)blockIdx.x & 7, jg = (int)blockIdx.x >> 3;
    for (int unit = own ? jg : F.vcu; unit < (own ? 96 : 128 * GG); unit += own ? 32 : F.G) {
        const int bc = own ? 16 * xg + unit / GG : unit / GG, g = unit % GG, r0 = bc * 128;
        if (tid < 128) { const f32x4* p = (const f32x4*)(vstat + (size_t)(r0 + tid) * 24); float s = 0.f;
#pragma unroll
            for (int i = 0; i < 6; ++i) { const f32x4 v = p[i]; s += (v[0] + v[1]) + (v[2] + v[3]); }
            rs[tid] = 1.0f / sqrtf(s * (1.0f / MIXW) + EPS); }
        { const int s = tid & 127, cb = (tid >> 7) * 8;
#pragma unroll
          for (int it = 0; it < 8; ++it) { const int d8 = (cb + it) * 8; const bf16x8 v = *(const bf16x8*)(ZA + (size_t)(r0 + s) * 3072 + 1536 + g * 256 + d8);
#pragma unroll
              for (int e = 0; e < 8; ++e) *(LAS unsigned short*)(lds + GM_VT + (d8 + e) * GM_VTS + s * 2) = (unsigned short)v[e]; } }
        __syncthreads();
        for (int idx = tid; idx < 128 * 32; idx += 512) { const int t = idx >> 5, s4 = (idx & 31) * 4; const f32x4 w = *(const f32x4*)(w_s + ((size_t)g * 128 + t) * 128 + s4);
            float e[4];
#pragma unroll
            for (int j = 0; j < 4; ++j) e[j] = (s4 + j <= t) ? w[j] * rs[s4 + j] : 0.f;
            v2u o; o.x = pk2(e[0], e[1]); o.y = pk2(e[2], e[3]); *(LAS v2u*)(lds + GM_WL + t * GM_WLS + s4 * 2) = o; }
        __syncthreads();
        f32x4 acc[8][2];
#pragma unroll
        for (int tt = 0; tt < 8; ++tt) { acc[tt][0] = (f32x4){0.f, 0.f, 0.f, 0.f}; acc[tt][1] = (f32x4){0.f, 0.f, 0.f, 0.f}; }
#pragma unroll
        for (int ks = 0; ks < 4; ++ks) {
            bf16x8 bfr[2];
#pragma unroll
            for (int dd = 0; dd < 2; ++dd) bfr[dd] = *(const LAS bf16x8*)(lds + GM_VT + (32 * wave + 16 * dd + fr) * GM_VTS + (32 * ks + 8 * fq) * 2);
#pragma unroll
            for (int tt = 0; tt < 8; ++tt) { if (32 * ks <= 16 * tt + 15) {
                const bf16x8 afr = *(const LAS bf16x8*)(lds + GM_WL + (16 * tt + fr) * GM_WLS + (32 * ks + 8 * fq) * 2);
#pragma unroll
                for (int dd = 0; dd < 2; ++dd) acc[tt][dd] = __builtin_amdgcn_mfma_f32_16x16x32_bf16(bfr[dd], afr, acc[tt][dd], 0, 0, 0); } }
        }
#pragma unroll
        for (int tt = 0; tt < 8; ++tt) { const int t = 16 * tt + fr, row = r0 + t; const float bias = b_s[g * 128 + t];
#pragma unroll
            for (int dd = 0; dd < 2; ++dd) { const int d = 32 * wave + 16 * dd + 4 * fq; const f32x4 gg = *(const f32x4*)(gv + g * 256 + d);
                const v2u uu = *(const v2u*)(ZA + (size_t)row * 3072 + g * 256 + d);
                const float u0 = bf2f((unsigned short)(uu.x & 0xffff)), u1 = bf2f((unsigned short)(uu.x >> 16)), u2 = bf2f((unsigned short)(uu.y & 0xffff)), u3 = bf2f((unsigned short)(uu.y >> 16));
                const f32x4 a = acc[tt][dd]; v2u o; o.x = pk2(u0 * (a[0] * gg[0] + bias), u1 * (a[1] * gg[1] + bias)); o.y = pk2(u2 * (a[2] * gg[2] + bias), u3 * (a[3] * gg[3] + bias));
                *(v2u*)(cat + (size_t)row * DM + g * 256 + d) = o; } }
        __syncthreads();
    }
}
namespace att {
__device__ __forceinline__ BlockRef<bf16, float> diff_ref(int L, int pass, const bf16* Q, const bf16* K, const bf16* V, float* O) {
    const int vh = L >> 3, x = L & 7, qb = pass ? 15 - x : x;
    const int b = vh / 24, r = vh % 24, h = r >> 2, c = (r >> 1) & 1, half = r & 1;
    BlockRef<bf16, float> R;
    R.Q = Q + ((size_t)((b * 2 + c) * 6 + h) * SEQ + (size_t)qb * QB) * D; R.K = K + (size_t)((b * 2 + c) * 6 + h) * SEQ * D; R.V = V + (size_t)((b * 6 + h) * 2 + half) * SEQ * D;
    R.O = O + ((size_t)vh * SEQ + (size_t)qb * QB) * D; R.P0 = qb * QB; R.ldo = D;
    return R;
}
__device__ __forceinline__ void diff_attn_phase(char* lds, const bf16* Q, const bf16* K, const bf16* V, float* O, int G, int c0) {
    constexpr int total = 96 * 8; const int W = 1 << 30;
    int L = c0; if (L >= total) return;
    int pass = 0; BlockRef<bf16, float> cur = diff_ref(L, 0, Q, K, V, O);
    Seam<bf16> S;
    causal_swa_prime<bf16, float>(cur, W, lds, S);
    for (;;) {
        const bool more_pass = pass == 0, more_item = L + G < total, last = !more_pass && !more_item;
        int passn = pass + 1, Ln = L;
        if (!more_pass) { passn = 0; Ln = more_item ? L + G : L; }
        const BlockRef<bf16, float> nxt = last ? cur : diff_ref(Ln, passn, Q, K, V, O);
        causal_swa_block<bf16, float>(cur, nxt, SEQ, W, lds, S);
        if (last) break;
        cur = nxt; pass = passn; L = Ln;
    }
}
__device__ __forceinline__ Ref2 diff_ref2(int L, int pass, const bf16* Q, const bf16* K, const bf16* V, float* O) {
    const int bhc = L >> 4, x = L & 15, qb = pass ? 31 - x : x;
    const int b = bhc / 12, r = bhc % 12, h = r >> 1, c = r & 1;
    Ref2 R; const size_t qk = (size_t)((b * 2 + c) * 6 + h) * SEQ;
    R.Q = Q + (qk + (size_t)qb * QB2) * D; R.K = K + qk * D;
    R.V0 = V + (size_t)((b * 6 + h) * 2) * SEQ * D; R.V1 = R.V0 + (size_t)SEQ * D;
    const size_t vh = (size_t)b * 24 + h * 4 + c * 2;
    R.O0 = O + (vh * SEQ + (size_t)qb * QB2) * D; R.O1 = R.O0 + (size_t)SEQ * D; R.P0 = qb * QB2;
    return R;
}
template <bool RS>
__device__ __forceinline__ void diff_attn2_role(char* lds, float* xl, const bf16* Q, const bf16* K, const bf16* V, float* O, int G, int c0) {
    constexpr int total = 48 * 16;
    int L = c0; if (L >= total) return;
    int pass = 0; Ref2 cur = diff_ref2(L, 0, Q, K, V, O);
    Seam2 S;
    diff2_prime<RS>(cur, lds, S);
    for (;;) {
        const bool more_pass = pass == 0, more_item = L + G < total, last = !more_pass && !more_item;
        int passn = pass + 1, Ln = L;
        if (!more_pass) { passn = 0; Ln = more_item ? L + G : L; }
        const Ref2 nxt = last ? cur : diff_ref2(Ln, passn, Q, K, V, O);
        diff2_block<RS>(cur, nxt, lds, xl, S);
        if (last) break;
        cur = nxt; pass = passn; L = Ln;
    }
}
__device__ __forceinline__ void diff_attn2_phase(char* lds, float* xl, const bf16* Q, const bf16* K, const bf16* V, float* O, int G, int c0) {
    if (__builtin_amdgcn_readfirstlane((int)threadIdx.x >> 6) < 4) diff_attn2_role<true>(lds, xl, Q, K, V, O, G, c0);
    else diff_attn2_role<false>(lds, xl, Q, K, V, O, G, c0);
}
__device__ __forceinline__ BlockRef<bf16, bf16> mem_ref(int L, const bf16* Q, const bf16* K, const bf16* V, bf16* cat) {
    const int bh = L >> 4, qb = L & 15, b = bh >> 2, hm = bh & 3;
    BlockRef<bf16, bf16> R;
    R.Q = Q + ((size_t)bh * SEQ + (size_t)qb * QB) * D; R.K = K + (size_t)bh * MEML * D; R.V = V + (size_t)bh * MEML * D;
    R.O = cat + ((size_t)b * SEQ + (size_t)qb * QB) * DM + 1536 + hm * 128; R.P0 = 256; R.ldo = DM;
    return R;
}
__device__ __forceinline__ void mem_attn_phase(char* lds, const bf16* Q, const bf16* K, const bf16* V, bf16* cat, int G, int c0) {
    constexpr int total = 256; const int W = 1 << 30;
    int L = c0; if (L >= total) return;
    BlockRef<bf16, bf16> cur = mem_ref(L, Q, K, V, cat);
    Seam<bf16> S;
    causal_swa_prime<bf16, bf16>(cur, W, lds, S);
    for (;;) {
        const bool last = L + G >= total;
        const BlockRef<bf16, bf16> nxt = last ? cur : mem_ref(L + G, Q, K, V, cat);
        causal_swa_block<bf16, bf16>(cur, nxt, MEML, W, lds, S);
        if (last) break;
        cur = nxt; L += G;
    }
}

struct DynAttn { unsigned* qcnt; const unsigned* rq; const unsigned* rkv; unsigned tag; unsigned* tmo; volatile __attribute__((address_space(3))) unsigned* bc; };
__device__ __forceinline__ unsigned dyn_pull(const DynAttn& C, int bpref) {
    if (threadIdx.x == 0) {
        unsigned code = 0xffffffffu;
        for (unsigned spins = 0;; ++spins) {
            bool any_left = false;
#pragma unroll 1
            for (int k = 0; k < 4 && code == 0xffffffffu; ++k) { const int b = (bpref + k) & 3;
                if (__hip_atomic_load(C.qcnt + 64 * b, __ATOMIC_RELAXED, __HIP_MEMORY_SCOPE_AGENT) >= 384u) continue;
                any_left = true;
                const bool ready = __hip_atomic_load(C.rq + 64 * (2 * b), __ATOMIC_RELAXED, __HIP_MEMORY_SCOPE_AGENT) == C.tag && __hip_atomic_load(C.rq + 64 * (2 * b + 1), __ATOMIC_RELAXED, __HIP_MEMORY_SCOPE_AGENT) == C.tag &&
                                   __hip_atomic_load(C.rkv + 64 * (2 * b), __ATOMIC_RELAXED, __HIP_MEMORY_SCOPE_AGENT) != 0u && __hip_atomic_load(C.rkv + 64 * (2 * b + 1), __ATOMIC_RELAXED, __HIP_MEMORY_SCOPE_AGENT) != 0u;
                if (!ready) continue;
                const unsigned n = __hip_atomic_fetch_add(C.qcnt + 64 * b, 1u, __ATOMIC_RELAXED, __HIP_MEMORY_SCOPE_AGENT);
                if (n < 384u) code = ((unsigned)b << 16) | n;
            }
            if (code != 0xffffffffu || !any_left) break;
            __builtin_amdgcn_s_sleep(8);
            if ((spins & 255u) == 255u) { if (__hip_atomic_load(C.tmo, __ATOMIC_RELAXED, __HIP_MEMORY_SCOPE_AGENT)) break; if (spins > (1u << 20)) { __hip_atomic_store(C.tmo, 1u, __ATOMIC_RELAXED, __HIP_MEMORY_SCOPE_AGENT); break; } }
        }
        __builtin_amdgcn_fence(__ATOMIC_ACQUIRE, "agent");
        asm volatile("s_waitcnt vmcnt(0)" ::: "memory");
        C.bc[0] = code;
    }
    __syncthreads();
    const unsigned code = C.bc[0];
    __syncthreads();
    return code;
}
__device__ __forceinline__ BlockRef<bf16, float> dyn_ref(unsigned code, const bf16* Q, const bf16* K, const bf16* V, float* O) {
    const int b = (int)(code >> 16), n = (int)(code & 0xffffu), qb = 15 - (n & 15), r = n >> 4, h = r >> 2, c = (r >> 1) & 1, half = r & 1, vh = b * 24 + r;
    BlockRef<bf16, float> R;
    R.Q = Q + ((size_t)((b * 2 + c) * 6 + h) * SEQ + (size_t)qb * QB) * D; R.K = K + (size_t)((b * 2 + c) * 6 + h) * SEQ * D; R.V = V + (size_t)((b * 6 + h) * 2 + half) * SEQ * D;
    R.O = O + ((size_t)vh * SEQ + (size_t)qb * QB) * D; R.P0 = qb * QB; R.ldo = D;
    return R;
}
__device__ __forceinline__ void diff_attn_dyn_phase(char* lds, const bf16* Q, const bf16* K, const bf16* V, float* O, const DynAttn& C, int bpref) {
    const int W = 1 << 30;
    unsigned code = dyn_pull(C, bpref); if (code == 0xffffffffu) return;
    BlockRef<bf16, float> cur = dyn_ref(code, Q, K, V, O);
    Seam<bf16> S;
    causal_swa_prime<bf16, float>(cur, W, lds, S);
    for (;;) {
        const unsigned nc = dyn_pull(C, bpref); const bool last = nc == 0xffffffffu;
        const BlockRef<bf16, float> nxt = last ? cur : dyn_ref(nc, Q, K, V, O);
        causal_swa_block<bf16, float>(cur, nxt, SEQ, W, lds, S);
        if (last) break;
        cur = nxt;
    }
}
}

constexpr int NPL = 8, PH_BASE = 1, NPH = PH_BASE + DEPTH * NPL;
enum { I_X = 0, I_MEM, I_NORMG, I_WGU, I_WDN, I_WOUT, I_MEMNG, I_MEMWKV, I_MEMQG, I_MEMKG, I_AWIN, I_AVG, I_AWS, I_ABS, I_KVG, I_WKV, I_KG, I_BWIN, I_BQG, I_BLAM, I_BSUBG, N_IN };
struct Args { const float* in[N_IN]; float* out; unsigned char* ws; int ph_lo, ph_hi, li, pad; };

#ifndef EN_MASK
#define EN_MASK 0xFFFFFFFFu
#endif
#define SITE(n) (((EN_MASK) >> (n)) & 1u)
#define IN(k) (lo <= (k) && (k) < hi)
#ifndef PROBE_WAIT
#define PROBE_WAIT 0
#endif
#ifndef PROBE_PHASE
#define PROBE_PHASE 0
#endif
#ifndef LOCAL_SEAMS
#define LOCAL_SEAMS 1
#endif
#define SEAM_X(k, local) do { if (IN((k) + 1)) { unsigned long long t0_ = 0; if (PROBE_WAIT) t0_ = __builtin_amdgcn_s_memrealtime(); \
    if (LOCAL_SEAMS && (local) && F.MISC[24] != 0u) xcd_local_barrier(bar); else xcd_barrier(bar); \
    if (PROBE_WAIT && ((PROBE_WAIT >> CUR_SITE) & 1) && F.tid == 0) F.MISC[16] += (unsigned)(__builtin_amdgcn_s_memrealtime() - t0_); \
    } \
    if (PROBE_PHASE && ((PROBE_PHASE >> CUR_SITE) & 1) && F.tid == 0) F.MISC[17] += (unsigned)(__builtin_amdgcn_s_memrealtime() - tsite_); } while (0)
#define SEAM(k) SEAM_X(k, false)
#define SEAM_L(k) SEAM_X(k, true)
constexpr int CW_RQ = 70016, CW_RKV = 70656, CW_QCNT = 71296;
#define PUBLISH_FLAG(word, val) do { if (blockIdx.x < 8 && F.tid == 0) { __builtin_amdgcn_fence(__ATOMIC_RELEASE, "agent"); asm volatile("s_waitcnt vmcnt(0)" ::: "memory"); \
    __hip_atomic_store((unsigned*)F.ctl + (word) + 64 * (blockIdx.x & 7), (unsigned)(val), __ATOMIC_RELAXED, __HIP_MEMORY_SCOPE_AGENT); } } while (0)
#define SITE_T0 unsigned long long tsite_ = 0; if (PROBE_PHASE) tsite_ = __builtin_amdgcn_s_memrealtime(); (void)tsite_;
#define CAS __attribute__((address_space(4)))
#define WS_PTRS \
    const CAS Args* ap = (const CAS Args*)__builtin_amdgcn_kernarg_segment_ptr(); asm volatile("" : "+s"(ap)); \
    unsigned char* const ws = ap->ws; \
    bf16r* const Wgu = (bf16r*)(ws + WS_WGU); bf16r* const Wdn = (bf16r*)(ws + WS_WDN); bf16r* const Wout = (bf16r*)(ws + WS_WOUT); bf16r* const Wmem = (bf16r*)(ws + WS_WMEM); \
    bf16r* const Wain = (bf16r*)(ws + WS_WAIN); bf16r* const Wkv = (bf16r*)(ws + WS_WKV); bf16r* const Wbin = (bf16r*)(ws + WS_WBIN); \
    unsigned* const CS = (unsigned*)(ws + WS_COS); \
    bf16r* const MEMN = (bf16r*)(ws + WS_MEMN); bf16r* const MK = (bf16r*)(ws + WS_MK); bf16r* const MV = (bf16r*)(ws + WS_MV); \
    bf16r* const XB = (bf16r*)(ws + WS_XB); float* const SS = (float*)(ws + WS_SS); _Float16* const XH = (_Float16*)(ws + WS_XH); bf16r* const HID = (bf16r*)(ws + WS_HID); bf16r* const ZA = (bf16r*)(ws + WS_ZA); \
    float* const VSTAT = (float*)(ws + WS_VSTAT); \
    bf16r* const QB_ = (bf16r*)(ws + WS_QB); bf16r* const KSH = (bf16r*)(ws + WS_KSH); bf16r* const VSH = (bf16r*)(ws + WS_VSH); bf16r* const QMB = (bf16r*)(ws + WS_QMB); \
    float* const OATT = (float*)(ws + WS_OATT); bf16r* const CAT = (bf16r*)(ws + WS_CAT); \
    float* const X = ap->out; \
    (void)Wgu; (void)Wdn; (void)Wout; (void)Wmem; (void)Wain; (void)Wkv; (void)Wbin; (void)CS; (void)MEMN; (void)MK; (void)MV; (void)XB; (void)SS; (void)XH; (void)HID; (void)ZA; \
    (void)VSTAT; (void)QB_; (void)KSH; (void)VSH; (void)QMB; (void)OATT; (void)CAT; (void)X;

constexpr int EX_OFF = RING_BYTES + 2048;
constexpr int RTAB_OFF = RING_BYTES;
__device__ __forceinline__ pg8::RowScale fill_rstd(const Frame& F, const float* ss, const pg8::StaticOrder& So) {
    pg8::Unit u0; const int pm0 = So.next(0, u0) ? u0.pm : -1;
    { pg8::Unit ui; bool same = true; for (int i = 1; So.next(i, ui); ++i) same &= (ui.pm == pm0); if (!same && F.tid == 0) __hip_atomic_store((unsigned*)F.ctl + XB_TMO, 1u, __ATOMIC_RELAXED, __HIP_MEMORY_SCOPE_AGENT); }
    LAS float* tab = (LAS float*)(F.lds + RTAB_OFF);
    __syncthreads();
    if (pm0 >= 0 && F.tid < 256) { const f32x4* p = (const f32x4*)(ss + (size_t)(pm0 * 256 + F.tid) * 32); float s = 0.f;
#pragma unroll
        for (int i = 0; i < 8; ++i) { const f32x4 v = p[i]; s += (v[0] + v[1]) + (v[2] + v[3]); }
        const float v = s * (1.0f / DM) + EPS; tab[2 * F.tid] = 1.0f / sqrtf(v); tab[2 * F.tid + 1] = v; }
    __syncthreads();
    return pg8::RowScale{(const LAS float*)tab};
}
#ifndef ATTN2
#define ATTN2 1
#endif
#ifndef DYN_ATTN
#define DYN_ATTN 0
#endif
template <int L, int S>
__device__ __forceinline__ void ffn_part(const Frame& F, const XcdBarrier& bar, unsigned char* smem, const int lo, const int hi) {
    constexpr int pf = PH_BASE + L * NPL + (S ? 6 : 0);
    if (SITE(3) && IN(pf)) { constexpr int CUR_SITE = 3; (void)CUR_SITE; SITE_T0 WS_PTRS
        pg8::Gemm g{XB, Wgu + (size_t)(L * 2 + S) * NGU * DM, M, NGU, DM}; pg8::StaticOrder So; So.init(M, NGU, F.G, (int)blockIdx.x);
        pg8::EpiSwiglu E{HID, FF, fill_rstd(F, SS, So)};
        pg8::gemm_phase<pg8::EpiSwiglu, pg8::StaticOrder, true, true, true, true>(F.lds + RING_OFF, g, So, E);
        if constexpr (L == NA && S == 0) {
            pg8::Gemm g2{XB, Wkv, M, NKV, DM}; pg8::StaticOrder S2; S2.init(M, NKV, F.G, (int)blockIdx.x);
            pg8::EpiQKRope E2{1, KSH, VSH, ap->in[I_KG], nullptr, CS, (LAS float*)(F.lds + EX_OFF), fill_rstd(F, SS, S2)};
            pg8::gemm_phase<pg8::EpiQKRope, pg8::StaticOrder, true, true, true, true>(F.lds + RING_OFF, g2, S2, E2);
        }
        SEAM_L(pf);
        if constexpr (L == NA && S == 0) { if (DYN_ATTN && IN(pf + 1)) PUBLISH_FLAG(CW_RKV, 1u); }
    }
    if (SITE(4) && IN(pf + 1)) { constexpr int CUR_SITE = 4; (void)CUR_SITE; SITE_T0 WS_PTRS
        pg8::Gemm g{HID, Wdn + (size_t)(L * 2 + S) * DM * FF, M, DM, FF}; pg8::ColSweepOrder So{(int)blockIdx.x};
        pg8::EpiResid E{(L == 0 && S == 0) ? ap->in[I_X] : nullptr, (L == DEPTH - 1 && S == 1) ? X : nullptr, DM, 0.5f, XB, SS, XH};
        pg8::gemm_phase<pg8::EpiResid, pg8::ColSweepOrder, true, true, true, true>(F.lds + RING_OFF, g, So, E);
        SEAM_L(pf + 1);
    }
}
template <int L>
__device__ __forceinline__ void mixer_part(const Frame& F, const XcdBarrier& bar, unsigned char* smem, const int lo, const int hi) {
    constexpr int pb = PH_BASE + L * NPL;
    if (SITE(6) && IN(pb + 2)) { constexpr int CUR_SITE = 6; (void)CUR_SITE; SITE_T0 WS_PTRS
        if constexpr (L < NA) { pg8::Gemm g{XB, Wain + (size_t)L * NAIN * DM, M, NAIN, DM}; pg8::StaticOrder So; So.init(M, NAIN, F.G, (int)blockIdx.x);
            pg8::EpiAin E{ZA, VSTAT, QMB, ap->in[I_MEMQG] + L * HD, (LAS float*)(F.lds + EX_OFF), fill_rstd(F, SS, So)};
            pg8::gemm_phase<pg8::EpiAin, pg8::StaticOrder, true, true, true, true>(F.lds + RING_OFF, g, So, E);
            if constexpr (L == 0) {
                if ((int)blockIdx.x >= 128) { pg8::Gemm gm{MEMN, Wmem, 4096, 4096, DM}; pg8::MemKvOrder Sm{F.G, (int)blockIdx.x - 128};
                    pg8::EpiMemKv Em{MK, MV, ap->in[I_MEMKG], (LAS float*)(F.lds + EX_OFF)};
                    pg8::gemm_phase<pg8::EpiMemKv, pg8::MemKvOrder, true, true, false, true>(F.lds + RING_OFF, gm, Sm, Em); } } }
        else { pg8::Gemm g{XB, Wbin + (size_t)(L - NA) * NBIN * DM, M, NBIN, DM}; pg8::StaticOrder So; So.init(M, NBIN, F.G, (int)blockIdx.x);
            pg8::EpiQKRope E{0, QB_, QMB, ap->in[I_BQG] + (L - NA) * HD, ap->in[I_MEMQG] + L * HD, CS, (LAS float*)(F.lds + EX_OFF), fill_rstd(F, SS, So)};
            pg8::gemm_phase<pg8::EpiQKRope, pg8::StaticOrder, true, true, true, true>(F.lds + RING_OFF, g, So, E); }
        if constexpr (L == 1 || (L >= NA && DYN_ATTN)) SEAM_L(pb + 2); else SEAM(pb + 2);
        if constexpr (L >= NA) { if (DYN_ATTN && IN(pb + 3)) PUBLISH_FLAG(CW_RQ, (unsigned)L); }
    }
    if (SITE(8) && IN(pb + 3)) { constexpr int CUR_SITE = 8; (void)CUR_SITE; SITE_T0 WS_PTRS
        if constexpr (L < NA) gmlp_phase(F, ZA, VSTAT, ap->in[I_AWS] + (size_t)L * GG * 128 * 128, ap->in[I_ABS] + (size_t)L * GG * 128, ap->in[I_AVG] + (size_t)L * MIXW, CAT);
        { const int xg = (int)blockIdx.x & 7, jg = (int)blockIdx.x >> 3, pnl = 8 * xg + (jg >> 2);
          const int c0 = ((L < NA || DYN_ATTN) && F.G == 256) ? (((pnl >> 4) * 4 + (jg & 3)) * 16 + (pnl & 15)) : F.vcu;
          att::mem_attn_phase((char*)smem, (const att::bf16*)QMB, (const att::bf16*)(MK + (size_t)L * 1024 * 512), (const att::bf16*)(MV + (size_t)L * 1024 * 512), (att::bf16*)CAT, F.G, c0); }
        if constexpr (L >= NA) {
            float* const Ol = OATT + (size_t)(L - NA) * 96 * SEQ * 128;
            if (DYN_ATTN) { const att::DynAttn C{(unsigned*)F.ctl + CW_QCNT + 64 * 4 * (L - NA), (const unsigned*)F.ctl + CW_RQ, (const unsigned*)F.ctl + CW_RKV, (unsigned)L, (unsigned*)F.ctl + XB_TMO, F.MISC + 28};
                att::diff_attn_dyn_phase((char*)smem, (const att::bf16*)QB_, (const att::bf16*)KSH, (const att::bf16*)VSH, Ol, C, ((int)blockIdx.x & 7) >> 1); }
            else if (ATTN2) att::diff_attn2_phase((char*)smem, (float*)(smem + 133120), (const att::bf16*)QB_, (const att::bf16*)KSH, (const att::bf16*)VSH, Ol, F.G, F.vcu);
            else att::diff_attn_phase((char*)smem, (const att::bf16*)QB_, (const att::bf16*)KSH, (const att::bf16*)VSH, Ol, F.G, F.vcu);
        }
        if constexpr (L < NA) SEAM_L(pb + 3); else SEAM(pb + 3);
    }
    if constexpr (L >= NA) {
        if (SITE(9) && IN(pb + 4)) { constexpr int CUR_SITE = 9; (void)CUR_SITE; SITE_T0 WS_PTRS constexpr float lam_init = (L == 2) ? 0.47071301834358416f : 0.5560582041556405f;
            combine_phase(F, OATT + (size_t)(L - NA) * 96 * SEQ * 128, ap->in[I_BLAM] + (size_t)(L - NA) * 512, ap->in[I_BSUBG] + (size_t)(L - NA) * DV, lam_init, CAT);
            SEAM_L(pb + 4); }
    }
    if (SITE(10) && IN(pb + 5)) { constexpr int CUR_SITE = 10; (void)CUR_SITE; SITE_T0 WS_PTRS
        pg8::Gemm g{CAT, Wout + (size_t)L * DM * DM, M, DM, DM}; pg8::ColSweepOrder So{(int)blockIdx.x};
        pg8::EpiResid E{nullptr, nullptr, DM, 1.0f, XB, SS, XH};
        pg8::gemm_phase<pg8::EpiResid, pg8::ColSweepOrder, true, true, false, true>(F.lds + RING_OFF, g, So, E);
        SEAM_L(pb + 5);
    }
}

__global__ void __launch_bounds__(NWAVES * 64, 2) yoco_fwd(Args args) {
    extern __shared__ __attribute__((aligned(16))) unsigned char smem[];
    Frame F;
    F.lds_g = smem; F.lds = (LAS unsigned char*)smem;
    F.MISC = (volatile LAS unsigned*)(F.lds + MISC_OFF);
    F.tid = threadIdx.x; F.lane = F.tid & 63; F.wave = __builtin_amdgcn_readfirstlane(F.tid >> 6);
    F.G = gridDim.x; { const int bx = blockIdx.x; F.vcu = (F.G % 8 == 0) ? (bx % 8) * (F.G / 8) + bx / 8 : bx; }
    F.ws = args.ws;
    F.ctl = (gu32*)(args.ws + WS_CTL);
    for (int u = F.tid; u < (LDS_BYTES - LDSCTL_OFF) / 4; u += NWAVES * 64) ((LAS unsigned*)(F.lds + LDSCTL_OFF))[u] = 0u;
    __syncthreads();
    XcdBarrier bar = xcd_barrier_post((unsigned*)F.ctl + (size_t)args.li * XCD_BAR_WORDS, F.MISC + 8);
    if (F.tid == 0) __hip_atomic_store((unsigned*)F.ctl + XB_XCCTAB + blockIdx.x, bar.x + 1u, __ATOMIC_RELAXED, __HIP_MEMORY_SCOPE_AGENT);
    const int lo = args.ph_lo, hi = args.ph_hi;
    {
    const int gw = F.vcu * NWAVES + F.wave, NGW = F.G * NWAVES;
    if (SITE(0) && IN(0)) { constexpr int CUR_SITE = 0; (void)CUR_SITE; SITE_T0 WS_PTRS
        LAS float* scr = (LAS float*)(F.lds + RING_OFF + F.wave * 16640);
        constexpr int NIT = 8 * (DM / 64) * (NGU / 64) + 8 * (FF / 64) * (DM / 64) + 4 * 32 * 32 + 4 * 32 * 16 + 2 * 32 * (NAIN / 64) + 32 * (NKV / 64) + 2 * 32 * 32;
        for (int it = gw; it < NIT; it += NGW) { int r = it;
            if (transpose_group(r, ap->in[I_WGU], 8, DM, NGU, Wgu, true, scr, F.lane, ap->in[I_NORMG], 1)) continue;
            if (transpose_group(r, ap->in[I_WDN], 8, FF, DM, Wdn, false, scr, F.lane, nullptr, 0)) continue;
            if (transpose_group(r, ap->in[I_WOUT], 4, DM, DM, Wout, false, scr, F.lane, nullptr, 0)) continue;
            if (transpose_group(r, ap->in[I_MEMWKV], 4, DM, 1024, Wmem, false, scr, F.lane, nullptr, 0)) continue;
            if (transpose_group(r, ap->in[I_AWIN], 2, DM, NAIN, Wain, false, scr, F.lane, ap->in[I_NORMG], 2)) continue;
            if (transpose_group(r, ap->in[I_WKV], 1, DM, NKV, Wkv, false, scr, F.lane, ap->in[I_KVG], 0)) continue;
            transpose_group(r, ap->in[I_BWIN], 2, DM, NBIN, Wbin, false, scr, F.lane, ap->in[I_NORMG], 4); }
        for (int i = gw * 64 + F.lane; i < SEQ * 64; i += NGW * 64) { const int pos = i >> 6, k = i & 63; const float inv = (float)pow(10000.0, -(double)k / 64.0); const float ang = (float)pos * inv;
            float sn, cs; sincos_d(ang, sn, cs); typedef _Float16 h2 __attribute__((ext_vector_type(2))); h2 t; t.x = (_Float16)cs; t.y = (_Float16)sn; CS[i] = __builtin_bit_cast(unsigned, t); }
        for (int r = gw; r < 4096; r += NGW) { const int l = r >> 10, mm = r & 1023; norm_row(ap->in[I_MEM] + (size_t)mm * DM, ap->in[I_MEMNG] + l * DM, MEMN + (size_t)r * DM, F.lane); }
        xb_ss_phase(F, ap->in[I_X], XB, SS);
        SEAM(0);
        if (LOCAL_SEAMS && IN(1)) { if (F.tid < 64) { bool ok = F.G == 256; unsigned mine[4];
#pragma unroll
                for (int q = 0; q < 4; ++q) { const unsigned i = F.tid + 64 * q; mine[q] = __hip_atomic_load((unsigned*)F.ctl + XB_XCCTAB + i, __ATOMIC_RELAXED, __HIP_MEMORY_SCOPE_AGENT);
                    const unsigned rep = __hip_atomic_load((unsigned*)F.ctl + XB_XCCTAB + (i & 7u), __ATOMIC_RELAXED, __HIP_MEMORY_SCOPE_AGENT); ok = ok && mine[q] != 0u && mine[q] == rep; }
                if (F.tid < 8) { for (unsigned o = 0; o < 8; ++o) { const unsigned other = __hip_atomic_load((unsigned*)F.ctl + XB_XCCTAB + o, __ATOMIC_RELAXED, __HIP_MEMORY_SCOPE_AGENT); ok = ok && (o == (unsigned)F.tid || other != mine[0]); } }
                ok = __all(ok); if (F.tid == 0) F.MISC[24] = ok ? 1u : 0u; }
            __syncthreads(); }
    }
    }
    ffn_part<0, 0>(F, bar, smem, lo, hi); mixer_part<0>(F, bar, smem, lo, hi); ffn_part<0, 1>(F, bar, smem, lo, hi);
    ffn_part<1, 0>(F, bar, smem, lo, hi); mixer_part<1>(F, bar, smem, lo, hi); ffn_part<1, 1>(F, bar, smem, lo, hi);
    ffn_part<2, 0>(F, bar, smem, lo, hi); mixer_part<2>(F, bar, smem, lo, hi); ffn_part<2, 1>(F, bar, smem, lo, hi);
    ffn_part<3, 0>(F, bar, smem, lo, hi); mixer_part<3>(F, bar, smem, lo, hi); ffn_part<3, 1>(F, bar, smem, lo, hi);
    if (PROBE_PHASE) { if (blockIdx.x == 0 && F.tid == 0) { const unsigned long long tot = F.MISC[17], t0 = __builtin_amdgcn_s_memrealtime(); while (__builtin_amdgcn_s_memrealtime() - t0 < tot) __builtin_amdgcn_s_sleep(8); } }
#ifdef PROBE_LOCALOK
    if (blockIdx.x == 0 && F.tid == 0 && F.MISC[24] != 0u) { const unsigned long long t0 = __builtin_amdgcn_s_memrealtime(); while (__builtin_amdgcn_s_memrealtime() - t0 < 50000ull) __builtin_amdgcn_s_sleep(8); }
#endif
    if (PROBE_WAIT) {
        unsigned* sumw = (unsigned*)F.ctl + 65536;
        if (F.tid == 0) __hip_atomic_fetch_add(sumw, F.MISC[16], __ATOMIC_RELAXED, __HIP_MEMORY_SCOPE_AGENT);
        xcd_barrier(bar);
        if (blockIdx.x == 0 && F.tid == 0) { const unsigned tot = __hip_atomic_load(sumw, __ATOMIC_RELAXED, __HIP_MEMORY_SCOPE_AGENT); const unsigned long long avg = tot / gridDim.x, t0 = __builtin_amdgcn_s_memrealtime();
            while (__builtin_amdgcn_s_memrealtime() - t0 < avg) __builtin_amdgcn_s_sleep(8); }
    }
}
#undef IN
#undef SEAM

#ifndef MK_MODE
#define MK_MODE 1
#endif
extern "C" void kernel_launch(void* const* d_in, const int* in_sizes, int n_in, void* d_out, int out_size, void* d_ws, size_t ws_size, hipStream_t stream) {
    static int grid = 0;
    if (grid == 0) {
        if (n_in != N_IN || out_size != M * DM || ws_size < WS_END) { fprintf(stderr, "kernel_launch: unexpected shapes: n_in %d out %d ws %zu (need %zu)\n", n_in, out_size, ws_size, (size_t)WS_END); grid = -1; return; }
        int dev = 0, cus = 0, per_cu = 0;
        if (hipGetDevice(&dev) != hipSuccess || hipDeviceGetAttribute(&cus, hipDeviceAttributeMultiprocessorCount, dev) != hipSuccess) { grid = -1; return; }
        if (hipFuncSetAttribute((const void*)yoco_fwd, hipFuncAttributeMaxDynamicSharedMemorySize, LDS_BYTES) != hipSuccess) { fprintf(stderr, "kernel_launch: hipFuncSetAttribute failed\n"); grid = -1; return; }
        if (hipOccupancyMaxActiveBlocksPerMultiprocessor(&per_cu, (const void*)yoco_fwd, NWAVES * 64, LDS_BYTES) != hipSuccess || per_cu < 1) fprintf(stderr, "kernel_launch: occupancy query says %d blocks per CU\n", per_cu);
        (void)hipGetLastError();
        grid = cus;
        if (cus != 256) { fprintf(stderr, "kernel_launch: built for a 256-CU device (got %d)\n", cus); grid = -1; return; }
    }
    if (grid < 0) return;
    (void)in_sizes;
    if (hipMemsetAsync((char*)d_ws + WS_CTL, 0, CTL_ZERO_BYTES, stream) != hipSuccess) return;
    Args a{};
    for (int i = 0; i < N_IN; ++i) a.in[i] = (const float*)d_in[i];
    a.out = (float*)d_out; a.ws = (unsigned char*)d_ws; a.pad = 0;
#if MK_MODE == 1
    a.ph_lo = 0; a.ph_hi = NPH; a.li = 0;
    hipLaunchKernelGGL(yoco_fwd, dim3(grid), dim3(NWAVES * 64), LDS_BYTES, stream, a);
#else
    for (int p = 0; p < NPH; ++p) {
        const int k = (p - PH_BASE) % NPL, l = (p - PH_BASE) / NPL;
        if (p >= PH_BASE && (k == 4 && l < NA)) continue;
        a.ph_lo = p; a.ph_hi = p + 1; a.li = 0;
        hipLaunchKernelGGL(yoco_fwd, dim3(grid), dim3(NWAVES * 64), LDS_BYTES, stream, a);
    }
#endif
}
```

```cpp
#include <hip/hip_runtime.h>
#include <hip/hip_bf16.h>
#include <cstdio>
#include <cstdint>

constexpr int BATCH = 4, SEQ = 4096, DM = 2048, DEPTH = 4, NA = 2;
constexpr int M = BATCH * SEQ;
constexpr int MEML = 256, HD = 128, MEMH = 4, MEMW = 512, MIXW = 1536, CHUNK = 128, GG = 6, GW = 256, DH = 6, DV = 256, FF = 5632;
constexpr int NGU = 2 * FF;
constexpr int NAIN = 2 * MIXW + MEMW;
constexpr int NBIN = MIXW + MEMW;
constexpr int NKV = 2 * DH * HD + DH * DV;
constexpr float EPS = 1e-6f;
namespace pg8 {
#define PG8_LAS __attribute__((address_space(3)))
typedef unsigned short bf16_t;
typedef short bf16x8 __attribute__((ext_vector_type(8)));
typedef float f32x4 __attribute__((ext_vector_type(4)));
typedef unsigned u32x4 __attribute__((ext_vector_type(4)));
constexpr int BM = 256, BK = 64, HALF = 128, HTB = HALF * BK * 2  , STAGE_BYTES = 8 * HTB, NXCD = 8, WGM = 8;

__host__ __device__ __forceinline__ int lds_byte(int r, int c) { const int st = (r >> 4) * 2 + (c >> 5), rr = r & 15, cc = c & 31, ob = rr * 64 + cc * 2; return st * 1024 + (ob ^ (((ob >> 9) & 1) << 5)); }
__host__ __device__ __forceinline__ void stage_rc(int b, int& R, int& C) { const int st = b / 1024, sb = b % 1024, swz = sb ^ (((sb >> 9) & 1) << 5); R = (st >> 1) * 16 + swz / 64; C = (st & 1) * 32 + (swz % 64) / 2; }
__host__ __device__ __forceinline__ int perm32(int rho) { const int n = rho >> 4, i = rho & 15; return 8 * (i >> 2) + 4 * n + (i & 3); }

struct Unit { int pm, pn; };
struct Gemm { const bf16_t* A; const bf16_t* Bt; int M, N, K; };

struct StaticOrder {
    int nM, nN, nwg, G, c;
    __host__ __device__ void init(int M, int N, int G_, int c_) { nM = M / BM; nN = N / BM; nwg = nM * nN; G = G_; c = c_; }
    __host__ __device__ bool next(int i, Unit& u) const {
        const long L = (long)i * G + c; if (L >= nwg) return false;
        int wgid = (int)L; { const int q = nwg / NXCD, r = nwg % NXCD, xcd = wgid % NXCD, off = wgid / NXCD; wgid = (xcd < r ? xcd * (q + 1) : r * (q + 1) + (xcd - r) * q) + off; }
        const int nig = WGM * nN, gid = wgid / nig, fm = gid * WGM, gsz = (nM - fm) < WGM ? (nM - fm) : WGM;
        u.pm = fm + ((wgid % nig) % gsz); u.pn = (wgid % nig) / gsz; return true;
    }
    __device__ __forceinline__ void a_ready(const Unit&) const {}
    __device__ __forceinline__ void done(const Unit&) const {}
};
__device__ __forceinline__ unsigned cvt_pk_bf16(float lo, float hi) { unsigned r; asm volatile("v_cvt_pk_bf16_f32 %0, %1, %2" : "=v"(r) : "v"(lo), "v"(hi)); return r; }
typedef float f32x2 __attribute__((ext_vector_type(2)));
typedef unsigned u32x2 __attribute__((ext_vector_type(2)));
__device__ __forceinline__ f32x2 gelu_pk(f32x2 v) {
    const f32x2 av = __builtin_elementwise_abs(v), d = av * 0.2316418882f + 1.0f;
    f32x2 t; t.x = __builtin_amdgcn_rcpf(d.x); t.y = __builtin_amdgcn_rcpf(d.y);
    f32x2 q = t * 0.5307027145f + (-0.7265760135f); q = q * t + 0.7107068705f; q = q * t + (-0.142248368f); q = q * t + 0.127414796f; q = q * t;
    const f32x2 s = (v * v) * (-0.72134752044f);
    f32x2 e; e.x = __builtin_amdgcn_exp2f(s.x); e.y = __builtin_amdgcn_exp2f(s.y);
    const f32x2 m = v * (q * e), r = v - m;
    f32x2 o; o.x = v.x < 0.f ? m.x : r.x; o.y = v.y < 0.f ? m.y : r.y; return o;
}
__device__ __forceinline__ float silu_f(float g) { return g * __builtin_amdgcn_rcpf(1.0f + __builtin_amdgcn_exp2f(-1.4426950408889634f * g)); }
__device__ __forceinline__ u32x4 pack8_bf16(f32x4 a, f32x4 b) { u32x4 w; w.x = cvt_pk_bf16(a[0], a[1]); w.y = cvt_pk_bf16(a[2], a[3]); w.z = cvt_pk_bf16(b[0], b[1]); w.w = cvt_pk_bf16(b[2], b[3]); return w; }

__host__ __device__ __forceinline__ size_t blk_off(int row, int col, int kt) { return ((size_t)((row >> 8) * kt + (col >> 6)) << 14) + ((row & 255) << 6) + (col & 63); }
struct RowScale { const PG8_LAS float* rtab; };
__device__ __forceinline__ void get_rstd(float (&rs)[2][4], const RowScale& R, int wr, int fr) {
#pragma unroll
    for (int ai = 0; ai < 2; ++ai)
#pragma unroll
        for (int m = 0; m < 4; ++m) rs[ai][m] = R.rtab ? R.rtab[2 * (ai * HALF + wr * 64 + m * 16 + fr)] : 1.0f;
}
struct EpiSwiglu {
    static constexpr bool PERM = true, AFTER_DRAIN = false;
    static __host__ __device__ __forceinline__ int bmap(int R) { return (R & ~31) + perm32(R & 31); }
    bf16_t* H; int ldh; RowScale R;
    __device__ __forceinline__ void operator()(const f32x4 (&acc)[2][2][4][2], const Unit& u, int wr, int wc, int fr, int fq) const {
        const int row0 = u.pm * BM + wr * 64 + fr, col0 = u.pn * HALF + wc * 32 + 8 * fq;
#pragma unroll
        for (int ai = 0; ai < 2; ++ai)
#pragma unroll
            for (int m = 0; m < 4; ++m) { const f32x2 rv = *(const PG8_LAS f32x2*)(R.rtab + 2 * (ai * HALF + wr * 64 + m * 16 + fr)); const float c1 = -1.4426950408889634f * rv.x, v = rv.y;
                const f32x4 g0 = acc[ai][0][m][0], g1 = acc[ai][0][m][1], u0 = acc[ai][1][m][0], u1 = acc[ai][1][m][1];
                f32x4 h0, h1;
#pragma unroll
                for (int j = 0; j < 4; ++j) { const float e0 = __builtin_amdgcn_exp2f(g0[j] * c1), e1 = __builtin_amdgcn_exp2f(g1[j] * c1);
                    h0[j] = (g0[j] * u0[j]) * __builtin_amdgcn_rcpf(__builtin_fmaf(e0, v, v)); h1[j] = (g1[j] * u1[j]) * __builtin_amdgcn_rcpf(__builtin_fmaf(e1, v, v)); }
                *(u32x4*)(H + blk_off(row0 + ai * HALF + m * 16, col0, ldh >> 6)) = pack8_bf16(h0, h1);
            }
    }
};
struct EpiResid {
    static constexpr bool PERM = true, AFTER_DRAIN = false;
    static __host__ __device__ __forceinline__ int bmap(int R) { return (R & ~31) + perm32(R & 31); }
    const float* base_f32; float* out_f32; int ld; float scale; bf16_t* xb; float* ss; _Float16* xh;
    typedef _Float16 h8 __attribute__((ext_vector_type(8)));
    static __device__ __forceinline__ void one(const f32x4 b0, const f32x4 b1, const f32x4 a0, const f32x4 a1, int row, int col, size_t off, float& s, float scale, float* out_f32, _Float16* xh, bf16_t* xb, int ld) {
        const f32x4 o0 = b0 + a0 * scale, o1 = b1 + a1 * scale;
        if (out_f32) { *(f32x4*)(out_f32 + off) = o0; *(f32x4*)(out_f32 + off + 4) = o1; }
        else { h8 w; w[0] = (_Float16)o0[0]; w[1] = (_Float16)o0[1]; w[2] = (_Float16)o0[2]; w[3] = (_Float16)o0[3]; w[4] = (_Float16)o1[0]; w[5] = (_Float16)o1[1]; w[6] = (_Float16)o1[2]; w[7] = (_Float16)o1[3];
            *(h8*)(xh + off) = w;
            *(u32x4*)(xb + blk_off(row, col, ld >> 6)) = pack8_bf16(o0, o1);
            s += ((o0[0] * o0[0] + o0[1] * o0[1]) + (o0[2] * o0[2] + o0[3] * o0[3])) + ((o1[0] * o1[0] + o1[1] * o1[1]) + (o1[2] * o1[2] + o1[3] * o1[3])); }
    }
    __device__ __forceinline__ void operator()(const f32x4 (&acc)[2][2][4][2], const Unit& u, int wr, int wc, int fr, int fq) const {
        const int row0 = u.pm * BM + wr * 64 + fr, col0 = u.pn * BM + wc * 32 + 8 * fq;
        const float scale_ = scale; float* const out_ = out_f32; _Float16* const xh_ = xh; bf16_t* const xb_ = xb; const int ld_ = ld;
        if (base_f32) {
#pragma unroll
            for (int ai = 0; ai < 2; ++ai)
#pragma unroll
                for (int m = 0; m < 4; ++m) { const int row = row0 + ai * HALF + m * 16; const size_t off = (size_t)row * ld + col0; float s = 0.f;
#pragma unroll
                    for (int bj = 0; bj < 2; ++bj) one(*(const f32x4*)(base_f32 + off + bj * HALF), *(const f32x4*)(base_f32 + off + bj * HALF + 4), acc[ai][bj][m][0], acc[ai][bj][m][1], row, col0 + bj * HALF, off + bj * HALF, s, scale_, out_, xh_, xb_, ld_);
                    if (!out_f32) { s += __shfl_xor(s, 16); s += __shfl_xor(s, 32); if (fq == 0) ss[(size_t)row * 32 + u.pn * 4 + wc] = s; }
                    asm volatile("" ::: "memory"); }
            return;
        }
#pragma unroll
        for (int ai = 0; ai < 2; ++ai) {
            h8 w[4][2];
#pragma unroll
            for (int m = 0; m < 4; ++m)
#pragma unroll
                for (int bj = 0; bj < 2; ++bj) w[m][bj] = *(const h8*)(xh + (size_t)(row0 + ai * HALF + m * 16) * ld + col0 + bj * HALF);
#pragma unroll
            for (int m = 0; m < 4; ++m) { const int row = row0 + ai * HALF + m * 16; const size_t off = (size_t)row * ld + col0; float s = 0.f;
#pragma unroll
                for (int bj = 0; bj < 2; ++bj) { const h8 v = w[m][bj];
                    one((f32x4){(float)v[0], (float)v[1], (float)v[2], (float)v[3]}, (f32x4){(float)v[4], (float)v[5], (float)v[6], (float)v[7]}, acc[ai][bj][m][0], acc[ai][bj][m][1], row, col0 + bj * HALF, off + bj * HALF, s, scale_, out_, xh_, xb_, ld_); }
                if (!out_f32) { s += __shfl_xor(s, 16); s += __shfl_xor(s, 32); if (fq == 0) ss[(size_t)row * 32 + u.pn * 4 + wc] = s; } }
            asm volatile("" ::: "memory");
        }
    }
};
__device__ __forceinline__ void head_ss_put(PG8_LAS float* ex, int rl, int bj, int wc, int fq, float s) { s += __shfl_xor(s, 16); s += __shfl_xor(s, 32); if (fq == 0) ex[(rl * 2 + bj) * 4 + wc] = s; }
__device__ __forceinline__ float head_rstd_get(const PG8_LAS float* ex, int rl, int bj) { const f32x4 p = *(const PG8_LAS f32x4*)(ex + (rl * 2 + bj) * 4); return 1.0f / sqrtf(((p[0] + p[1]) + (p[2] + p[3])) * (1.0f / 128.0f) + 1e-6f); }
#define PG8_EPI_BARRIER() do { asm volatile("s_waitcnt lgkmcnt(0)" ::: "memory"); __builtin_amdgcn_s_barrier(); asm volatile("" ::: "memory"); } while (0)
struct EpiAin {
    static constexpr bool PERM = true, AFTER_DRAIN = false;
    static __host__ __device__ __forceinline__ int bmap(int R) { return (R & ~31) + perm32(R & 31); }
    bf16_t* ZA; float* vstat; bf16_t* qmb; const float* gq; PG8_LAS float* ex; RowScale R;
    __device__ __forceinline__ void operator()(const f32x4 (&acc)[2][2][4][2], const Unit& u, int wr, int wc, int fr, int fq) const {
        const int row0 = u.pm * BM + wr * 64 + fr;
        float rs[2][4]; get_rstd(rs, R, wr, fr);
        if (u.pn < 12) {
            const int col0 = u.pn * BM + wc * 32 + 8 * fq; const bool st = u.pn >= 6;
#pragma unroll
            for (int ai = 0; ai < 2; ++ai)
#pragma unroll
                for (int m = 0; m < 4; ++m) { const int row = row0 + ai * HALF + m * 16; float sq = 0.f;
#pragma unroll
                    for (int bj = 0; bj < 2; ++bj) { f32x4 v0 = acc[ai][bj][m][0] * rs[ai][m], v1 = acc[ai][bj][m][1] * rs[ai][m];
                        f32x2 a = gelu_pk((f32x2){v0[0], v0[1]}), b = gelu_pk((f32x2){v0[2], v0[3]}), c = gelu_pk((f32x2){v1[0], v1[1]}), d = gelu_pk((f32x2){v1[2], v1[3]});
                        v0 = (f32x4){a.x, a.y, b.x, b.y}; v1 = (f32x4){c.x, c.y, d.x, d.y};
                        sq += (v0[0] * v0[0] + v0[1] * v0[1]) + (v0[2] * v0[2] + v0[3] * v0[3]) + (v1[0] * v1[0] + v1[1] * v1[1]) + (v1[2] * v1[2] + v1[3] * v1[3]);
                        *(u32x4*)(ZA + (size_t)row * 3072 + col0 + bj * HALF) = pack8_bf16(v0, v1); }
                    if (st) { sq += __shfl_xor(sq, 16); sq += __shfl_xor(sq, 32); if (fq == 0) vstat[(size_t)row * 24 + (u.pn - 6) * 4 + wc] = sq; } }
        } else {
            const int d0 = wc * 32 + 8 * fq; const f32x4 g0 = *(const f32x4*)(gq + d0), g1 = *(const f32x4*)(gq + d0 + 4);
#pragma unroll
            for (int ai = 0; ai < 2; ++ai)
#pragma unroll
                for (int m = 0; m < 4; ++m) { const int rl = ai * HALF + wr * 64 + m * 16 + fr;
#pragma unroll
                    for (int bj = 0; bj < 2; ++bj) { const f32x4 v0 = acc[ai][bj][m][0], v1 = acc[ai][bj][m][1];
                        head_ss_put(ex, rl, bj, wc, fq, (((v0[0] * v0[0] + v0[1] * v0[1]) + (v0[2] * v0[2] + v0[3] * v0[3])) + ((v1[0] * v1[0] + v1[1] * v1[1]) + (v1[2] * v1[2] + v1[3] * v1[3]))) * (rs[ai][m] * rs[ai][m])); } }
            PG8_EPI_BARRIER();
#pragma unroll
            for (int ai = 0; ai < 2; ++ai)
#pragma unroll
                for (int m = 0; m < 4; ++m) { const int rl = ai * HALF + wr * 64 + m * 16 + fr, row = u.pm * BM + rl, b = row >> 12, s = row & 4095;
#pragma unroll
                    for (int bj = 0; bj < 2; ++bj) { const float sc = rs[ai][m] * head_rstd_get(ex, rl, bj); const int hm = (u.pn - 12) * 2 + bj;
                        *(u32x4*)(qmb + ((size_t)(b * 4 + hm) * 4096 + s) * 128 + d0) = pack8_bf16(acc[ai][bj][m][0] * sc * g0, acc[ai][bj][m][1] * sc * g1); } }
        }
    }
};
struct EpiF32Split {
    static constexpr bool PERM = true, AFTER_DRAIN = false;
    static __host__ __device__ __forceinline__ int bmap(int R) { return (R & ~31) + perm32(R & 31); }
    float* d0; int ld0; int split; float* d1; int ld1; int pnmod; RowScale R;
    __device__ __forceinline__ void operator()(const f32x4 (&acc)[2][2][4][2], const Unit& u, int wr, int wc, int fr, int fq) const {
        const int row0 = u.pm * BM + wr * 64 + fr; int pn = pnmod ? (u.pn % pnmod) : u.pn; float* d = d0; int ld = ld0;
        if (pn >= split) { d = d1; ld = ld1; pn -= split; }
        const int col0 = pn * BM + wc * 32 + 8 * fq;
        float rs[2][4]; get_rstd(rs, R, wr, fr);
#pragma unroll
        for (int ai = 0; ai < 2; ++ai)
#pragma unroll
            for (int m = 0; m < 4; ++m) { float* p = d + (size_t)(row0 + ai * HALF + m * 16) * ld + col0;
#pragma unroll
                for (int bj = 0; bj < 2; ++bj) { *(f32x4*)(p + bj * HALF) = acc[ai][bj][m][0] * rs[ai][m]; *(f32x4*)(p + bj * HALF + 4) = acc[ai][bj][m][1] * rs[ai][m]; } }
    }
};
struct EpiQKRope {
    static constexpr bool PERM = true, AFTER_DRAIN = false;
    static __host__ __device__ __forceinline__ int bmap(int R) { return 64 * ((R >> 4) & 1) + 16 * (R >> 5) + (R & 15); }
    int kind; bf16_t* qk; bf16_t* other; const float* gr; const float* gn; const unsigned* cs; PG8_LAS float* ex; RowScale R;
    __device__ __forceinline__ void operator()(const f32x4 (&acc)[2][2][4][2], const Unit& u, int wr, int wc, int fr, int fq) const {
        typedef _Float16 h2 __attribute__((ext_vector_type(2)));
        float rs[2][4]; get_rstd(rs, R, wr, fr);
        const int d0 = 16 * wc + 4 * fq;
        const bool rope = u.pn < 6;
        if (!rope && kind == 1) {
            const int h = u.pn - 6;
#pragma unroll
            for (int ai = 0; ai < 2; ++ai)
#pragma unroll
                for (int m = 0; m < 4; ++m) { const int row = u.pm * BM + ai * HALF + wr * 64 + m * 16 + fr, b = row >> 12, s = row & 4095;
#pragma unroll
                    for (int bj = 0; bj < 2; ++bj) { bf16_t* p = other + ((size_t)((b * 6 + h) * 2 + bj) * 4096 + s) * 128 + d0;
#pragma unroll
                        for (int n = 0; n < 2; ++n) { const f32x4 v = acc[ai][bj][m][n] * rs[ai][m]; u32x2 w; w.x = cvt_pk_bf16(v[0], v[1]); w.y = cvt_pk_bf16(v[2], v[3]); *(u32x2*)(p + 64 * n) = w; } } }
            return;
        }
        const float* g = rope ? gr : gn; const f32x4 ga = *(const f32x4*)(g + d0), gb = *(const f32x4*)(g + 64 + d0);
        u32x4 cst[2][4];
        if (rope) {
#pragma unroll
            for (int ai = 0; ai < 2; ++ai)
#pragma unroll
                for (int m = 0; m < 4; ++m) { const int s = (u.pm * BM + ai * HALF + wr * 64 + m * 16 + fr) & 4095; cst[ai][m] = *(const u32x4*)(cs + (size_t)s * 64 + d0); }
        }
#pragma unroll
        for (int ai = 0; ai < 2; ++ai)
#pragma unroll
            for (int m = 0; m < 4; ++m) { const int rl = ai * HALF + wr * 64 + m * 16 + fr;
#pragma unroll
                for (int bj = 0; bj < 2; ++bj) { const f32x4 v0 = acc[ai][bj][m][0], v1 = acc[ai][bj][m][1];
                    head_ss_put(ex, rl, bj, wc, fq, (((v0[0] * v0[0] + v0[1] * v0[1]) + (v0[2] * v0[2] + v0[3] * v0[3])) + ((v1[0] * v1[0] + v1[1] * v1[1]) + (v1[2] * v1[2] + v1[3] * v1[3]))) * (rs[ai][m] * rs[ai][m])); } }
        PG8_EPI_BARRIER();
#pragma unroll
        for (int ai = 0; ai < 2; ++ai)
#pragma unroll
            for (int m = 0; m < 4; ++m) { const int rl = ai * HALF + wr * 64 + m * 16 + fr, row = u.pm * BM + rl, b = row >> 12, s = row & 4095;
#pragma unroll
                for (int bj = 0; bj < 2; ++bj) { const float sc = rs[ai][m] * head_rstd_get(ex, rl, bj);
                    f32x4 y0 = acc[ai][bj][m][0] * sc * ga, y1 = acc[ai][bj][m][1] * sc * gb; bf16_t* p;
                    if (rope) { f32x4 o0, o1;
#pragma unroll
                        for (int j = 0; j < 4; ++j) { const unsigned cw = cst[ai][m][j]; const h2 t = __builtin_bit_cast(h2, cw); const float c = (float)t.x, sn = (float)t.y; o0[j] = y0[j] * c - y1[j] * sn; o1[j] = y1[j] * c + y0[j] * sn; }
                        y0 = o0; y1 = o1; p = qk + ((size_t)(b * 12 + u.pn * 2 + bj) * 4096 + s) * 128 + d0; }
                    else p = other + ((size_t)(b * 4 + (u.pn - 6) * 2 + bj) * 4096 + s) * 128 + d0;
                    u32x2 w0, w1; w0.x = cvt_pk_bf16(y0[0], y0[1]); w0.y = cvt_pk_bf16(y0[2], y0[3]); w1.x = cvt_pk_bf16(y1[0], y1[1]); w1.y = cvt_pk_bf16(y1[2], y1[3]);
                    *(u32x2*)p = w0; *(u32x2*)(p + 64) = w1; } }
    }
};
struct ColSweepOrder {
    int c;
    __device__ bool next(int i, Unit& u) const { if (i >= 2) return false; const int xcd = c & 7, j = c >> 3; u.pm = 8 * xcd + 4 * i + (j & 3); u.pn = j >> 2; return true; }
    __device__ __forceinline__ void a_ready(const Unit&) const {}
    __device__ __forceinline__ void done(const Unit&) const {}
};
struct EpiMemKv {
    static constexpr bool PERM = true, AFTER_DRAIN = false;
    static __host__ __device__ __forceinline__ int bmap(int R) { return (R & ~31) + perm32(R & 31); }
    bf16_t* mk; bf16_t* mv; const float* gk; PG8_LAS float* ex;
    __device__ __forceinline__ void operator()(const f32x4 (&acc)[2][2][4][2], const Unit& u, int wr, int wc, int fr, int fq) const {
        const int t = u.pn & 3, d0 = wc * 32 + 8 * fq; const size_t base = (size_t)u.pm * 4;
        if (t < 2) {
            const f32x4 g0 = *(const f32x4*)(gk + (u.pm >> 2) * 128 + d0), g1 = *(const f32x4*)(gk + (u.pm >> 2) * 128 + d0 + 4);
#pragma unroll
            for (int ai = 0; ai < 2; ++ai)
#pragma unroll
                for (int m = 0; m < 4; ++m) { const int rl = ai * HALF + wr * 64 + m * 16 + fr;
#pragma unroll
                    for (int bj = 0; bj < 2; ++bj) { const f32x4 v0 = acc[ai][bj][m][0], v1 = acc[ai][bj][m][1];
                        head_ss_put(ex, rl, bj, wc, fq, ((v0[0] * v0[0] + v0[1] * v0[1]) + (v0[2] * v0[2] + v0[3] * v0[3])) + ((v1[0] * v1[0] + v1[1] * v1[1]) + (v1[2] * v1[2] + v1[3] * v1[3]))); } }
            PG8_EPI_BARRIER();
#pragma unroll
            for (int ai = 0; ai < 2; ++ai)
#pragma unroll
                for (int m = 0; m < 4; ++m) { const int rl = ai * HALF + wr * 64 + m * 16 + fr;
#pragma unroll
                    for (int bj = 0; bj < 2; ++bj) { const float sc = head_rstd_get(ex, rl, bj);
                        *(u32x4*)(mk + ((base + t * 2 + bj) * 256 + rl) * 128 + d0) = pack8_bf16(acc[ai][bj][m][0] * sc * g0, acc[ai][bj][m][1] * sc * g1); } }
        } else {
#pragma unroll
            for (int ai = 0; ai < 2; ++ai)
#pragma unroll
                for (int m = 0; m < 4; ++m) { const int rl = ai * HALF + wr * 64 + m * 16 + fr;
#pragma unroll
                    for (int bj = 0; bj < 2; ++bj) *(u32x4*)(mv + ((base + (t - 2) * 2 + bj) * 256 + rl) * 128 + d0) = pack8_bf16(acc[ai][bj][m][0], acc[ai][bj][m][1]); }
        }
    }
};
struct MemKvOrder {
    int G, c;
    __device__ bool next(int i, Unit& u) const { const int L = i * G + c; if (L >= 64) return false; const int layer = L >> 4, r = L & 15; u.pm = layer * 4 + (r >> 2); u.pn = layer * 4 + (r & 3); return true; }
    __device__ __forceinline__ void a_ready(const Unit&) const {}
    __device__ __forceinline__ void done(const Unit&) const {}
};
template <class Epi, class Sched, bool ALIGN_EPI = false, bool SP2 = false, bool ABLK = false, bool BBLK = false>
__device__ __forceinline__ void gemm_phase(PG8_LAS unsigned char* lds, const Gemm g, const Sched& S, const Epi& E) {
    int tid_ = threadIdx.x; asm volatile("" : "+v"(tid_));
    const int tid = tid_, wid = __builtin_amdgcn_readfirstlane(tid >> 6), lane = tid & 63, wr = wid >> 2, wc = wid & 3, fr = lane & 15, fq = lane >> 4;
    const int K = g.K, nt = K / BK;
    unsigned voffA[2], voffB[2];
#pragma unroll
    for (int i = 0; i < 2; ++i) { int R, C; stage_rc(tid * 16 + i * 8192, R, C); const int Rb = Epi::bmap(R);
        voffA[i] = ABLK ? (unsigned)(R * BK + C) * 2u : (unsigned)(R * K + C) * 2u; voffB[i] = BBLK ? (unsigned)(Rb * BK + C) * 2u : (unsigned)(Rb * K + C) * 2u; }
    const size_t kstepA = ABLK ? (size_t)(BM * BK * 2) : (size_t)(BK * 2), kstepB = BBLK ? (size_t)(BM * BK * 2) : (size_t)(BK * 2);
    const size_t hstepA = ABLK ? (size_t)(HALF * BK * 2) : (size_t)HALF * K * 2, hstepB = BBLK ? (size_t)(HALF * BK * 2) : (size_t)HALF * K * 2;
    const size_t tstep = (size_t)BM * K * 2;
#ifndef PG8_PF
#define PG8_PF 0
#endif
    PG8_LAS unsigned* const pfjunk = (PG8_LAS unsigned*)(lds + 143360 + wid * 256);
    const unsigned ldsw = (unsigned)wid * 1024u;
    const int aoff = lds_byte(wr * 64 + fr, fq * 8), boff = lds_byte(wc * 32 + fr, fq * 8);
#define PG8_SA(b, h) (((b) * 2 + (h)) * HTB)
#define PG8_SB(b, h) ((4 + (b) * 2 + (h)) * HTB)
#define PG8_STAGE(bufoff, gbase, voff) do { _Pragma("unroll") for (int _i = 0; _i < 2; ++_i) \
        __builtin_amdgcn_global_load_lds((const unsigned*)((const char*)(gbase) + (voff)[_i]), (PG8_LAS unsigned*)(lds + (bufoff) + ldsw + _i * 8192), 16, 0, 0); } while (0)
#define PG8_LDA(dst, b, h) do { _Pragma("unroll") for (int m = 0; m < 4; ++m) _Pragma("unroll") for (int k = 0; k < 2; ++k) dst[m][k] = *(const PG8_LAS bf16x8*)(lds + PG8_SA(b, h) + aoff + m * 2048 + k * 1024); } while (0)
#define PG8_LDB(dst, b, h) do { _Pragma("unroll") for (int n = 0; n < 2; ++n) _Pragma("unroll") for (int k = 0; k < 2; ++k) dst[n][k] = *(const PG8_LAS bf16x8*)(lds + PG8_SB(b, h) + boff + n * 2048 + k * 1024); } while (0)
#define PG8_MMA(ai, bj, At, Bt) do { __builtin_amdgcn_s_setprio(1); _Pragma("unroll") for (int m = 0; m < 4; ++m) _Pragma("unroll") for (int n = 0; n < 2; ++n) _Pragma("unroll") for (int k = 0; k < 2; ++k) \
        acc[ai][bj][m][n] = __builtin_amdgcn_mfma_f32_16x16x32_bf16(Bt[n][k], At[m][k], acc[ai][bj][m][n], 0, 0, 0); __builtin_amdgcn_s_setprio(0); } while (0)
#define PG8_WAIT_V(n) asm volatile("s_waitcnt vmcnt(" #n ")" ::: "memory")
#define PG8_WAIT_LOOP() do { if (PG8_PF) asm volatile("s_waitcnt vmcnt(9)" ::: "memory"); else asm volatile("s_waitcnt vmcnt(8)" ::: "memory"); } while (0)
#define PG8_PREFETCH(tp) do { if (PG8_PF) { const int tp_ = (tp); const char* pb_ = (wid < 4) ? (tp_ < nt ? cA + (size_t)tp_ * kstepA : nA + (size_t)(tp_ - nt) * kstepA) : (tp_ < nt ? cB + (size_t)tp_ * kstepB : nB + (size_t)(tp_ - nt) * kstepB); \
        const unsigned ln_ = __builtin_amdgcn_mbcnt_hi(~0u, __builtin_amdgcn_mbcnt_lo(~0u, 0u)) + (unsigned)(wid & 3) * 64u; const unsigned pfl_ = ln_ * ((wid < 4) ? (ABLK ? 128u : (unsigned)K * 2u) : (BBLK ? 128u : (unsigned)K * 2u)); \
        __builtin_amdgcn_global_load_lds((const unsigned*)(pb_ + pfl_), pfjunk, 4, 0, 0); } } while (0)
#define PG8_WAIT_L(n) asm volatile("s_waitcnt lgkmcnt(" #n ")" ::: "memory")
#define PG8_BAR __builtin_amdgcn_s_barrier()
#define PG8_SCHED __builtin_amdgcn_sched_barrier(0)
    Unit cur, nxt; int ui = 0;
    if (!S.next(0, cur)) return;
    f32x4 acc[2][2][4][2];
#pragma unroll
    for (int a = 0; a < 2; ++a)
#pragma unroll
        for (int b = 0; b < 2; ++b)
#pragma unroll
            for (int m = 0; m < 4; ++m)
#pragma unroll
                for (int n = 0; n < 2; ++n) acc[a][b][m][n] = (f32x4){0.f, 0.f, 0.f, 0.f};
    bf16x8 At[4][2], B0[2][2], B1[2][2];
    const char* cA = (const char*)g.A + (size_t)cur.pm * tstep; const char* cB = (const char*)g.Bt + (size_t)cur.pn * tstep;
    S.a_ready(cur);
    if constexpr (SP2) {
        PG8_STAGE(PG8_SB(0, 0), cB, voffB); PG8_STAGE(PG8_SB(0, 1), cB + hstepB, voffB); PG8_STAGE(PG8_SA(0, 0), cA, voffA); PG8_STAGE(PG8_SA(0, 1), cA + hstepA, voffA);
        if (wr == 1) PG8_BAR;
        PG8_WAIT_V(2); PG8_BAR;
        PG8_STAGE(PG8_SB(1, 0), cB + kstepB, voffB); PG8_STAGE(PG8_SA(1, 0), cA + kstepA, voffA); PG8_STAGE(PG8_SB(1, 1), cB + hstepB + kstepB, voffB);
        PG8_WAIT_V(6); PG8_BAR;
    } else {
        PG8_STAGE(PG8_SB(0, 0), cB, voffB); PG8_STAGE(PG8_SA(0, 0), cA, voffA); PG8_STAGE(PG8_SB(0, 1), cB + hstepB, voffB); PG8_STAGE(PG8_SA(0, 1), cA + hstepA, voffA);
        if (wr == 1) PG8_BAR;
        PG8_WAIT_V(4); PG8_BAR;
        PG8_STAGE(PG8_SB(1, 0), cB + kstepB, voffB); PG8_STAGE(PG8_SA(1, 0), cA + kstepA, voffA); PG8_STAGE(PG8_SB(1, 1), cB + hstepB + kstepB, voffB);
        PG8_WAIT_V(6); PG8_BAR;
    }
    for (;;) {
        const bool has_next = S.next(ui + 1, nxt);
        const char* nA = has_next ? (const char*)g.A + (size_t)nxt.pm * tstep : cA; const char* nB = has_next ? (const char*)g.Bt + (size_t)nxt.pn * tstep : cB;
        for (int t = 0; t < nt; t += 2) {
            const bool last = (t == nt - 2);
            const char* a1 = cA + (size_t)(t + 1) * kstepA;
            const char* a2 = last ? nA : cA + (size_t)(t + 2) * kstepA; const char* b2 = last ? nB : cB + (size_t)(t + 2) * kstepB;
            const char* a3 = a2 + kstepA; const char* b3 = b2 + kstepB;
            if (last && has_next) S.a_ready(nxt);
            if constexpr (SP2) {
            PG8_LDB(B0, 0, 0); PG8_LDB(B1, 0, 1); PG8_SCHED; PG8_LDA(At, 0, 0); PG8_STAGE(PG8_SA(1, 1), a1 + hstepA, voffA); PG8_PREFETCH(t + PG8_PF);
            PG8_WAIT_LOOP(); PG8_WAIT_L(0); PG8_BAR; PG8_MMA(0, 0, At, B0); PG8_MMA(0, 1, At, B1); PG8_BAR; PG8_SCHED;
            PG8_LDA(At, 0, 1); PG8_STAGE(PG8_SB(0, 0), b2, voffB); PG8_STAGE(PG8_SB(0, 1), b2 + hstepB, voffB); PG8_STAGE(PG8_SA(0, 0), a2, voffA);
            PG8_WAIT_LOOP(); PG8_WAIT_L(0); PG8_BAR; PG8_MMA(1, 0, At, B0); PG8_MMA(1, 1, At, B1); PG8_BAR; PG8_SCHED;
            PG8_LDB(B0, 1, 0); PG8_LDB(B1, 1, 1); PG8_SCHED; PG8_LDA(At, 1, 0); PG8_STAGE(PG8_SA(0, 1), a2 + hstepA, voffA); PG8_PREFETCH(t + 1 + PG8_PF);
            PG8_WAIT_LOOP(); PG8_WAIT_L(0); PG8_BAR; PG8_MMA(0, 0, At, B0); PG8_MMA(0, 1, At, B1); PG8_BAR; PG8_SCHED;
            PG8_LDA(At, 1, 1); PG8_STAGE(PG8_SB(1, 0), b3, voffB); PG8_STAGE(PG8_SB(1, 1), b3 + hstepB, voffB); PG8_STAGE(PG8_SA(1, 0), a3, voffA);
            PG8_WAIT_LOOP(); PG8_WAIT_L(0); PG8_BAR; PG8_MMA(1, 0, At, B0); PG8_MMA(1, 1, At, B1); PG8_BAR; PG8_SCHED;
            } else {
            PG8_LDB(B0, 0, 0); PG8_SCHED; PG8_LDA(At, 0, 0); PG8_STAGE(PG8_SA(1, 1), a1 + hstepA, voffA);
            PG8_WAIT_L(8); PG8_BAR; PG8_WAIT_L(0); PG8_MMA(0, 0, At, B0); PG8_BAR; PG8_SCHED;
            PG8_LDB(B1, 0, 1); PG8_STAGE(PG8_SB(0, 0), b2, voffB);
            PG8_BAR; PG8_WAIT_L(0); PG8_MMA(0, 1, At, B1); PG8_BAR;
            PG8_LDA(At, 0, 1); PG8_STAGE(PG8_SA(0, 0), a2, voffA);
            PG8_BAR; PG8_WAIT_L(0); PG8_MMA(1, 0, At, B0); PG8_BAR; PG8_SCHED;
            PG8_STAGE(PG8_SB(0, 1), b2 + hstepB, voffB);
            PG8_WAIT_V(6); PG8_BAR; PG8_MMA(1, 1, At, B1); PG8_BAR;
            PG8_LDB(B0, 1, 0); PG8_SCHED; PG8_LDA(At, 1, 0); PG8_STAGE(PG8_SA(0, 1), a2 + hstepA, voffA);
            PG8_WAIT_L(8); PG8_BAR; PG8_WAIT_L(0); PG8_MMA(0, 0, At, B0); PG8_BAR; PG8_SCHED;
            PG8_LDB(B1, 1, 1); PG8_STAGE(PG8_SB(1, 0), b3, voffB);
            PG8_BAR; PG8_WAIT_L(0); PG8_MMA(0, 1, At, B1); PG8_BAR;
            PG8_LDA(At, 1, 1); PG8_STAGE(PG8_SA(1, 0), a3, voffA);
            PG8_BAR; PG8_WAIT_L(0); PG8_MMA(1, 0, At, B0); PG8_BAR; PG8_SCHED;
            PG8_STAGE(PG8_SB(1, 1), b3 + hstepB, voffB);
            PG8_WAIT_V(6); PG8_BAR; PG8_MMA(1, 1, At, B1); PG8_BAR;
            }
        }
        if constexpr (ALIGN_EPI) { if (wr == 0) PG8_BAR; }
        if constexpr (!Epi::AFTER_DRAIN) { int fr_e = fr, fq_e = fq; asm volatile("" : "+v"(fr_e), "+v"(fq_e));
            E(acc, cur, wr, wc, fr_e, fq_e); S.done(cur); }
        if (!has_next) break;
#pragma unroll
        for (int a = 0; a < 2; ++a)
#pragma unroll
            for (int b = 0; b < 2; ++b)
#pragma unroll
                for (int m = 0; m < 4; ++m)
#pragma unroll
                    for (int n = 0; n < 2; ++n) acc[a][b][m][n] = (f32x4){0.f, 0.f, 0.f, 0.f};
        cur = nxt; cA = nA; cB = nB; ++ui;
        if constexpr (ALIGN_EPI) { if (wr == 1) PG8_BAR; }
    }
    PG8_WAIT_V(0);
    if constexpr (!ALIGN_EPI) { if (wr == 0) PG8_BAR; }
    PG8_BAR;
    if constexpr (Epi::AFTER_DRAIN) { E.fused(acc, cur, wr, wc, fr, fq, lds, wid, lane); S.done(cur); }
#undef PG8_SA
#undef PG8_SB
#undef PG8_STAGE
#undef PG8_LDA
#undef PG8_LDB
#undef PG8_MMA
#undef PG8_WAIT_V
#undef PG8_WAIT_L
#undef PG8_WAIT_LOOP
#undef PG8_PREFETCH
#undef PG8_BAR
#undef PG8_SCHED
}
}
namespace att {
constexpr int D = 128; constexpr float THR = 8.f; constexpr bool WSKIP = false;
constexpr float SCALE = 0.08838834764831845f;
constexpr int NW = 8, QBLK = 32, KVBLK = 64, QB = NW * QBLK;
constexpr int SHM_V = KVBLK * D * 2, SHM_K = KVBLK * D * 2;
constexpr int LDS_BYTES = 2 * SHM_V + 2 * SHM_K + NW * 64 * 4;

using bf16 = __hip_bfloat16;
typedef short bf16x8 __attribute__((ext_vector_type(8)));
typedef short s16x4 __attribute__((ext_vector_type(4)));
typedef float f32x16 __attribute__((ext_vector_type(16)));
typedef float f32x4 __attribute__((ext_vector_type(4)));
typedef unsigned u32x4 __attribute__((ext_vector_type(4)));
template <class A, class Bt> struct same_t { static constexpr bool v = false; };
template <class A> struct same_t<A, A> { static constexpr bool v = true; };

#define KSWZ(row, colB) ((row) * 256 + ((colB) ^ (((row) & 7) << 4)))
#define SBAR() __builtin_amdgcn_sched_barrier(0)
__device__ __forceinline__ int v_st(int k, int c) { const int kk = (k & ~0xC) | ((k & 4) << 1) | ((k & 8) >> 1); return ((kk >> 3) * 4 + (c >> 5)) * 512 + ((kk & 7) * 32 + (c & 31)) * 2; }
__device__ __forceinline__ int v_rd_base(int lane) { return ((lane & 3) << 3) | (((lane >> 2) & 3) << 6) | (((lane >> 4) & 1) << 5) | (((lane >> 5) & 1) << 8); }
constexpr int v_rd_off(int d0, int ks, int half) { return d0 * 512 + ks * 4096 + half * 2048; }
__device__ __forceinline__ int crow(int r, int hi) { return (r & 3) + 8 * (r >> 2) + 4 * hi; }
__device__ __forceinline__ unsigned cvtpk(float lo, float hi) {
    unsigned r; asm volatile("v_cvt_pk_bf16_f32 %0, %1, %2" : "=v"(r) : "v"(lo), "v"(hi)); return r;
}
__device__ __forceinline__ bf16x8 pack8(f32x4 a, f32x4 b) {
    u32x4 w = {cvtpk(a[0], a[1]), cvtpk(a[2], a[3]), cvtpk(b[0], b[1]), cvtpk(b[2], b[3])};
    return *reinterpret_cast<bf16x8*>(&w);
}
template <class T> __device__ __forceinline__ bf16x8 load8(const T* p) {
    if constexpr (same_t<T, float>::v) { return pack8(*(const f32x4*)p, *(const f32x4*)(p + 4)); }
    else { return *reinterpret_cast<const bf16x8*>(p); }
}
__device__ __forceinline__ void mask_tile(f32x16& p0, f32x16& p1, int dq, unsigned W) {
    const float NEG = -__builtin_inff();
#pragma unroll
    for (int r = 0; r < 16; ++r) {
        const int c = (r & 3) + 8 * (r >> 2);
        if ((unsigned)(dq - c) >= W) p0[r] = NEG;
        if ((unsigned)(dq - c - 32) >= W) p1[r] = NEG;
    }
}
__device__ __forceinline__ void partialSM(f32x16& p0, f32x16& p1, float& m_reg, float& mn, float& alpha) {
    float pmax = p0[0]; for (int r = 1; r < 16; ++r) pmax = fmaxf(pmax, p0[r]); for (int r = 0; r < 16; ++r) pmax = fmaxf(pmax, p1[r]);
    { auto rr = __builtin_amdgcn_permlane32_swap(__float_as_uint(pmax), __float_as_uint(pmax), false, false);
      pmax = fmaxf(__uint_as_float(rr[0]), __uint_as_float(rr[1])); }
    constexpr float C2 = 1.4426950408889634f * SCALE;
    if (__builtin_expect(__all((pmax - m_reg) * SCALE <= THR), 1)) { mn = m_reg; alpha = 1.f; }
    else { mn = fmaxf(m_reg, pmax); alpha = __builtin_amdgcn_exp2f((m_reg - mn) * C2); m_reg = mn; }
    const float mnL = -mn * C2;
    for (int r = 0; r < 16; ++r) p0[r] = fmaf(p0[r], C2, mnL); for (int r = 0; r < 16; ++r) p1[r] = fmaf(p1[r], C2, mnL);
    for (int r = 0; r < 16; ++r) p0[r] = __builtin_amdgcn_exp2f(p0[r]);
}
__device__ __forceinline__ void finishSM(f32x16& p0, f32x16& p1, float alpha, float& l_reg, bf16x8& pa0, bf16x8& pa1, bf16x8& pa2, bf16x8& pa3) {
    for (int r = 0; r < 16; ++r) p1[r] = __builtin_amdgcn_exp2f(p1[r]);
    float ps = 0; for (int r = 0; r < 16; ++r) ps += p0[r]; for (int r = 0; r < 16; ++r) ps += p1[r];
    { auto rr = __builtin_amdgcn_permlane32_swap(__float_as_uint(ps), __float_as_uint(ps), false, false);
      ps = __uint_as_float(rr[0]) + __uint_as_float(rr[1]); }
    l_reg = l_reg * alpha + ps;
#define PK4(P, B_, OUT) do { unsigned a0 = cvtpk(P[B_+0], P[B_+1]), a1 = cvtpk(P[B_+2], P[B_+3]);                          \
        unsigned b0 = cvtpk(P[B_+4], P[B_+5]), b1 = cvtpk(P[B_+6], P[B_+7]);                                             \
        auto r0 = __builtin_amdgcn_permlane32_swap(a0, b0, false, false); auto r1 = __builtin_amdgcn_permlane32_swap(a1, b1, false, false); \
        u32x4 w = {r0[0], r1[0], r0[1], r1[1]}; OUT = *reinterpret_cast<bf16x8*>(&w); } while (0)
    PK4(p0, 0, pa0); PK4(p0, 8, pa1); PK4(p1, 0, pa2); PK4(p1, 8, pa3);
#undef PK4
}
template <int KB, bool SK>
__device__ __forceinline__ void qkt(f32x16& p0, f32x16& p1, const char* K_lds, int r32, int hi, const bf16x8* qr, bool act) {
    if (SK && !act) { const float NEG = -__builtin_inff();
#pragma unroll
        for (int r = 0; r < 16; ++r) { p0[r] = NEG; p1[r] = NEG; } return; }
    p0 = f32x16{}; p1 = f32x16{};
    const char* kb[4];
#pragma unroll
    for (int dd = 0; dd < 4; ++dd) kb[dd] = K_lds + KB * SHM_K + KSWZ(r32, (dd * 16 + hi * 8) * 2);
#pragma unroll
    for (int d0 = 0; d0 < 8; ++d0) { const char* a = kb[d0 & 3] + (d0 >> 2) * 128;
        bf16x8 b0 = *reinterpret_cast<const bf16x8*>(a);
        bf16x8 b1 = *reinterpret_cast<const bf16x8*>(a + 32 * 256);
        p0 = __builtin_amdgcn_mfma_f32_32x32x16_bf16(b0, qr[d0], p0, 0, 0, 0);
        p1 = __builtin_amdgcn_mfma_f32_32x32x16_bf16(b1, qr[d0], p1, 0, 0, 0); }
}
__device__ __forceinline__ void kfrag_load(bf16x8* kf, const char* K_tile, int r32, int hi) {
    const char* kb[4];
#pragma unroll
    for (int dd = 0; dd < 4; ++dd) kb[dd] = K_tile + KSWZ(r32, (dd * 16 + hi * 8) * 2);
#pragma unroll
    for (int d0 = 0; d0 < 8; ++d0) { const char* a = kb[d0 & 3] + (d0 >> 2) * 128;
        kf[2 * d0] = *reinterpret_cast<const bf16x8*>(a); kf[2 * d0 + 1] = *reinterpret_cast<const bf16x8*>(a + 32 * 256); }
}
__device__ __forceinline__ void qk_mma(f32x16& p0, f32x16& p1, const bf16x8* kf, const bf16x8* qr) {
    p0 = f32x16{}; p1 = f32x16{};
#pragma unroll
    for (int d0 = 0; d0 < 8; ++d0) { p0 = __builtin_amdgcn_mfma_f32_32x32x16_bf16(kf[2 * d0], qr[d0], p0, 0, 0, 0); p1 = __builtin_amdgcn_mfma_f32_32x32x16_bf16(kf[2 * d0 + 1], qr[d0], p1, 0, 0, 0); }
}
template <int VB, bool SK>
__device__ __forceinline__ void pv_tile(f32x16* o, int vb0, bf16x8 pa0, bf16x8 pa1, bf16x8 pa2, bf16x8 pa3, bool act) {
    if (SK && !act) return;
#define TRRD(dst, off) asm volatile("ds_read_b64_tr_b16 %0, %1 offset:%2" : "=&v"(dst) : "v"(vb0), "i"(off) : "memory")
#define PV_D0(d0) do { s16x4 l0, l1, l2, l3, h0, h1, h2, h3; constexpr int b_ = VB * SHM_V + v_rd_off(d0, 0, 0);     \
        TRRD(l0, b_); TRRD(h0, b_ + 2048); TRRD(l1, b_ + 4096); TRRD(h1, b_ + 6144); TRRD(l2, b_ + 8192); TRRD(h2, b_ + 10240); TRRD(l3, b_ + 12288); TRRD(h3, b_ + 14336); \
        asm volatile("s_waitcnt lgkmcnt(0)" ::: "memory"); SBAR();                 \
        o[d0] = __builtin_amdgcn_mfma_f32_32x32x16_bf16(pa0, (bf16x8){l0[0], l0[1], l0[2], l0[3], h0[0], h0[1], h0[2], h0[3]}, o[d0], 0, 0, 0);   \
        o[d0] = __builtin_amdgcn_mfma_f32_32x32x16_bf16(pa1, (bf16x8){l1[0], l1[1], l1[2], l1[3], h1[0], h1[1], h1[2], h1[3]}, o[d0], 0, 0, 0);   \
        o[d0] = __builtin_amdgcn_mfma_f32_32x32x16_bf16(pa2, (bf16x8){l2[0], l2[1], l2[2], l2[3], h2[0], h2[1], h2[2], h2[3]}, o[d0], 0, 0, 0);   \
        o[d0] = __builtin_amdgcn_mfma_f32_32x32x16_bf16(pa3, (bf16x8){l3[0], l3[1], l3[2], l3[3], h3[0], h3[1], h3[2], h3[3]}, o[d0], 0, 0, 0); } while (0)
    PV_D0(0); PV_D0(1); PV_D0(2); PV_D0(3);
#undef PV_D0
#undef TRRD
}

template <class TIn, class TOut> struct BlockRef { const TIn* Q; const TIn* K; const TIn* V; TOut* O; int P0; int ldo; };
template <class TIn> struct Seam {
    bf16x8 qr[8];
    bf16x8 st_v0, st_v1, st_k0, st_k1; f32x4 sf0, sf1, sf2, sf3;
    f32x4 tq[16];
};
__device__ __forceinline__ int swa_jlo(int P0, int W) { const int lowk = P0 - W + 1; return lowk > 0 ? lowk / KVBLK : 0; }
#define ROW(p, k0, rr) ((p) + (size_t)((k0) + (rr)) * D + sc)
#define VMW() asm volatile("s_waitcnt vmcnt(0)" ::: "memory")
#define VMWN(n) asm volatile("s_waitcnt vmcnt(%0)" :: "i"(n) : "memory")
#define SLOAD_H(Kp, Vp, k0) do { S.st_v0 = load8<TIn>(ROW(Vp, k0, sr)); S.st_v1 = load8<TIn>(ROW(Vp, k0, 32 + sr));              \
                         S.st_k0 = load8<TIn>(ROW(Kp, k0, sr)); S.st_k1 = load8<TIn>(ROW(Kp, k0, 32 + sr)); } while (0)
#define SWRITE_HK(bf) do { *(bf16x8*)(K_lds + (bf) * SHM_K + kws) = S.st_k0; *(bf16x8*)(K_lds + (bf) * SHM_K + kws + 32 * 256) = S.st_k1; } while (0)
#define SWRITE_HV(bf) do { *(bf16x8*)(V_lds + (bf) * SHM_V + vst0) = S.st_v0; *(bf16x8*)(V_lds + (bf) * SHM_V + vst1) = S.st_v1; } while (0)
#define SWRITE_H(bf) do { SWRITE_HV(bf); SWRITE_HK(bf); } while (0)
#define SLOAD_F(p, k0) do { S.sf0 = *(const f32x4*)ROW(p, k0, sr); S.sf1 = *(const f32x4*)(ROW(p, k0, sr) + 4);                \
                            S.sf2 = *(const f32x4*)ROW(p, k0, 32 + sr); S.sf3 = *(const f32x4*)(ROW(p, k0, 32 + sr) + 4); } while (0)
#define SWRITE_KF(bf) do { *(bf16x8*)(K_lds + (bf) * SHM_K + kws) = pack8(S.sf0, S.sf1); *(bf16x8*)(K_lds + (bf) * SHM_K + kws + 32 * 256) = pack8(S.sf2, S.sf3); } while (0)
#define SWRITE_VF(bf) do { *(bf16x8*)(V_lds + (bf) * SHM_V + vst0) = pack8(S.sf0, S.sf1); *(bf16x8*)(V_lds + (bf) * SHM_V + vst1) = pack8(S.sf2, S.sf3); } while (0)
template <class TIn, class TOut>
__device__ __forceinline__ void causal_swa_prime(const BlockRef<TIn, TOut>& cur, int W, char* lds, Seam<TIn>& S) {
    constexpr bool F32 = same_t<TIn, float>::v;
    int tid_ = threadIdx.x; asm volatile("" : "+v"(tid_));
    const int tid = tid_, wid = __builtin_amdgcn_readfirstlane(tid >> 6), lane = tid & 63, r32 = lane & 31, hi = lane >> 5;
    const int sr = tid >> 4, sc = (tid & 15) * 8, kws = KSWZ(sr, sc * 2); char* K_lds = lds + 2 * SHM_V;
    const int kb0 = swa_jlo(cur.P0, W) * KVBLK;
    for (int d0 = 0; d0 < 8; ++d0) S.qr[d0] = load8<TIn>(cur.Q + (size_t)(wid * QBLK + r32) * D + d0 * 16 + hi * 8);
    if constexpr (F32) { SLOAD_F((const float*)cur.K, kb0); VMW(); SWRITE_KF(0); SBAR(); SLOAD_F((const float*)cur.V, kb0); }
    else { SLOAD_H(cur.K, cur.V, kb0); VMW(); SWRITE_HK(0); }
    __syncthreads();
}
template <class TIn, class TOut>
__device__ __forceinline__ void causal_swa_block(const BlockRef<TIn, TOut>& cur, const BlockRef<TIn, TOut>& nxt, int skv, int W, char* lds, Seam<TIn>& S) {
    constexpr bool F32 = same_t<TIn, float>::v;
    int tid_ = threadIdx.x; asm volatile("" : "+v"(tid_));
    const int tid = tid_, wid = __builtin_amdgcn_readfirstlane(tid >> 6), lane = tid & 63, r32 = lane & 31, hi = lane >> 5;
    const int j_lo = swa_jlo(cur.P0, W);
    int j_hi = (cur.P0 + QB - 1) / KVBLK + 1; if (j_hi > skv / KVBLK) j_hi = skv / KVBLK;
    const int NT = j_hi - j_lo;
    const int kbn = swa_jlo(nxt.P0, W) * KVBLK;
    const int qlo = cur.P0 + wid * QBLK, qm = qlo + r32 - 4 * hi;
    char* V_lds = lds; char* K_lds = lds + 2 * SHM_V;
    float* ws = (float*)(lds + 2 * SHM_V + 2 * SHM_K) + wid * 64; float* li_l = ws, * al_l = ws + 32;
    float m_reg = -1e30f, l_reg = 0; f32x16 o[4] = {};
    const int sr = tid >> 4, sc = (tid & 15) * 8, vst0 = v_st(sr, sc), vst1 = v_st(32 + sr, sc), kws = KSWZ(sr, sc * 2);
    const int vb0 = (int)(uintptr_t)V_lds + v_rd_base(lane);
    const TIn* Kh = cur.K; const TIn* Vh = cur.V;
#define RESC(a) do { if (__any((a) < 1.f)) { if (hi == 0) al_l[r32] = (a); asm volatile("s_waitcnt lgkmcnt(0)" ::: "memory");              \
                     for (int d_ = 0; d_ < 4; ++d_) for (int r = 0; r < 16; ++r) o[d_][r] *= al_l[crow(r, hi)]; } } while (0)
#define KBASE(t) ((j_lo + (t)) * KVBLK)
#define ACT(t) (KBASE(t) <= qlo + QBLK - 1 && KBASE(t) + KVBLK - 1 >= qlo - W + 1)
#define MASKT(P0_, P1_, t) do { const int kb_ = KBASE(t); if ((!SK || ACT(t)) && (kb_ + KVBLK - 1 > qlo || kb_ <= qlo + QBLK - 1 - W)) mask_tile(P0_, P1_, qm - kb_, (unsigned)W); } while (0)
    constexpr int NQL = F32 ? 16 : 8;
    constexpr bool SK = WSKIP && !F32;
#define SEAM_K0() do { VMWN(NQL); if constexpr (F32) { SWRITE_KF(0); SBAR(); SLOAD_F((const float*)nxt.V, kbn); } else { SWRITE_HK(0); } SBAR(); } while (0)
    f32x16 pA0, pA1, pB0, pB1; float mnA, mnB, alA, alB; bf16x8 pa0, pa1, pa2, pa3;
    if constexpr (F32) { VMW(); SWRITE_VF(0); SBAR(); } else { SWRITE_HV(0); SBAR(); }
    if (NT > 1) { if constexpr (F32) SLOAD_F((const float*)Kh, KBASE(1)); else SLOAD_H(Kh, Vh, KBASE(1)); }
    SBAR(); qkt<0, SK>(pA0, pA1, K_lds, r32, hi, S.qr, ACT(0));
    if constexpr (F32) { if (NT > 1) { VMW(); SWRITE_KF(1); SBAR(); SLOAD_F((const float*)Vh, KBASE(1)); } }
    MASKT(pA0, pA1, 0); partialSM(pA0, pA1, m_reg, mnA, alA);
    if (NT > 1) { VMW(); if constexpr (F32) { SWRITE_VF(1); SBAR(); if (NT > 2) SLOAD_F((const float*)Kh, KBASE(2)); } else SWRITE_H(1); }
    __syncthreads();
#define HALF_STEP(PX0, PX1, mnX, alX, PY0, PY1, alY, t, KB, VB, SB) do {                                                      \
        SBAR(); qkt<KB, SK>(PX0, PX1, K_lds, r32, hi, S.qr, ACT(t));                                             \
        finishSM(PY0, PY1, alY, l_reg, pa0, pa1, pa2, pa3); SBAR();                                                           \
        if ((t) + 1 < NT) { if constexpr (F32) { VMW(); SWRITE_KF(SB); SBAR(); SLOAD_F((const float*)Vh, KBASE((t) + 1)); }  \
                            else { SLOAD_H(Kh, Vh, KBASE((t) + 1)); } SBAR(); }                                               \
        pv_tile<VB, SK>(o, vb0, pa0, pa1, pa2, pa3, ACT((t) - 1)); MASKT(PX0, PX1, (t)); partialSM(PX0, PX1, m_reg, mnX, alX);                                        \
        __syncthreads();                                                                                                      \
        if ((t) + 1 < NT) { VMW(); if constexpr (F32) { SWRITE_VF(SB); SBAR(); if ((t) + 2 < NT) SLOAD_F((const float*)Kh, KBASE((t) + 2)); } \
                            else { SWRITE_H(SB); } }                                                                          \
        RESC(alX); __syncthreads(); } while (0)
    for (int t = 1; t + 1 < NT; t += 2) {
        HALF_STEP(pB0, pB1, mnB, alB, pA0, pA1, alA, t, 1, 0, 0);
        HALF_STEP(pA0, pA1, mnA, alA, pB0, pB1, alB, t + 1, 0, 1, 1);
    }
    const bool even = (NT & 1) == 0;
    if (even) { SBAR(); qkt<1, SK>(pB0, pB1, K_lds, r32, hi, S.qr, ACT(NT - 1)); SBAR(); }
#define QROW(e) (nxt.Q + (size_t)(wid * QBLK + r32) * D + ((e) >> 1) * 16 + hi * 8 + ((e) & 1) * 4)
    if constexpr (F32) { SLOAD_F((const float*)nxt.K, kbn); SBAR();
#pragma unroll
        for (int e = 0; e < 8; ++e) S.tq[e] = *(const f32x4*)QROW(e); }
    else { SLOAD_H(nxt.K, nxt.V, kbn); SBAR();
#pragma unroll
        for (int d0 = 0; d0 < 8; ++d0) S.qr[d0] = load8<TIn>(nxt.Q + (size_t)(wid * QBLK + r32) * D + d0 * 16 + hi * 8); }
    SBAR();
    finishSM(pA0, pA1, alA, l_reg, pa0, pa1, pa2, pa3); SBAR();
    if constexpr (F32) {
#pragma unroll
        for (int e = 8; e < 16; ++e) S.tq[e] = *(const f32x4*)QROW(e); SBAR(); }
#undef QROW
    pv_tile<0, SK>(o, vb0, pa0, pa1, pa2, pa3, ACT(even ? NT - 2 : NT - 1));
    if (even) { MASKT(pB0, pB1, NT - 1); partialSM(pB0, pB1, m_reg, mnB, alB); __syncthreads(); RESC(alB);
        finishSM(pB0, pB1, alB, l_reg, pa0, pa1, pa2, pa3); SBAR(); pv_tile<1, SK>(o, vb0, pa0, pa1, pa2, pa3, ACT(NT - 1)); }
    SBAR(); SEAM_K0();
    if (hi == 0) li_l[r32] = l_reg; asm volatile("s_waitcnt lgkmcnt(0)" ::: "memory");
    float rli[16];
#pragma unroll
    for (int r = 0; r < 16; ++r) rli[r] = __builtin_amdgcn_rcpf(li_l[crow(r, hi)]);
    const int LDO = cur.ldo; TOut* Ow = cur.O + (size_t)(wid * QBLK) * LDO;
#pragma unroll
    for (int r = 0; r < 16; ++r) { const int orow = crow(r, hi);
#pragma unroll
        for (int d0 = 0; d0 < 4; ++d0) { const float v = o[d0][r] * rli[r];
            if constexpr (same_t<TOut, float>::v) { Ow[(size_t)orow * LDO + d0 * 32 + r32] = v; }
            else { const float vn = __shfl_xor(v, 1);
                   if ((r32 & 1) == 0) *(unsigned*)(Ow + (size_t)orow * LDO + d0 * 32 + r32) = cvtpk(v, vn); } } }
    if constexpr (F32) {
#pragma unroll
        for (int d0 = 0; d0 < 8; ++d0) S.qr[d0] = pack8(S.tq[2 * d0], S.tq[2 * d0 + 1]); }
    __syncthreads();
#undef RESC
#undef KBASE
#undef ACT
#undef MASKT
#undef SEAM_K0
#undef HALF_STEP
}
#undef ROW
#undef VMW
#undef VMWN
#undef SLOAD_H
#undef SWRITE_HK
#undef SWRITE_HV
#undef SWRITE_H
#undef SLOAD_F
#undef SWRITE_KF
#undef SWRITE_VF


constexpr int QB2 = 128, L2_K = 0, L2_V0 = 32768, L2_V1 = 65536, L2_P = 98304;
struct Ref2 { const bf16* Q; const bf16* K; const bf16* V0; const bf16* V1; float* O0; float* O1; int P0; };
struct Seam2 { bf16x8 qr[8]; bf16x8 sk0, sk1, sa0, sa1, sb0, sb1; f32x16 pA0, pA1; };
#define LD8(p) (*reinterpret_cast<const bf16x8*>(p))
#define VMW2() asm volatile("s_waitcnt vmcnt(0)" ::: "memory")
__device__ __forceinline__ void pv3_tile(f32x16* o, int vb, bf16x8 pa0, bf16x8 pa1, bf16x8 pa2, bf16x8 pa3, bf16x8 pb0, bf16x8 pb1, bf16x8 pb2, bf16x8 pb3, float fA, float fB, const float* alA, int hi) {
#define TRRD(dst, off) asm volatile("ds_read_b64_tr_b16 %0, %1 offset:%2" : "=&v"(dst) : "v"(vb), "i"(off) : "memory")
#define RD8(X, g) do { constexpr int b_ = v_rd_off((g), 0, 0); TRRD(X##0, b_); TRRD(X##1, b_ + 2048); TRRD(X##2, b_ + 4096); TRRD(X##3, b_ + 6144); \
        TRRD(X##4, b_ + 8192); TRRD(X##5, b_ + 10240); TRRD(X##6, b_ + 12288); TRRD(X##7, b_ + 14336); } while (0)
#define VF(X, a, b) (bf16x8){X##a[0], X##a[1], X##a[2], X##a[3], X##b[0], X##b[1], X##b[2], X##b[3]}
#define MM8(X, g) do { \
        o[g] = __builtin_amdgcn_mfma_f32_32x32x16_bf16(pa0, VF(X, 0, 1), o[g], 0, 0, 0); o[4 + g] = __builtin_amdgcn_mfma_f32_32x32x16_bf16(pb0, VF(X, 0, 1), o[4 + g], 0, 0, 0); \
        o[g] = __builtin_amdgcn_mfma_f32_32x32x16_bf16(pa1, VF(X, 2, 3), o[g], 0, 0, 0); o[4 + g] = __builtin_amdgcn_mfma_f32_32x32x16_bf16(pb1, VF(X, 2, 3), o[4 + g], 0, 0, 0); \
        o[g] = __builtin_amdgcn_mfma_f32_32x32x16_bf16(pa2, VF(X, 4, 5), o[g], 0, 0, 0); o[4 + g] = __builtin_amdgcn_mfma_f32_32x32x16_bf16(pb2, VF(X, 4, 5), o[4 + g], 0, 0, 0); \
        o[g] = __builtin_amdgcn_mfma_f32_32x32x16_bf16(pa3, VF(X, 6, 7), o[g], 0, 0, 0); o[4 + g] = __builtin_amdgcn_mfma_f32_32x32x16_bf16(pb3, VF(X, 6, 7), o[4 + g], 0, 0, 0); } while (0)
#define LGK8() do { asm volatile("s_waitcnt lgkmcnt(8)" ::: "memory"); SBAR(); } while (0)
    s16x4 A0, A1, A2, A3, A4, A5, A6, A7, B0, B1, B2, B3, B4, B5, B6, B7;
    RD8(A, 0); RD8(B, 1);
    if (__builtin_amdgcn_readfirstlane(__float_as_int(fA)) != 0) {
        const f32x4* a4p = (const f32x4*)alA + hi; const f32x4 a0 = a4p[0], a1 = a4p[2], a2 = a4p[4], a3 = a4p[6];
#pragma unroll
        for (int d_ = 0; d_ < 4; ++d_)
#pragma unroll
            for (int j = 0; j < 4; ++j) { o[d_][j] *= a0[j]; o[d_][4 + j] *= a1[j]; o[d_][8 + j] *= a2[j]; o[d_][12 + j] *= a3[j]; } }
    if (__builtin_amdgcn_readfirstlane(__float_as_int(fB)) != 0) {
        const f32x4* a4p = (const f32x4*)(alA + 32) + hi; const f32x4 a0 = a4p[0], a1 = a4p[2], a2 = a4p[4], a3 = a4p[6];
#pragma unroll
        for (int d_ = 4; d_ < 8; ++d_)
#pragma unroll
            for (int j = 0; j < 4; ++j) { o[d_][j] *= a0[j]; o[d_][4 + j] *= a1[j]; o[d_][8 + j] *= a2[j]; o[d_][12 + j] *= a3[j]; } }
    asm volatile("s_waitcnt lgkmcnt(0)" ::: "memory"); SBAR(); MM8(A, 0); SBAR();
    RD8(A, 2); LGK8(); MM8(B, 1); SBAR();
    RD8(B, 3); LGK8(); MM8(A, 2); SBAR();
    asm volatile("s_waitcnt lgkmcnt(0)" ::: "memory"); SBAR(); MM8(B, 3);
#undef TRRD
#undef RD8
#undef VF
#undef MM8
#undef LGK8
}
template <bool RS>
__device__ __forceinline__ void diff2_prime(const Ref2& cur, char* lds, Seam2& S) {
    int tid_ = threadIdx.x; asm volatile("" : "+v"(tid_));
    const int tid = tid_, wid = __builtin_amdgcn_readfirstlane(tid >> 6), lane = tid & 63, r32 = lane & 31, hi = lane >> 5;
    const int sr = tid >> 4, sc = (tid & 15) * 8, kws = KSWZ(sr, sc * 2);
    if constexpr (RS) {
#pragma unroll
        for (int d0 = 0; d0 < 8; ++d0) S.qr[d0] = LD8(cur.Q + (size_t)(wid * QBLK + r32) * D + d0 * 16 + hi * 8); }
    S.sk0 = LD8(cur.K + (size_t)sr * D + sc); S.sk1 = LD8(cur.K + (size_t)(32 + sr) * D + sc);
    VMW2();
    *(bf16x8*)(lds + L2_K + kws) = S.sk0; *(bf16x8*)(lds + L2_K + kws + 32 * 256) = S.sk1;
    S.sk0 = LD8(cur.K + (size_t)(KVBLK + sr) * D + sc); S.sk1 = LD8(cur.K + (size_t)(KVBLK + 32 + sr) * D + sc);
    S.sa0 = LD8(cur.V0 + (size_t)sr * D + sc); S.sa1 = LD8(cur.V0 + (size_t)(32 + sr) * D + sc);
    S.sb0 = LD8(cur.V1 + (size_t)sr * D + sc); S.sb1 = LD8(cur.V1 + (size_t)(32 + sr) * D + sc);
    VMW2();
    *(bf16x8*)(lds + L2_K + SHM_K + kws) = S.sk0; *(bf16x8*)(lds + L2_K + SHM_K + kws + 32 * 256) = S.sk1;
    __syncthreads();
    if constexpr (RS) qkt<0, false>(S.pA0, S.pA1, lds + L2_K, r32, hi, S.qr, true);
}
template <bool RS>
__device__ __forceinline__ void diff2_block(const Ref2& cur, const Ref2& nxt, char* lds, float* xl, Seam2& S) {
    int tid_ = threadIdx.x; asm volatile("" : "+v"(tid_));
    const int tid = tid_, wid = __builtin_amdgcn_readfirstlane(tid >> 6), lane = tid & 63, r32 = lane & 31, hi = lane >> 5;
    const int w4 = wid & 3;
    const int NT = (cur.P0 + QB2 - 1) / KVBLK + 1;
    const int qlo = cur.P0 + w4 * QBLK, qm = qlo + r32 - 4 * hi;
    char* K_lds = lds + L2_K; char* V0_lds = lds + L2_V0; char* V1_lds = lds + L2_V1; char* P_lds = lds + L2_P + w4 * 4096;
    float* alp = xl + w4 * 32; float* li = xl + 256 + (RS ? w4 : (w4 >> 1) * 2) * 32; float* flg = xl + 384 + w4;
    const int sr = tid >> 4, sc = (tid & 15) * 8, vst0 = v_st(sr, sc), vst1 = v_st(32 + sr, sc), kws = KSWZ(sr, sc * 2);
    const int vbase = (int)(uintptr_t)V0_lds + v_rd_base(lane);
    float m_reg = -1e30f, l_reg = 0.f; f32x16 o[RS ? 1 : 8] = {};
    auto stage_top = [&](const int t, const bool drain) __attribute__((always_inline)) {
        const int par = t & 1;
        if (!drain) { *(bf16x8*)(V0_lds + par * SHM_V + vst0) = S.sa0; *(bf16x8*)(V0_lds + par * SHM_V + vst1) = S.sa1;
                      *(bf16x8*)(V1_lds + par * SHM_V + vst0) = S.sb0; *(bf16x8*)(V1_lds + par * SHM_V + vst1) = S.sb1; }
        const bool kc = !drain && t + 2 < NT, kn = drain || t == NT - 1;
        if (kc || kn) { const bf16* Kp = kc ? cur.K : nxt.K; const int k0 = kc ? (t + 2) * KVBLK : (drain ? KVBLK : 0);
            S.sk0 = LD8(Kp + (size_t)(k0 + sr) * D + sc); S.sk1 = LD8(Kp + (size_t)(k0 + 32 + sr) * D + sc); }
        const bool vc = !drain && t + 1 < NT;
        if (vc || drain) { const bf16* Ap = vc ? cur.V0 : nxt.V0; const bf16* Bp = vc ? cur.V1 : nxt.V1; const int k0 = vc ? (t + 1) * KVBLK : 0;
            S.sa0 = LD8(Ap + (size_t)(k0 + sr) * D + sc); S.sa1 = LD8(Ap + (size_t)(k0 + 32 + sr) * D + sc);
            S.sb0 = LD8(Bp + (size_t)(k0 + sr) * D + sc); S.sb1 = LD8(Bp + (size_t)(k0 + 32 + sr) * D + sc); }
    };
    auto stage_end = [&](const int t, const bool drain, const int nyoung) __attribute__((always_inline)) {
        const bool kc = !drain && t + 2 < NT, kn = drain || t == NT - 1;
        if (kc || kn) { const int wb = kc ? (t & 1) : (drain ? 1 : 0);
            (void)nyoung;
            *(bf16x8*)(K_lds + wb * SHM_K + kws) = S.sk0; *(bf16x8*)(K_lds + wb * SHM_K + kws + 32 * 256) = S.sk1; }
    };
    if constexpr (RS) {
        f32x16 pB0, pB1;
        auto siter = [&](f32x16& pX0, f32x16& pX1, f32x16& pY0, f32x16& pY1, const int t) __attribute__((always_inline)) {
            const int par = t & 1;
            stage_top(t, false);
            if (t == NT - 1) {
#pragma unroll
                for (int d0 = 0; d0 < 8; ++d0) S.qr[d0] = LD8(nxt.Q + (size_t)(w4 * QBLK + r32) * D + d0 * 16 + hi * 8); }
            SBAR();
            bf16x8 kf[16];
            if (t + 1 < NT) kfrag_load(kf, K_lds + ((t + 1) & 1) * SHM_K, r32, hi);
            SBAR();
            float mn, alpha; bf16x8 pa0, pa1, pa2, pa3;
            { const int kb = t * KVBLK; if (kb + KVBLK - 1 > qlo) mask_tile(pX0, pX1, qm - kb, 1u << 30); }
            partialSM(pX0, pX1, m_reg, mn, alpha);
            SBAR();
            if (t + 1 < NT) qk_mma(pY0, pY1, kf, S.qr);
            finishSM(pX0, pX1, alpha, l_reg, pa0, pa1, pa2, pa3);
            { bf16x8* pw = (bf16x8*)(P_lds + par * 16384) + lane; pw[0] = pa0; pw[64] = pa1; pw[128] = pa2; pw[192] = pa3; }
            const bool need = __any(alpha < 1.f);
            if (hi == 0) { alp[par * 128 + r32] = alpha; if (t == NT - 1) li[r32] = l_reg; if (r32 == 0) flg[par * 4] = need ? 1.f : 0.f; }
            SBAR();
            stage_end(t, false, t == NT - 1 ? 12 : 4);
            __syncthreads();
        };
#pragma unroll 1
        for (int t = 0; t < NT; t += 2) { siter(S.pA0, S.pA1, pB0, pB1, t); siter(pB0, pB1, S.pA0, S.pA1, t + 1); }
        stage_top(NT, true);
        SBAR();
        qkt<0, false>(S.pA0, S.pA1, K_lds, r32, hi, S.qr, true);
        SBAR();
        stage_end(NT, true, 4);
        __syncthreads();
    } else {
#pragma unroll 1
        for (int t = 0; t <= NT; ++t) {
            const bool drain = t == NT;
            stage_top(t, drain);
            SBAR();
            if (t >= 1) {
                const int pp = (t - 1) & 1, rg = w4 >> 1, hf = w4 & 1;
                char* PA = lds + L2_P + (2 * rg) * 4096 + pp * 16384; float* alA = xl + (2 * rg) * 32 + pp * 128; float* flA = xl + 384 + 2 * rg + pp * 4;
                bf16x8 pa0, pa1, pa2, pa3, pb0, pb1, pb2, pb3;
                { const bf16x8* pr = (const bf16x8*)PA + lane; pa0 = pr[0]; pa1 = pr[64]; pa2 = pr[128]; pa3 = pr[192]; pb0 = pr[256]; pb1 = pr[320]; pb2 = pr[384]; pb3 = pr[448]; }
                const float fA = flA[0], fB = flA[1];
                pv3_tile(o, vbase + hf * (L2_V1 - L2_V0) + pp * SHM_V, pa0, pa1, pa2, pa3, pb0, pb1, pb2, pb3, fA, fB, alA, hi);
            }
            SBAR();
            stage_end(t, drain, 4);
            if (drain) {
                int r32e = r32, hie = hi; asm volatile("" : "+v"(r32e), "+v"(hie));
                const f32x4* l4p = (const f32x4*)li + hie; const f32x4 l0 = l4p[0], l1 = l4p[2], l2 = l4p[4], l3 = l4p[6];
                float rli[16];
#pragma unroll
                for (int j = 0; j < 4; ++j) { rli[j] = __builtin_amdgcn_rcpf(l0[j]); rli[4 + j] = __builtin_amdgcn_rcpf(l1[j]); rli[8 + j] = __builtin_amdgcn_rcpf(l2[j]); rli[12 + j] = __builtin_amdgcn_rcpf(l3[j]); }
                const f32x4* m4p = (const f32x4*)(li + 32) + hie; const f32x4 n0 = m4p[0], n1 = m4p[2], n2 = m4p[4], n3 = m4p[6];
                float rlj[16];
#pragma unroll
                for (int j = 0; j < 4; ++j) { rlj[j] = __builtin_amdgcn_rcpf(n0[j]); rlj[4 + j] = __builtin_amdgcn_rcpf(n1[j]); rlj[8 + j] = __builtin_amdgcn_rcpf(n2[j]); rlj[12 + j] = __builtin_amdgcn_rcpf(n3[j]); }
                float* Ow = ((w4 & 1) ? cur.O1 : cur.O0) + (size_t)((w4 >> 1) * 2 * QBLK) * D;
#pragma unroll
                for (int r = 0; r < 16; ++r) { const int orow = crow(r, hie);
#pragma unroll
                    for (int d0 = 0; d0 < 4; ++d0) { Ow[(size_t)orow * D + d0 * 32 + r32e] = o[d0][r] * rli[r]; Ow[(size_t)(QBLK + orow) * D + d0 * 32 + r32e] = o[4 + d0][r] * rlj[r]; } }
            }
            __syncthreads();
        }
    }
}
#undef LD8
#undef VMW2
}
constexpr size_t al256(size_t x) { return (x + 255) & ~(size_t)255; }
constexpr size_t WS_CTL = 0, CTL_ZERO_BYTES = 1u << 20;
constexpr size_t WS_WGU   = CTL_ZERO_BYTES;
constexpr size_t WS_WDN   = WS_WGU  + (size_t)8 * NGU * DM * 2;
constexpr size_t WS_WOUT  = WS_WDN  + (size_t)8 * DM * FF * 2;
constexpr size_t WS_WMEM  = WS_WOUT + (size_t)4 * DM * DM * 2;
constexpr size_t WS_WAIN  = WS_WMEM + (size_t)4 * 1024 * DM * 2;
constexpr size_t WS_WKV   = WS_WAIN + (size_t)2 * NAIN * DM * 2;
constexpr size_t WS_WBIN  = WS_WKV  + (size_t)NKV * DM * 2;
constexpr size_t WS_COS   = WS_WBIN + (size_t)2 * NBIN * DM * 2;
constexpr size_t WS_MEMN  = WS_COS  + (size_t)SEQ * 64 * 4;
constexpr size_t WS_MK    = WS_MEMN + (size_t)4 * 1024 * DM * 2;
constexpr size_t WS_MV    = WS_MK   + (size_t)4 * 1024 * 512 * 2;
constexpr size_t WS_XB    = WS_MV   + (size_t)4 * 1024 * 512 * 2;
constexpr size_t WS_SS    = WS_XB   + (size_t)M * DM * 2;
constexpr size_t WS_XH    = WS_SS   + (size_t)M * 32 * 4;
constexpr size_t WS_HID   = WS_XH   + (size_t)M * DM * 2;
constexpr size_t WS_ZA    = WS_HID  + (size_t)M * FF * 2;
constexpr size_t WS_VSTAT = WS_ZA   + (size_t)M * 3072 * 2;
constexpr size_t WS_QB    = WS_VSTAT + (size_t)M * 24 * 4;
constexpr size_t WS_KSH   = WS_QB   + (size_t)M * 1536 * 2;
constexpr size_t WS_VSH   = WS_KSH  + (size_t)M * 1536 * 2;
constexpr size_t WS_QMB   = WS_VSH  + (size_t)M * 1536 * 2;
constexpr size_t WS_OATT  = WS_QMB  + (size_t)M * 512 * 2;
constexpr size_t WS_CAT   = WS_OATT + (size_t)2 * 96 * SEQ * 128 * 4;
constexpr size_t WS_END   = WS_CAT  + (size_t)M * DM * 2;
static_assert(WS_WGU % 256 == 0 && WS_COS % 256 == 0 && WS_VSTAT % 256 == 0 && WS_QB % 256 == 0 && WS_END % 256 == 0, "ws alignment");

constexpr int RING_OFF = 0, RING_BYTES = 131072;
constexpr int LDSCTL_OFF = 141312, MISC_OFF = LDSCTL_OFF + 320;
constexpr int LDS_BYTES = 147456;
constexpr int NWAVES = 8;

#define GAS __attribute__((address_space(1)))
#define LAS __attribute__((address_space(3)))
typedef unsigned short bf16r;
typedef unsigned v4u __attribute__((ext_vector_type(4)));
typedef unsigned v2u __attribute__((ext_vector_type(2)));
typedef float f32x4 __attribute__((ext_vector_type(4)));
typedef short bf16x8 __attribute__((ext_vector_type(8)));
typedef GAS unsigned gu32;
#define LDS_WAIT() asm volatile("s_waitcnt lgkmcnt(0)" ::: "memory")
#define VM_WAIT() asm volatile("s_waitcnt vmcnt(0)" ::: "memory")
__device__ __forceinline__ unsigned f2bf(float f) { unsigned u = __builtin_bit_cast(unsigned, f); return (u + 0x7fffu + ((u >> 16) & 1u)) >> 16; }
__device__ __forceinline__ unsigned pk2(float lo, float hi) { return f2bf(lo) | (f2bf(hi) << 16); }
__device__ __forceinline__ float bf2f(unsigned short b) { return __builtin_bit_cast(float, ((unsigned)b) << 16); }
__device__ __forceinline__ float wave_sum(float v) {
#pragma unroll
    for (int o = 1; o < 64; o <<= 1) v += __shfl_xor(v, o);
    return v;
}
#define XB_TMO      128
#define XB_XCNT(j)  (256  + 64 * (j))
#define XB_XSUB(j)  (1280 + 64 * (j))
#define XB_XGEN(j)  (2304 + 64 * (j))
#define XB_TOP      3328
#define XB_TOPGEN   3392
#define XCD_BAR_WORDS 3456
#define XB_SPIN_CAP (1u << 18)

__device__ __forceinline__ unsigned xb_ld(unsigned* p)              { return __hip_atomic_load(p, __ATOMIC_RELAXED, __HIP_MEMORY_SCOPE_AGENT); }
__device__ __forceinline__ unsigned xb_add(unsigned* p, unsigned v) { return __hip_atomic_fetch_add(p, v, __ATOMIC_RELAXED, __HIP_MEMORY_SCOPE_AGENT); }
__device__ __forceinline__ unsigned xb_xcc_id() { return (unsigned)__builtin_amdgcn_s_getreg((3 << 11) | 20) & 0xFu; }
#define XB_SPIN(cond, bar) do { unsigned _sp = 0; while (cond) { __builtin_amdgcn_s_sleep(1); \
    if ((++_sp & 255u) == 0u) { if (xb_ld(&(bar)[XB_TMO])) break; if (_sp > XB_SPIN_CAP) { atomicAdd(&(bar)[XB_TMO], 1u); break; } } } } while (0)

struct XcdBarrier {
    unsigned* bar; unsigned x;
    volatile LAS unsigned* st;
};

__device__ __forceinline__ XcdBarrier xcd_barrier_post(unsigned* bar, volatile LAS unsigned* st) {
    XcdBarrier b; b.bar = bar; b.x = xb_xcc_id(); b.st = st;
    if (threadIdx.x == 0) (void)xb_add(&bar[XB_XCNT(b.x)], 1u);
    return b;
}
__device__ __forceinline__ void xcd_barrier_complete(unsigned* bar, unsigned x, unsigned& nloc, unsigned& nx) {
    const unsigned G = gridDim.x * gridDim.y * gridDim.z;
    unsigned sum, cnt, mine, sp = 0u;
    for (;;) {
        sum = 0u; cnt = 0u; mine = 0u;
#pragma unroll
        for (unsigned j = 0; j < 16; ++j) { const unsigned c = xb_ld(&bar[XB_XCNT(j)]); sum += c; cnt += (c > 0u) ? 1u : 0u; mine = (j == x) ? c : mine; }
        if (sum == G) break;
        __builtin_amdgcn_s_sleep(1);
        if ((++sp & 255u) == 0u) { if (xb_ld(&bar[XB_TMO])) break; if (sp > XB_SPIN_CAP) { atomicAdd(&bar[XB_TMO], 1u); break; } }
    }
    nloc = mine > 0u ? mine : 1u; nx = cnt > 0u ? cnt : 1u;
}

__device__ __forceinline__ void xcd_barrier(const XcdBarrier& b) {
    asm volatile("s_waitcnt vmcnt(0)" ::: "memory");
    __syncthreads();
    if (threadIdx.x == 0) {
        unsigned* bar = b.bar;
        __builtin_amdgcn_s_waitcnt(0);
        unsigned nloc = b.st[0], nx = b.st[1];
        if (nloc == 0u) { xcd_barrier_complete(bar, b.x, nloc, nx); b.st[0] = nloc; b.st[1] = nx; }
        const unsigned old = xb_add(&bar[XB_XSUB(b.x)], 1u);
        const unsigned gen = old / nloc;
        if (old + 1u == (gen + 1u) * nloc) {
            __builtin_amdgcn_fence(__ATOMIC_RELEASE, "agent");
            asm volatile("s_waitcnt vmcnt(0)" ::: "memory");
            const unsigned og = xb_add(&bar[XB_TOP], 1u);
            const unsigned tg = og / nx;
            if (og + 1u == (tg + 1u) * nx) xb_add(&bar[XB_TOPGEN], 1u);
            else XB_SPIN(xb_ld(&bar[XB_TOPGEN]) == tg, bar);
            __builtin_amdgcn_fence(__ATOMIC_ACQUIRE, "agent");
            xb_add(&bar[XB_XGEN(b.x)], 1u);
            asm volatile("s_waitcnt vmcnt(0)" ::: "memory");
        } else {
            XB_SPIN(xb_ld(&bar[XB_XGEN(b.x)]) == gen, bar);
            __builtin_amdgcn_fence(__ATOMIC_ACQUIRE, "agent");
            asm volatile("s_waitcnt vmcnt(0)" ::: "memory");
        }
    }
    __syncthreads();
}

#define XB_LSUB(j)  (4096 + 64 * (j))
#define XB_LGEN(j)  (5120 + 64 * (j))
#define XB_XCCTAB   6144
__device__ __forceinline__ void xcd_local_barrier(const XcdBarrier& b) {
    asm volatile("s_waitcnt vmcnt(0)" ::: "memory");
    __syncthreads();
    if (threadIdx.x == 0) {
        unsigned* bar = b.bar;
        __builtin_amdgcn_s_waitcnt(0);
        const unsigned nloc = b.st[0] ? b.st[0] : 1u;
        const unsigned old = xb_add(&bar[XB_LSUB(b.x)], 1u);
        const unsigned gen = old / nloc;
        if (old + 1u == (gen + 1u) * nloc) {
#ifndef LOCAL_BAR_RELEASE
#define LOCAL_BAR_RELEASE 0
#endif
            if (LOCAL_BAR_RELEASE) { __builtin_amdgcn_fence(__ATOMIC_RELEASE, "agent"); asm volatile("s_waitcnt vmcnt(0)" ::: "memory"); }
            __builtin_amdgcn_fence(__ATOMIC_ACQUIRE, "agent");
            xb_add(&bar[XB_LGEN(b.x)], 1u);
            asm volatile("s_waitcnt vmcnt(0)" ::: "memory");
        } else {
            XB_SPIN(xb_ld(&bar[XB_LGEN(b.x)]) == gen, bar);
            __builtin_amdgcn_fence(__ATOMIC_ACQUIRE, "agent");
            asm volatile("s_waitcnt vmcnt(0)" ::: "memory");
        }
    }
    __syncthreads();
}
struct Frame {
    unsigned char* lds_g;
    LAS unsigned char* lds;
    volatile LAS unsigned* MISC;
    gu32* ctl;
    int tid, lane, wave;
    int vcu, G;
    unsigned char* ws;
};

__device__ __forceinline__ void transpose_item(const float* W, int K, int N, bf16r* WT, size_t dst_row0, int k0, int n0, LAS float* scr, int lane, const float* gain) {
    f32x4 v[16]; float gk[16];
#pragma unroll
    for (int i = 0; i < 16; ++i) { const int kk = 4 * i + (lane >> 4); v[i] = *(const f32x4*)(W + (size_t)(k0 + kk) * N + n0 + (lane & 15) * 4); gk[i] = gain ? gain[k0 + kk] : 1.0f; }
#pragma unroll
    for (int i = 0; i < 16; ++i) { const int kk = 4 * i + (lane >> 4); const f32x4 w = v[i] * gk[i];
        LAS float* s = scr + kk * 65 + (lane & 15) * 4; s[0] = w[0]; s[1] = w[1]; s[2] = w[2]; s[3] = w[3]; }
    LDS_WAIT(); asm volatile("" ::: "memory");
    const int c = lane & 7;
#pragma unroll
    for (int j = 0; j < 8; ++j) { const int n = (lane >> 3) + 8 * j; const LAS float* s = scr + (8 * c) * 65 + n;
        v4u o; o.x = pk2(s[0 * 65], s[1 * 65]); o.y = pk2(s[2 * 65], s[3 * 65]); o.z = pk2(s[4 * 65], s[5 * 65]); o.w = pk2(s[6 * 65], s[7 * 65]);
        const size_t row = dst_row0 + n;
        *(v4u*)(WT + (((row >> 8) * (size_t)(K >> 6) + (k0 >> 6)) << 14) + ((row & 255) << 6) + 8 * c) = o; }
    LDS_WAIT(); asm volatile("" ::: "memory");
}
__device__ __forceinline__ bool transpose_group(int& r, const float* src, int cnt, int K, int N, bf16r* dst, bool gu, LAS float* scr, int lane, const float* gain, int gmode) {
    const int nkb = K / 64, nnb = N / 64, per = nkb * nnb;
    if (r >= cnt * per) { r -= cnt * per; return false; }
    const int mi = r / per, q = r % per, kb = q / nnb, nb = q % nnb, n0 = nb * 64;
    size_t drow = n0;
    if (gu) { drow = (n0 < FF) ? (size_t)(n0 / 128) * 256 + (n0 % 128) : (size_t)((n0 - FF) / 128) * 256 + 128 + ((n0 - FF) % 128); }
    const float* gp = gain;
    if (gain) { if (gmode == 1) gp = gain + (size_t)((mi >> 1) * 3 + (mi & 1) * 2) * K; else if (gmode >= 2) gp = gain + (size_t)((mi + (gmode - 2)) * 3 + 1) * K; }
    transpose_item(src + (size_t)mi * K * N, K, N, dst + (size_t)mi * K * N, gu ? drow : (size_t)n0, kb * 64, n0, scr, lane, gp);
    return true;
}
__device__ __forceinline__ void norm_row(const float* xrow, const float* gain, bf16r* orow, int lane) {
    const f32x4* xr = (const f32x4*)xrow + lane; f32x4 v[8]; float s = 0.f;
#pragma unroll
    for (int j = 0; j < 8; ++j) { v[j] = xr[64 * j]; s += (v[j][0] * v[j][0] + v[j][1] * v[j][1]) + (v[j][2] * v[j][2] + v[j][3] * v[j][3]); }
    const float rstd = 1.0f / sqrtf(wave_sum(s) * (1.0f / DM) + EPS);
    const f32x4* g4 = (const f32x4*)gain + lane; v2u* o8 = (v2u*)orow + lane;
#pragma unroll
    for (int j = 0; j < 8; ++j) { const f32x4 g = g4[64 * j]; v2u w; w.x = pk2(v[j][0] * rstd * g[0], v[j][1] * rstd * g[1]); w.y = pk2(v[j][2] * rstd * g[2], v[j][3] * rstd * g[3]); o8[64 * j] = w; }
}
__device__ __forceinline__ void xb_ss_phase(const Frame& F, const float* x, bf16r* xb, float* ss) {
    const int gw = F.vcu * NWAVES + F.wave, NGW = F.G * NWAVES, lane = F.lane;
    for (int m = gw; m < M; m += NGW) { const f32x4* xr = (const f32x4*)(x + (size_t)m * DM) + lane; float s = 0.f;
#pragma unroll
        for (int j = 0; j < 8; ++j) { const f32x4 v = xr[64 * j]; s += (v[0] * v[0] + v[1] * v[1]) + (v[2] * v[2] + v[3] * v[3]); v2u w; w.x = pk2(v[0], v[1]); w.y = pk2(v[2], v[3]); const int col = 4 * lane + 256 * j; *(v2u*)(xb + (((size_t)((m >> 8) * (DM >> 6) + (col >> 6))) << 14) + ((m & 255) << 6) + (col & 63)) = w; }
        s = wave_sum(s); if (lane < 32) ss[(size_t)m * 32 + lane] = (lane == 0) ? s : 0.f; }
}
__device__ __forceinline__ void sincos_d(float angf, float& sn, float& cs) {
    const double a = (double)angf; const double k = __builtin_rint(a * 0.15915494309189535); const double r = a - k * 6.283185307179586476925286766559;
    const double r2 = r * r; double ts = r, tc = 1.0, ss = r, cc = 1.0;
#pragma unroll
    for (int n = 1; n <= 14; ++n) { tc = -tc * r2 / (double)((2 * n - 1) * (2 * n)); ts = -ts * r2 / (double)((2 * n) * (2 * n + 1)); cc += tc; ss += ts; }
    sn = (float)ss; cs = (float)cc;
}
__device__ __forceinline__ void combine_phase(const Frame& F, const float* oatt, const float* lamp  , const float* subg  , float lam_init, bf16r* cat) {
    const int gw = F.vcu * NWAVES + F.wave, NGW = F.G * NWAVES, lane = F.lane;
    const float d01 = wave_sum(lamp[lane] * lamp[128 + lane] + lamp[64 + lane] * lamp[192 + lane]);
    const float d23 = wave_sum(lamp[256 + lane] * lamp[384 + lane] + lamp[320 + lane] * lamp[448 + lane]);
    const float lam = expf(d01) - expf(d23) + lam_init;
    const int half = lane >> 5, d4 = (lane & 31) * 4; const f32x4 g = *(const f32x4*)(subg + half * 128 + d4) * (1.0f - lam_init);
    const bool own = F.G == 256; const int m0 = own ? 2048 * ((int)blockIdx.x & 7) + ((int)blockIdx.x >> 3) * NWAVES + F.wave : gw, mstep = own ? 256 : NGW, mend = own ? 2048 * ((int)blockIdx.x & 7) + 2048 : M;
    for (int m = m0; m < mend; m += mstep) { const int b = m >> 12, s = m & 4095;
        f32x4 o[DH]; float ss[DH];
#pragma unroll
        for (int h = 0; h < DH; ++h) { const size_t vh0 = (size_t)((b * 6 + h) * 2 + 0) * 2 + half, vh1 = (size_t)((b * 6 + h) * 2 + 1) * 2 + half;
            const f32x4 o0 = *(const f32x4*)(oatt + (vh0 * SEQ + s) * 128 + d4), o1 = *(const f32x4*)(oatt + (vh1 * SEQ + s) * 128 + d4);
            o[h] = o0 - o1 * lam; ss[h] = (o[h][0] * o[h][0] + o[h][1] * o[h][1]) + (o[h][2] * o[h][2] + o[h][3] * o[h][3]); }
#pragma unroll
        for (int sh = 1; sh < 64; sh <<= 1) {
#pragma unroll
            for (int h = 0; h < DH; ++h) ss[h] += __shfl_xor(ss[h], sh); }
#pragma unroll
        for (int h = 0; h < DH; ++h) { const float rstd = 1.0f / sqrtf(ss[h] * (1.0f / DV) + EPS);
            v2u w; w.x = pk2(o[h][0] * rstd * g[0], o[h][1] * rstd * g[1]); w.y = pk2(o[h][2] * rstd * g[2], o[h][3] * rstd * g[3]);
            *(v2u*)(cat + (size_t)m * DM + h * 256 + half * 128 + d4) = w; }
    }
}

constexpr int GM_WL = 0, GM_WLS = 272, GM_VT = 128 * GM_WLS, GM_VTS = 272, GM_RS = GM_VT + 256 * GM_VTS;
static_assert(GM_RS + 512 <= RING_BYTES, "gmlp LDS");
__device__ __forceinline__ void gmlp_phase(const Frame& F, const bf16r* ZA, const float* vstat, const float* w_s  , const float* b_s  , const float* gv  , bf16r* cat) {
    const int tid = F.tid, lane = F.lane, wave = F.wave, fr = lane & 15, fq = lane >> 4;
    LAS unsigned char* lds = F.lds;
    LAS float* rs = (LAS float*)(lds + GM_RS);
    const bool own = F.G == 256; const int xg = (int)blockIdx.x & 7, jg = (int)blockIdx.x >> 3;
    for (int unit = own ? jg : F.vcu; unit < (own ? 96 : 128 * GG); unit += own ? 32 : F.G) {
        const int bc = own ? 16 * xg + unit / GG : unit / GG, g = unit % GG, r0 = bc * 128;
        if (tid < 128) { const f32x4* p = (const f32x4*)(vstat + (size_t)(r0 + tid) * 24); float s = 0.f;
#pragma unroll
            for (int i = 0; i < 6; ++i) { const f32x4 v = p[i]; s += (v[0] + v[1]) + (v[2] + v[3]); }
            rs[tid] = 1.0f / sqrtf(s * (1.0f / MIXW) + EPS); }
        { const int s = tid & 127, cb = (tid >> 7) * 8;
#pragma unroll
          for (int it = 0; it < 8; ++it) { const int d8 = (cb + it) * 8; const bf16x8 v = *(const bf16x8*)(ZA + (size_t)(r0 + s) * 3072 + 1536 + g * 256 + d8);
#pragma unroll
              for (int e = 0; e < 8; ++e) *(LAS unsigned short*)(lds + GM_VT + (d8 + e) * GM_VTS + s * 2) = (unsigned short)v[e]; } }
        __syncthreads();
        for (int idx = tid; idx < 128 * 32; idx += 512) { const int t = idx >> 5, s4 = (idx & 31) * 4; const f32x4 w = *(const f32x4*)(w_s + ((size_t)g * 128 + t) * 128 + s4);
            float e[4];
#pragma unroll
            for (int j = 0; j < 4; ++j) e[j] = (s4 + j <= t) ? w[j] * rs[s4 + j] : 0.f;
            v2u o; o.x = pk2(e[0], e[1]); o.y = pk2(e[2], e[3]); *(LAS v2u*)(lds + GM_WL + t * GM_WLS + s4 * 2) = o; }
        __syncthreads();
        f32x4 acc[8][2];
#pragma unroll
        for (int tt = 0; tt < 8; ++tt) { acc[tt][0] = (f32x4){0.f, 0.f, 0.f, 0.f}; acc[tt][1] = (f32x4){0.f, 0.f, 0.f, 0.f}; }
#pragma unroll
        for (int ks = 0; ks < 4; ++ks) {
            bf16x8 bfr[2];
#pragma unroll
            for (int dd = 0; dd < 2; ++dd) bfr[dd] = *(const LAS bf16x8*)(lds + GM_VT + (32 * wave + 16 * dd + fr) * GM_VTS + (32 * ks + 8 * fq) * 2);
#pragma unroll
            for (int tt = 0; tt < 8; ++tt) { if (32 * ks <= 16 * tt + 15) {
                const bf16x8 afr = *(const LAS bf16x8*)(lds + GM_WL + (16 * tt + fr) * GM_WLS + (32 * ks + 8 * fq) * 2);
#pragma unroll
                for (int dd = 0; dd < 2; ++dd) acc[tt][dd] = __builtin_amdgcn_mfma_f32_16x16x32_bf16(bfr[dd], afr, acc[tt][dd], 0, 0, 0); } }
        }
#pragma unroll
        for (int tt = 0; tt < 8; ++tt) { const int t = 16 * tt + fr, row = r0 + t; const float bias = b_s[g * 128 + t];
#pragma unroll
            for (int dd = 0; dd < 2; ++dd) { const int d = 32 * wave + 16 * dd + 4 * fq; const f32x4 gg = *(const f32x4*)(gv + g * 256 + d);
                const v2u uu = *(const v2u*)(ZA + (size_t)row * 3072 + g * 256 + d);
                const float u0 = bf2f((unsigned short)(uu.x & 0xffff)), u1 = bf2f((unsigned short)(uu.x >> 16)), u2 = bf2f((unsigned short)(uu.y & 0xffff)), u3 = bf2f((unsigned short)(uu.y >> 16));
                const f32x4 a = acc[tt][dd]; v2u o; o.x = pk2(u0 * (a[0] * gg[0] + bias), u1 * (a[1] * gg[1] + bias)); o.y = pk2(u2 * (a[2] * gg[2] + bias), u3 * (a[3] * gg[3] + bias));
                *(v2u*)(cat + (size_t)row * DM + g * 256 + d) = o; } }
        __syncthreads();
    }
}
namespace att {
__device__ __forceinline__ BlockRef<bf16, float> diff_ref(int L, int pass, const bf16* Q, const bf16* K, const bf16* V, float* O) {
    const int vh = L >> 3, x = L & 7, qb = pass ? 15 - x : x;
    const int b = vh / 24, r = vh % 24, h = r >> 2, c = (r >> 1) & 1, half = r & 1;
    BlockRef<bf16, float> R;
    R.Q = Q + ((size_t)((b * 2 + c) * 6 + h) * SEQ + (size_t)qb * QB) * D; R.K = K + (size_t)((b * 2 + c) * 6 + h) * SEQ * D; R.V = V + (size_t)((b * 6 + h) * 2 + half) * SEQ * D;
    R.O = O + ((size_t)vh * SEQ + (size_t)qb * QB) * D; R.P0 = qb * QB; R.ldo = D;
    return R;
}
__device__ __forceinline__ void diff_attn_phase(char* lds, const bf16* Q, const bf16* K, const bf16* V, float* O, int G, int c0) {
    constexpr int total = 96 * 8; const int W = 1 << 30;
    int L = c0; if (L >= total) return;
    int pass = 0; BlockRef<bf16, float> cur = diff_ref(L, 0, Q, K, V, O);
    Seam<bf16> S;
    causal_swa_prime<bf16, float>(cur, W, lds, S);
    for (;;) {
        const bool more_pass = pass == 0, more_item = L + G < total, last = !more_pass && !more_item;
        int passn = pass + 1, Ln = L;
        if (!more_pass) { passn = 0; Ln = more_item ? L + G : L; }
        const BlockRef<bf16, float> nxt = last ? cur : diff_ref(Ln, passn, Q, K, V, O);
        causal_swa_block<bf16, float>(cur, nxt, SEQ, W, lds, S);
        if (last) break;
        cur = nxt; pass = passn; L = Ln;
    }
}
__device__ __forceinline__ Ref2 diff_ref2(int L, int pass, const bf16* Q, const bf16* K, const bf16* V, float* O) {
    const int bhc = L >> 4, x = L & 15, qb = pass ? 31 - x : x;
    const int b = bhc / 12, r = bhc % 12, h = r >> 1, c = r & 1;
    Ref2 R; const size_t qk = (size_t)((b * 2 + c) * 6 + h) * SEQ;
    R.Q = Q + (qk + (size_t)qb * QB2) * D; R.K = K + qk * D;
    R.V0 = V + (size_t)((b * 6 + h) * 2) * SEQ * D; R.V1 = R.V0 + (size_t)SEQ * D;
    const size_t vh = (size_t)b * 24 + h * 4 + c * 2;
    R.O0 = O + (vh * SEQ + (size_t)qb * QB2) * D; R.O1 = R.O0 + (size_t)SEQ * D; R.P0 = qb * QB2;
    return R;
}
template <bool RS>
__device__ __forceinline__ void diff_attn2_role(char* lds, float* xl, const bf16* Q, const bf16* K, const bf16* V, float* O, int G, int c0) {
    constexpr int total = 48 * 16;
    int L = c0; if (L >= total) return;
    int pass = 0; Ref2 cur = diff_ref2(L, 0, Q, K, V, O);
    Seam2 S;
    diff2_prime<RS>(cur, lds, S);
    for (;;) {
        const bool more_pass = pass == 0, more_item = L + G < total, last = !more_pass && !more_item;
        int passn = pass + 1, Ln = L;
        if (!more_pass) { passn = 0; Ln = more_item ? L + G : L; }
        const Ref2 nxt = last ? cur : diff_ref2(Ln, passn, Q, K, V, O);
        diff2_block<RS>(cur, nxt, lds, xl, S);
        if (last) break;
        cur = nxt; pass = passn; L = Ln;
    }
}
__device__ __forceinline__ void diff_attn2_phase(char* lds, float* xl, const bf16* Q, const bf16* K, const bf16* V, float* O, int G, int c0) {
    if (__builtin_amdgcn_readfirstlane((int)threadIdx.x >> 6) < 4) diff_attn2_role<true>(lds, xl, Q, K, V, O, G, c0);
    else diff_attn2_role<false>(lds, xl, Q, K, V, O, G, c0);
}
__device__ __forceinline__ BlockRef<bf16, bf16> mem_ref(int L, const bf16* Q, const bf16* K, const bf16* V, bf16* cat) {
    const int bh = L >> 4, qb = L & 15, b = bh >> 2, hm = bh & 3;
    BlockRef<bf16, bf16> R;
    R.Q = Q + ((size_t)bh * SEQ + (size_t)qb * QB) * D; R.K = K + (size_t)bh * MEML * D; R.V = V + (size_t)bh * MEML * D;
    R.O = cat + ((size_t)b * SEQ + (size_t)qb * QB) * DM + 1536 + hm * 128; R.P0 = 256; R.ldo = DM;
    return R;
}
__device__ __forceinline__ void mem_attn_phase(char* lds, const bf16* Q, const bf16* K, const bf16* V, bf16* cat, int G, int c0) {
    constexpr int total = 256; const int W = 1 << 30;
    int L = c0; if (L >= total) return;
    BlockRef<bf16, bf16> cur = mem_ref(L, Q, K, V, cat);
    Seam<bf16> S;
    causal_swa_prime<bf16, bf16>(cur, W, lds, S);
    for (;;) {
        const bool last = L + G >= total;
        const BlockRef<bf16, bf16> nxt = last ? cur : mem_ref(L + G, Q, K, V, cat);
        causal_swa_block<bf16, bf16>(cur, nxt, MEML, W, lds, S);
        if (last) break;
        cur = nxt; L += G;
    }
}

struct DynAttn { unsigned* qcnt; const unsigned* rq; const unsigned* rkv; unsigned tag; unsigned* tmo; volatile __attribute__((address_space(3))) unsigned* bc; };
__device__ __forceinline__ unsigned dyn_pull(const DynAttn& C, int bpref) {
    if (threadIdx.x == 0) {
        unsigned code = 0xffffffffu;
        for (unsigned spins = 0;; ++spins) {
            bool any_left = false;
#pragma unroll 1
            for (int k = 0; k < 4 && code == 0xffffffffu; ++k) { const int b = (bpref + k) & 3;
                if (__hip_atomic_load(C.qcnt + 64 * b, __ATOMIC_RELAXED, __HIP_MEMORY_SCOPE_AGENT) >= 384u) continue;
                any_left = true;
                const bool ready = __hip_atomic_load(C.rq + 64 * (2 * b), __ATOMIC_RELAXED, __HIP_MEMORY_SCOPE_AGENT) == C.tag && __hip_atomic_load(C.rq + 64 * (2 * b + 1), __ATOMIC_RELAXED, __HIP_MEMORY_SCOPE_AGENT) == C.tag &&
                                   __hip_atomic_load(C.rkv + 64 * (2 * b), __ATOMIC_RELAXED, __HIP_MEMORY_SCOPE_AGENT) != 0u && __hip_atomic_load(C.rkv + 64 * (2 * b + 1), __ATOMIC_RELAXED, __HIP_MEMORY_SCOPE_AGENT) != 0u;
                if (!ready) continue;
                const unsigned n = __hip_atomic_fetch_add(C.qcnt + 64 * b, 1u, __ATOMIC_RELAXED, __HIP_MEMORY_SCOPE_AGENT);
                if (n < 384u) code = ((unsigned)b << 16) | n;
            }
            if (code != 0xffffffffu || !any_left) break;
            __builtin_amdgcn_s_sleep(8);
            if ((spins & 255u) == 255u) { if (__hip_atomic_load(C.tmo, __ATOMIC_RELAXED, __HIP_MEMORY_SCOPE_AGENT)) break; if (spins > (1u << 20)) { __hip_atomic_store(C.tmo, 1u, __ATOMIC_RELAXED, __HIP_MEMORY_SCOPE_AGENT); break; } }
        }
        __builtin_amdgcn_fence(__ATOMIC_ACQUIRE, "agent");
        asm volatile("s_waitcnt vmcnt(0)" ::: "memory");
        C.bc[0] = code;
    }
    __syncthreads();
    const unsigned code = C.bc[0];
    __syncthreads();
    return code;
}
__device__ __forceinline__ BlockRef<bf16, float> dyn_ref(unsigned code, const bf16* Q, const bf16* K, const bf16* V, float* O) {
    const int b = (int)(code >> 16), n = (int)(code & 0xffffu), qb = 15 - (n & 15), r = n >> 4, h = r >> 2, c = (r >> 1) & 1, half = r & 1, vh = b * 24 + r;
    BlockRef<bf16, float> R;
    R.Q = Q + ((size_t)((b * 2 + c) * 6 + h) * SEQ + (size_t)qb * QB) * D; R.K = K + (size_t)((b * 2 + c) * 6 + h) * SEQ * D; R.V = V + (size_t)((b * 6 + h) * 2 + half) * SEQ * D;
    R.O = O + ((size_t)vh * SEQ + (size_t)qb * QB) * D; R.P0 = qb * QB; R.ldo = D;
    return R;
}
__device__ __forceinline__ void diff_attn_dyn_phase(char* lds, const bf16* Q, const bf16* K, const bf16* V, float* O, const DynAttn& C, int bpref) {
    const int W = 1 << 30;
    unsigned code = dyn_pull(C, bpref); if (code == 0xffffffffu) return;
    BlockRef<bf16, float> cur = dyn_ref(code, Q, K, V, O);
    Seam<bf16> S;
    causal_swa_prime<bf16, float>(cur, W, lds, S);
    for (;;) {
        const unsigned nc = dyn_pull(C, bpref); const bool last = nc == 0xffffffffu;
        const BlockRef<bf16, float> nxt = last ? cur : dyn_ref(nc, Q, K, V, O);
        causal_swa_block<bf16, float>(cur, nxt, SEQ, W, lds, S);
        if (last) break;
        cur = nxt;
    }
}
}

constexpr int NPL = 8, PH_BASE = 1, NPH = PH_BASE + DEPTH * NPL;
enum { I_X = 0, I_MEM, I_NORMG, I_WGU, I_WDN, I_WOUT, I_MEMNG, I_MEMWKV, I_MEMQG, I_MEMKG, I_AWIN, I_AVG, I_AWS, I_ABS, I_KVG, I_WKV, I_KG, I_BWIN, I_BQG, I_BLAM, I_BSUBG, N_IN };
struct Args { const float* in[N_IN]; float* out; unsigned char* ws; int ph_lo, ph_hi, li, pad; };

#ifndef EN_MASK
#define EN_MASK 0xFFFFFFFFu
#endif
#define SITE(n) (((EN_MASK) >> (n)) & 1u)
#define IN(k) (lo <= (k) && (k) < hi)
#ifndef PROBE_WAIT
#define PROBE_WAIT 0
#endif
#ifndef PROBE_PHASE
#define PROBE_PHASE 0
#endif
#ifndef LOCAL_SEAMS
#define LOCAL_SEAMS 1
#endif
#define SEAM_X(k, local) do { if (IN((k) + 1)) { unsigned long long t0_ = 0; if (PROBE_WAIT) t0_ = __builtin_amdgcn_s_memrealtime(); \
    if (LOCAL_SEAMS && (local) && F.MISC[24] != 0u) xcd_local_barrier(bar); else xcd_barrier(bar); \
    if (PROBE_WAIT && ((PROBE_WAIT >> CUR_SITE) & 1) && F.tid == 0) F.MISC[16] += (unsigned)(__builtin_amdgcn_s_memrealtime() - t0_); \
    } \
    if (PROBE_PHASE && ((PROBE_PHASE >> CUR_SITE) & 1) && F.tid == 0) F.MISC[17] += (unsigned)(__builtin_amdgcn_s_memrealtime() - tsite_); } while (0)
#define SEAM(k) SEAM_X(k, false)
#define SEAM_L(k) SEAM_X(k, true)
constexpr int CW_RQ = 70016, CW_RKV = 70656, CW_QCNT = 71296;
#define PUBLISH_FLAG(word, val) do { if (blockIdx.x < 8 && F.tid == 0) { __builtin_amdgcn_fence(__ATOMIC_RELEASE, "agent"); asm volatile("s_waitcnt vmcnt(0)" ::: "memory"); \
    __hip_atomic_store((unsigned*)F.ctl + (word) + 64 * (blockIdx.x & 7), (unsigned)(val), __ATOMIC_RELAXED, __HIP_MEMORY_SCOPE_AGENT); } } while (0)
#define SITE_T0 unsigned long long tsite_ = 0; if (PROBE_PHASE) tsite_ = __builtin_amdgcn_s_memrealtime(); (void)tsite_;
#define CAS __attribute__((address_space(4)))
#define WS_PTRS \
    const CAS Args* ap = (const CAS Args*)__builtin_amdgcn_kernarg_segment_ptr(); asm volatile("" : "+s"(ap)); \
    unsigned char* const ws = ap->ws; \
    bf16r* const Wgu = (bf16r*)(ws + WS_WGU); bf16r* const Wdn = (bf16r*)(ws + WS_WDN); bf16r* const Wout = (bf16r*)(ws + WS_WOUT); bf16r* const Wmem = (bf16r*)(ws + WS_WMEM); \
    bf16r* const Wain = (bf16r*)(ws + WS_WAIN); bf16r* const Wkv = (bf16r*)(ws + WS_WKV); bf16r* const Wbin = (bf16r*)(ws + WS_WBIN); \
    unsigned* const CS = (unsigned*)(ws + WS_COS); \
    bf16r* const MEMN = (bf16r*)(ws + WS_MEMN); bf16r* const MK = (bf16r*)(ws + WS_MK); bf16r* const MV = (bf16r*)(ws + WS_MV); \
    bf16r* const XB = (bf16r*)(ws + WS_XB); float* const SS = (float*)(ws + WS_SS); _Float16* const XH = (_Float16*)(ws + WS_XH); bf16r* const HID = (bf16r*)(ws + WS_HID); bf16r* const ZA = (bf16r*)(ws + WS_ZA); \
    float* const VSTAT = (float*)(ws + WS_VSTAT); \
    bf16r* const QB_ = (bf16r*)(ws + WS_QB); bf16r* const KSH = (bf16r*)(ws + WS_KSH); bf16r* const VSH = (bf16r*)(ws + WS_VSH); bf16r* const QMB = (bf16r*)(ws + WS_QMB); \
    float* const OATT = (float*)(ws + WS_OATT); bf16r* const CAT = (bf16r*)(ws + WS_CAT); \
    float* const X = ap->out; \
    (void)Wgu; (void)Wdn; (void)Wout; (void)Wmem; (void)Wain; (void)Wkv; (void)Wbin; (void)CS; (void)MEMN; (void)MK; (void)MV; (void)XB; (void)SS; (void)XH; (void)HID; (void)ZA; \
    (void)VSTAT; (void)QB_; (void)KSH; (void)VSH; (void)QMB; (void)OATT; (void)CAT; (void)X;

constexpr int EX_OFF = RING_BYTES + 2048;
constexpr int RTAB_OFF = RING_BYTES;
__device__ __forceinline__ pg8::RowScale fill_rstd(const Frame& F, const float* ss, const pg8::StaticOrder& So) {
    pg8::Unit u0; const int pm0 = So.next(0, u0) ? u0.pm : -1;
    { pg8::Unit ui; bool same = true; for (int i = 1; So.next(i, ui); ++i) same &= (ui.pm == pm0); if (!same && F.tid == 0) __hip_atomic_store((unsigned*)F.ctl + XB_TMO, 1u, __ATOMIC_RELAXED, __HIP_MEMORY_SCOPE_AGENT); }
    LAS float* tab = (LAS float*)(F.lds + RTAB_OFF);
    __syncthreads();
    if (pm0 >= 0 && F.tid < 256) { const f32x4* p = (const f32x4*)(ss + (size_t)(pm0 * 256 + F.tid) * 32); float s = 0.f;
#pragma unroll
        for (int i = 0; i < 8; ++i) { const f32x4 v = p[i]; s += (v[0] + v[1]) + (v[2] + v[3]); }
        const float v = s * (1.0f / DM) + EPS; tab[2 * F.tid] = 1.0f / sqrtf(v); tab[2 * F.tid + 1] = v; }
    __syncthreads();
    return pg8::RowScale{(const LAS float*)tab};
}
#ifndef ATTN2
#define ATTN2 1
#endif
#ifndef DYN_ATTN
#define DYN_ATTN 0
#endif
template <int L, int S>
__device__ __forceinline__ void ffn_part(const Frame& F, const XcdBarrier& bar, unsigned char* smem, const int lo, const int hi) {
    constexpr int pf = PH_BASE + L * NPL + (S ? 6 : 0);
    if (SITE(3) && IN(pf)) { constexpr int CUR_SITE = 3; (void)CUR_SITE; SITE_T0 WS_PTRS
        pg8::Gemm g{XB, Wgu + (size_t)(L * 2 + S) * NGU * DM, M, NGU, DM}; pg8::StaticOrder So; So.init(M, NGU, F.G, (int)blockIdx.x);
        pg8::EpiSwiglu E{HID, FF, fill_rstd(F, SS, So)};
        pg8::gemm_phase<pg8::EpiSwiglu, pg8::StaticOrder, true, true, true, true>(F.lds + RING_OFF, g, So, E);
        if constexpr (L == NA && S == 0) {
            pg8::Gemm g2{XB, Wkv, M, NKV, DM}; pg8::StaticOrder S2; S2.init(M, NKV, F.G, (int)blockIdx.x);
            pg8::EpiQKRope E2{1, KSH, VSH, ap->in[I_KG], nullptr, CS, (LAS float*)(F.lds + EX_OFF), fill_rstd(F, SS, S2)};
            pg8::gemm_phase<pg8::EpiQKRope, pg8::StaticOrder, true, true, true, true>(F.lds + RING_OFF, g2, S2, E2);
        }
        SEAM_L(pf);
        if constexpr (L == NA && S == 0) { if (DYN_ATTN && IN(pf + 1)) PUBLISH_FLAG(CW_RKV, 1u); }
    }
    if (SITE(4) && IN(pf + 1)) { constexpr int CUR_SITE = 4; (void)CUR_SITE; SITE_T0 WS_PTRS
        pg8::Gemm g{HID, Wdn + (size_t)(L * 2 + S) * DM * FF, M, DM, FF}; pg8::ColSweepOrder So{(int)blockIdx.x};
        pg8::EpiResid E{(L == 0 && S == 0) ? ap->in[I_X] : nullptr, (L == DEPTH - 1 && S == 1) ? X : nullptr, DM, 0.5f, XB, SS, XH};
        pg8::gemm_phase<pg8::EpiResid, pg8::ColSweepOrder, true, true, true, true>(F.lds + RING_OFF, g, So, E);
        SEAM_L(pf + 1);
    }
}
template <int L>
__device__ __forceinline__ void mixer_part(const Frame& F, const XcdBarrier& bar, unsigned char* smem, const int lo, const int hi) {
    constexpr int pb = PH_BASE + L * NPL;
    if (SITE(6) && IN(pb + 2)) { constexpr int CUR_SITE = 6; (void)CUR_SITE; SITE_T0 WS_PTRS
        if constexpr (L < NA) { pg8::Gemm g{XB, Wain + (size_t)L * NAIN * DM, M, NAIN, DM}; pg8::StaticOrder So; So.init(M, NAIN, F.G, (int)blockIdx.x);
            pg8::EpiAin E{ZA, VSTAT, QMB, ap->in[I_MEMQG] + L * HD, (LAS float*)(F.lds + EX_OFF), fill_rstd(F, SS, So)};
            pg8::gemm_phase<pg8::EpiAin, pg8::StaticOrder, true, true, true, true>(F.lds + RING_OFF, g, So, E);
            if constexpr (L == 0) {
                if ((int)blockIdx.x >= 128) { pg8::Gemm gm{MEMN, Wmem, 4096, 4096, DM}; pg8::MemKvOrder Sm{F.G, (int)blockIdx.x - 128};
                    pg8::EpiMemKv Em{MK, MV, ap->in[I_MEMKG], (LAS float*)(F.lds + EX_OFF)};
                    pg8::gemm_phase<pg8::EpiMemKv, pg8::MemKvOrder, true, true, false, true>(F.lds + RING_OFF, gm, Sm, Em); } } }
        else { pg8::Gemm g{XB, Wbin + (size_t)(L - NA) * NBIN * DM, M, NBIN, DM}; pg8::StaticOrder So; So.init(M, NBIN, F.G, (int)blockIdx.x);
            pg8::EpiQKRope E{0, QB_, QMB, ap->in[I_BQG] + (L - NA) * HD, ap->in[I_MEMQG] + L * HD, CS, (LAS float*)(F.lds + EX_OFF), fill_rstd(F, SS, So)};
            pg8::gemm_phase<pg8::EpiQKRope, pg8::StaticOrder, true, true, true, true>(F.lds + RING_OFF, g, So, E); }
        if constexpr (L == 1 || (L >= NA && DYN_ATTN)) SEAM_L(pb + 2); else SEAM(pb + 2);
        if constexpr (L >= NA) { if (DYN_ATTN && IN(pb + 3)) PUBLISH_FLAG(CW_RQ, (unsigned)L); }
    }
    if (SITE(8) && IN(pb + 3)) { constexpr int CUR_SITE = 8; (void)CUR_SITE; SITE_T0 WS_PTRS
        if constexpr (L < NA) gmlp_phase(F, ZA, VSTAT, ap->in[I_AWS] + (size_t)L * GG * 128 * 128, ap->in[I_ABS] + (size_t)L * GG * 128, ap->in[I_AVG] + (size_t)L * MIXW, CAT);
        { const int xg = (int)blockIdx.x & 7, jg = (int)blockIdx.x >> 3, pnl = 8 * xg + (jg >> 2);
          const int c0 = ((L < NA || DYN_ATTN) && F.G == 256) ? (((pnl >> 4) * 4 + (jg & 3)) * 16 + (pnl & 15)) : F.vcu;
          att::mem_attn_phase((char*)smem, (const att::bf16*)QMB, (const att::bf16*)(MK + (size_t)L * 1024 * 512), (const att::bf16*)(MV + (size_t)L * 1024 * 512), (att::bf16*)CAT, F.G, c0); }
        if constexpr (L >= NA) {
            float* const Ol = OATT + (size_t)(L - NA) * 96 * SEQ * 128;
            if (DYN_ATTN) { const att::DynAttn C{(unsigned*)F.ctl + CW_QCNT + 64 * 4 * (L - NA), (const unsigned*)F.ctl + CW_RQ, (const unsigned*)F.ctl + CW_RKV, (unsigned)L, (unsigned*)F.ctl + XB_TMO, F.MISC + 28};
                att::diff_attn_dyn_phase((char*)smem, (const att::bf16*)QB_, (const att::bf16*)KSH, (const att::bf16*)VSH, Ol, C, ((int)blockIdx.x & 7) >> 1); }
            else if (ATTN2) att::diff_attn2_phase((char*)smem, (float*)(smem + 133120), (const att::bf16*)QB_, (const att::bf16*)KSH, (const att::bf16*)VSH, Ol, F.G, F.vcu);
            else att::diff_attn_phase((char*)smem, (const att::bf16*)QB_, (const att::bf16*)KSH, (const att::bf16*)VSH, Ol, F.G, F.vcu);
        }
        if constexpr (L < NA) SEAM_L(pb + 3); else SEAM(pb + 3);
    }
    if constexpr (L >= NA) {
        if (SITE(9) && IN(pb + 4)) { constexpr int CUR_SITE = 9; (void)CUR_SITE; SITE_T0 WS_PTRS constexpr float lam_init = (L == 2) ? 0.47071301834358416f : 0.5560582041556405f;
            combine_phase(F, OATT + (size_t)(L - NA) * 96 * SEQ * 128, ap->in[I_BLAM] + (size_t)(L - NA) * 512, ap->in[I_BSUBG] + (size_t)(L - NA) * DV, lam_init, CAT);
            SEAM_L(pb + 4); }
    }
    if (SITE(10) && IN(pb + 5)) { constexpr int CUR_SITE = 10; (void)CUR_SITE; SITE_T0 WS_PTRS
        pg8::Gemm g{CAT, Wout + (size_t)L * DM * DM, M, DM, DM}; pg8::ColSweepOrder So{(int)blockIdx.x};
        pg8::EpiResid E{nullptr, nullptr, DM, 1.0f, XB, SS, XH};
        pg8::gemm_phase<pg8::EpiResid, pg8::ColSweepOrder, true, true, false, true>(F.lds + RING_OFF, g, So, E);
        SEAM_L(pb + 5);
    }
}

__global__ void __launch_bounds__(NWAVES * 64, 2) yoco_fwd(Args args) {
    extern __shared__ __attribute__((aligned(16))) unsigned char smem[];
    Frame F;
    F.lds_g = smem; F.lds = (LAS unsigned char*)smem;
    F.MISC = (volatile LAS unsigned*)(F.lds + MISC_OFF);
    F.tid = threadIdx.x; F.lane = F.tid & 63; F.wave = __builtin_amdgcn_readfirstlane(F.tid >> 6);
    F.G = gridDim.x; { const int bx = blockIdx.x; F.vcu = (F.G % 8 == 0) ? (bx % 8) * (F.G / 8) + bx / 8 : bx; }
    F.ws = args.ws;
    F.ctl = (gu32*)(args.ws + WS_CTL);
    for (int u = F.tid; u < (LDS_BYTES - LDSCTL_OFF) / 4; u += NWAVES * 64) ((LAS unsigned*)(F.lds + LDSCTL_OFF))[u] = 0u;
    __syncthreads();
    XcdBarrier bar = xcd_barrier_post((unsigned*)F.ctl + (size_t)args.li * XCD_BAR_WORDS, F.MISC + 8);
    if (F.tid == 0) __hip_atomic_store((unsigned*)F.ctl + XB_XCCTAB + blockIdx.x, bar.x + 1u, __ATOMIC_RELAXED, __HIP_MEMORY_SCOPE_AGENT);
    const int lo = args.ph_lo, hi = args.ph_hi;
    {
    const int gw = F.vcu * NWAVES + F.wave, NGW = F.G * NWAVES;
    if (SITE(0) && IN(0)) { constexpr int CUR_SITE = 0; (void)CUR_SITE; SITE_T0 WS_PTRS
        LAS float* scr = (LAS float*)(F.lds + RING_OFF + F.wave * 16640);
        constexpr int NIT = 8 * (DM / 64) * (NGU / 64) + 8 * (FF / 64) * (DM / 64) + 4 * 32 * 32 + 4 * 32 * 16 + 2 * 32 * (NAIN / 64) + 32 * (NKV / 64) + 2 * 32 * 32;
        for (int it = gw; it < NIT; it += NGW) { int r = it;
            if (transpose_group(r, ap->in[I_WGU], 8, DM, NGU, Wgu, true, scr, F.lane, ap->in[I_NORMG], 1)) continue;
            if (transpose_group(r, ap->in[I_WDN], 8, FF, DM, Wdn, false, scr, F.lane, nullptr, 0)) continue;
            if (transpose_group(r, ap->in[I_WOUT], 4, DM, DM, Wout, false, scr, F.lane, nullptr, 0)) continue;
            if (transpose_group(r, ap->in[I_MEMWKV], 4, DM, 1024, Wmem, false, scr, F.lane, nullptr, 0)) continue;
            if (transpose_group(r, ap->in[I_AWIN], 2, DM, NAIN, Wain, false, scr, F.lane, ap->in[I_NORMG], 2)) continue;
            if (transpose_group(r, ap->in[I_WKV], 1, DM, NKV, Wkv, false, scr, F.lane, ap->in[I_KVG], 0)) continue;
            transpose_group(r, ap->in[I_BWIN], 2, DM, NBIN, Wbin, false, scr, F.lane, ap->in[I_NORMG], 4); }
        for (int i = gw * 64 + F.lane; i < SEQ * 64; i += NGW * 64) { const int pos = i >> 6, k = i & 63; const float inv = (float)pow(10000.0, -(double)k / 64.0); const float ang = (float)pos * inv;
            float sn, cs; sincos_d(ang, sn, cs); typedef _Float16 h2 __attribute__((ext_vector_type(2))); h2 t; t.x = (_Float16)cs; t.y = (_Float16)sn; CS[i] = __builtin_bit_cast(unsigned, t); }
        for (int r = gw; r < 4096; r += NGW) { const int l = r >> 10, mm = r & 1023; norm_row(ap->in[I_MEM] + (size_t)mm * DM, ap->in[I_MEMNG] + l * DM, MEMN + (size_t)r * DM, F.lane); }
        xb_ss_phase(F, ap->in[I_X], XB, SS);
        SEAM(0);
        if (LOCAL_SEAMS && IN(1)) { if (F.tid < 64) { bool ok = F.G == 256; unsigned mine[4];
#pragma unroll
                for (int q = 0; q < 4; ++q) { const unsigned i = F.tid + 64 * q; mine[q] = __hip_atomic_load((unsigned*)F.ctl + XB_XCCTAB + i, __ATOMIC_RELAXED, __HIP_MEMORY_SCOPE_AGENT);
                    const unsigned rep = __hip_atomic_load((unsigned*)F.ctl + XB_XCCTAB + (i & 7u), __ATOMIC_RELAXED, __HIP_MEMORY_SCOPE_AGENT); ok = ok && mine[q] != 0u && mine[q] == rep; }
                if (F.tid < 8) { for (unsigned o = 0; o < 8; ++o) { const unsigned other = __hip_atomic_load((unsigned*)F.ctl + XB_XCCTAB + o, __ATOMIC_RELAXED, __HIP_MEMORY_SCOPE_AGENT); ok = ok && (o == (unsigned)F.tid || other != mine[0]); } }
                ok = __all(ok); if (F.tid == 0) F.MISC[24] = ok ? 1u : 0u; }
            __syncthreads(); }
    }
    }
    ffn_part<0, 0>(F, bar, smem, lo, hi); mixer_part<0>(F, bar, smem, lo, hi); ffn_part<0, 1>(F, bar, smem, lo, hi);
    ffn_part<1, 0>(F, bar, smem, lo, hi); mixer_part<1>(F, bar, smem, lo, hi); ffn_part<1, 1>(F, bar, smem, lo, hi);
    ffn_part<2, 0>(F, bar, smem, lo, hi); mixer_part<2>(F, bar, smem, lo, hi); ffn_part<2, 1>(F, bar, smem, lo, hi);
    ffn_part<3, 0>(F, bar, smem, lo, hi); mixer_part<3>(F, bar, smem, lo, hi); ffn_part<3, 1>(F, bar, smem, lo, hi);
    if (PROBE_PHASE) { if (blockIdx.x == 0 && F.tid == 0) { const unsigned long long tot = F.MISC[17], t0 = __builtin_amdgcn_s_memrealtime(); while (__builtin_amdgcn_s_memrealtime() - t0 < tot) __builtin_amdgcn_s_sleep(8); } }
#ifdef PROBE_LOCALOK
    if (blockIdx.x == 0 && F.tid == 0 && F.MISC[24] != 0u) { const unsigned long long t0 = __builtin_amdgcn_s_memrealtime(); while (__builtin_amdgcn_s_memrealtime() - t0 < 50000ull) __builtin_amdgcn_s_sleep(8); }
#endif
    if (PROBE_WAIT) {
        unsigned* sumw = (unsigned*)F.ctl + 65536;
        if (F.tid == 0) __hip_atomic_fetch_add(sumw, F.MISC[16], __ATOMIC_RELAXED, __HIP_MEMORY_SCOPE_AGENT);
        xcd_barrier(bar);
        if (blockIdx.x == 0 && F.tid == 0) { const unsigned tot = __hip_atomic_load(sumw, __ATOMIC_RELAXED, __HIP_MEMORY_SCOPE_AGENT); const unsigned long long avg = tot / gridDim.x, t0 = __builtin_amdgcn_s_memrealtime();
            while (__builtin_amdgcn_s_memrealtime() - t0 < avg) __builtin_amdgcn_s_sleep(8); }
    }
}
#undef IN
#undef SEAM

#ifndef MK_MODE
#define MK_MODE 1
#endif
extern "C" void kernel_launch(void* const* d_in, const int* in_sizes, int n_in, void* d_out, int out_size, void* d_ws, size_t ws_size, hipStream_t stream) {
    static int grid = 0;
    if (grid == 0) {
        if (n_in != N_IN || out_size != M * DM || ws_size < WS_END) { fprintf(stderr, "kernel_launch: unexpected shapes: n_in %d out %d ws %zu (need %zu)\n", n_in, out_size, ws_size, (size_t)WS_END); grid = -1; return; }
        int dev = 0, cus = 0, per_cu = 0;
        if (hipGetDevice(&dev) != hipSuccess || hipDeviceGetAttribute(&cus, hipDeviceAttributeMultiprocessorCount, dev) != hipSuccess) { grid = -1; return; }
        if (hipFuncSetAttribute((const void*)yoco_fwd, hipFuncAttributeMaxDynamicSharedMemorySize, LDS_BYTES) != hipSuccess) { fprintf(stderr, "kernel_launch: hipFuncSetAttribute failed\n"); grid = -1; return; }
        if (hipOccupancyMaxActiveBlocksPerMultiprocessor(&per_cu, (const void*)yoco_fwd, NWAVES * 64, LDS_BYTES) != hipSuccess || per_cu < 1) fprintf(stderr, "kernel_launch: occupancy query says %d blocks per CU\n", per_cu);
        (void)hipGetLastError();
        grid = cus;
        if (cus != 256) { fprintf(stderr, "kernel_launch: built for a 256-CU device (got %d)\n", cus); grid = -1; return; }
    }
    if (grid < 0) return;
    (void)in_sizes;
    if (hipMemsetAsync((char*)d_ws + WS_CTL, 0, CTL_ZERO_BYTES, stream) != hipSuccess) return;
    Args a{};
    for (int i = 0; i < N_IN; ++i) a.in[i] = (const float*)d_in[i];
    a.out = (float*)d_out; a.ws = (unsigned char*)d_ws; a.pad = 0;
#if MK_MODE == 1
    a.ph_lo = 0; a.ph_hi = NPH; a.li = 0;
    hipLaunchKernelGGL(yoco_fwd, dim3(grid), dim3(NWAVES * 64), LDS_BYTES, stream, a);
#else
    for (int p = 0; p < NPH; ++p) {
        const int k = (p - PH_BASE) % NPL, l = (p - PH_BASE) / NPL;
        if (p >= PH_BASE && (k == 4 && l < NA)) continue;
        a.ph_lo = p; a.ph_hi = p + 1; a.li = 0;
        hipLaunchKernelGGL(yoco_fwd, dim3(grid), dim3(NWAVES * 64), LDS_BYTES, stream, a);
    }
#endif
}
```

```cpp
#include <hip/hip_runtime.h>
#include <hip/hip_bf16.h>
#include <cstdio>
#include <cstdint>

constexpr int BATCH = 4, SEQ = 4096, DM = 2048, DEPTH = 4, NA = 2;
constexpr int M = BATCH * SEQ;
constexpr int MEML = 256, HD = 128, MEMH = 4, MEMW = 512, MIXW = 1536, CHUNK = 128, GG = 6, GW = 256, DH = 6, DV = 256, FF = 5632;
constexpr int NGU = 2 * FF;
constexpr int NAIN = 2 * MIXW + MEMW;
constexpr int NBIN = MIXW + MEMW;
constexpr int NKV = 2 * DH * HD + DH * DV;
constexpr float EPS = 1e-6f;
namespace pg8 {
#define PG8_LAS __attribute__((address_space(3)))
typedef unsigned short bf16_t;
typedef short bf16x8 __attribute__((ext_vector_type(8)));
typedef float f32x4 __attribute__((ext_vector_type(4)));
typedef unsigned u32x4 __attribute__((ext_vector_type(4)));
constexpr int BM = 256, BK = 64, HALF = 128, HTB = HALF * BK * 2  , STAGE_BYTES = 8 * HTB, NXCD = 8, WGM = 8;

__host__ __device__ __forceinline__ int lds_byte(int r, int c) { const int st = (r >> 4) * 2 + (c >> 5), rr = r & 15, cc = c & 31, ob = rr * 64 + cc * 2; return st * 1024 + (ob ^ (((ob >> 9) & 1) << 5)); }
__host__ __device__ __forceinline__ void stage_rc(int b, int& R, int& C) { const int st = b / 1024, sb = b % 1024, swz = sb ^ (((sb >> 9) & 1) << 5); R = (st >> 1) * 16 + swz / 64; C = (st & 1) * 32 + (swz % 64) / 2; }
__host__ __device__ __forceinline__ int perm32(int rho) { const int n = rho >> 4, i = rho & 15; return 8 * (i >> 2) + 4 * n + (i & 3); }

struct Unit { int pm, pn; };
struct Gemm { const bf16_t* A; const bf16_t* Bt; int M, N, K; };

struct StaticOrder {
    int nM, nN, nwg, G, c;
    __host__ __device__ void init(int M, int N, int G_, int c_) { nM = M / BM; nN = N / BM; nwg = nM * nN; G = G_; c = c_; }
    __host__ __device__ bool next(int i, Unit& u) const {
        const long L = (long)i * G + c; if (L >= nwg) return false;
        int wgid = (int)L; { const int q = nwg / NXCD, r = nwg % NXCD, xcd = wgid % NXCD, off = wgid / NXCD; wgid = (xcd < r ? xcd * (q + 1) : r * (q + 1) + (xcd - r) * q) + off; }
        const int nig = WGM * nN, gid = wgid / nig, fm = gid * WGM, gsz = (nM - fm) < WGM ? (nM - fm) : WGM;
        u.pm = fm + ((wgid % nig) % gsz); u.pn = (wgid % nig) / gsz; return true;
    }
    __device__ __forceinline__ void a_ready(const Unit&) const {}
    __device__ __forceinline__ void done(const Unit&) const {}
};
__device__ __forceinline__ unsigned cvt_pk_bf16(float lo, float hi) { unsigned r; asm volatile("v_cvt_pk_bf16_f32 %0, %1, %2" : "=v"(r) : "v"(lo), "v"(hi)); return r; }
typedef float f32x2 __attribute__((ext_vector_type(2)));
typedef unsigned u32x2 __attribute__((ext_vector_type(2)));
__device__ __forceinline__ f32x2 gelu_pk(f32x2 v) {
    const f32x2 av = __builtin_elementwise_abs(v), d = av * 0.2316418882f + 1.0f;
    f32x2 t; t.x = __builtin_amdgcn_rcpf(d.x); t.y = __builtin_amdgcn_rcpf(d.y);
    f32x2 q = t * 0.5307027145f + (-0.7265760135f); q = q * t + 0.7107068705f; q = q * t + (-0.142248368f); q = q * t + 0.127414796f; q = q * t;
    const f32x2 s = (v * v) * (-0.72134752044f);
    f32x2 e; e.x = __builtin_amdgcn_exp2f(s.x); e.y = __builtin_amdgcn_exp2f(s.y);
    const f32x2 m = v * (q * e), r = v - m;
    f32x2 o; o.x = v.x < 0.f ? m.x : r.x; o.y = v.y < 0.f ? m.y : r.y; return o;
}
__device__ __forceinline__ float silu_f(float g) { return g * __builtin_amdgcn_rcpf(1.0f + __builtin_amdgcn_exp2f(-1.4426950408889634f * g)); }
__device__ __forceinline__ u32x4 pack8_bf16(f32x4 a, f32x4 b) { u32x4 w; w.x = cvt_pk_bf16(a[0], a[1]); w.y = cvt_pk_bf16(a[2], a[3]); w.z = cvt_pk_bf16(b[0], b[1]); w.w = cvt_pk_bf16(b[2], b[3]); return w; }

__host__ __device__ __forceinline__ size_t blk_off(int row, int col, int kt) { return ((size_t)((row >> 8) * kt + (col >> 6)) << 14) + ((row & 255) << 6) + (col & 63); }
struct RowScale { const PG8_LAS float* rtab; };
__device__ __forceinline__ void get_rstd(float (&rs)[2][4], const RowScale& R, int wr, int fr) {
#pragma unroll
    for (int ai = 0; ai < 2; ++ai)
#pragma unroll
        for (int m = 0; m < 4; ++m) rs[ai][m] = R.rtab ? R.rtab[2 * (ai * HALF + wr * 64 + m * 16 + fr)] : 1.0f;
}
struct EpiSwiglu {
    static constexpr bool PERM = true, AFTER_DRAIN = false;
    static __host__ __device__ __forceinline__ int bmap(int R) { return (R & ~31) + perm32(R & 31); }
    bf16_t* H; int ldh; RowScale R;
    __device__ __forceinline__ void operator()(const f32x4 (&acc)[2][2][4][2], const Unit& u, int wr, int wc, int fr, int fq) const {
        const int row0 = u.pm * BM + wr * 64 + fr, col0 = u.pn * HALF + wc * 32 + 8 * fq;
#pragma unroll
        for (int ai = 0; ai < 2; ++ai)
#pragma unroll
            for (int m = 0; m < 4; ++m) { const f32x2 rv = *(const PG8_LAS f32x2*)(R.rtab + 2 * (ai * HALF + wr * 64 + m * 16 + fr)); const float c1 = -1.4426950408889634f * rv.x, v = rv.y;
                const f32x4 g0 = acc[ai][0][m][0], g1 = acc[ai][0][m][1], u0 = acc[ai][1][m][0], u1 = acc[ai][1][m][1];
                f32x4 h0, h1;
#pragma unroll
                for (int j = 0; j < 4; ++j) { const float e0 = __builtin_amdgcn_exp2f(g0[j] * c1), e1 = __builtin_amdgcn_exp2f(g1[j] * c1);
                    h0[j] = (g0[j] * u0[j]) * __builtin_amdgcn_rcpf(__builtin_fmaf(e0, v, v)); h1[j] = (g1[j] * u1[j]) * __builtin_amdgcn_rcpf(__builtin_fmaf(e1, v, v)); }
                *(u32x4*)(H + blk_off(row0 + ai * HALF + m * 16, col0, ldh >> 6)) = pack8_bf16(h0, h1);
            }
    }
};
struct EpiResid {
    static constexpr bool PERM = true, AFTER_DRAIN = false;
    static __host__ __device__ __forceinline__ int bmap(int R) { return (R & ~31) + perm32(R & 31); }
    const float* base_f32; float* out_f32; int ld; float scale; bf16_t* xb; float* ss; _Float16* xh;
    typedef _Float16 h8 __attribute__((ext_vector_type(8)));
    static __device__ __forceinline__ void one(const f32x4 b0, const f32x4 b1, const f32x4 a0, const f32x4 a1, int row, int col, size_t off, float& s, float scale, float* out_f32, _Float16* xh, bf16_t* xb, int ld) {
        const f32x4 o0 = b0 + a0 * scale, o1 = b1 + a1 * scale;
        if (out_f32) { *(f32x4*)(out_f32 + off) = o0; *(f32x4*)(out_f32 + off + 4) = o1; }
        else { h8 w; w[0] = (_Float16)o0[0]; w[1] = (_Float16)o0[1]; w[2] = (_Float16)o0[2]; w[3] = (_Float16)o0[3]; w[4] = (_Float16)o1[0]; w[5] = (_Float16)o1[1]; w[6] = (_Float16)o1[2]; w[7] = (_Float16)o1[3];
            *(h8*)(xh + off) = w;
            *(u32x4*)(xb + blk_off(row, col, ld >> 6)) = pack8_bf16(o0, o1);
            s += ((o0[0] * o0[0] + o0[1] * o0[1]) + (o0[2] * o0[2] + o0[3] * o0[3])) + ((o1[0] * o1[0] + o1[1] * o1[1]) + (o1[2] * o1[2] + o1[3] * o1[3])); }
    }
    __device__ __forceinline__ void operator()(const f32x4 (&acc)[2][2][4][2], const Unit& u, int wr, int wc, int fr, int fq) const {
        const int row0 = u.pm * BM + wr * 64 + fr, col0 = u.pn * BM + wc * 32 + 8 * fq;
        const float scale_ = scale; float* const out_ = out_f32; _Float16* const xh_ = xh; bf16_t* const xb_ = xb; const int ld_ = ld;
        if (base_f32) {
#pragma unroll
            for (int ai = 0; ai < 2; ++ai)
#pragma unroll
                for (int m = 0; m < 4; ++m) { const int row = row0 + ai * HALF + m * 16; const size_t off = (size_t)row * ld + col0; float s = 0.f;
#pragma unroll
                    for (int bj = 0; bj < 2; ++bj) one(*(const f32x4*)(base_f32 + off + bj * HALF), *(const f32x4*)(base_f32 + off + bj * HALF + 4), acc[ai][bj][m][0], acc[ai][bj][m][1], row, col0 + bj * HALF, off + bj * HALF, s, scale_, out_, xh_, xb_, ld_);
                    if (!out_f32) { s += __shfl_xor(s, 16); s += __shfl_xor(s, 32); if (fq == 0) ss[(size_t)row * 32 + u.pn * 4 + wc] = s; }
                    asm volatile("" ::: "memory"); }
            return;
        }
#pragma unroll
        for (int ai = 0; ai < 2; ++ai) {
            h8 w[4][2];
#pragma unroll
            for (int m = 0; m < 4; ++m)
#pragma unroll
                for (int bj = 0; bj < 2; ++bj) w[m][bj] = *(const h8*)(xh + (size_t)(row0 + ai * HALF + m * 16) * ld + col0 + bj * HALF);
#pragma unroll
            for (int m = 0; m < 4; ++m) { const int row = row0 + ai * HALF + m * 16; const size_t off = (size_t)row * ld + col0; float s = 0.f;
#pragma unroll
                for (int bj = 0; bj < 2; ++bj) { const h8 v = w[m][bj];
                    one((f32x4){(float)v[0], (float)v[1], (float)v[2], (float)v[3]}, (f32x4){(float)v[4], (float)v[5], (float)v[6], (float)v[7]}, acc[ai][bj][m][0], acc[ai][bj][m][1], row, col0 + bj * HALF, off + bj * HALF, s, scale_, out_, xh_, xb_, ld_); }
                if (!out_f32) { s += __shfl_xor(s, 16); s += __shfl_xor(s, 32); if (fq == 0) ss[(size_t)row * 32 + u.pn * 4 + wc] = s; } }
            asm volatile("" ::: "memory");
        }
    }
};
__device__ __forceinline__ void head_ss_put(PG8_LAS float* ex, int rl, int bj, int wc, int fq, float s) { s += __shfl_xor(s, 16); s += __shfl_xor(s, 32); if (fq == 0) ex[(rl * 2 + bj) * 4 + wc] = s; }
__device__ __forceinline__ float head_rstd_get(const PG8_LAS float* ex, int rl, int bj) { const f32x4 p = *(const PG8_LAS f32x4*)(ex + (rl * 2 + bj) * 4); return 1.0f / sqrtf(((p[0] + p[1]) + (p[2] + p[3])) * (1.0f / 128.0f) + 1e-6f); }
#define PG8_EPI_BARRIER() do { asm volatile("s_waitcnt lgkmcnt(0)" ::: "memory"); __builtin_amdgcn_s_barrier(); asm volatile("" ::: "memory"); } while (0)
struct EpiAin {
    static constexpr bool PERM = true, AFTER_DRAIN = false;
    static __host__ __device__ __forceinline__ int bmap(int R) { return (R & ~31) + perm32(R & 31); }
    bf16_t* ZA; float* vstat; bf16_t* qmb; const float* gq; PG8_LAS float* ex; RowScale R;
    __device__ __forceinline__ void operator()(const f32x4 (&acc)[2][2][4][2], const Unit& u, int wr, int wc, int fr, int fq) const {
        const int row0 = u.pm * BM + wr * 64 + fr;
        float rs[2][4]; get_rstd(rs, R, wr, fr);
        if (u.pn < 12) {
            const int col0 = u.pn * BM + wc * 32 + 8 * fq; const bool st = u.pn >= 6;
#pragma unroll
            for (int ai = 0; ai < 2; ++ai)
#pragma unroll
                for (int m = 0; m < 4; ++m) { const int row = row0 + ai * HALF + m * 16; float sq = 0.f;
#pragma unroll
                    for (int bj = 0; bj < 2; ++bj) { f32x4 v0 = acc[ai][bj][m][0] * rs[ai][m], v1 = acc[ai][bj][m][1] * rs[ai][m];
                        f32x2 a = gelu_pk((f32x2){v0[0], v0[1]}), b = gelu_pk((f32x2){v0[2], v0[3]}), c = gelu_pk((f32x2){v1[0], v1[1]}), d = gelu_pk((f32x2){v1[2], v1[3]});
                        v0 = (f32x4){a.x, a.y, b.x, b.y}; v1 = (f32x4){c.x, c.y, d.x, d.y};
                        sq += (v0[0] * v0[0] + v0[1] * v0[1]) + (v0[2] * v0[2] + v0[3] * v0[3]) + (v1[0] * v1[0] + v1[1] * v1[1]) + (v1[2] * v1[2] + v1[3] * v1[3]);
                        *(u32x4*)(ZA + (size_t)row * 3072 + col0 + bj * HALF) = pack8_bf16(v0, v1); }
                    if (st) { sq += __shfl_xor(sq, 16); sq += __shfl_xor(sq, 32); if (fq == 0) vstat[(size_t)row * 24 + (u.pn - 6) * 4 + wc] = sq; } }
        } else {
            const int d0 = wc * 32 + 8 * fq; const f32x4 g0 = *(const f32x4*)(gq + d0), g1 = *(const f32x4*)(gq + d0 + 4);
#pragma unroll
            for (int ai = 0; ai < 2; ++ai)
#pragma unroll
                for (int m = 0; m < 4; ++m) { const int rl = ai * HALF + wr * 64 + m * 16 + fr;
#pragma unroll
                    for (int bj = 0; bj < 2; ++bj) { const f32x4 v0 = acc[ai][bj][m][0], v1 = acc[ai][bj][m][1];
                        head_ss_put(ex, rl, bj, wc, fq, (((v0[0] * v0[0] + v0[1] * v0[1]) + (v0[2] * v0[2] + v0[3] * v0[3])) + ((v1[0] * v1[0] + v1[1] * v1[1]) + (v1[2] * v1[2] + v1[3] * v1[3]))) * (rs[ai][m] * rs[ai][m])); } }
            PG8_EPI_BARRIER();
#pragma unroll
            for (int ai = 0; ai < 2; ++ai)
#pragma unroll
                for (int m = 0; m < 4; ++m) { const int rl = ai * HALF + wr * 64 + m * 16 + fr, row = u.pm * BM + rl, b = row >> 12, s = row & 4095;
#pragma unroll
                    for (int bj = 0; bj < 2; ++bj) { const float sc = rs[ai][m] * head_rstd_get(ex, rl, bj); const int hm = (u.pn - 12) * 2 + bj;
                        *(u32x4*)(qmb + ((size_t)(b * 4 + hm) * 4096 + s) * 128 + d0) = pack8_bf16(acc[ai][bj][m][0] * sc * g0, acc[ai][bj][m][1] * sc * g1); } }
        }
    }
};
struct EpiF32Split {
    static constexpr bool PERM = true, AFTER_DRAIN = false;
    static __host__ __device__ __forceinline__ int bmap(int R) { return (R & ~31) + perm32(R & 31); }
    float* d0; int ld0; int split; float* d1; int ld1; int pnmod; RowScale R;
    __device__ __forceinline__ void operator()(const f32x4 (&acc)[2][2][4][2], const Unit& u, int wr, int wc, int fr, int fq) const {
        const int row0 = u.pm * BM + wr * 64 + fr; int pn = pnmod ? (u.pn % pnmod) : u.pn; float* d = d0; int ld = ld0;
        if (pn >= split) { d = d1; ld = ld1; pn -= split; }
        const int col0 = pn * BM + wc * 32 + 8 * fq;
        float rs[2][4]; get_rstd(rs, R, wr, fr);
#pragma unroll
        for (int ai = 0; ai < 2; ++ai)
#pragma unroll
            for (int m = 0; m < 4; ++m) { float* p = d + (size_t)(row0 + ai * HALF + m * 16) * ld + col0;
#pragma unroll
                for (int bj = 0; bj < 2; ++bj) { *(f32x4*)(p + bj * HALF) = acc[ai][bj][m][0] * rs[ai][m]; *(f32x4*)(p + bj * HALF + 4) = acc[ai][bj][m][1] * rs[ai][m]; } }
    }
};
struct EpiQKRope {
    static constexpr bool PERM = true, AFTER_DRAIN = false;
    static __host__ __device__ __forceinline__ int bmap(int R) { return 64 * ((R >> 4) & 1) + 16 * (R >> 5) + (R & 15); }
    int kind; bf16_t* qk; bf16_t* other; const float* gr; const float* gn; const unsigned* cs; PG8_LAS float* ex; RowScale R;
    __device__ __forceinline__ void operator()(const f32x4 (&acc)[2][2][4][2], const Unit& u, int wr, int wc, int fr, int fq) const {
        typedef _Float16 h2 __attribute__((ext_vector_type(2)));
        float rs[2][4]; get_rstd(rs, R, wr, fr);
        const int d0 = 16 * wc + 4 * fq;
        const bool rope = u.pn < 6;
        if (!rope && kind == 1) {
            const int h = u.pn - 6;
#pragma unroll
            for (int ai = 0; ai < 2; ++ai)
#pragma unroll
                for (int m = 0; m < 4; ++m) { const int row = u.pm * BM + ai * HALF + wr * 64 + m * 16 + fr, b = row >> 12, s = row & 4095;
#pragma unroll
                    for (int bj = 0; bj < 2; ++bj) { bf16_t* p = other + ((size_t)((b * 6 + h) * 2 + bj) * 4096 + s) * 128 + d0;
#pragma unroll
                        for (int n = 0; n < 2; ++n) { const f32x4 v = acc[ai][bj][m][n] * rs[ai][m]; u32x2 w; w.x = cvt_pk_bf16(v[0], v[1]); w.y = cvt_pk_bf16(v[2], v[3]); *(u32x2*)(p + 64 * n) = w; } } }
            return;
        }
        const float* g = rope ? gr : gn; const f32x4 ga = *(const f32x4*)(g + d0), gb = *(const f32x4*)(g + 64 + d0);
        u32x4 cst[2][4];
        if (rope) {
#pragma unroll
            for (int ai = 0; ai < 2; ++ai)
#pragma unroll
                for (int m = 0; m < 4; ++m) { const int s = (u.pm * BM + ai * HALF + wr * 64 + m * 16 + fr) & 4095; cst[ai][m] = *(const u32x4*)(cs + (size_t)s * 64 + d0); }
        }
#pragma unroll
        for (int ai = 0; ai < 2; ++ai)
#pragma unroll
            for (int m = 0; m < 4; ++m) { const int rl = ai * HALF + wr * 64 + m * 16 + fr;
#pragma unroll
                for (int bj = 0; bj < 2; ++bj) { const f32x4 v0 = acc[ai][bj][m][0], v1 = acc[ai][bj][m][1];
                    head_ss_put(ex, rl, bj, wc, fq, (((v0[0] * v0[0] + v0[1] * v0[1]) + (v0[2] * v0[2] + v0[3] * v0[3])) + ((v1[0] * v1[0] + v1[1] * v1[1]) + (v1[2] * v1[2] + v1[3] * v1[3]))) * (rs[ai][m] * rs[ai][m])); } }
        PG8_EPI_BARRIER();
#pragma unroll
        for (int ai = 0; ai < 2; ++ai)
#pragma unroll
            for (int m = 0; m < 4; ++m) { const int rl = ai * HALF + wr * 64 + m * 16 + fr, row = u.pm * BM + rl, b = row >> 12, s = row & 4095;
#pragma unroll
                for (int bj = 0; bj < 2; ++bj) { const float sc = rs[ai][m] * head_rstd_get(ex, rl, bj);
                    f32x4 y0 = acc[ai][bj][m][0] * sc * ga, y1 = acc[ai][bj][m][1] * sc * gb; bf16_t* p;
                    if (rope) { f32x4 o0, o1;
#pragma unroll
                        for (int j = 0; j < 4; ++j) { const unsigned cw = cst[ai][m][j]; const h2 t = __builtin_bit_cast(h2, cw); const float c = (float)t.x, sn = (float)t.y; o0[j] = y0[j] * c - y1[j] * sn; o1[j] = y1[j] * c + y0[j] * sn; }
                        y0 = o0; y1 = o1; p = qk + ((size_t)(b * 12 + u.pn * 2 + bj) * 4096 + s) * 128 + d0; }
                    else p = other + ((size_t)(b * 4 + (u.pn - 6) * 2 + bj) * 4096 + s) * 128 + d0;
                    u32x2 w0, w1; w0.x = cvt_pk_bf16(y0[0], y0[1]); w0.y = cvt_pk_bf16(y0[2], y0[3]); w1.x = cvt_pk_bf16(y1[0], y1[1]); w1.y = cvt_pk_bf16(y1[2], y1[3]);
                    *(u32x2*)p = w0; *(u32x2*)(p + 64) = w1; } }
    }
};
struct ColSweepOrder {
    int c;
    __device__ bool next(int i, Unit& u) const { if (i >= 2) return false; const int xcd = c & 7, j = c >> 3; u.pm = 8 * xcd + 4 * i + (j & 3); u.pn = j >> 2; return true; }
    __device__ __forceinline__ void a_ready(const Unit&) const {}
    __device__ __forceinline__ void done(const Unit&) const {}
};
struct EpiMemKv {
    static constexpr bool PERM = true, AFTER_DRAIN = false;
    static __host__ __device__ __forceinline__ int bmap(int R) { return (R & ~31) + perm32(R & 31); }
    bf16_t* mk; bf16_t* mv; const float* gk; PG8_LAS float* ex;
    __device__ __forceinline__ void operator()(const f32x4 (&acc)[2][2][4][2], const Unit& u, int wr, int wc, int fr, int fq) const {
        const int t = u.pn & 3, d0 = wc * 32 + 8 * fq; const size_t base = (size_t)u.pm * 4;
        if (t < 2) {
            const f32x4 g0 = *(const f32x4*)(gk + (u.pm >> 2) * 128 + d0), g1 = *(const f32x4*)(gk + (u.pm >> 2) * 128 + d0 + 4);
#pragma unroll
            for (int ai = 0; ai < 2; ++ai)
#pragma unroll
                for (int m = 0; m < 4; ++m) { const int rl = ai * HALF + wr * 64 + m * 16 + fr;
#pragma unroll
                    for (int bj = 0; bj < 2; ++bj) { const f32x4 v0 = acc[ai][bj][m][0], v1 = acc[ai][bj][m][1];
                        head_ss_put(ex, rl, bj, wc, fq, ((v0[0] * v0[0] + v0[1] * v0[1]) + (v0[2] * v0[2] + v0[3] * v0[3])) + ((v1[0] * v1[0] + v1[1] * v1[1]) + (v1[2] * v1[2] + v1[3] * v1[3]))); } }
            PG8_EPI_BARRIER();
#pragma unroll
            for (int ai = 0; ai < 2; ++ai)
#pragma unroll
                for (int m = 0; m < 4; ++m) { const int rl = ai * HALF + wr * 64 + m * 16 + fr;
#pragma unroll
                    for (int bj = 0; bj < 2; ++bj) { const float sc = head_rstd_get(ex, rl, bj);
                        *(u32x4*)(mk + ((base + t * 2 + bj) * 256 + rl) * 128 + d0) = pack8_bf16(acc[ai][bj][m][0] * sc * g0, acc[ai][bj][m][1] * sc * g1); } }
        } else {
#pragma unroll
            for (int ai = 0; ai < 2; ++ai)
#pragma unroll
                for (int m = 0; m < 4; ++m) { const int rl = ai * HALF + wr * 64 + m * 16 + fr;
#pragma unroll
                    for (int bj = 0; bj < 2; ++bj) *(u32x4*)(mv + ((base + (t - 2) * 2 + bj) * 256 + rl) * 128 + d0) = pack8_bf16(acc[ai][bj][m][0], acc[ai][bj][m][1]); }
        }
    }
};
struct MemKvOrder {
    int G, c;
    __device__ bool next(int i, Unit& u) const { const int L = i * G + c; if (L >= 64) return false; const int layer = L >> 4, r = L & 15; u.pm = layer * 4 + (r >> 2); u.pn = layer * 4 + (r & 3); return true; }
    __device__ __forceinline__ void a_ready(const Unit&) const {}
    __device__ __forceinline__ void done(const Unit&) const {}
};
template <class Epi, class Sched, bool ALIGN_EPI = false, bool SP2 = false, bool ABLK = false, bool BBLK = false>
__device__ __forceinline__ void gemm_phase(PG8_LAS unsigned char* lds, const Gemm g, const Sched& S, const Epi& E) {
    int tid_ = threadIdx.x; asm volatile("" : "+v"(tid_));
    const int tid = tid_, wid = __builtin_amdgcn_readfirstlane(tid >> 6), lane = tid & 63, wr = wid >> 2, wc = wid & 3, fr = lane & 15, fq = lane >> 4;
    const int K = g.K, nt = K / BK;
    unsigned voffA[2], voffB[2];
#pragma unroll
    for (int i = 0; i < 2; ++i) { int R, C; stage_rc(tid * 16 + i * 8192, R, C); const int Rb = Epi::bmap(R);
        voffA[i] = ABLK ? (unsigned)(R * BK + C) * 2u : (unsigned)(R * K + C) * 2u; voffB[i] = BBLK ? (unsigned)(Rb * BK + C) * 2u : (unsigned)(Rb * K + C) * 2u; }
    const size_t kstepA = ABLK ? (size_t)(BM * BK * 2) : (size_t)(BK * 2), kstepB = BBLK ? (size_t)(BM * BK * 2) : (size_t)(BK * 2);
    const size_t hstepA = ABLK ? (size_t)(HALF * BK * 2) : (size_t)HALF * K * 2, hstepB = BBLK ? (size_t)(HALF * BK * 2) : (size_t)HALF * K * 2;
    const size_t tstep = (size_t)BM * K * 2;
#ifndef PG8_PF
#define PG8_PF 0
#endif
    PG8_LAS unsigned* const pfjunk = (PG8_LAS unsigned*)(lds + 143360 + wid * 256);
    const unsigned ldsw = (unsigned)wid * 1024u;
    const int aoff = lds_byte(wr * 64 + fr, fq * 8), boff = lds_byte(wc * 32 + fr, fq * 8);
#define PG8_SA(b, h) (((b) * 2 + (h)) * HTB)
#define PG8_SB(b, h) ((4 + (b) * 2 + (h)) * HTB)
#define PG8_STAGE(bufoff, gbase, voff) do { _Pragma("unroll") for (int _i = 0; _i < 2; ++_i) \
        __builtin_amdgcn_global_load_lds((const unsigned*)((const char*)(gbase) + (voff)[_i]), (PG8_LAS unsigned*)(lds + (bufoff) + ldsw + _i * 8192), 16, 0, 0); } while (0)
#define PG8_LDA(dst, b, h) do { _Pragma("unroll") for (int m = 0; m < 4; ++m) _Pragma("unroll") for (int k = 0; k < 2; ++k) dst[m][k] = *(const PG8_LAS bf16x8*)(lds + PG8_SA(b, h) + aoff + m * 2048 + k * 1024); } while (0)
#define PG8_LDB(dst, b, h) do { _Pragma("unroll") for (int n = 0; n < 2; ++n) _Pragma("unroll") for (int k = 0; k < 2; ++k) dst[n][k] = *(const PG8_LAS bf16x8*)(lds + PG8_SB(b, h) + boff + n * 2048 + k * 1024); } while (0)
#define PG8_MMA(ai, bj, At, Bt) do { __builtin_amdgcn_s_setprio(1); _Pragma("unroll") for (int m = 0; m < 4; ++m) _Pragma("unroll") for (int n = 0; n < 2; ++n) _Pragma("unroll") for (int k = 0; k < 2; ++k) \
        acc[ai][bj][m][n] = __builtin_amdgcn_mfma_f32_16x16x32_bf16(Bt[n][k], At[m][k], acc[ai][bj][m][n], 0, 0, 0); __builtin_amdgcn_s_setprio(0); } while (0)
#define PG8_WAIT_V(n) asm volatile("s_waitcnt vmcnt(" #n ")" ::: "memory")
#define PG8_WAIT_LOOP() do { if (PG8_PF) asm volatile("s_waitcnt vmcnt(9)" ::: "memory"); else asm volatile("s_waitcnt vmcnt(8)" ::: "memory"); } while (0)
#define PG8_PREFETCH(tp) do { if (PG8_PF) { const int tp_ = (tp); const char* pb_ = (wid < 4) ? (tp_ < nt ? cA + (size_t)tp_ * kstepA : nA + (size_t)(tp_ - nt) * kstepA) : (tp_ < nt ? cB + (size_t)tp_ * kstepB : nB + (size_t)(tp_ - nt) * kstepB); \
        const unsigned ln_ = __builtin_amdgcn_mbcnt_hi(~0u, __builtin_amdgcn_mbcnt_lo(~0u, 0u)) + (unsigned)(wid & 3) * 64u; const unsigned pfl_ = ln_ * ((wid < 4) ? (ABLK ? 128u : (unsigned)K * 2u) : (BBLK ? 128u : (unsigned)K * 2u)); \
        __builtin_amdgcn_global_load_lds((const unsigned*)(pb_ + pfl_), pfjunk, 4, 0, 0); } } while (0)
#define PG8_WAIT_L(n) asm volatile("s_waitcnt lgkmcnt(" #n ")" ::: "memory")
#define PG8_BAR __builtin_amdgcn_s_barrier()
#define PG8_SCHED __builtin_amdgcn_sched_barrier(0)
    Unit cur, nxt; int ui = 0;
    if (!S.next(0, cur)) return;
    f32x4 acc[2][2][4][2];
#pragma unroll
    for (int a = 0; a < 2; ++a)
#pragma unroll
        for (int b = 0; b < 2; ++b)
#pragma unroll
            for (int m = 0; m < 4; ++m)
#pragma unroll
                for (int n = 0; n < 2; ++n) acc[a][b][m][n] = (f32x4){0.f, 0.f, 0.f, 0.f};
    bf16x8 At[4][2], B0[2][2], B1[2][2];
    const char* cA = (const char*)g.A + (size_t)cur.pm * tstep; const char* cB = (const char*)g.Bt + (size_t)cur.pn * tstep;
    S.a_ready(cur);
    if constexpr (SP2) {
        PG8_STAGE(PG8_SB(0, 0), cB, voffB); PG8_STAGE(PG8_SB(0, 1), cB + hstepB, voffB); PG8_STAGE(PG8_SA(0, 0), cA, voffA); PG8_STAGE(PG8_SA(0, 1), cA + hstepA, voffA);
        if (wr == 1) PG8_BAR;
        PG8_WAIT_V(2); PG8_BAR;
        PG8_STAGE(PG8_SB(1, 0), cB + kstepB, voffB); PG8_STAGE(PG8_SA(1, 0), cA + kstepA, voffA); PG8_STAGE(PG8_SB(1, 1), cB + hstepB + kstepB, voffB);
        PG8_WAIT_V(6); PG8_BAR;
    } else {
        PG8_STAGE(PG8_SB(0, 0), cB, voffB); PG8_STAGE(PG8_SA(0, 0), cA, voffA); PG8_STAGE(PG8_SB(0, 1), cB + hstepB, voffB); PG8_STAGE(PG8_SA(0, 1), cA + hstepA, voffA);
        if (wr == 1) PG8_BAR;
        PG8_WAIT_V(4); PG8_BAR;
        PG8_STAGE(PG8_SB(1, 0), cB + kstepB, voffB); PG8_STAGE(PG8_SA(1, 0), cA + kstepA, voffA); PG8_STAGE(PG8_SB(1, 1), cB + hstepB + kstepB, voffB);
        PG8_WAIT_V(6); PG8_BAR;
    }
    for (;;) {
        const bool has_next = S.next(ui + 1, nxt);
        const char* nA = has_next ? (const char*)g.A + (size_t)nxt.pm * tstep : cA; const char* nB = has_next ? (const char*)g.Bt + (size_t)nxt.pn * tstep : cB;
        for (int t = 0; t < nt; t += 2) {
            const bool last = (t == nt - 2);
            const char* a1 = cA + (size_t)(t + 1) * kstepA;
            const char* a2 = last ? nA : cA + (size_t)(t + 2) * kstepA; const char* b2 = last ? nB : cB + (size_t)(t + 2) * kstepB;
            const char* a3 = a2 + kstepA; const char* b3 = b2 + kstepB;
            if (last && has_next) S.a_ready(nxt);
            if constexpr (SP2) {
            PG8_LDB(B0, 0, 0); PG8_LDB(B1, 0, 1); PG8_SCHED; PG8_LDA(At, 0, 0); PG8_STAGE(PG8_SA(1, 1), a1 + hstepA, voffA); PG8_PREFETCH(t + PG8_PF);
            PG8_WAIT_LOOP(); PG8_WAIT_L(0); PG8_BAR; PG8_MMA(0, 0, At, B0); PG8_MMA(0, 1, At, B1); PG8_BAR; PG8_SCHED;
            PG8_LDA(At, 0, 1); PG8_STAGE(PG8_SB(0, 0), b2, voffB); PG8_STAGE(PG8_SB(0, 1), b2 + hstepB, voffB); PG8_STAGE(PG8_SA(0, 0), a2, voffA);
            PG8_WAIT_LOOP(); PG8_WAIT_L(0); PG8_BAR; PG8_MMA(1, 0, At, B0); PG8_MMA(1, 1, At, B1); PG8_BAR; PG8_SCHED;
            PG8_LDB(B0, 1, 0); PG8_LDB(B1, 1, 1); PG8_SCHED; PG8_LDA(At, 1, 0); PG8_STAGE(PG8_SA(0, 1), a2 + hstepA, voffA); PG8_PREFETCH(t + 1 + PG8_PF);
            PG8_WAIT_LOOP(); PG8_WAIT_L(0); PG8_BAR; PG8_MMA(0, 0, At, B0); PG8_MMA(0, 1, At, B1); PG8_BAR; PG8_SCHED;
            PG8_LDA(At, 1, 1); PG8_STAGE(PG8_SB(1, 0), b3, voffB); PG8_STAGE(PG8_SB(1, 1), b3 + hstepB, voffB); PG8_STAGE(PG8_SA(1, 0), a3, voffA);
            PG8_WAIT_LOOP(); PG8_WAIT_L(0); PG8_BAR; PG8_MMA(1, 0, At, B0); PG8_MMA(1, 1, At, B1); PG8_BAR; PG8_SCHED;
            } else {
            PG8_LDB(B0, 0, 0); PG8_SCHED; PG8_LDA(At, 0, 0); PG8_STAGE(PG8_SA(1, 1), a1 + hstepA, voffA);
            PG8_WAIT_L(8); PG8_BAR; PG8_WAIT_L(0); PG8_MMA(0, 0, At, B0); PG8_BAR; PG8_SCHED;
            PG8_LDB(B1, 0, 1); PG8_STAGE(PG8_SB(0, 0), b2, voffB);
            PG8_BAR; PG8_WAIT_L(0); PG8_MMA(0, 1, At, B1); PG8_BAR;
            PG8_LDA(At, 0, 1); PG8_STAGE(PG8_SA(0, 0), a2, voffA);
            PG8_BAR; PG8_WAIT_L(0); PG8_MMA(1, 0, At, B0); PG8_BAR; PG8_SCHED;
            PG8_STAGE(PG8_SB(0, 1), b2 + hstepB, voffB);
            PG8_WAIT_V(6); PG8_BAR; PG8_MMA(1, 1, At, B1); PG8_BAR;
            PG8_LDB(B0, 1, 0); PG8_SCHED; PG8_LDA(At, 1, 0); PG8_STAGE(PG8_SA(0, 1), a2 + hstepA, voffA);
            PG8_WAIT_L(8); PG8_BAR; PG8_WAIT_L(0); PG8_MMA(0, 0, At, B0); PG8_BAR; PG8_SCHED;
            PG8_LDB(B1, 1, 1); PG8_STAGE(PG8_SB(1, 0), b3, voffB);
            PG8_BAR; PG8_WAIT_L(0); PG8_MMA(0, 1, At, B1); PG8_BAR;
            PG8_LDA(At, 1, 1); PG8_STAGE(PG8_SA(1, 0), a3, voffA);
            PG8_BAR; PG8_WAIT_L(0); PG8_MMA(1, 0, At, B0); PG8_BAR; PG8_SCHED;
            PG8_STAGE(PG8_SB(1, 1), b3 + hstepB, voffB);
            PG8_WAIT_V(6); PG8_BAR; PG8_MMA(1, 1, At, B1); PG8_BAR;
            }
        }
        if constexpr (ALIGN_EPI) { if (wr == 0) PG8_BAR; }
        if constexpr (!Epi::AFTER_DRAIN) { int fr_e = fr, fq_e = fq; asm volatile("" : "+v"(fr_e), "+v"(fq_e));
            E(acc, cur, wr, wc, fr_e, fq_e); S.done(cur); }
        if (!has_next) break;
#pragma unroll
        for (int a = 0; a < 2; ++a)
#pragma unroll
            for (int b = 0; b < 2; ++b)
#pragma unroll
                for (int m = 0; m < 4; ++m)
#pragma unroll
                    for (int n = 0; n < 2; ++n) acc[a][b][m][n] = (f32x4){0.f, 0.f, 0.f, 0.f};
        cur = nxt; cA = nA; cB = nB; ++ui;
        if constexpr (ALIGN_EPI) { if (wr == 1) PG8_BAR; }
    }
    PG8_WAIT_V(0);
    if constexpr (!ALIGN_EPI) { if (wr == 0) PG8_BAR; }
    PG8_BAR;
    if constexpr (Epi::AFTER_DRAIN) { E.fused(acc, cur, wr, wc, fr, fq, lds, wid, lane); S.done(cur); }
#undef PG8_SA
#undef PG8_SB
#undef PG8_STAGE
#undef PG8_LDA
#undef PG8_LDB
#undef PG8_MMA
#undef PG8_WAIT_V
#undef PG8_WAIT_L
#undef PG8_WAIT_LOOP
#undef PG8_PREFETCH
#undef PG8_BAR
#undef PG8_SCHED
}
}
namespace att {
constexpr int D = 128; constexpr float THR = 8.f; constexpr bool WSKIP = false;
constexpr float SCALE = 0.08838834764831845f;
constexpr int NW = 8, QBLK = 32, KVBLK = 64, QB = NW * QBLK;
constexpr int SHM_V = KVBLK * D * 2, SHM_K = KVBLK * D * 2;
constexpr int LDS_BYTES = 2 * SHM_V + 2 * SHM_K + NW * 64 * 4;

using bf16 = __hip_bfloat16;
typedef short bf16x8 __attribute__((ext_vector_type(8)));
typedef short s16x4 __attribute__((ext_vector_type(4)));
typedef float f32x16 __attribute__((ext_vector_type(16)));
typedef float f32x4 __attribute__((ext_vector_type(4)));
typedef unsigned u32x4 __attribute__((ext_vector_type(4)));
template <class A, class Bt> struct same_t { static constexpr bool v = false; };
template <class A> struct same_t<A, A> { static constexpr bool v = true; };

#define KSWZ(row, colB) ((row) * 256 + ((colB) ^ (((row) & 7) << 4)))
#define SBAR() __builtin_amdgcn_sched_barrier(0)
__device__ __forceinline__ int v_st(int k, int c) { const int kk = (k & ~0xC) | ((k & 4) << 1) | ((k & 8) >> 1); return ((kk >> 3) * 4 + (c >> 5)) * 512 + ((kk & 7) * 32 + (c & 31)) * 2; }
__device__ __forceinline__ int v_rd_base(int lane) { return ((lane & 3) << 3) | (((lane >> 2) & 3) << 6) | (((lane >> 4) & 1) << 5) | (((lane >> 5) & 1) << 8); }
constexpr int v_rd_off(int d0, int ks, int half) { return d0 * 512 + ks * 4096 + half * 2048; }
__device__ __forceinline__ int crow(int r, int hi) { return (r & 3) + 8 * (r >> 2) + 4 * hi; }
__device__ __forceinline__ unsigned cvtpk(float lo, float hi) {
    unsigned r; asm volatile("v_cvt_pk_bf16_f32 %0, %1, %2" : "=v"(r) : "v"(lo), "v"(hi)); return r;
}
__device__ __forceinline__ bf16x8 pack8(f32x4 a, f32x4 b) {
    u32x4 w = {cvtpk(a[0], a[1]), cvtpk(a[2], a[3]), cvtpk(b[0], b[1]), cvtpk(b[2], b[3])};
    return *reinterpret_cast<bf16x8*>(&w);
}
template <class T> __device__ __forceinline__ bf16x8 load8(const T* p) {
    if constexpr (same_t<T, float>::v) { return pack8(*(const f32x4*)p, *(const f32x4*)(p + 4)); }
    else { return *reinterpret_cast<const bf16x8*>(p); }
}
__device__ __forceinline__ void mask_tile(f32x16& p0, f32x16& p1, int dq, unsigned W) {
    const float NEG = -__builtin_inff();
#pragma unroll
    for (int r = 0; r < 16; ++r) {
        const int c = (r & 3) + 8 * (r >> 2);
        if ((unsigned)(dq - c) >= W) p0[r] = NEG;
        if ((unsigned)(dq - c - 32) >= W) p1[r] = NEG;
    }
}
__device__ __forceinline__ void partialSM(f32x16& p0, f32x16& p1, float& m_reg, float& mn, float& alpha) {
    float pmax = p0[0]; for (int r = 1; r < 16; ++r) pmax = fmaxf(pmax, p0[r]); for (int r = 0; r < 16; ++r) pmax = fmaxf(pmax, p1[r]);
    { auto rr = __builtin_amdgcn_permlane32_swap(__float_as_uint(pmax), __float_as_uint(pmax), false, false);
      pmax = fmaxf(__uint_as_float(rr[0]), __uint_as_float(rr[1])); }
    constexpr float C2 = 1.4426950408889634f * SCALE;
    if (__builtin_expect(__all((pmax - m_reg) * SCALE <= THR), 1)) { mn = m_reg; alpha = 1.f; }
    else { mn = fmaxf(m_reg, pmax); alpha = __builtin_amdgcn_exp2f((m_reg - mn) * C2); m_reg = mn; }
    const float mnL = -mn * C2;
    for (int r = 0; r < 16; ++r) p0[r] = fmaf(p0[r], C2, mnL); for (int r = 0; r < 16; ++r) p1[r] = fmaf(p1[r], C2, mnL);
    for (int r = 0; r < 16; ++r) p0[r] = __builtin_amdgcn_exp2f(p0[r]);
}
__device__ __forceinline__ void finishSM(f32x16& p0, f32x16& p1, float alpha, float& l_reg, bf16x8& pa0, bf16x8& pa1, bf16x8& pa2, bf16x8& pa3) {
    for (int r = 0; r < 16; ++r) p1[r] = __builtin_amdgcn_exp2f(p1[r]);
    float ps = 0; for (int r = 0; r < 16; ++r) ps += p0[r]; for (int r = 0; r < 16; ++r) ps += p1[r];
    { auto rr = __builtin_amdgcn_permlane32_swap(__float_as_uint(ps), __float_as_uint(ps), false, false);
      ps = __uint_as_float(rr[0]) + __uint_as_float(rr[1]); }
    l_reg = l_reg * alpha + ps;
#define PK4(P, B_, OUT) do { unsigned a0 = cvtpk(P[B_+0], P[B_+1]), a1 = cvtpk(P[B_+2], P[B_+3]);                          \
        unsigned b0 = cvtpk(P[B_+4], P[B_+5]), b1 = cvtpk(P[B_+6], P[B_+7]);                                             \
        auto r0 = __builtin_amdgcn_permlane32_swap(a0, b0, false, false); auto r1 = __builtin_amdgcn_permlane32_swap(a1, b1, false, false); \
        u32x4 w = {r0[0], r1[0], r0[1], r1[1]}; OUT = *reinterpret_cast<bf16x8*>(&w); } while (0)
    PK4(p0, 0, pa0); PK4(p0, 8, pa1); PK4(p1, 0, pa2); PK4(p1, 8, pa3);
#undef PK4
}
template <int KB, bool SK>
__device__ __forceinline__ void qkt(f32x16& p0, f32x16& p1, const char* K_lds, int r32, int hi, const bf16x8* qr, bool act) {
    if (SK && !act) { const float NEG = -__builtin_inff();
#pragma unroll
        for (int r = 0; r < 16; ++r) { p0[r] = NEG; p1[r] = NEG; } return; }
    p0 = f32x16{}; p1 = f32x16{};
    const char* kb[4];
#pragma unroll
    for (int dd = 0; dd < 4; ++dd) kb[dd] = K_lds + KB * SHM_K + KSWZ(r32, (dd * 16 + hi * 8) * 2);
#pragma unroll
    for (int d0 = 0; d0 < 8; ++d0) { const char* a = kb[d0 & 3] + (d0 >> 2) * 128;
        bf16x8 b0 = *reinterpret_cast<const bf16x8*>(a);
        bf16x8 b1 = *reinterpret_cast<const bf16x8*>(a + 32 * 256);
        p0 = __builtin_amdgcn_mfma_f32_32x32x16_bf16(b0, qr[d0], p0, 0, 0, 0);
        p1 = __builtin_amdgcn_mfma_f32_32x32x16_bf16(b1, qr[d0], p1, 0, 0, 0); }
}
template <int VB, bool SK>
__device__ __forceinline__ void pv_tile(f32x16* o, int vb0, bf16x8 pa0, bf16x8 pa1, bf16x8 pa2, bf16x8 pa3, bool act) {
    if (SK && !act) return;
#define TRRD(dst, off) asm volatile("ds_read_b64_tr_b16 %0, %1 offset:%2" : "=&v"(dst) : "v"(vb0), "i"(off) : "memory")
#define PV_D0(d0) do { s16x4 l0, l1, l2, l3, h0, h1, h2, h3; constexpr int b_ = VB * SHM_V + v_rd_off(d0, 0, 0);     \
        TRRD(l0, b_); TRRD(h0, b_ + 2048); TRRD(l1, b_ + 4096); TRRD(h1, b_ + 6144); TRRD(l2, b_ + 8192); TRRD(h2, b_ + 10240); TRRD(l3, b_ + 12288); TRRD(h3, b_ + 14336); \
        asm volatile("s_waitcnt lgkmcnt(0)" ::: "memory"); SBAR();                 \
        o[d0] = __builtin_amdgcn_mfma_f32_32x32x16_bf16(pa0, (bf16x8){l0[0], l0[1], l0[2], l0[3], h0[0], h0[1], h0[2], h0[3]}, o[d0], 0, 0, 0);   \
        o[d0] = __builtin_amdgcn_mfma_f32_32x32x16_bf16(pa1, (bf16x8){l1[0], l1[1], l1[2], l1[3], h1[0], h1[1], h1[2], h1[3]}, o[d0], 0, 0, 0);   \
        o[d0] = __builtin_amdgcn_mfma_f32_32x32x16_bf16(pa2, (bf16x8){l2[0], l2[1], l2[2], l2[3], h2[0], h2[1], h2[2], h2[3]}, o[d0], 0, 0, 0);   \
        o[d0] = __builtin_amdgcn_mfma_f32_32x32x16_bf16(pa3, (bf16x8){l3[0], l3[1], l3[2], l3[3], h3[0], h3[1], h3[2], h3[3]}, o[d0], 0, 0, 0); } while (0)
    PV_D0(0); PV_D0(1); PV_D0(2); PV_D0(3);
#undef PV_D0
#undef TRRD
}

template <class TIn, class TOut> struct BlockRef { const TIn* Q; const TIn* K; const TIn* V; TOut* O; int P0; int ldo; };
template <class TIn> struct Seam {
    bf16x8 qr[8];
    bf16x8 st_v0, st_v1, st_k0, st_k1; f32x4 sf0, sf1, sf2, sf3;
    f32x4 tq[16];
};
__device__ __forceinline__ int swa_jlo(int P0, int W) { const int lowk = P0 - W + 1; return lowk > 0 ? lowk / KVBLK : 0; }
#define ROW(p, k0, rr) ((p) + (size_t)((k0) + (rr)) * D + sc)
#define VMW() asm volatile("s_waitcnt vmcnt(0)" ::: "memory")
#define VMWN(n) asm volatile("s_waitcnt vmcnt(%0)" :: "i"(n) : "memory")
#define SLOAD_H(Kp, Vp, k0) do { S.st_v0 = load8<TIn>(ROW(Vp, k0, sr)); S.st_v1 = load8<TIn>(ROW(Vp, k0, 32 + sr));              \
                         S.st_k0 = load8<TIn>(ROW(Kp, k0, sr)); S.st_k1 = load8<TIn>(ROW(Kp, k0, 32 + sr)); } while (0)
#define SWRITE_HK(bf) do { *(bf16x8*)(K_lds + (bf) * SHM_K + kws) = S.st_k0; *(bf16x8*)(K_lds + (bf) * SHM_K + kws + 32 * 256) = S.st_k1; } while (0)
#define SWRITE_HV(bf) do { *(bf16x8*)(V_lds + (bf) * SHM_V + vst0) = S.st_v0; *(bf16x8*)(V_lds + (bf) * SHM_V + vst1) = S.st_v1; } while (0)
#define SWRITE_H(bf) do { SWRITE_HV(bf); SWRITE_HK(bf); } while (0)
#define SLOAD_F(p, k0) do { S.sf0 = *(const f32x4*)ROW(p, k0, sr); S.sf1 = *(const f32x4*)(ROW(p, k0, sr) + 4);                \
                            S.sf2 = *(const f32x4*)ROW(p, k0, 32 + sr); S.sf3 = *(const f32x4*)(ROW(p, k0, 32 + sr) + 4); } while (0)
#define SWRITE_KF(bf) do { *(bf16x8*)(K_lds + (bf) * SHM_K + kws) = pack8(S.sf0, S.sf1); *(bf16x8*)(K_lds + (bf) * SHM_K + kws + 32 * 256) = pack8(S.sf2, S.sf3); } while (0)
#define SWRITE_VF(bf) do { *(bf16x8*)(V_lds + (bf) * SHM_V + vst0) = pack8(S.sf0, S.sf1); *(bf16x8*)(V_lds + (bf) * SHM_V + vst1) = pack8(S.sf2, S.sf3); } while (0)
template <class TIn, class TOut>
__device__ __forceinline__ void causal_swa_prime(const BlockRef<TIn, TOut>& cur, int W, char* lds, Seam<TIn>& S) {
    constexpr bool F32 = same_t<TIn, float>::v;
    int tid_ = threadIdx.x; asm volatile("" : "+v"(tid_));
    const int tid = tid_, wid = __builtin_amdgcn_readfirstlane(tid >> 6), lane = tid & 63, r32 = lane & 31, hi = lane >> 5;
    const int sr = tid >> 4, sc = (tid & 15) * 8, kws = KSWZ(sr, sc * 2); char* K_lds = lds + 2 * SHM_V;
    const int kb0 = swa_jlo(cur.P0, W) * KVBLK;
    for (int d0 = 0; d0 < 8; ++d0) S.qr[d0] = load8<TIn>(cur.Q + (size_t)(wid * QBLK + r32) * D + d0 * 16 + hi * 8);
    if constexpr (F32) { SLOAD_F((const float*)cur.K, kb0); VMW(); SWRITE_KF(0); SBAR(); SLOAD_F((const float*)cur.V, kb0); }
    else { SLOAD_H(cur.K, cur.V, kb0); VMW(); SWRITE_HK(0); }
    __syncthreads();
}
template <class TIn, class TOut>
__device__ __forceinline__ void causal_swa_block(const BlockRef<TIn, TOut>& cur, const BlockRef<TIn, TOut>& nxt, int skv, int W, char* lds, Seam<TIn>& S) {
    constexpr bool F32 = same_t<TIn, float>::v;
    int tid_ = threadIdx.x; asm volatile("" : "+v"(tid_));
    const int tid = tid_, wid = __builtin_amdgcn_readfirstlane(tid >> 6), lane = tid & 63, r32 = lane & 31, hi = lane >> 5;
    const int j_lo = swa_jlo(cur.P0, W);
    int j_hi = (cur.P0 + QB - 1) / KVBLK + 1; if (j_hi > skv / KVBLK) j_hi = skv / KVBLK;
    const int NT = j_hi - j_lo;
    const int kbn = swa_jlo(nxt.P0, W) * KVBLK;
    const int qlo = cur.P0 + wid * QBLK, qm = qlo + r32 - 4 * hi;
    char* V_lds = lds; char* K_lds = lds + 2 * SHM_V;
    float* ws = (float*)(lds + 2 * SHM_V + 2 * SHM_K) + wid * 64; float* li_l = ws, * al_l = ws + 32;
    float m_reg = -1e30f, l_reg = 0; f32x16 o[4] = {};
    const int sr = tid >> 4, sc = (tid & 15) * 8, vst0 = v_st(sr, sc), vst1 = v_st(32 + sr, sc), kws = KSWZ(sr, sc * 2);
    const int vb0 = (int)(uintptr_t)V_lds + v_rd_base(lane);
    const TIn* Kh = cur.K; const TIn* Vh = cur.V;
#define RESC(a) do { if (__any((a) < 1.f)) { if (hi == 0) al_l[r32] = (a); asm volatile("s_waitcnt lgkmcnt(0)" ::: "memory");              \
                     for (int d_ = 0; d_ < 4; ++d_) for (int r = 0; r < 16; ++r) o[d_][r] *= al_l[crow(r, hi)]; } } while (0)
#define KBASE(t) ((j_lo + (t)) * KVBLK)
#define ACT(t) (KBASE(t) <= qlo + QBLK - 1 && KBASE(t) + KVBLK - 1 >= qlo - W + 1)
#define MASKT(P0_, P1_, t) do { const int kb_ = KBASE(t); if ((!SK || ACT(t)) && (kb_ + KVBLK - 1 > qlo || kb_ <= qlo + QBLK - 1 - W)) mask_tile(P0_, P1_, qm - kb_, (unsigned)W); } while (0)
    constexpr int NQL = F32 ? 16 : 8;
    constexpr bool SK = WSKIP && !F32;
#define SEAM_K0() do { VMWN(NQL); if constexpr (F32) { SWRITE_KF(0); SBAR(); SLOAD_F((const float*)nxt.V, kbn); } else { SWRITE_HK(0); } SBAR(); } while (0)
    f32x16 pA0, pA1, pB0, pB1; float mnA, mnB, alA, alB; bf16x8 pa0, pa1, pa2, pa3;
    if constexpr (F32) { VMW(); SWRITE_VF(0); SBAR(); } else { SWRITE_HV(0); SBAR(); }
    if (NT > 1) { if constexpr (F32) SLOAD_F((const float*)Kh, KBASE(1)); else SLOAD_H(Kh, Vh, KBASE(1)); }
    SBAR(); qkt<0, SK>(pA0, pA1, K_lds, r32, hi, S.qr, ACT(0));
    if constexpr (F32) { if (NT > 1) { VMW(); SWRITE_KF(1); SBAR(); SLOAD_F((const float*)Vh, KBASE(1)); } }
    MASKT(pA0, pA1, 0); partialSM(pA0, pA1, m_reg, mnA, alA);
    if (NT > 1) { VMW(); if constexpr (F32) { SWRITE_VF(1); SBAR(); if (NT > 2) SLOAD_F((const float*)Kh, KBASE(2)); } else SWRITE_H(1); }
    __syncthreads();
#define HALF_STEP(PX0, PX1, mnX, alX, PY0, PY1, alY, t, KB, VB, SB) do {                                                      \
        SBAR(); qkt<KB, SK>(PX0, PX1, K_lds, r32, hi, S.qr, ACT(t));                                             \
        finishSM(PY0, PY1, alY, l_reg, pa0, pa1, pa2, pa3); SBAR();                                                           \
        if ((t) + 1 < NT) { if constexpr (F32) { VMW(); SWRITE_KF(SB); SBAR(); SLOAD_F((const float*)Vh, KBASE((t) + 1)); }  \
                            else { SLOAD_H(Kh, Vh, KBASE((t) + 1)); } SBAR(); }                                               \
        pv_tile<VB, SK>(o, vb0, pa0, pa1, pa2, pa3, ACT((t) - 1)); MASKT(PX0, PX1, (t)); partialSM(PX0, PX1, m_reg, mnX, alX);                                        \
        __syncthreads();                                                                                                      \
        if ((t) + 1 < NT) { VMW(); if constexpr (F32) { SWRITE_VF(SB); SBAR(); if ((t) + 2 < NT) SLOAD_F((const float*)Kh, KBASE((t) + 2)); } \
                            else { SWRITE_H(SB); } }                                                                          \
        RESC(alX); __syncthreads(); } while (0)
    for (int t = 1; t + 1 < NT; t += 2) {
        HALF_STEP(pB0, pB1, mnB, alB, pA0, pA1, alA, t, 1, 0, 0);
        HALF_STEP(pA0, pA1, mnA, alA, pB0, pB1, alB, t + 1, 0, 1, 1);
    }
    const bool even = (NT & 1) == 0;
    if (even) { SBAR(); qkt<1, SK>(pB0, pB1, K_lds, r32, hi, S.qr, ACT(NT - 1)); SBAR(); }
#define QROW(e) (nxt.Q + (size_t)(wid * QBLK + r32) * D + ((e) >> 1) * 16 + hi * 8 + ((e) & 1) * 4)
    if constexpr (F32) { SLOAD_F((const float*)nxt.K, kbn); SBAR();
#pragma unroll
        for (int e = 0; e < 8; ++e) S.tq[e] = *(const f32x4*)QROW(e); }
    else { SLOAD_H(nxt.K, nxt.V, kbn); SBAR();
#pragma unroll
        for (int d0 = 0; d0 < 8; ++d0) S.qr[d0] = load8<TIn>(nxt.Q + (size_t)(wid * QBLK + r32) * D + d0 * 16 + hi * 8); }
    SBAR();
    finishSM(pA0, pA1, alA, l_reg, pa0, pa1, pa2, pa3); SBAR();
    if constexpr (F32) {
#pragma unroll
        for (int e = 8; e < 16; ++e) S.tq[e] = *(const f32x4*)QROW(e); SBAR(); }
#undef QROW
    pv_tile<0, SK>(o, vb0, pa0, pa1, pa2, pa3, ACT(even ? NT - 2 : NT - 1));
    if (even) { MASKT(pB0, pB1, NT - 1); partialSM(pB0, pB1, m_reg, mnB, alB); __syncthreads(); RESC(alB);
        finishSM(pB0, pB1, alB, l_reg, pa0, pa1, pa2, pa3); SBAR(); pv_tile<1, SK>(o, vb0, pa0, pa1, pa2, pa3, ACT(NT - 1)); }
    SBAR(); SEAM_K0();
    if (hi == 0) li_l[r32] = l_reg; asm volatile("s_waitcnt lgkmcnt(0)" ::: "memory");
    float rli[16];
#pragma unroll
    for (int r = 0; r < 16; ++r) rli[r] = __builtin_amdgcn_rcpf(li_l[crow(r, hi)]);
    const int LDO = cur.ldo; TOut* Ow = cur.O + (size_t)(wid * QBLK) * LDO;
#pragma unroll
    for (int r = 0; r < 16; ++r) { const int orow = crow(r, hi);
#pragma unroll
        for (int d0 = 0; d0 < 4; ++d0) { const float v = o[d0][r] * rli[r];
            if constexpr (same_t<TOut, float>::v) { Ow[(size_t)orow * LDO + d0 * 32 + r32] = v; }
            else { const float vn = __shfl_xor(v, 1);
                   if ((r32 & 1) == 0) *(unsigned*)(Ow + (size_t)orow * LDO + d0 * 32 + r32) = cvtpk(v, vn); } } }
    if constexpr (F32) {
#pragma unroll
        for (int d0 = 0; d0 < 8; ++d0) S.qr[d0] = pack8(S.tq[2 * d0], S.tq[2 * d0 + 1]); }
    __syncthreads();
#undef RESC
#undef KBASE
#undef ACT
#undef MASKT
#undef SEAM_K0
#undef HALF_STEP
}
#undef ROW
#undef VMW
#undef VMWN
#undef SLOAD_H
#undef SWRITE_HK
#undef SWRITE_HV
#undef SWRITE_H
#undef SLOAD_F
#undef SWRITE_KF
#undef SWRITE_VF


constexpr int QB2 = 128, L2_K = 0, L2_V0 = 32768, L2_V1 = 65536, L2_P = 98304;
struct Ref2 { const bf16* Q; const bf16* K; const bf16* V0; const bf16* V1; float* O0; float* O1; int P0; };
struct Seam2 { bf16x8 qr[8]; bf16x8 sk0, sk1, sa0, sa1, sb0, sb1; f32x16 pA0, pA1; };
#define LD8(p) (*reinterpret_cast<const bf16x8*>(p))
#define VMW2() asm volatile("s_waitcnt vmcnt(0)" ::: "memory")
__device__ __forceinline__ void pv3_tile(f32x16* o, int vb, bf16x8 pa0, bf16x8 pa1, bf16x8 pa2, bf16x8 pa3, bf16x8 pb0, bf16x8 pb1, bf16x8 pb2, bf16x8 pb3, float fA, float fB, const float* alA, int hi) {
#define TRRD(dst, off) asm volatile("ds_read_b64_tr_b16 %0, %1 offset:%2" : "=&v"(dst) : "v"(vb), "i"(off) : "memory")
#define RD8(X, g) do { constexpr int b_ = v_rd_off((g), 0, 0); TRRD(X##0, b_); TRRD(X##1, b_ + 2048); TRRD(X##2, b_ + 4096); TRRD(X##3, b_ + 6144); \
        TRRD(X##4, b_ + 8192); TRRD(X##5, b_ + 10240); TRRD(X##6, b_ + 12288); TRRD(X##7, b_ + 14336); } while (0)
#define VF(X, a, b) (bf16x8){X##a[0], X##a[1], X##a[2], X##a[3], X##b[0], X##b[1], X##b[2], X##b[3]}
#define MM8(X, g) do { \
        o[g] = __builtin_amdgcn_mfma_f32_32x32x16_bf16(pa0, VF(X, 0, 1), o[g], 0, 0, 0); o[4 + g] = __builtin_amdgcn_mfma_f32_32x32x16_bf16(pb0, VF(X, 0, 1), o[4 + g], 0, 0, 0); \
        o[g] = __builtin_amdgcn_mfma_f32_32x32x16_bf16(pa1, VF(X, 2, 3), o[g], 0, 0, 0); o[4 + g] = __builtin_amdgcn_mfma_f32_32x32x16_bf16(pb1, VF(X, 2, 3), o[4 + g], 0, 0, 0); \
        o[g] = __builtin_amdgcn_mfma_f32_32x32x16_bf16(pa2, VF(X, 4, 5), o[g], 0, 0, 0); o[4 + g] = __builtin_amdgcn_mfma_f32_32x32x16_bf16(pb2, VF(X, 4, 5), o[4 + g], 0, 0, 0); \
        o[g] = __builtin_amdgcn_mfma_f32_32x32x16_bf16(pa3, VF(X, 6, 7), o[g], 0, 0, 0); o[4 + g] = __builtin_amdgcn_mfma_f32_32x32x16_bf16(pb3, VF(X, 6, 7), o[4 + g], 0, 0, 0); } while (0)
#define LGK8() do { asm volatile("s_waitcnt lgkmcnt(8)" ::: "memory"); SBAR(); } while (0)
    s16x4 A0, A1, A2, A3, A4, A5, A6, A7, B0, B1, B2, B3, B4, B5, B6, B7;
    RD8(A, 0); RD8(B, 1);
    if (__builtin_amdgcn_readfirstlane(__float_as_int(fA)) != 0) {
        const f32x4* a4p = (const f32x4*)alA + hi; const f32x4 a0 = a4p[0], a1 = a4p[2], a2 = a4p[4], a3 = a4p[6];
#pragma unroll
        for (int d_ = 0; d_ < 4; ++d_)
#pragma unroll
            for (int j = 0; j < 4; ++j) { o[d_][j] *= a0[j]; o[d_][4 + j] *= a1[j]; o[d_][8 + j] *= a2[j]; o[d_][12 + j] *= a3[j]; } }
    if (__builtin_amdgcn_readfirstlane(__float_as_int(fB)) != 0) {
        const f32x4* a4p = (const f32x4*)(alA + 32) + hi; const f32x4 a0 = a4p[0], a1 = a4p[2], a2 = a4p[4], a3 = a4p[6];
#pragma unroll
        for (int d_ = 4; d_ < 8; ++d_)
#pragma unroll
            for (int j = 0; j < 4; ++j) { o[d_][j] *= a0[j]; o[d_][4 + j] *= a1[j]; o[d_][8 + j] *= a2[j]; o[d_][12 + j] *= a3[j]; } }
    asm volatile("s_waitcnt lgkmcnt(0)" ::: "memory"); SBAR(); MM8(A, 0); SBAR();
    RD8(A, 2); LGK8(); MM8(B, 1); SBAR();
    RD8(B, 3); LGK8(); MM8(A, 2); SBAR();
    asm volatile("s_waitcnt lgkmcnt(0)" ::: "memory"); SBAR(); MM8(B, 3);
#undef TRRD
#undef RD8
#undef VF
#undef MM8
#undef LGK8
}
template <bool RS>
__device__ __forceinline__ void diff2_prime(const Ref2& cur, char* lds, Seam2& S) {
    int tid_ = threadIdx.x; asm volatile("" : "+v"(tid_));
    const int tid = tid_, wid = __builtin_amdgcn_readfirstlane(tid >> 6), lane = tid & 63, r32 = lane & 31, hi = lane >> 5;
    const int sr = tid >> 4, sc = (tid & 15) * 8, kws = KSWZ(sr, sc * 2);
    if constexpr (RS) {
#pragma unroll
        for (int d0 = 0; d0 < 8; ++d0) S.qr[d0] = LD8(cur.Q + (size_t)(wid * QBLK + r32) * D + d0 * 16 + hi * 8); }
    S.sk0 = LD8(cur.K + (size_t)sr * D + sc); S.sk1 = LD8(cur.K + (size_t)(32 + sr) * D + sc);
    VMW2();
    *(bf16x8*)(lds + L2_K + kws) = S.sk0; *(bf16x8*)(lds + L2_K + kws + 32 * 256) = S.sk1;
    S.sk0 = LD8(cur.K + (size_t)(KVBLK + sr) * D + sc); S.sk1 = LD8(cur.K + (size_t)(KVBLK + 32 + sr) * D + sc);
    S.sa0 = LD8(cur.V0 + (size_t)sr * D + sc); S.sa1 = LD8(cur.V0 + (size_t)(32 + sr) * D + sc);
    S.sb0 = LD8(cur.V1 + (size_t)sr * D + sc); S.sb1 = LD8(cur.V1 + (size_t)(32 + sr) * D + sc);
    VMW2();
    *(bf16x8*)(lds + L2_K + SHM_K + kws) = S.sk0; *(bf16x8*)(lds + L2_K + SHM_K + kws + 32 * 256) = S.sk1;
    __syncthreads();
    if constexpr (RS) qkt<0, false>(S.pA0, S.pA1, lds + L2_K, r32, hi, S.qr, true);
}
template <bool RS>
__device__ __forceinline__ void diff2_block(const Ref2& cur, const Ref2& nxt, char* lds, float* xl, Seam2& S) {
    int tid_ = threadIdx.x; asm volatile("" : "+v"(tid_));
    const int tid = tid_, wid = __builtin_amdgcn_readfirstlane(tid >> 6), lane = tid & 63, r32 = lane & 31, hi = lane >> 5;
    const int w4 = wid & 3;
    const int NT = (cur.P0 + QB2 - 1) / KVBLK + 1;
    const int qlo = cur.P0 + w4 * QBLK, qm = qlo + r32 - 4 * hi;
    char* K_lds = lds + L2_K; char* V0_lds = lds + L2_V0; char* V1_lds = lds + L2_V1; char* P_lds = lds + L2_P + w4 * 4096;
    float* alp = xl + w4 * 32; float* li = xl + 256 + (RS ? w4 : (w4 >> 1) * 2) * 32; float* flg = xl + 384 + w4;
    const int sr = tid >> 4, sc = (tid & 15) * 8, vst0 = v_st(sr, sc), vst1 = v_st(32 + sr, sc), kws = KSWZ(sr, sc * 2);
    const int vbase = (int)(uintptr_t)V0_lds + v_rd_base(lane);
    float m_reg = -1e30f, l_reg = 0.f; f32x16 o[RS ? 1 : 8] = {};
    auto stage_top = [&](const int t, const bool drain) __attribute__((always_inline)) {
        const int par = t & 1;
        if (!drain) { *(bf16x8*)(V0_lds + par * SHM_V + vst0) = S.sa0; *(bf16x8*)(V0_lds + par * SHM_V + vst1) = S.sa1;
                      *(bf16x8*)(V1_lds + par * SHM_V + vst0) = S.sb0; *(bf16x8*)(V1_lds + par * SHM_V + vst1) = S.sb1; }
        const bool kc = !drain && t + 2 < NT, kn = drain || t == NT - 1;
        if (kc || kn) { const bf16* Kp = kc ? cur.K : nxt.K; const int k0 = kc ? (t + 2) * KVBLK : (drain ? KVBLK : 0);
            S.sk0 = LD8(Kp + (size_t)(k0 + sr) * D + sc); S.sk1 = LD8(Kp + (size_t)(k0 + 32 + sr) * D + sc); }
        const bool vc = !drain && t + 1 < NT;
        if (vc || drain) { const bf16* Ap = vc ? cur.V0 : nxt.V0; const bf16* Bp = vc ? cur.V1 : nxt.V1; const int k0 = vc ? (t + 1) * KVBLK : 0;
            S.sa0 = LD8(Ap + (size_t)(k0 + sr) * D + sc); S.sa1 = LD8(Ap + (size_t)(k0 + 32 + sr) * D + sc);
            S.sb0 = LD8(Bp + (size_t)(k0 + sr) * D + sc); S.sb1 = LD8(Bp + (size_t)(k0 + 32 + sr) * D + sc); }
    };
    auto stage_end = [&](const int t, const bool drain, const int nyoung) __attribute__((always_inline)) {
        const bool kc = !drain && t + 2 < NT, kn = drain || t == NT - 1;
        if (kc || kn) { const int wb = kc ? (t & 1) : (drain ? 1 : 0);
            (void)nyoung;
            *(bf16x8*)(K_lds + wb * SHM_K + kws) = S.sk0; *(bf16x8*)(K_lds + wb * SHM_K + kws + 32 * 256) = S.sk1; }
    };
    if constexpr (RS) {
        f32x16 pB0, pB1;
        auto siter = [&](f32x16& pX0, f32x16& pX1, f32x16& pY0, f32x16& pY1, const int t) __attribute__((always_inline)) {
            const int par = t & 1;
            stage_top(t, false);
            if (t == NT - 1) {
#pragma unroll
                for (int d0 = 0; d0 < 8; ++d0) S.qr[d0] = LD8(nxt.Q + (size_t)(w4 * QBLK + r32) * D + d0 * 16 + hi * 8); }
            SBAR();
            if (t + 1 < NT) qkt<0, false>(pY0, pY1, K_lds + ((t + 1) & 1) * SHM_K, r32, hi, S.qr, true);
            float mn, alpha; bf16x8 pa0, pa1, pa2, pa3;
            { const int kb = t * KVBLK; if (kb + KVBLK - 1 > qlo) mask_tile(pX0, pX1, qm - kb, 1u << 30); }
            partialSM(pX0, pX1, m_reg, mn, alpha); finishSM(pX0, pX1, alpha, l_reg, pa0, pa1, pa2, pa3);
            { bf16x8* pw = (bf16x8*)(P_lds + par * 16384) + lane; pw[0] = pa0; pw[64] = pa1; pw[128] = pa2; pw[192] = pa3; }
            const bool need = __any(alpha < 1.f);
            if (hi == 0) { alp[par * 128 + r32] = alpha; if (t == NT - 1) li[r32] = l_reg; if (r32 == 0) flg[par * 4] = need ? 1.f : 0.f; }
            SBAR();
            stage_end(t, false, t == NT - 1 ? 12 : 4);
            __syncthreads();
        };
#pragma unroll 1
        for (int t = 0; t < NT; t += 2) { siter(S.pA0, S.pA1, pB0, pB1, t); siter(pB0, pB1, S.pA0, S.pA1, t + 1); }
        stage_top(NT, true);
        SBAR();
        qkt<0, false>(S.pA0, S.pA1, K_lds, r32, hi, S.qr, true);
        SBAR();
        stage_end(NT, true, 4);
        __syncthreads();
    } else {
#pragma unroll 1
        for (int t = 0; t <= NT; ++t) {
            const bool drain = t == NT;
            stage_top(t, drain);
            SBAR();
            if (t >= 1) {
                const int pp = (t - 1) & 1, rg = w4 >> 1, hf = w4 & 1;
                char* PA = lds + L2_P + (2 * rg) * 4096 + pp * 16384; float* alA = xl + (2 * rg) * 32 + pp * 128; float* flA = xl + 384 + 2 * rg + pp * 4;
                bf16x8 pa0, pa1, pa2, pa3, pb0, pb1, pb2, pb3;
                { const bf16x8* pr = (const bf16x8*)PA + lane; pa0 = pr[0]; pa1 = pr[64]; pa2 = pr[128]; pa3 = pr[192]; pb0 = pr[256]; pb1 = pr[320]; pb2 = pr[384]; pb3 = pr[448]; }
                const float fA = flA[0], fB = flA[1];
                pv3_tile(o, vbase + hf * (L2_V1 - L2_V0) + pp * SHM_V, pa0, pa1, pa2, pa3, pb0, pb1, pb2, pb3, fA, fB, alA, hi);
            }
            SBAR();
            stage_end(t, drain, 4);
            if (drain) {
                int r32e = r32, hie = hi; asm volatile("" : "+v"(r32e), "+v"(hie));
                const f32x4* l4p = (const f32x4*)li + hie; const f32x4 l0 = l4p[0], l1 = l4p[2], l2 = l4p[4], l3 = l4p[6];
                float rli[16];
#pragma unroll
                for (int j = 0; j < 4; ++j) { rli[j] = __builtin_amdgcn_rcpf(l0[j]); rli[4 + j] = __builtin_amdgcn_rcpf(l1[j]); rli[8 + j] = __builtin_amdgcn_rcpf(l2[j]); rli[12 + j] = __builtin_amdgcn_rcpf(l3[j]); }
                const f32x4* m4p = (const f32x4*)(li + 32) + hie; const f32x4 n0 = m4p[0], n1 = m4p[2], n2 = m4p[4], n3 = m4p[6];
                float rlj[16];
#pragma unroll
                for (int j = 0; j < 4; ++j) { rlj[j] = __builtin_amdgcn_rcpf(n0[j]); rlj[4 + j] = __builtin_amdgcn_rcpf(n1[j]); rlj[8 + j] = __builtin_amdgcn_rcpf(n2[j]); rlj[12 + j] = __builtin_amdgcn_rcpf(n3[j]); }
                float* Ow = ((w4 & 1) ? cur.O1 : cur.O0) + (size_t)((w4 >> 1) * 2 * QBLK) * D;
#pragma unroll
                for (int r = 0; r < 16; ++r) { const int orow = crow(r, hie);
#pragma unroll
                    for (int d0 = 0; d0 < 4; ++d0) { Ow[(size_t)orow * D + d0 * 32 + r32e] = o[d0][r] * rli[r]; Ow[(size_t)(QBLK + orow) * D + d0 * 32 + r32e] = o[4 + d0][r] * rlj[r]; } }
            }
            __syncthreads();
        }
    }
}
#undef LD8
#undef VMW2
}
constexpr size_t al256(size_t x) { return (x + 255) & ~(size_t)255; }
constexpr size_t WS_CTL = 0, CTL_ZERO_BYTES = 1u << 20;
constexpr size_t WS_WGU   = CTL_ZERO_BYTES;
constexpr size_t WS_WDN   = WS_WGU  + (size_t)8 * NGU * DM * 2;
constexpr size_t WS_WOUT  = WS_WDN  + (size_t)8 * DM * FF * 2;
constexpr size_t WS_WMEM  = WS_WOUT + (size_t)4 * DM * DM * 2;
constexpr size_t WS_WAIN  = WS_WMEM + (size_t)4 * 1024 * DM * 2;
constexpr size_t WS_WKV   = WS_WAIN + (size_t)2 * NAIN * DM * 2;
constexpr size_t WS_WBIN  = WS_WKV  + (size_t)NKV * DM * 2;
constexpr size_t WS_COS   = WS_WBIN + (size_t)2 * NBIN * DM * 2;
constexpr size_t WS_MEMN  = WS_COS  + (size_t)SEQ * 64 * 4;
constexpr size_t WS_MK    = WS_MEMN + (size_t)4 * 1024 * DM * 2;
constexpr size_t WS_MV    = WS_MK   + (size_t)4 * 1024 * 512 * 2;
constexpr size_t WS_XB    = WS_MV   + (size_t)4 * 1024 * 512 * 2;
constexpr size_t WS_SS    = WS_XB   + (size_t)M * DM * 2;
constexpr size_t WS_XH    = WS_SS   + (size_t)M * 32 * 4;
constexpr size_t WS_HID   = WS_XH   + (size_t)M * DM * 2;
constexpr size_t WS_ZA    = WS_HID  + (size_t)M * FF * 2;
constexpr size_t WS_VSTAT = WS_ZA   + (size_t)M * 3072 * 2;
constexpr size_t WS_QB    = WS_VSTAT + (size_t)M * 24 * 4;
constexpr size_t WS_KSH   = WS_QB   + (size_t)M * 1536 * 2;
constexpr size_t WS_VSH   = WS_KSH  + (size_t)M * 1536 * 2;
constexpr size_t WS_QMB   = WS_VSH  + (size_t)M * 1536 * 2;
constexpr size_t WS_OATT  = WS_QMB  + (size_t)M * 512 * 2;
constexpr size_t WS_CAT   = WS_OATT + (size_t)2 * 96 * SEQ * 128 * 4;
constexpr size_t WS_END   = WS_CAT  + (size_t)M * DM * 2;
static_assert(WS_WGU % 256 == 0 && WS_COS % 256 == 0 && WS_VSTAT % 256 == 0 && WS_QB % 256 == 0 && WS_END % 256 == 0, "ws alignment");

constexpr int RING_OFF = 0, RING_BYTES = 131072;
constexpr int LDSCTL_OFF = 141312, MISC_OFF = LDSCTL_OFF + 320;
constexpr int LDS_BYTES = 147456;
constexpr int NWAVES = 8;

#define GAS __attribute__((address_space(1)))
#define LAS __attribute__((address_space(3)))
typedef unsigned short bf16r;
typedef unsigned v4u __attribute__((ext_vector_type(4)));
typedef unsigned v2u __attribute__((ext_vector_type(2)));
typedef float f32x4 __attribute__((ext_vector_type(4)));
typedef short bf16x8 __attribute__((ext_vector_type(8)));
typedef GAS unsigned gu32;
#define LDS_WAIT() asm volatile("s_waitcnt lgkmcnt(0)" ::: "memory")
#define VM_WAIT() asm volatile("s_waitcnt vmcnt(0)" ::: "memory")
__device__ __forceinline__ unsigned f2bf(float f) { unsigned u = __builtin_bit_cast(unsigned, f); return (u + 0x7fffu + ((u >> 16) & 1u)) >> 16; }
__device__ __forceinline__ unsigned pk2(float lo, float hi) { return f2bf(lo) | (f2bf(hi) << 16); }
__device__ __forceinline__ float bf2f(unsigned short b) { return __builtin_bit_cast(float, ((unsigned)b) << 16); }
__device__ __forceinline__ float wave_sum(float v) {
#pragma unroll
    for (int o = 1; o < 64; o <<= 1) v += __shfl_xor(v, o);
    return v;
}
#define XB_TMO      128
#define XB_XCNT(j)  (256  + 64 * (j))
#define XB_XSUB(j)  (1280 + 64 * (j))
#define XB_XGEN(j)  (2304 + 64 * (j))
#define XB_TOP      3328
#define XB_TOPGEN   3392
#define XCD_BAR_WORDS 3456
#define XB_SPIN_CAP (1u << 18)

__device__ __forceinline__ unsigned xb_ld(unsigned* p)              { return __hip_atomic_load(p, __ATOMIC_RELAXED, __HIP_MEMORY_SCOPE_AGENT); }
__device__ __forceinline__ unsigned xb_add(unsigned* p, unsigned v) { return __hip_atomic_fetch_add(p, v, __ATOMIC_RELAXED, __HIP_MEMORY_SCOPE_AGENT); }
__device__ __forceinline__ unsigned xb_xcc_id() { return (unsigned)__builtin_amdgcn_s_getreg((3 << 11) | 20) & 0xFu; }
#define XB_SPIN(cond, bar) do { unsigned _sp = 0; while (cond) { __builtin_amdgcn_s_sleep(1); \
    if ((++_sp & 255u) == 0u) { if (xb_ld(&(bar)[XB_TMO])) break; if (_sp > XB_SPIN_CAP) { atomicAdd(&(bar)[XB_TMO], 1u); break; } } } } while (0)

struct XcdBarrier {
    unsigned* bar; unsigned x;
    volatile LAS unsigned* st;
};

__device__ __forceinline__ XcdBarrier xcd_barrier_post(unsigned* bar, volatile LAS unsigned* st) {
    XcdBarrier b; b.bar = bar; b.x = xb_xcc_id(); b.st = st;
    if (threadIdx.x == 0) (void)xb_add(&bar[XB_XCNT(b.x)], 1u);
    return b;
}
__device__ __forceinline__ void xcd_barrier_complete(unsigned* bar, unsigned x, unsigned& nloc, unsigned& nx) {
    const unsigned G = gridDim.x * gridDim.y * gridDim.z;
    unsigned sum, cnt, mine, sp = 0u;
    for (;;) {
        sum = 0u; cnt = 0u; mine = 0u;
#pragma unroll
        for (unsigned j = 0; j < 16; ++j) { const unsigned c = xb_ld(&bar[XB_XCNT(j)]); sum += c; cnt += (c > 0u) ? 1u : 0u; mine = (j == x) ? c : mine; }
        if (sum == G) break;
        __builtin_amdgcn_s_sleep(1);
        if ((++sp & 255u) == 0u) { if (xb_ld(&bar[XB_TMO])) break; if (sp > XB_SPIN_CAP) { atomicAdd(&bar[XB_TMO], 1u); break; } }
    }
    nloc = mine > 0u ? mine : 1u; nx = cnt > 0u ? cnt : 1u;
}

__device__ __forceinline__ void xcd_barrier(const XcdBarrier& b) {
    asm volatile("s_waitcnt vmcnt(0)" ::: "memory");
    __syncthreads();
    if (threadIdx.x == 0) {
        unsigned* bar = b.bar;
        __builtin_amdgcn_s_waitcnt(0);
        unsigned nloc = b.st[0], nx = b.st[1];
        if (nloc == 0u) { xcd_barrier_complete(bar, b.x, nloc, nx); b.st[0] = nloc; b.st[1] = nx; }
        const unsigned old = xb_add(&bar[XB_XSUB(b.x)], 1u);
        const unsigned gen = old / nloc;
        if (old + 1u == (gen + 1u) * nloc) {
            __builtin_amdgcn_fence(__ATOMIC_RELEASE, "agent");
            asm volatile("s_waitcnt vmcnt(0)" ::: "memory");
            const unsigned og = xb_add(&bar[XB_TOP], 1u);
            const unsigned tg = og / nx;
            if (og + 1u == (tg + 1u) * nx) xb_add(&bar[XB_TOPGEN], 1u);
            else XB_SPIN(xb_ld(&bar[XB_TOPGEN]) == tg, bar);
            __builtin_amdgcn_fence(__ATOMIC_ACQUIRE, "agent");
            xb_add(&bar[XB_XGEN(b.x)], 1u);
            asm volatile("s_waitcnt vmcnt(0)" ::: "memory");
        } else {
            XB_SPIN(xb_ld(&bar[XB_XGEN(b.x)]) == gen, bar);
            __builtin_amdgcn_fence(__ATOMIC_ACQUIRE, "agent");
            asm volatile("s_waitcnt vmcnt(0)" ::: "memory");
        }
    }
    __syncthreads();
}

#define XB_LSUB(j)  (4096 + 64 * (j))
#define XB_LGEN(j)  (5120 + 64 * (j))
#define XB_XCCTAB   6144
__device__ __forceinline__ void xcd_local_barrier(const XcdBarrier& b) {
    asm volatile("s_waitcnt vmcnt(0)" ::: "memory");
    __syncthreads();
    if (threadIdx.x == 0) {
        unsigned* bar = b.bar;
        __builtin_amdgcn_s_waitcnt(0);
        const unsigned nloc = b.st[0] ? b.st[0] : 1u;
        const unsigned old = xb_add(&bar[XB_LSUB(b.x)], 1u);
        const unsigned gen = old / nloc;
        if (old + 1u == (gen + 1u) * nloc) {
#ifndef LOCAL_BAR_RELEASE
#define LOCAL_BAR_RELEASE 0
#endif
            if (LOCAL_BAR_RELEASE) { __builtin_amdgcn_fence(__ATOMIC_RELEASE, "agent"); asm volatile("s_waitcnt vmcnt(0)" ::: "memory"); }
            __builtin_amdgcn_fence(__ATOMIC_ACQUIRE, "agent");
            xb_add(&bar[XB_LGEN(b.x)], 1u);
            asm volatile("s_waitcnt vmcnt(0)" ::: "memory");
        } else {
            XB_SPIN(xb_ld(&bar[XB_LGEN(b.x)]) == gen, bar);
            __builtin_amdgcn_fence(__ATOMIC_ACQUIRE, "agent");
            asm volatile("s_waitcnt vmcnt(0)" ::: "memory");
        }
    }
    __syncthreads();
}

#define XB_PSUB(j)    (6400 + 64 * (j))
#define XB_PGEN(j)    (6912 + 64 * (j))
#define XB_PTOP(p)    (7424 + 64 * (p))
#define XB_PTOPGEN(p) (7680 + 64 * (p))
__device__ __forceinline__ void xcd_pair_barrier(const XcdBarrier& b) {
    asm volatile("s_waitcnt vmcnt(0)" ::: "memory");
    __syncthreads();
    if (threadIdx.x == 0) {
        unsigned* bar = b.bar;
        __builtin_amdgcn_s_waitcnt(0);
        const unsigned nloc = b.st[0] ? b.st[0] : 1u, pr = ((unsigned)blockIdx.x & 7u) >> 1;
        const unsigned old = xb_add(&bar[XB_PSUB(b.x)], 1u);
        const unsigned gen = old / nloc;
        if (old + 1u == (gen + 1u) * nloc) {
            __builtin_amdgcn_fence(__ATOMIC_RELEASE, "agent");
            asm volatile("s_waitcnt vmcnt(0)" ::: "memory");
            const unsigned og = xb_add(&bar[XB_PTOP(pr)], 1u);
            const unsigned tg = og / 2u;
            if (og + 1u == (tg + 1u) * 2u) xb_add(&bar[XB_PTOPGEN(pr)], 1u);
            else XB_SPIN(xb_ld(&bar[XB_PTOPGEN(pr)]) == tg, bar);
            __builtin_amdgcn_fence(__ATOMIC_ACQUIRE, "agent");
            xb_add(&bar[XB_PGEN(b.x)], 1u);
            asm volatile("s_waitcnt vmcnt(0)" ::: "memory");
        } else {
            XB_SPIN(xb_ld(&bar[XB_PGEN(b.x)]) == gen, bar);
            __builtin_amdgcn_fence(__ATOMIC_ACQUIRE, "agent");
            asm volatile("s_waitcnt vmcnt(0)" ::: "memory");
        }
    }
    __syncthreads();
}
struct Frame {
    unsigned char* lds_g;
    LAS unsigned char* lds;
    volatile LAS unsigned* MISC;
    gu32* ctl;
    int tid, lane, wave;
    int vcu, G;
    unsigned char* ws;
};

__device__ __forceinline__ void transpose_item(const float* W, int K, int N, bf16r* WT, size_t dst_row0, int k0, int n0, LAS float* scr, int lane, const float* gain) {
    f32x4 v[16]; float gk[16];
#pragma unroll
    for (int i = 0; i < 16; ++i) { const int kk = 4 * i + (lane >> 4); v[i] = *(const f32x4*)(W + (size_t)(k0 + kk) * N + n0 + (lane & 15) * 4); gk[i] = gain ? gain[k0 + kk] : 1.0f; }
#pragma unroll
    for (int i = 0; i < 16; ++i) { const int kk = 4 * i + (lane >> 4); const f32x4 w = v[i] * gk[i];
        LAS float* s = scr + kk * 65 + (lane & 15) * 4; s[0] = w[0]; s[1] = w[1]; s[2] = w[2]; s[3] = w[3]; }
    LDS_WAIT(); asm volatile("" ::: "memory");
    const int c = lane & 7;
#pragma unroll
    for (int j = 0; j < 8; ++j) { const int n = (lane >> 3) + 8 * j; const LAS float* s = scr + (8 * c) * 65 + n;
        v4u o; o.x = pk2(s[0 * 65], s[1 * 65]); o.y = pk2(s[2 * 65], s[3 * 65]); o.z = pk2(s[4 * 65], s[5 * 65]); o.w = pk2(s[6 * 65], s[7 * 65]);
        const size_t row = dst_row0 + n;
        *(v4u*)(WT + (((row >> 8) * (size_t)(K >> 6) + (k0 >> 6)) << 14) + ((row & 255) << 6) + 8 * c) = o; }
    LDS_WAIT(); asm volatile("" ::: "memory");
}
__device__ __forceinline__ bool transpose_group(int& r, const float* src, int cnt, int K, int N, bf16r* dst, bool gu, LAS float* scr, int lane, const float* gain, int gmode) {
    const int nkb = K / 64, nnb = N / 64, per = nkb * nnb;
    if (r >= cnt * per) { r -= cnt * per; return false; }
    const int mi = r / per, q = r % per, kb = q / nnb, nb = q % nnb, n0 = nb * 64;
    size_t drow = n0;
    if (gu) { drow = (n0 < FF) ? (size_t)(n0 / 128) * 256 + (n0 % 128) : (size_t)((n0 - FF) / 128) * 256 + 128 + ((n0 - FF) % 128); }
    const float* gp = gain;
    if (gain) { if (gmode == 1) gp = gain + (size_t)((mi >> 1) * 3 + (mi & 1) * 2) * K; else if (gmode >= 2) gp = gain + (size_t)((mi + (gmode - 2)) * 3 + 1) * K; }
    transpose_item(src + (size_t)mi * K * N, K, N, dst + (size_t)mi * K * N, gu ? drow : (size_t)n0, kb * 64, n0, scr, lane, gp);
    return true;
}
__device__ __forceinline__ void norm_row(const float* xrow, const float* gain, bf16r* orow, int lane) {
    const f32x4* xr = (const f32x4*)xrow + lane; f32x4 v[8]; float s = 0.f;
#pragma unroll
    for (int j = 0; j < 8; ++j) { v[j] = xr[64 * j]; s += (v[j][0] * v[j][0] + v[j][1] * v[j][1]) + (v[j][2] * v[j][2] + v[j][3] * v[j][3]); }
    const float rstd = 1.0f / sqrtf(wave_sum(s) * (1.0f / DM) + EPS);
    const f32x4* g4 = (const f32x4*)gain + lane; v2u* o8 = (v2u*)orow + lane;
#pragma unroll
    for (int j = 0; j < 8; ++j) { const f32x4 g = g4[64 * j]; v2u w; w.x = pk2(v[j][0] * rstd * g[0], v[j][1] * rstd * g[1]); w.y = pk2(v[j][2] * rstd * g[2], v[j][3] * rstd * g[3]); o8[64 * j] = w; }
}
__device__ __forceinline__ void xb_ss_phase(const Frame& F, const float* x, bf16r* xb, float* ss) {
    const int gw = F.vcu * NWAVES + F.wave, NGW = F.G * NWAVES, lane = F.lane;
    for (int m = gw; m < M; m += NGW) { const f32x4* xr = (const f32x4*)(x + (size_t)m * DM) + lane; float s = 0.f;
#pragma unroll
        for (int j = 0; j < 8; ++j) { const f32x4 v = xr[64 * j]; s += (v[0] * v[0] + v[1] * v[1]) + (v[2] * v[2] + v[3] * v[3]); v2u w; w.x = pk2(v[0], v[1]); w.y = pk2(v[2], v[3]); const int col = 4 * lane + 256 * j; *(v2u*)(xb + (((size_t)((m >> 8) * (DM >> 6) + (col >> 6))) << 14) + ((m & 255) << 6) + (col & 63)) = w; }
        s = wave_sum(s); if (lane < 32) ss[(size_t)m * 32 + lane] = (lane == 0) ? s : 0.f; }
}
__device__ __forceinline__ void sincos_d(float angf, float& sn, float& cs) {
    const double a = (double)angf; const double k = __builtin_rint(a * 0.15915494309189535); const double r = a - k * 6.283185307179586476925286766559;
    const double r2 = r * r; double ts = r, tc = 1.0, ss = r, cc = 1.0;
#pragma unroll
    for (int n = 1; n <= 14; ++n) { tc = -tc * r2 / (double)((2 * n - 1) * (2 * n)); ts = -ts * r2 / (double)((2 * n) * (2 * n + 1)); cc += tc; ss += ts; }
    sn = (float)ss; cs = (float)cc;
}
__device__ __forceinline__ void combine_phase(const Frame& F, const float* oatt, const float* lamp  , const float* subg  , float lam_init, bf16r* cat) {
    const int gw = F.vcu * NWAVES + F.wave, NGW = F.G * NWAVES, lane = F.lane;
    const float d01 = wave_sum(lamp[lane] * lamp[128 + lane] + lamp[64 + lane] * lamp[192 + lane]);
    const float d23 = wave_sum(lamp[256 + lane] * lamp[384 + lane] + lamp[320 + lane] * lamp[448 + lane]);
    const float lam = expf(d01) - expf(d23) + lam_init;
    const int half = lane >> 5, d4 = (lane & 31) * 4; const f32x4 g = *(const f32x4*)(subg + half * 128 + d4) * (1.0f - lam_init);
    const bool own = F.G == 256; const int m0 = own ? 2048 * ((int)blockIdx.x & 7) + ((int)blockIdx.x >> 3) * NWAVES + F.wave : gw, mstep = own ? 256 : NGW, mend = own ? 2048 * ((int)blockIdx.x & 7) + 2048 : M;
    for (int m = m0; m < mend; m += mstep) { const int b = m >> 12, s = m & 4095;
        f32x4 o[DH]; float ss[DH];
#pragma unroll
        for (int h = 0; h < DH; ++h) { const size_t vh0 = (size_t)((b * 6 + h) * 2 + 0) * 2 + half, vh1 = (size_t)((b * 6 + h) * 2 + 1) * 2 + half;
            const f32x4 o0 = *(const f32x4*)(oatt + (vh0 * SEQ + s) * 128 + d4), o1 = *(const f32x4*)(oatt + (vh1 * SEQ + s) * 128 + d4);
            o[h] = o0 - o1 * lam; ss[h] = (o[h][0] * o[h][0] + o[h][1] * o[h][1]) + (o[h][2] * o[h][2] + o[h][3] * o[h][3]); }
#pragma unroll
        for (int sh = 1; sh < 64; sh <<= 1) {
#pragma unroll
            for (int h = 0; h < DH; ++h) ss[h] += __shfl_xor(ss[h], sh); }
#pragma unroll
        for (int h = 0; h < DH; ++h) { const float rstd = 1.0f / sqrtf(ss[h] * (1.0f / DV) + EPS);
            v2u w; w.x = pk2(o[h][0] * rstd * g[0], o[h][1] * rstd * g[1]); w.y = pk2(o[h][2] * rstd * g[2], o[h][3] * rstd * g[3]);
            *(v2u*)(cat + (size_t)m * DM + h * 256 + half * 128 + d4) = w; }
    }
}

constexpr int GM_WL = 0, GM_WLS = 272, GM_VT = 128 * GM_WLS, GM_VTS = 272, GM_RS = GM_VT + 256 * GM_VTS;
static_assert(GM_RS + 512 <= RING_BYTES, "gmlp LDS");
__device__ __forceinline__ void gmlp_phase(const Frame& F, const bf16r* ZA, const float* vstat, const float* w_s  , const float* b_s  , const float* gv  , bf16r* cat) {
    const int tid = F.tid, lane = F.lane, wave = F.wave, fr = lane & 15, fq = lane >> 4;
    LAS unsigned char* lds = F.lds;
    LAS float* rs = (LAS float*)(lds + GM_RS);
    const bool own = F.G == 256; const int xg = (int)blockIdx.x & 7, jg = (int)blockIdx.x >> 3;
    for (int unit = own ? jg : F.vcu; unit < (own ? 96 : 128 * GG); unit += own ? 32 : F.G) {
        const int bc = own ? 16 * xg + unit / GG : unit / GG, g = unit % GG, r0 = bc * 128;
        if (tid < 128) { const f32x4* p = (const f32x4*)(vstat + (size_t)(r0 + tid) * 24); float s = 0.f;
#pragma unroll
            for (int i = 0; i < 6; ++i) { const f32x4 v = p[i]; s += (v[0] + v[1]) + (v[2] + v[3]); }
            rs[tid] = 1.0f / sqrtf(s * (1.0f / MIXW) + EPS); }
        { const int s = tid & 127, cb = (tid >> 7) * 8;
#pragma unroll
          for (int it = 0; it < 8; ++it) { const int d8 = (cb + it) * 8; const bf16x8 v = *(const bf16x8*)(ZA + (size_t)(r0 + s) * 3072 + 1536 + g * 256 + d8);
#pragma unroll
              for (int e = 0; e < 8; ++e) *(LAS unsigned short*)(lds + GM_VT + (d8 + e) * GM_VTS + s * 2) = (unsigned short)v[e]; } }
        __syncthreads();
        for (int idx = tid; idx < 128 * 32; idx += 512) { const int t = idx >> 5, s4 = (idx & 31) * 4; const f32x4 w = *(const f32x4*)(w_s + ((size_t)g * 128 + t) * 128 + s4);
            float e[4];
#pragma unroll
            for (int j = 0; j < 4; ++j) e[j] = (s4 + j <= t) ? w[j] * rs[s4 + j] : 0.f;
            v2u o; o.x = pk2(e[0], e[1]); o.y = pk2(e[2], e[3]); *(LAS v2u*)(lds + GM_WL + t * GM_WLS + s4 * 2) = o; }
        __syncthreads();
        f32x4 acc[8][2];
#pragma unroll
        for (int tt = 0; tt < 8; ++tt) { acc[tt][0] = (f32x4){0.f, 0.f, 0.f, 0.f}; acc[tt][1] = (f32x4){0.f, 0.f, 0.f, 0.f}; }
#pragma unroll
        for (int ks = 0; ks < 4; ++ks) {
            bf16x8 bfr[2];
#pragma unroll
            for (int dd = 0; dd < 2; ++dd) bfr[dd] = *(const LAS bf16x8*)(lds + GM_VT + (32 * wave + 16 * dd + fr) * GM_VTS + (32 * ks + 8 * fq) * 2);
#pragma unroll
            for (int tt = 0; tt < 8; ++tt) { if (32 * ks <= 16 * tt + 15) {
                const bf16x8 afr = *(const LAS bf16x8*)(lds + GM_WL + (16 * tt + fr) * GM_WLS + (32 * ks + 8 * fq) * 2);
#pragma unroll
                for (int dd = 0; dd < 2; ++dd) acc[tt][dd] = __builtin_amdgcn_mfma_f32_16x16x32_bf16(bfr[dd], afr, acc[tt][dd], 0, 0, 0); } }
        }
#pragma unroll
        for (int tt = 0; tt < 8; ++tt) { const int t = 16 * tt + fr, row = r0 + t; const float bias = b_s[g * 128 + t];
#pragma unroll
            for (int dd = 0; dd < 2; ++dd) { const int d = 32 * wave + 16 * dd + 4 * fq; const f32x4 gg = *(const f32x4*)(gv + g * 256 + d);
                const v2u uu = *(const v2u*)(ZA + (size_t)row * 3072 + g * 256 + d);
                const float u0 = bf2f((unsigned short)(uu.x & 0xffff)), u1 = bf2f((unsigned short)(uu.x >> 16)), u2 = bf2f((unsigned short)(uu.y & 0xffff)), u3 = bf2f((unsigned short)(uu.y >> 16));
                const f32x4 a = acc[tt][dd]; v2u o; o.x = pk2(u0 * (a[0] * gg[0] + bias), u1 * (a[1] * gg[1] + bias)); o.y = pk2(u2 * (a[2] * gg[2] + bias), u3 * (a[3] * gg[3] + bias));
                *(v2u*)(cat + (size_t)row * DM + g * 256 + d) = o; } }
        __syncthreads();
    }
}
namespace att {
__device__ __forceinline__ BlockRef<bf16, float> diff_ref(int L, int pass, const bf16* Q, const bf16* K, const bf16* V, float* O) {
    const int vh = L >> 3, x = L & 7, qb = pass ? 15 - x : x;
    const int b = vh / 24, r = vh % 24, h = r >> 2, c = (r >> 1) & 1, half = r & 1;
    BlockRef<bf16, float> R;
    R.Q = Q + ((size_t)((b * 2 + c) * 6 + h) * SEQ + (size_t)qb * QB) * D; R.K = K + (size_t)((b * 2 + c) * 6 + h) * SEQ * D; R.V = V + (size_t)((b * 6 + h) * 2 + half) * SEQ * D;
    R.O = O + ((size_t)vh * SEQ + (size_t)qb * QB) * D; R.P0 = qb * QB; R.ldo = D;
    return R;
}
__device__ __forceinline__ void diff_attn_phase(char* lds, const bf16* Q, const bf16* K, const bf16* V, float* O, int G, int c0) {
    constexpr int total = 96 * 8; const int W = 1 << 30;
    int L = c0; if (L >= total) return;
    int pass = 0; BlockRef<bf16, float> cur = diff_ref(L, 0, Q, K, V, O);
    Seam<bf16> S;
    causal_swa_prime<bf16, float>(cur, W, lds, S);
    for (;;) {
        const bool more_pass = pass == 0, more_item = L + G < total, last = !more_pass && !more_item;
        int passn = pass + 1, Ln = L;
        if (!more_pass) { passn = 0; Ln = more_item ? L + G : L; }
        const BlockRef<bf16, float> nxt = last ? cur : diff_ref(Ln, passn, Q, K, V, O);
        causal_swa_block<bf16, float>(cur, nxt, SEQ, W, lds, S);
        if (last) break;
        cur = nxt; pass = passn; L = Ln;
    }
}
__device__ __forceinline__ Ref2 diff_ref2(int L, int pass, const bf16* Q, const bf16* K, const bf16* V, float* O) {
    const int bhc = L >> 4, x = L & 15, qb = pass ? 31 - x : x;
    const int b = bhc / 12, r = bhc % 12, h = r >> 1, c = r & 1;
    Ref2 R; const size_t qk = (size_t)((b * 2 + c) * 6 + h) * SEQ;
    R.Q = Q + (qk + (size_t)qb * QB2) * D; R.K = K + qk * D;
    R.V0 = V + (size_t)((b * 6 + h) * 2) * SEQ * D; R.V1 = R.V0 + (size_t)SEQ * D;
    const size_t vh = (size_t)b * 24 + h * 4 + c * 2;
    R.O0 = O + (vh * SEQ + (size_t)qb * QB2) * D; R.O1 = R.O0 + (size_t)SEQ * D; R.P0 = qb * QB2;
    return R;
}
template <bool RS>
__device__ __forceinline__ void diff_attn2_role(char* lds, float* xl, const bf16* Q, const bf16* K, const bf16* V, float* O, int G, int c0, int total) {
    int L = c0; if (L >= total) return;
    int pass = 0; Ref2 cur = diff_ref2(L, 0, Q, K, V, O);
    Seam2 S;
    diff2_prime<RS>(cur, lds, S);
    for (;;) {
        const bool more_pass = pass == 0, more_item = L + G < total, last = !more_pass && !more_item;
        int passn = pass + 1, Ln = L;
        if (!more_pass) { passn = 0; Ln = more_item ? L + G : L; }
        const Ref2 nxt = last ? cur : diff_ref2(Ln, passn, Q, K, V, O);
        diff2_block<RS>(cur, nxt, lds, xl, S);
        if (last) break;
        cur = nxt; pass = passn; L = Ln;
    }
}
__device__ __forceinline__ void diff_attn2_phase(char* lds, float* xl, const bf16* Q, const bf16* K, const bf16* V, float* O, int G, int c0, int total) {
    if (__builtin_amdgcn_readfirstlane((int)threadIdx.x >> 6) < 4) diff_attn2_role<true>(lds, xl, Q, K, V, O, G, c0, total);
    else diff_attn2_role<false>(lds, xl, Q, K, V, O, G, c0, total);
}
__device__ __forceinline__ BlockRef<bf16, bf16> mem_ref(int L, const bf16* Q, const bf16* K, const bf16* V, bf16* cat) {
    const int bh = L >> 4, qb = L & 15, b = bh >> 2, hm = bh & 3;
    BlockRef<bf16, bf16> R;
    R.Q = Q + ((size_t)bh * SEQ + (size_t)qb * QB) * D; R.K = K + (size_t)bh * MEML * D; R.V = V + (size_t)bh * MEML * D;
    R.O = cat + ((size_t)b * SEQ + (size_t)qb * QB) * DM + 1536 + hm * 128; R.P0 = 256; R.ldo = DM;
    return R;
}
__device__ __forceinline__ void mem_attn_phase(char* lds, const bf16* Q, const bf16* K, const bf16* V, bf16* cat, int G, int c0) {
    constexpr int total = 256; const int W = 1 << 30;
    int L = c0; if (L >= total) return;
    BlockRef<bf16, bf16> cur = mem_ref(L, Q, K, V, cat);
    Seam<bf16> S;
    causal_swa_prime<bf16, bf16>(cur, W, lds, S);
    for (;;) {
        const bool last = L + G >= total;
        const BlockRef<bf16, bf16> nxt = last ? cur : mem_ref(L + G, Q, K, V, cat);
        causal_swa_block<bf16, bf16>(cur, nxt, MEML, W, lds, S);
        if (last) break;
        cur = nxt; L += G;
    }
}

struct DynAttn { unsigned* qcnt; const unsigned* rq; const unsigned* rkv; unsigned tag; unsigned* tmo; volatile __attribute__((address_space(3))) unsigned* bc; };
__device__ __forceinline__ unsigned dyn_pull(const DynAttn& C, int bpref) {
    if (threadIdx.x == 0) {
        unsigned code = 0xffffffffu;
        for (unsigned spins = 0;; ++spins) {
            bool any_left = false;
#pragma unroll 1
            for (int k = 0; k < 4 && code == 0xffffffffu; ++k) { const int b = (bpref + k) & 3;
                if (__hip_atomic_load(C.qcnt + 64 * b, __ATOMIC_RELAXED, __HIP_MEMORY_SCOPE_AGENT) >= 384u) continue;
                any_left = true;
                const bool ready = __hip_atomic_load(C.rq + 64 * (2 * b), __ATOMIC_RELAXED, __HIP_MEMORY_SCOPE_AGENT) == C.tag && __hip_atomic_load(C.rq + 64 * (2 * b + 1), __ATOMIC_RELAXED, __HIP_MEMORY_SCOPE_AGENT) == C.tag &&
                                   __hip_atomic_load(C.rkv + 64 * (2 * b), __ATOMIC_RELAXED, __HIP_MEMORY_SCOPE_AGENT) != 0u && __hip_atomic_load(C.rkv + 64 * (2 * b + 1), __ATOMIC_RELAXED, __HIP_MEMORY_SCOPE_AGENT) != 0u;
                if (!ready) continue;
                const unsigned n = __hip_atomic_fetch_add(C.qcnt + 64 * b, 1u, __ATOMIC_RELAXED, __HIP_MEMORY_SCOPE_AGENT);
                if (n < 384u) code = ((unsigned)b << 16) | n;
            }
            if (code != 0xffffffffu || !any_left) break;
            __builtin_amdgcn_s_sleep(8);
            if ((spins & 255u) == 255u) { if (__hip_atomic_load(C.tmo, __ATOMIC_RELAXED, __HIP_MEMORY_SCOPE_AGENT)) break; if (spins > (1u << 20)) { __hip_atomic_store(C.tmo, 1u, __ATOMIC_RELAXED, __HIP_MEMORY_SCOPE_AGENT); break; } }
        }
        __builtin_amdgcn_fence(__ATOMIC_ACQUIRE, "agent");
        asm volatile("s_waitcnt vmcnt(0)" ::: "memory");
        C.bc[0] = code;
    }
    __syncthreads();
    const unsigned code = C.bc[0];
    __syncthreads();
    return code;
}
__device__ __forceinline__ BlockRef<bf16, float> dyn_ref(unsigned code, const bf16* Q, const bf16* K, const bf16* V, float* O) {
    const int b = (int)(code >> 16), n = (int)(code & 0xffffu), qb = 15 - (n & 15), r = n >> 4, h = r >> 2, c = (r >> 1) & 1, half = r & 1, vh = b * 24 + r;
    BlockRef<bf16, float> R;
    R.Q = Q + ((size_t)((b * 2 + c) * 6 + h) * SEQ + (size_t)qb * QB) * D; R.K = K + (size_t)((b * 2 + c) * 6 + h) * SEQ * D; R.V = V + (size_t)((b * 6 + h) * 2 + half) * SEQ * D;
    R.O = O + ((size_t)vh * SEQ + (size_t)qb * QB) * D; R.P0 = qb * QB; R.ldo = D;
    return R;
}
__device__ __forceinline__ void diff_attn_dyn_phase(char* lds, const bf16* Q, const bf16* K, const bf16* V, float* O, const DynAttn& C, int bpref) {
    const int W = 1 << 30;
    unsigned code = dyn_pull(C, bpref); if (code == 0xffffffffu) return;
    BlockRef<bf16, float> cur = dyn_ref(code, Q, K, V, O);
    Seam<bf16> S;
    causal_swa_prime<bf16, float>(cur, W, lds, S);
    for (;;) {
        const unsigned nc = dyn_pull(C, bpref); const bool last = nc == 0xffffffffu;
        const BlockRef<bf16, float> nxt = last ? cur : dyn_ref(nc, Q, K, V, O);
        causal_swa_block<bf16, float>(cur, nxt, SEQ, W, lds, S);
        if (last) break;
        cur = nxt;
    }
}
}

constexpr int NPL = 8, PH_BASE = 1, NPH = PH_BASE + DEPTH * NPL;
enum { I_X = 0, I_MEM, I_NORMG, I_WGU, I_WDN, I_WOUT, I_MEMNG, I_MEMWKV, I_MEMQG, I_MEMKG, I_AWIN, I_AVG, I_AWS, I_ABS, I_KVG, I_WKV, I_KG, I_BWIN, I_BQG, I_BLAM, I_BSUBG, N_IN };
struct Args { const float* in[N_IN]; float* out; unsigned char* ws; int ph_lo, ph_hi, li, pad; };

#ifndef EN_MASK
#define EN_MASK 0xFFFFFFFFu
#endif
#define SITE(n) (((EN_MASK) >> (n)) & 1u)
#define IN(k) (lo <= (k) && (k) < hi)
#ifndef PROBE_WAIT
#define PROBE_WAIT 0
#endif
#ifndef PROBE_PHASE
#define PROBE_PHASE 0
#endif
#ifndef LOCAL_SEAMS
#define PAIR_SEAMS 1
#define LOCAL_SEAMS 1
#endif
#define SEAM_X(k, local) do { if (IN((k) + 1)) { unsigned long long t0_ = 0; if (PROBE_WAIT) t0_ = __builtin_amdgcn_s_memrealtime(); \
    if (LOCAL_SEAMS && (local) == 1 && F.MISC[24] != 0u) xcd_local_barrier(bar); else if (LOCAL_SEAMS && PAIR_SEAMS && (local) == 2 && F.MISC[24] != 0u) xcd_pair_barrier(bar); else xcd_barrier(bar); \
    if (PROBE_WAIT && ((PROBE_WAIT >> CUR_SITE) & 1) && F.tid == 0) F.MISC[16] += (unsigned)(__builtin_amdgcn_s_memrealtime() - t0_); \
    } \
    if (PROBE_PHASE && ((PROBE_PHASE >> CUR_SITE) & 1) && F.tid == 0) F.MISC[17] += (unsigned)(__builtin_amdgcn_s_memrealtime() - tsite_); } while (0)
#define SEAM(k) SEAM_X(k, 0)
#define SEAM_L(k) SEAM_X(k, 1)
#define SEAM_P(k) SEAM_X(k, 2)
constexpr int CW_RQ = 70016, CW_RKV = 70656, CW_QCNT = 71296;
#define PUBLISH_FLAG(word, val) do { if (blockIdx.x < 8 && F.tid == 0) { __builtin_amdgcn_fence(__ATOMIC_RELEASE, "agent"); asm volatile("s_waitcnt vmcnt(0)" ::: "memory"); \
    __hip_atomic_store((unsigned*)F.ctl + (word) + 64 * (blockIdx.x & 7), (unsigned)(val), __ATOMIC_RELAXED, __HIP_MEMORY_SCOPE_AGENT); } } while (0)
#define SITE_T0 unsigned long long tsite_ = 0; if (PROBE_PHASE) tsite_ = __builtin_amdgcn_s_memrealtime(); (void)tsite_;
#define CAS __attribute__((address_space(4)))
#define WS_PTRS \
    const CAS Args* ap = (const CAS Args*)__builtin_amdgcn_kernarg_segment_ptr(); asm volatile("" : "+s"(ap)); \
    unsigned char* const ws = ap->ws; \
    bf16r* const Wgu = (bf16r*)(ws + WS_WGU); bf16r* const Wdn = (bf16r*)(ws + WS_WDN); bf16r* const Wout = (bf16r*)(ws + WS_WOUT); bf16r* const Wmem = (bf16r*)(ws + WS_WMEM); \
    bf16r* const Wain = (bf16r*)(ws + WS_WAIN); bf16r* const Wkv = (bf16r*)(ws + WS_WKV); bf16r* const Wbin = (bf16r*)(ws + WS_WBIN); \
    unsigned* const CS = (unsigned*)(ws + WS_COS); \
    bf16r* const MEMN = (bf16r*)(ws + WS_MEMN); bf16r* const MK = (bf16r*)(ws + WS_MK); bf16r* const MV = (bf16r*)(ws + WS_MV); \
    bf16r* const XB = (bf16r*)(ws + WS_XB); float* const SS = (float*)(ws + WS_SS); _Float16* const XH = (_Float16*)(ws + WS_XH); bf16r* const HID = (bf16r*)(ws + WS_HID); bf16r* const ZA = (bf16r*)(ws + WS_ZA); \
    float* const VSTAT = (float*)(ws + WS_VSTAT); \
    bf16r* const QB_ = (bf16r*)(ws + WS_QB); bf16r* const KSH = (bf16r*)(ws + WS_KSH); bf16r* const VSH = (bf16r*)(ws + WS_VSH); bf16r* const QMB = (bf16r*)(ws + WS_QMB); \
    float* const OATT = (float*)(ws + WS_OATT); bf16r* const CAT = (bf16r*)(ws + WS_CAT); \
    float* const X = ap->out; \
    (void)Wgu; (void)Wdn; (void)Wout; (void)Wmem; (void)Wain; (void)Wkv; (void)Wbin; (void)CS; (void)MEMN; (void)MK; (void)MV; (void)XB; (void)SS; (void)XH; (void)HID; (void)ZA; \
    (void)VSTAT; (void)QB_; (void)KSH; (void)VSH; (void)QMB; (void)OATT; (void)CAT; (void)X;

constexpr int EX_OFF = RING_BYTES + 2048;
constexpr int RTAB_OFF = RING_BYTES;
__device__ __forceinline__ pg8::RowScale fill_rstd(const Frame& F, const float* ss, const pg8::StaticOrder& So) {
    pg8::Unit u0; const int pm0 = So.next(0, u0) ? u0.pm : -1;
    { pg8::Unit ui; bool same = true; for (int i = 1; So.next(i, ui); ++i) same &= (ui.pm == pm0); if (!same && F.tid == 0) __hip_atomic_store((unsigned*)F.ctl + XB_TMO, 1u, __ATOMIC_RELAXED, __HIP_MEMORY_SCOPE_AGENT); }
    LAS float* tab = (LAS float*)(F.lds + RTAB_OFF);
    __syncthreads();
    if (pm0 >= 0 && F.tid < 256) { const f32x4* p = (const f32x4*)(ss + (size_t)(pm0 * 256 + F.tid) * 32); float s = 0.f;
#pragma unroll
        for (int i = 0; i < 8; ++i) { const f32x4 v = p[i]; s += (v[0] + v[1]) + (v[2] + v[3]); }
        const float v = s * (1.0f / DM) + EPS; tab[2 * F.tid] = 1.0f / sqrtf(v); tab[2 * F.tid + 1] = v; }
    __syncthreads();
    return pg8::RowScale{(const LAS float*)tab};
}
#ifndef ATTN2
#define ATTN2 1
#endif
#ifndef DYN_ATTN
#define DYN_ATTN 0
#endif
template <int L, int S>
__device__ __forceinline__ void ffn_part(const Frame& F, const XcdBarrier& bar, unsigned char* smem, const int lo, const int hi) {
    constexpr int pf = PH_BASE + L * NPL + (S ? 6 : 0);
    if (SITE(3) && IN(pf)) { constexpr int CUR_SITE = 3; (void)CUR_SITE; SITE_T0 WS_PTRS
        pg8::Gemm g{XB, Wgu + (size_t)(L * 2 + S) * NGU * DM, M, NGU, DM}; pg8::StaticOrder So; So.init(M, NGU, F.G, (int)blockIdx.x);
        pg8::EpiSwiglu E{HID, FF, fill_rstd(F, SS, So)};
        pg8::gemm_phase<pg8::EpiSwiglu, pg8::StaticOrder, true, true, true, true>(F.lds + RING_OFF, g, So, E);
        if constexpr (L == NA && S == 0) {
            pg8::Gemm g2{XB, Wkv, M, NKV, DM}; pg8::StaticOrder S2; S2.init(M, NKV, F.G, (int)blockIdx.x);
            pg8::EpiQKRope E2{1, KSH, VSH, ap->in[I_KG], nullptr, CS, (LAS float*)(F.lds + EX_OFF), fill_rstd(F, SS, S2)};
            pg8::gemm_phase<pg8::EpiQKRope, pg8::StaticOrder, true, true, true, true>(F.lds + RING_OFF, g2, S2, E2);
        }
        SEAM_L(pf);
        if constexpr (L == NA && S == 0) { if (DYN_ATTN && IN(pf + 1)) PUBLISH_FLAG(CW_RKV, 1u); }
    }
    if (SITE(4) && IN(pf + 1)) { constexpr int CUR_SITE = 4; (void)CUR_SITE; SITE_T0 WS_PTRS
        pg8::Gemm g{HID, Wdn + (size_t)(L * 2 + S) * DM * FF, M, DM, FF}; pg8::ColSweepOrder So{(int)blockIdx.x};
        pg8::EpiResid E{(L == 0 && S == 0) ? ap->in[I_X] : nullptr, (L == DEPTH - 1 && S == 1) ? X : nullptr, DM, 0.5f, XB, SS, XH};
        pg8::gemm_phase<pg8::EpiResid, pg8::ColSweepOrder, true, true, true, true>(F.lds + RING_OFF, g, So, E);
        SEAM_L(pf + 1);
    }
}
template <int L>
__device__ __forceinline__ void mixer_part(const Frame& F, const XcdBarrier& bar, unsigned char* smem, const int lo, const int hi) {
    constexpr int pb = PH_BASE + L * NPL;
    if (SITE(6) && IN(pb + 2)) { constexpr int CUR_SITE = 6; (void)CUR_SITE; SITE_T0 WS_PTRS
        if constexpr (L < NA) { pg8::Gemm g{XB, Wain + (size_t)L * NAIN * DM, M, NAIN, DM}; pg8::StaticOrder So; So.init(M, NAIN, F.G, (int)blockIdx.x);
            pg8::EpiAin E{ZA, VSTAT, QMB, ap->in[I_MEMQG] + L * HD, (LAS float*)(F.lds + EX_OFF), fill_rstd(F, SS, So)};
            pg8::gemm_phase<pg8::EpiAin, pg8::StaticOrder, true, true, true, true>(F.lds + RING_OFF, g, So, E);
            if constexpr (L == 0) {
                if ((int)blockIdx.x >= 128) { pg8::Gemm gm{MEMN, Wmem, 4096, 4096, DM}; pg8::MemKvOrder Sm{F.G, (int)blockIdx.x - 128};
                    pg8::EpiMemKv Em{MK, MV, ap->in[I_MEMKG], (LAS float*)(F.lds + EX_OFF)};
                    pg8::gemm_phase<pg8::EpiMemKv, pg8::MemKvOrder, true, true, false, true>(F.lds + RING_OFF, gm, Sm, Em); } } }
        else { pg8::Gemm g{XB, Wbin + (size_t)(L - NA) * NBIN * DM, M, NBIN, DM}; pg8::StaticOrder So; So.init(M, NBIN, F.G, (int)blockIdx.x);
            pg8::EpiQKRope E{0, QB_, QMB, ap->in[I_BQG] + (L - NA) * HD, ap->in[I_MEMQG] + L * HD, CS, (LAS float*)(F.lds + EX_OFF), fill_rstd(F, SS, So)};
            pg8::gemm_phase<pg8::EpiQKRope, pg8::StaticOrder, true, true, true, true>(F.lds + RING_OFF, g, So, E); }
        if constexpr (L == 1 || (L >= NA && DYN_ATTN)) SEAM_L(pb + 2); else if constexpr (L >= NA && PAIR_SEAMS) SEAM_P(pb + 2); else SEAM(pb + 2);
        if constexpr (L >= NA) { if (DYN_ATTN && IN(pb + 3)) PUBLISH_FLAG(CW_RQ, (unsigned)L); }
    }
    if (SITE(8) && IN(pb + 3)) { constexpr int CUR_SITE = 8; (void)CUR_SITE; SITE_T0 WS_PTRS
        if constexpr (L < NA) gmlp_phase(F, ZA, VSTAT, ap->in[I_AWS] + (size_t)L * GG * 128 * 128, ap->in[I_ABS] + (size_t)L * GG * 128, ap->in[I_AVG] + (size_t)L * MIXW, CAT);
        { const int xg = (int)blockIdx.x & 7, jg = (int)blockIdx.x >> 3, pnl = 8 * xg + (jg >> 2);
          const int c0 = ((L < NA || DYN_ATTN || PAIR_SEAMS) && F.G == 256) ? (((pnl >> 4) * 4 + (jg & 3)) * 16 + (pnl & 15)) : F.vcu;
          att::mem_attn_phase((char*)smem, (const att::bf16*)QMB, (const att::bf16*)(MK + (size_t)L * 1024 * 512), (const att::bf16*)(MV + (size_t)L * 1024 * 512), (att::bf16*)CAT, F.G, c0); }
        if constexpr (L >= NA) {
            float* const Ol = OATT + (size_t)(L - NA) * 96 * SEQ * 128;
            if (DYN_ATTN) { const att::DynAttn C{(unsigned*)F.ctl + CW_QCNT + 64 * 4 * (L - NA), (const unsigned*)F.ctl + CW_RQ, (const unsigned*)F.ctl + CW_RKV, (unsigned)L, (unsigned*)F.ctl + XB_TMO, F.MISC + 28};
                att::diff_attn_dyn_phase((char*)smem, (const att::bf16*)QB_, (const att::bf16*)KSH, (const att::bf16*)VSH, Ol, C, ((int)blockIdx.x & 7) >> 1); }
            else if (ATTN2) att::diff_attn2_phase((char*)smem, (float*)(smem + 133120), (const att::bf16*)QB_, (const att::bf16*)KSH, (const att::bf16*)VSH, Ol,
                    (PAIR_SEAMS && F.G == 256) ? 64 : F.G, (PAIR_SEAMS && F.G == 256) ? 192 * (((int)blockIdx.x & 7) >> 1) + ((int)blockIdx.x & 1) * 32 + ((int)blockIdx.x >> 3) : F.vcu,
                    (PAIR_SEAMS && F.G == 256) ? 192 * ((((int)blockIdx.x & 7) >> 1) + 1) : 48 * 16);
            else att::diff_attn_phase((char*)smem, (const att::bf16*)QB_, (const att::bf16*)KSH, (const att::bf16*)VSH, Ol, F.G, F.vcu);
        }
        if constexpr (L < NA) SEAM_L(pb + 3); else if constexpr (PAIR_SEAMS) SEAM_P(pb + 3); else SEAM(pb + 3);
    }
    if constexpr (L >= NA) {
        if (SITE(9) && IN(pb + 4)) { constexpr int CUR_SITE = 9; (void)CUR_SITE; SITE_T0 WS_PTRS constexpr float lam_init = (L == 2) ? 0.47071301834358416f : 0.5560582041556405f;
            combine_phase(F, OATT + (size_t)(L - NA) * 96 * SEQ * 128, ap->in[I_BLAM] + (size_t)(L - NA) * 512, ap->in[I_BSUBG] + (size_t)(L - NA) * DV, lam_init, CAT);
            SEAM_L(pb + 4); }
    }
    if (SITE(10) && IN(pb + 5)) { constexpr int CUR_SITE = 10; (void)CUR_SITE; SITE_T0 WS_PTRS
        pg8::Gemm g{CAT, Wout + (size_t)L * DM * DM, M, DM, DM}; pg8::ColSweepOrder So{(int)blockIdx.x};
        pg8::EpiResid E{nullptr, nullptr, DM, 1.0f, XB, SS, XH};
        pg8::gemm_phase<pg8::EpiResid, pg8::ColSweepOrder, true, true, false, true>(F.lds + RING_OFF, g, So, E);
        SEAM_L(pb + 5);
    }
}

__global__ void __launch_bounds__(NWAVES * 64, 2) yoco_fwd(Args args) {
    extern __shared__ __attribute__((aligned(16))) unsigned char smem[];
    Frame F;
    F.lds_g = smem; F.lds = (LAS unsigned char*)smem;
    F.MISC = (volatile LAS unsigned*)(F.lds + MISC_OFF);
    F.tid = threadIdx.x; F.lane = F.tid & 63; F.wave = __builtin_amdgcn_readfirstlane(F.tid >> 6);
    F.G = gridDim.x; { const int bx = blockIdx.x; F.vcu = (F.G % 8 == 0) ? (bx % 8) * (F.G / 8) + bx / 8 : bx; }
    F.ws = args.ws;
    F.ctl = (gu32*)(args.ws + WS_CTL);
    for (int u = F.tid; u < (LDS_BYTES - LDSCTL_OFF) / 4; u += NWAVES * 64) ((LAS unsigned*)(F.lds + LDSCTL_OFF))[u] = 0u;
    __syncthreads();
    XcdBarrier bar = xcd_barrier_post((unsigned*)F.ctl + (size_t)args.li * XCD_BAR_WORDS, F.MISC + 8);
    if (F.tid == 0) __hip_atomic_store((unsigned*)F.ctl + XB_XCCTAB + blockIdx.x, bar.x + 1u, __ATOMIC_RELAXED, __HIP_MEMORY_SCOPE_AGENT);
    const int lo = args.ph_lo, hi = args.ph_hi;
    {
    const int gw = F.vcu * NWAVES + F.wave, NGW = F.G * NWAVES;
    if (SITE(0) && IN(0)) { constexpr int CUR_SITE = 0; (void)CUR_SITE; SITE_T0 WS_PTRS
        LAS float* scr = (LAS float*)(F.lds + RING_OFF + F.wave * 16640);
        constexpr int NIT = 8 * (DM / 64) * (NGU / 64) + 8 * (FF / 64) * (DM / 64) + 4 * 32 * 32 + 4 * 32 * 16 + 2 * 32 * (NAIN / 64) + 32 * (NKV / 64) + 2 * 32 * 32;
        for (int it = gw; it < NIT; it += NGW) { int r = it;
            if (transpose_group(r, ap->in[I_WGU], 8, DM, NGU, Wgu, true, scr, F.lane, ap->in[I_NORMG], 1)) continue;
            if (transpose_group(r, ap->in[I_WDN], 8, FF, DM, Wdn, false, scr, F.lane, nullptr, 0)) continue;
            if (transpose_group(r, ap->in[I_WOUT], 4, DM, DM, Wout, false, scr, F.lane, nullptr, 0)) continue;
            if (transpose_group(r, ap->in[I_MEMWKV], 4, DM, 1024, Wmem, false, scr, F.lane, nullptr, 0)) continue;
            if (transpose_group(r, ap->in[I_AWIN], 2, DM, NAIN, Wain, false, scr, F.lane, ap->in[I_NORMG], 2)) continue;
            if (transpose_group(r, ap->in[I_WKV], 1, DM, NKV, Wkv, false, scr, F.lane, ap->in[I_KVG], 0)) continue;
            transpose_group(r, ap->in[I_BWIN], 2, DM, NBIN, Wbin, false, scr, F.lane, ap->in[I_NORMG], 4); }
        for (int i = gw * 64 + F.lane; i < SEQ * 64; i += NGW * 64) { const int pos = i >> 6, k = i & 63; const float inv = (float)pow(10000.0, -(double)k / 64.0); const float ang = (float)pos * inv;
            float sn, cs; sincos_d(ang, sn, cs); typedef _Float16 h2 __attribute__((ext_vector_type(2))); h2 t; t.x = (_Float16)cs; t.y = (_Float16)sn; CS[i] = __builtin_bit_cast(unsigned, t); }
        for (int r = gw; r < 4096; r += NGW) { const int l = r >> 10, mm = r & 1023; norm_row(ap->in[I_MEM] + (size_t)mm * DM, ap->in[I_MEMNG] + l * DM, MEMN + (size_t)r * DM, F.lane); }
        xb_ss_phase(F, ap->in[I_X], XB, SS);
        SEAM(0);
        if (LOCAL_SEAMS && IN(1)) { if (F.tid < 64) { bool ok = F.G == 256; unsigned mine[4];
#pragma unroll
                for (int q = 0; q < 4; ++q) { const unsigned i = F.tid + 64 * q; mine[q] = __hip_atomic_load((unsigned*)F.ctl + XB_XCCTAB + i, __ATOMIC_RELAXED, __HIP_MEMORY_SCOPE_AGENT);
                    const unsigned rep = __hip_atomic_load((unsigned*)F.ctl + XB_XCCTAB + (i & 7u), __ATOMIC_RELAXED, __HIP_MEMORY_SCOPE_AGENT); ok = ok && mine[q] != 0u && mine[q] == rep; }
                if (F.tid < 8) { for (unsigned o = 0; o < 8; ++o) { const unsigned other = __hip_atomic_load((unsigned*)F.ctl + XB_XCCTAB + o, __ATOMIC_RELAXED, __HIP_MEMORY_SCOPE_AGENT); ok = ok && (o == (unsigned)F.tid || other != mine[0]); } }
                ok = __all(ok); if (F.tid == 0) F.MISC[24] = ok ? 1u : 0u; }
            __syncthreads(); }
    }
    }
    ffn_part<0, 0>(F, bar, smem, lo, hi); mixer_part<0>(F, bar, smem, lo, hi); ffn_part<0, 1>(F, bar, smem, lo, hi);
    ffn_part<1, 0>(F, bar, smem, lo, hi); mixer_part<1>(F, bar, smem, lo, hi); ffn_part<1, 1>(F, bar, smem, lo, hi);
    ffn_part<2, 0>(F, bar, smem, lo, hi); mixer_part<2>(F, bar, smem, lo, hi); ffn_part<2, 1>(F, bar, smem, lo, hi);
    ffn_part<3, 0>(F, bar, smem, lo, hi); mixer_part<3>(F, bar, smem, lo, hi); ffn_part<3, 1>(F, bar, smem, lo, hi);
    if (PROBE_PHASE) { if (blockIdx.x == 0 && F.tid == 0) { const unsigned long long tot = F.MISC[17], t0 = __builtin_amdgcn_s_memrealtime(); while (__builtin_amdgcn_s_memrealtime() - t0 < tot) __builtin_amdgcn_s_sleep(8); } }
#ifdef PROBE_LOCALOK
    if (blockIdx.x == 0 && F.tid == 0 && F.MISC[24] != 0u) { const unsigned long long t0 = __builtin_amdgcn_s_memrealtime(); while (__builtin_amdgcn_s_memrealtime() - t0 < 50000ull) __builtin_amdgcn_s_sleep(8); }
#endif
    if (PROBE_WAIT) {
        unsigned* sumw = (unsigned*)F.ctl + 65536;
        if (F.tid == 0) __hip_atomic_fetch_add(sumw, F.MISC[16], __ATOMIC_RELAXED, __HIP_MEMORY_SCOPE_AGENT);
        xcd_barrier(bar);
        if (blockIdx.x == 0 && F.tid == 0) { const unsigned tot = __hip_atomic_load(sumw, __ATOMIC_RELAXED, __HIP_MEMORY_SCOPE_AGENT); const unsigned long long avg = tot / gridDim.x, t0 = __builtin_amdgcn_s_memrealtime();
            while (__builtin_amdgcn_s_memrealtime() - t0 < avg) __builtin_amdgcn_s_sleep(8); }
    }
}
#undef IN
#undef SEAM

#ifndef MK_MODE
#define MK_MODE 1
#endif
extern "C" void kernel_launch(void* const* d_in, const int* in_sizes, int n_in, void* d_out, int out_size, void* d_ws, size_t ws_size, hipStream_t stream) {
    static int grid = 0;
    if (grid == 0) {
        if (n_in != N_IN || out_size != M * DM || ws_size < WS_END) { fprintf(stderr, "kernel_launch: unexpected shapes: n_in %d out %d ws %zu (need %zu)\n", n_in, out_size, ws_size, (size_t)WS_END); grid = -1; return; }
        int dev = 0, cus = 0, per_cu = 0;
        if (hipGetDevice(&dev) != hipSuccess || hipDeviceGetAttribute(&cus, hipDeviceAttributeMultiprocessorCount, dev) != hipSuccess) { grid = -1; return; }
        if (hipFuncSetAttribute((const void*)yoco_fwd, hipFuncAttributeMaxDynamicSharedMemorySize, LDS_BYTES) != hipSuccess) { fprintf(stderr, "kernel_launch: hipFuncSetAttribute failed\n"); grid = -1; return; }
        if (hipOccupancyMaxActiveBlocksPerMultiprocessor(&per_cu, (const void*)yoco_fwd, NWAVES * 64, LDS_BYTES) != hipSuccess || per_cu < 1) fprintf(stderr, "kernel_launch: occupancy query says %d blocks per CU\n", per_cu);
        (void)hipGetLastError();
        grid = cus;
        if (cus != 256) { fprintf(stderr, "kernel_launch: built for a 256-CU device (got %d)\n", cus); grid = -1; return; }
    }
    if (grid < 0) return;
    (void)in_sizes;
    if (hipMemsetAsync((char*)d_ws + WS_CTL, 0, CTL_ZERO_BYTES, stream) != hipSuccess) return;
    Args a{};
    for (int i = 0; i < N_IN; ++i) a.in[i] = (const float*)d_in[i];
    a.out = (float*)d_out; a.ws = (unsigned char*)d_ws; a.pad = 0;
#if MK_MODE == 1
    a.ph_lo = 0; a.ph_hi = NPH; a.li = 0;
    hipLaunchKernelGGL(yoco_fwd, dim3(grid), dim3(NWAVES * 64), LDS_BYTES, stream, a);
#else
    for (int p = 0; p < NPH; ++p) {
        const int k = (p - PH_BASE) % NPL, l = (p - PH_BASE) / NPL;
        if (p >= PH_BASE && (k == 4 && l < NA)) continue;
        a.ph_lo = p; a.ph_hi = p + 1; a.li = 0;
        hipLaunchKernelGGL(yoco_fwd, dim3(grid), dim3(NWAVES * 64), LDS_BYTES, stream, a);
    }
#endif
}
```

```cpp
#include <hip/hip_runtime.h>
#include <hip/hip_bf16.h>
#include <cstdio>
#include <cstdint>

constexpr int BATCH = 4, SEQ = 4096, DM = 2048, DEPTH = 4, NA = 2;
constexpr int M = BATCH * SEQ;
constexpr int MEML = 256, HD = 128, MEMH = 4, MEMW = 512, MIXW = 1536, CHUNK = 128, GG = 6, GW = 256, DH = 6, DV = 256, FF = 5632;
constexpr int NGU = 2 * FF;
constexpr int NAIN = 2 * MIXW + MEMW;
constexpr int NBIN = MIXW + MEMW;
constexpr int NKV = 2 * DH * HD + DH * DV;
constexpr float EPS = 1e-6f;
namespace pg8 {
#define PG8_LAS __attribute__((address_space(3)))
typedef unsigned short bf16_t;
typedef short bf16x8 __attribute__((ext_vector_type(8)));
typedef float f32x4 __attribute__((ext_vector_type(4)));
typedef unsigned u32x4 __attribute__((ext_vector_type(4)));
constexpr int BM = 256, BK = 64, HALF = 128, HTB = HALF * BK * 2  , STAGE_BYTES = 8 * HTB, NXCD = 8, WGM = 8;

__host__ __device__ __forceinline__ int lds_byte(int r, int c) { const int st = (r >> 4) * 2 + (c >> 5), rr = r & 15, cc = c & 31, ob = rr * 64 + cc * 2; return st * 1024 + (ob ^ (((ob >> 9) & 1) << 5)); }
__host__ __device__ __forceinline__ void stage_rc(int b, int& R, int& C) { const int st = b / 1024, sb = b % 1024, swz = sb ^ (((sb >> 9) & 1) << 5); R = (st >> 1) * 16 + swz / 64; C = (st & 1) * 32 + (swz % 64) / 2; }
__host__ __device__ __forceinline__ int perm32(int rho) { const int n = rho >> 4, i = rho & 15; return 8 * (i >> 2) + 4 * n + (i & 3); }

struct Unit { int pm, pn; };
struct Gemm { const bf16_t* A; const bf16_t* Bt; int M, N, K; };

struct StaticOrder {
    int nM, nN, nwg, G, c;
    __host__ __device__ void init(int M, int N, int G_, int c_) { nM = M / BM; nN = N / BM; nwg = nM * nN; G = G_; c = c_; }
    __host__ __device__ bool next(int i, Unit& u) const {
        const long L = (long)i * G + c; if (L >= nwg) return false;
        int wgid = (int)L; { const int q = nwg / NXCD, r = nwg % NXCD, xcd = wgid % NXCD, off = wgid / NXCD; wgid = (xcd < r ? xcd * (q + 1) : r * (q + 1) + (xcd - r) * q) + off; }
        const int nig = WGM * nN, gid = wgid / nig, fm = gid * WGM, gsz = (nM - fm) < WGM ? (nM - fm) : WGM;
        u.pm = fm + ((wgid % nig) % gsz); u.pn = (wgid % nig) / gsz; return true;
    }
    __device__ __forceinline__ void a_ready(const Unit&) const {}
    __device__ __forceinline__ void done(const Unit&) const {}
};
__device__ __forceinline__ unsigned cvt_pk_bf16(float lo, float hi) { unsigned r; asm volatile("v_cvt_pk_bf16_f32 %0, %1, %2" : "=v"(r) : "v"(lo), "v"(hi)); return r; }
typedef float f32x2 __attribute__((ext_vector_type(2)));
typedef unsigned u32x2 __attribute__((ext_vector_type(2)));
__device__ __forceinline__ f32x2 gelu_pk(f32x2 v) {
    const f32x2 av = __builtin_elementwise_abs(v), d = av * 0.2316418882f + 1.0f;
    f32x2 t; t.x = __builtin_amdgcn_rcpf(d.x); t.y = __builtin_amdgcn_rcpf(d.y);
    f32x2 q = t * 0.5307027145f + (-0.7265760135f); q = q * t + 0.7107068705f; q = q * t + (-0.142248368f); q = q * t + 0.127414796f; q = q * t;
    const f32x2 s = (v * v) * (-0.72134752044f);
    f32x2 e; e.x = __builtin_amdgcn_exp2f(s.x); e.y = __builtin_amdgcn_exp2f(s.y);
    const f32x2 m = v * (q * e), r = v - m;
    f32x2 o; o.x = v.x < 0.f ? m.x : r.x; o.y = v.y < 0.f ? m.y : r.y; return o;
}
__device__ __forceinline__ float silu_f(float g) { return g * __builtin_amdgcn_rcpf(1.0f + __builtin_amdgcn_exp2f(-1.4426950408889634f * g)); }
__device__ __forceinline__ u32x4 pack8_bf16(f32x4 a, f32x4 b) { u32x4 w; w.x = cvt_pk_bf16(a[0], a[1]); w.y = cvt_pk_bf16(a[2], a[3]); w.z = cvt_pk_bf16(b[0], b[1]); w.w = cvt_pk_bf16(b[2], b[3]); return w; }

__host__ __device__ __forceinline__ size_t blk_off(int row, int col, int kt) { return ((size_t)((row >> 8) * kt + (col >> 6)) << 14) + ((row & 255) << 6) + (col & 63); }
struct RowScale { const PG8_LAS float* rtab; };
__device__ __forceinline__ void get_rstd(float (&rs)[2][4], const RowScale& R, int wr, int fr) {
#pragma unroll
    for (int ai = 0; ai < 2; ++ai)
#pragma unroll
        for (int m = 0; m < 4; ++m) rs[ai][m] = R.rtab ? R.rtab[2 * (ai * HALF + wr * 64 + m * 16 + fr)] : 1.0f;
}
struct EpiSwiglu {
    static constexpr bool PERM = true, AFTER_DRAIN = false;
    static __host__ __device__ __forceinline__ int bmap(int R) { return (R & ~31) + perm32(R & 31); }
    bf16_t* H; int ldh; RowScale R;
    __device__ __forceinline__ void operator()(const f32x4 (&acc)[2][2][4][2], const Unit& u, int wr, int wc, int fr, int fq) const {
        const int row0 = u.pm * BM + wr * 64 + fr, col0 = u.pn * HALF + wc * 32 + 8 * fq;
#pragma unroll
        for (int ai = 0; ai < 2; ++ai)
#pragma unroll
            for (int m = 0; m < 4; ++m) { const f32x2 rv = *(const PG8_LAS f32x2*)(R.rtab + 2 * (ai * HALF + wr * 64 + m * 16 + fr)); const float c1 = -1.4426950408889634f * rv.x, v = rv.y;
                const f32x4 g0 = acc[ai][0][m][0], g1 = acc[ai][0][m][1], u0 = acc[ai][1][m][0], u1 = acc[ai][1][m][1];
                f32x4 h0, h1;
#pragma unroll
                for (int j = 0; j < 4; ++j) { const float e0 = __builtin_amdgcn_exp2f(g0[j] * c1), e1 = __builtin_amdgcn_exp2f(g1[j] * c1);
                    h0[j] = (g0[j] * u0[j]) * __builtin_amdgcn_rcpf(__builtin_fmaf(e0, v, v)); h1[j] = (g1[j] * u1[j]) * __builtin_amdgcn_rcpf(__builtin_fmaf(e1, v, v)); }
                *(u32x4*)(H + blk_off(row0 + ai * HALF + m * 16, col0, ldh >> 6)) = pack8_bf16(h0, h1);
            }
    }
};
struct EpiResid {
    static constexpr bool PERM = true, AFTER_DRAIN = false;
    static __host__ __device__ __forceinline__ int bmap(int R) { return (R & ~31) + perm32(R & 31); }
    const float* base_f32; float* out_f32; int ld; float scale; bf16_t* xb; float* ss; _Float16* xh;
    int mode;
    typedef _Float16 h8 __attribute__((ext_vector_type(8)));
    static __device__ __forceinline__ void one(const f32x4 b0, const f32x4 b1, const f32x4 a0, const f32x4 a1, int row, int col, size_t off, float& s, float scale, float* out_f32, _Float16* xh, bf16_t* xb, int ld) {
        const f32x4 o0 = b0 + a0 * scale, o1 = b1 + a1 * scale;
        if (out_f32) { *(f32x4*)(out_f32 + off) = o0; *(f32x4*)(out_f32 + off + 4) = o1; }
        else { h8 w; w[0] = (_Float16)o0[0]; w[1] = (_Float16)o0[1]; w[2] = (_Float16)o0[2]; w[3] = (_Float16)o0[3]; w[4] = (_Float16)o1[0]; w[5] = (_Float16)o1[1]; w[6] = (_Float16)o1[2]; w[7] = (_Float16)o1[3];
            if (xh) *(h8*)(xh + off) = w;
            *(u32x4*)(xb + blk_off(row, col, ld >> 6)) = pack8_bf16(o0, o1);
            s += ((o0[0] * o0[0] + o0[1] * o0[1]) + (o0[2] * o0[2] + o0[3] * o0[3])) + ((o1[0] * o1[0] + o1[1] * o1[1]) + (o1[2] * o1[2] + o1[3] * o1[3])); }
    }
    __device__ __forceinline__ void operator()(const f32x4 (&acc)[2][2][4][2], const Unit& u, int wr, int wc, int fr, int fq) const {
        const int row0 = u.pm * BM + wr * 64 + fr, col0 = u.pn * BM + wc * 32 + 8 * fq;
        const float scale_ = scale; float* const out_ = out_f32; _Float16* const xh_ = mode == 0 ? xh : nullptr; bf16_t* const xb_ = xb; const int ld_ = ld; const bool rdb = mode == 1;
        if (base_f32) {
#pragma unroll
            for (int ai = 0; ai < 2; ++ai)
#pragma unroll
                for (int m = 0; m < 4; ++m) { const int row = row0 + ai * HALF + m * 16; const size_t off = (size_t)row * ld + col0; float s = 0.f;
#pragma unroll
                    for (int bj = 0; bj < 2; ++bj) one(*(const f32x4*)(base_f32 + off + bj * HALF), *(const f32x4*)(base_f32 + off + bj * HALF + 4), acc[ai][bj][m][0], acc[ai][bj][m][1], row, col0 + bj * HALF, off + bj * HALF, s, scale_, out_, xh_, xb_, ld_);
                    if (!out_f32) { s += __shfl_xor(s, 16); s += __shfl_xor(s, 32); if (fq == 0) ss[(size_t)row * 32 + u.pn * 4 + wc] = s; }
                    asm volatile("" ::: "memory"); }
            return;
        }
#pragma unroll
        for (int ai = 0; ai < 2; ++ai) {
            h8 w[4][2];
#pragma unroll
            for (int m = 0; m < 4; ++m)
#pragma unroll
                for (int bj = 0; bj < 2; ++bj) w[m][bj] = rdb ? *(const h8*)(xb + blk_off(row0 + ai * HALF + m * 16, col0 + bj * HALF, ld >> 6)) : *(const h8*)(xh + (size_t)(row0 + ai * HALF + m * 16) * ld + col0 + bj * HALF);
#pragma unroll
            for (int m = 0; m < 4; ++m) { const int row = row0 + ai * HALF + m * 16; const size_t off = (size_t)row * ld + col0; float s = 0.f;
#pragma unroll
                for (int bj = 0; bj < 2; ++bj) { const h8 v = w[m][bj]; f32x4 r0, r1;
                    if (rdb) { const u32x4 q = __builtin_bit_cast(u32x4, v);
                        r0 = (f32x4){__builtin_bit_cast(float, q[0] << 16), __builtin_bit_cast(float, q[0] & 0xffff0000u), __builtin_bit_cast(float, q[1] << 16), __builtin_bit_cast(float, q[1] & 0xffff0000u)};
                        r1 = (f32x4){__builtin_bit_cast(float, q[2] << 16), __builtin_bit_cast(float, q[2] & 0xffff0000u), __builtin_bit_cast(float, q[3] << 16), __builtin_bit_cast(float, q[3] & 0xffff0000u)}; }
                    else { r0 = (f32x4){(float)v[0], (float)v[1], (float)v[2], (float)v[3]}; r1 = (f32x4){(float)v[4], (float)v[5], (float)v[6], (float)v[7]}; }
                    one(r0, r1, acc[ai][bj][m][0], acc[ai][bj][m][1], row, col0 + bj * HALF, off + bj * HALF, s, scale_, out_, xh_, xb_, ld_); }
                if (!out_f32) { s += __shfl_xor(s, 16); s += __shfl_xor(s, 32); if (fq == 0) ss[(size_t)row * 32 + u.pn * 4 + wc] = s; } }
            asm volatile("" ::: "memory");
        }
    }
};
__device__ __forceinline__ void head_ss_put(PG8_LAS float* ex, int rl, int bj, int wc, int fq, float s) { s += __shfl_xor(s, 16); s += __shfl_xor(s, 32); if (fq == 0) ex[(rl * 2 + bj) * 4 + wc] = s; }
__device__ __forceinline__ float head_rstd_get(const PG8_LAS float* ex, int rl, int bj) { const f32x4 p = *(const PG8_LAS f32x4*)(ex + (rl * 2 + bj) * 4); return 1.0f / sqrtf(((p[0] + p[1]) + (p[2] + p[3])) * (1.0f / 128.0f) + 1e-6f); }
#define PG8_EPI_BARRIER() do { asm volatile("s_waitcnt lgkmcnt(0)" ::: "memory"); __builtin_amdgcn_s_barrier(); asm volatile("" ::: "memory"); } while (0)
struct EpiAin {
    static constexpr bool PERM = true, AFTER_DRAIN = false;
    static __host__ __device__ __forceinline__ int bmap(int R) { return (R & ~31) + perm32(R & 31); }
    bf16_t* ZA; float* vstat; bf16_t* qmb; const float* gq; PG8_LAS float* ex; RowScale R;
    __device__ __forceinline__ void operator()(const f32x4 (&acc)[2][2][4][2], const Unit& u, int wr, int wc, int fr, int fq) const {
        const int row0 = u.pm * BM + wr * 64 + fr;
        float rs[2][4]; get_rstd(rs, R, wr, fr);
        if (u.pn < 12) {
            const int col0 = u.pn * BM + wc * 32 + 8 * fq; const bool st = u.pn >= 6;
#pragma unroll
            for (int ai = 0; ai < 2; ++ai)
#pragma unroll
                for (int m = 0; m < 4; ++m) { const int row = row0 + ai * HALF + m * 16; float sq = 0.f;
#pragma unroll
                    for (int bj = 0; bj < 2; ++bj) { f32x4 v0 = acc[ai][bj][m][0] * rs[ai][m], v1 = acc[ai][bj][m][1] * rs[ai][m];
                        f32x2 a = gelu_pk((f32x2){v0[0], v0[1]}), b = gelu_pk((f32x2){v0[2], v0[3]}), c = gelu_pk((f32x2){v1[0], v1[1]}), d = gelu_pk((f32x2){v1[2], v1[3]});
                        v0 = (f32x4){a.x, a.y, b.x, b.y}; v1 = (f32x4){c.x, c.y, d.x, d.y};
                        sq += (v0[0] * v0[0] + v0[1] * v0[1]) + (v0[2] * v0[2] + v0[3] * v0[3]) + (v1[0] * v1[0] + v1[1] * v1[1]) + (v1[2] * v1[2] + v1[3] * v1[3]);
                        *(u32x4*)(ZA + (size_t)row * 3072 + col0 + bj * HALF) = pack8_bf16(v0, v1); }
                    if (st) { sq += __shfl_xor(sq, 16); sq += __shfl_xor(sq, 32); if (fq == 0) vstat[(size_t)row * 24 + (u.pn - 6) * 4 + wc] = sq; } }
        } else {
            const int d0 = wc * 32 + 8 * fq; const f32x4 g0 = *(const f32x4*)(gq + d0), g1 = *(const f32x4*)(gq + d0 + 4);
#pragma unroll
            for (int ai = 0; ai < 2; ++ai)
#pragma unroll
                for (int m = 0; m < 4; ++m) { const int rl = ai * HALF + wr * 64 + m * 16 + fr;
#pragma unroll
                    for (int bj = 0; bj < 2; ++bj) { const f32x4 v0 = acc[ai][bj][m][0], v1 = acc[ai][bj][m][1];
                        head_ss_put(ex, rl, bj, wc, fq, (((v0[0] * v0[0] + v0[1] * v0[1]) + (v0[2] * v0[2] + v0[3] * v0[3])) + ((v1[0] * v1[0] + v1[1] * v1[1]) + (v1[2] * v1[2] + v1[3] * v1[3]))) * (rs[ai][m] * rs[ai][m])); } }
            PG8_EPI_BARRIER();
#pragma unroll
            for (int ai = 0; ai < 2; ++ai)
#pragma unroll
                for (int m = 0; m < 4; ++m) { const int rl = ai * HALF + wr * 64 + m * 16 + fr, row = u.pm * BM + rl, b = row >> 12, s = row & 4095;
#pragma unroll
                    for (int bj = 0; bj < 2; ++bj) { const float sc = rs[ai][m] * head_rstd_get(ex, rl, bj); const int hm = (u.pn - 12) * 2 + bj;
                        *(u32x4*)(qmb + ((size_t)(b * 4 + hm) * 4096 + s) * 128 + d0) = pack8_bf16(acc[ai][bj][m][0] * sc * g0, acc[ai][bj][m][1] * sc * g1); } }
        }
    }
};
struct EpiF32Split {
    static constexpr bool PERM = true, AFTER_DRAIN = false;
    static __host__ __device__ __forceinline__ int bmap(int R) { return (R & ~31) + perm32(R & 31); }
    float* d0; int ld0; int split; float* d1; int ld1; int pnmod; RowScale R;
    __device__ __forceinline__ void operator()(const f32x4 (&acc)[2][2][4][2], const Unit& u, int wr, int wc, int fr, int fq) const {
        const int row0 = u.pm * BM + wr * 64 + fr; int pn = pnmod ? (u.pn % pnmod) : u.pn; float* d = d0; int ld = ld0;
        if (pn >= split) { d = d1; ld = ld1; pn -= split; }
        const int col0 = pn * BM + wc * 32 + 8 * fq;
        float rs[2][4]; get_rstd(rs, R, wr, fr);
#pragma unroll
        for (int ai = 0; ai < 2; ++ai)
#pragma unroll
            for (int m = 0; m < 4; ++m) { float* p = d + (size_t)(row0 + ai * HALF + m * 16) * ld + col0;
#pragma unroll
                for (int bj = 0; bj < 2; ++bj) { *(f32x4*)(p + bj * HALF) = acc[ai][bj][m][0] * rs[ai][m]; *(f32x4*)(p + bj * HALF + 4) = acc[ai][bj][m][1] * rs[ai][m]; } }
    }
};
struct EpiQKRope {
    static constexpr bool PERM = true, AFTER_DRAIN = false;
    static __host__ __device__ __forceinline__ int bmap(int R) { return 64 * ((R >> 4) & 1) + 16 * (R >> 5) + (R & 15); }
    int kind; bf16_t* qk; bf16_t* other; const float* gr; const float* gn; const unsigned* cs; PG8_LAS float* ex; RowScale R;
    __device__ __forceinline__ void operator()(const f32x4 (&acc)[2][2][4][2], const Unit& u, int wr, int wc, int fr, int fq) const {
        typedef _Float16 h2 __attribute__((ext_vector_type(2)));
        float rs[2][4]; get_rstd(rs, R, wr, fr);
        const int d0 = 16 * wc + 4 * fq;
        const bool rope = u.pn < 6;
        if (!rope && kind == 1) {
            const int h = u.pn - 6;
#pragma unroll
            for (int ai = 0; ai < 2; ++ai)
#pragma unroll
                for (int m = 0; m < 4; ++m) { const int row = u.pm * BM + ai * HALF + wr * 64 + m * 16 + fr, b = row >> 12, s = row & 4095;
#pragma unroll
                    for (int bj = 0; bj < 2; ++bj) { bf16_t* p = other + ((size_t)((b * 6 + h) * 2 + bj) * 4096 + s) * 128 + d0;
#pragma unroll
                        for (int n = 0; n < 2; ++n) { const f32x4 v = acc[ai][bj][m][n] * rs[ai][m]; u32x2 w; w.x = cvt_pk_bf16(v[0], v[1]); w.y = cvt_pk_bf16(v[2], v[3]); *(u32x2*)(p + 64 * n) = w; } } }
            return;
        }
        const float* g = rope ? gr : gn; const f32x4 ga = *(const f32x4*)(g + d0), gb = *(const f32x4*)(g + 64 + d0);
        u32x4 cst[2][4];
        if (rope) {
#pragma unroll
            for (int ai = 0; ai < 2; ++ai)
#pragma unroll
                for (int m = 0; m < 4; ++m) { const int s = (u.pm * BM + ai * HALF + wr * 64 + m * 16 + fr) & 4095; cst[ai][m] = *(const u32x4*)(cs + (size_t)s * 64 + d0); }
        }
#pragma unroll
        for (int ai = 0; ai < 2; ++ai)
#pragma unroll
            for (int m = 0; m < 4; ++m) { const int rl = ai * HALF + wr * 64 + m * 16 + fr;
#pragma unroll
                for (int bj = 0; bj < 2; ++bj) { const f32x4 v0 = acc[ai][bj][m][0], v1 = acc[ai][bj][m][1];
                    head_ss_put(ex, rl, bj, wc, fq, (((v0[0] * v0[0] + v0[1] * v0[1]) + (v0[2] * v0[2] + v0[3] * v0[3])) + ((v1[0] * v1[0] + v1[1] * v1[1]) + (v1[2] * v1[2] + v1[3] * v1[3]))) * (rs[ai][m] * rs[ai][m])); } }
        PG8_EPI_BARRIER();
#pragma unroll
        for (int ai = 0; ai < 2; ++ai)
#pragma unroll
            for (int m = 0; m < 4; ++m) { const int rl = ai * HALF + wr * 64 + m * 16 + fr, row = u.pm * BM + rl, b = row >> 12, s = row & 4095;
#pragma unroll
                for (int bj = 0; bj < 2; ++bj) { const float sc = rs[ai][m] * head_rstd_get(ex, rl, bj);
                    f32x4 y0 = acc[ai][bj][m][0] * sc * ga, y1 = acc[ai][bj][m][1] * sc * gb; bf16_t* p;
                    if (rope) { f32x4 o0, o1;
#pragma unroll
                        for (int j = 0; j < 4; ++j) { const unsigned cw = cst[ai][m][j]; const h2 t = __builtin_bit_cast(h2, cw); const float c = (float)t.x, sn = (float)t.y; o0[j] = y0[j] * c - y1[j] * sn; o1[j] = y1[j] * c + y0[j] * sn; }
                        y0 = o0; y1 = o1; p = qk + ((size_t)(b * 12 + u.pn * 2 + bj) * 4096 + s) * 128 + d0; }
                    else p = other + ((size_t)(b * 4 + (u.pn - 6) * 2 + bj) * 4096 + s) * 128 + d0;
                    u32x2 w0, w1; w0.x = cvt_pk_bf16(y0[0], y0[1]); w0.y = cvt_pk_bf16(y0[2], y0[3]); w1.x = cvt_pk_bf16(y1[0], y1[1]); w1.y = cvt_pk_bf16(y1[2], y1[3]);
                    *(u32x2*)p = w0; *(u32x2*)(p + 64) = w1; } }
    }
};
struct ColSweepOrder {
    int c;
    __device__ bool next(int i, Unit& u) const { if (i >= 2) return false; const int xcd = c & 7, j = c >> 3; u.pm = 8 * xcd + 4 * i + (j & 3); u.pn = j >> 2; return true; }
    __device__ __forceinline__ void a_ready(const Unit&) const {}
    __device__ __forceinline__ void done(const Unit&) const {}
};
struct EpiMemKv {
    static constexpr bool PERM = true, AFTER_DRAIN = false;
    static __host__ __device__ __forceinline__ int bmap(int R) { return (R & ~31) + perm32(R & 31); }
    bf16_t* mk; bf16_t* mv; const float* gk; PG8_LAS float* ex;
    __device__ __forceinline__ void operator()(const f32x4 (&acc)[2][2][4][2], const Unit& u, int wr, int wc, int fr, int fq) const {
        const int t = u.pn & 3, d0 = wc * 32 + 8 * fq; const size_t base = (size_t)u.pm * 4;
        if (t < 2) {
            const f32x4 g0 = *(const f32x4*)(gk + (u.pm >> 2) * 128 + d0), g1 = *(const f32x4*)(gk + (u.pm >> 2) * 128 + d0 + 4);
#pragma unroll
            for (int ai = 0; ai < 2; ++ai)
#pragma unroll
                for (int m = 0; m < 4; ++m) { const int rl = ai * HALF + wr * 64 + m * 16 + fr;
#pragma unroll
                    for (int bj = 0; bj < 2; ++bj) { const f32x4 v0 = acc[ai][bj][m][0], v1 = acc[ai][bj][m][1];
                        head_ss_put(ex, rl, bj, wc, fq, ((v0[0] * v0[0] + v0[1] * v0[1]) + (v0[2] * v0[2] + v0[3] * v0[3])) + ((v1[0] * v1[0] + v1[1] * v1[1]) + (v1[2] * v1[2] + v1[3] * v1[3]))); } }
            PG8_EPI_BARRIER();
#pragma unroll
            for (int ai = 0; ai < 2; ++ai)
#pragma unroll
                for (int m = 0; m < 4; ++m) { const int rl = ai * HALF + wr * 64 + m * 16 + fr;
#pragma unroll
                    for (int bj = 0; bj < 2; ++bj) { const float sc = head_rstd_get(ex, rl, bj);
                        *(u32x4*)(mk + ((base + t * 2 + bj) * 256 + rl) * 128 + d0) = pack8_bf16(acc[ai][bj][m][0] * sc * g0, acc[ai][bj][m][1] * sc * g1); } }
        } else {
#pragma unroll
            for (int ai = 0; ai < 2; ++ai)
#pragma unroll
                for (int m = 0; m < 4; ++m) { const int rl = ai * HALF + wr * 64 + m * 16 + fr;
#pragma unroll
                    for (int bj = 0; bj < 2; ++bj) *(u32x4*)(mv + ((base + (t - 2) * 2 + bj) * 256 + rl) * 128 + d0) = pack8_bf16(acc[ai][bj][m][0], acc[ai][bj][m][1]); }
        }
    }
};
struct MemKvOrder {
    int G, c;
    __device__ bool next(int i, Unit& u) const { const int L = i * G + c; if (L >= 64) return false; const int layer = L >> 4, r = L & 15; u.pm = layer * 4 + (r >> 2); u.pn = layer * 4 + (r & 3); return true; }
    __device__ __forceinline__ void a_ready(const Unit&) const {}
    __device__ __forceinline__ void done(const Unit&) const {}
};
template <class Epi, class Sched, bool ALIGN_EPI = false, bool SP2 = false, bool ABLK = false, bool BBLK = false>
__device__ __forceinline__ void gemm_phase(PG8_LAS unsigned char* lds, const Gemm g, const Sched& S, const Epi& E) {
    int tid_ = threadIdx.x; asm volatile("" : "+v"(tid_));
    const int tid = tid_, wid = __builtin_amdgcn_readfirstlane(tid >> 6), lane = tid & 63, wr = wid >> 2, wc = wid & 3, fr = lane & 15, fq = lane >> 4;
    const int K = g.K, nt = K / BK;
    unsigned voffA[2], voffB[2];
#pragma unroll
    for (int i = 0; i < 2; ++i) { int R, C; stage_rc(tid * 16 + i * 8192, R, C); const int Rb = Epi::bmap(R);
        voffA[i] = ABLK ? (unsigned)(R * BK + C) * 2u : (unsigned)(R * K + C) * 2u; voffB[i] = BBLK ? (unsigned)(Rb * BK + C) * 2u : (unsigned)(Rb * K + C) * 2u; }
    const size_t kstepA = ABLK ? (size_t)(BM * BK * 2) : (size_t)(BK * 2), kstepB = BBLK ? (size_t)(BM * BK * 2) : (size_t)(BK * 2);
    const size_t hstepA = ABLK ? (size_t)(HALF * BK * 2) : (size_t)HALF * K * 2, hstepB = BBLK ? (size_t)(HALF * BK * 2) : (size_t)HALF * K * 2;
    const size_t tstep = (size_t)BM * K * 2;
#ifndef PG8_PF
#define PG8_PF 0
#endif
    PG8_LAS unsigned* const pfjunk = (PG8_LAS unsigned*)(lds + 143360 + wid * 256);
    const unsigned ldsw = (unsigned)wid * 1024u;
    const int aoff = lds_byte(wr * 64 + fr, fq * 8), boff = lds_byte(wc * 32 + fr, fq * 8);
#define PG8_SA(b, h) (((b) * 2 + (h)) * HTB)
#define PG8_SB(b, h) ((4 + (b) * 2 + (h)) * HTB)
#define PG8_STAGE(bufoff, gbase, voff) do { _Pragma("unroll") for (int _i = 0; _i < 2; ++_i) \
        __builtin_amdgcn_global_load_lds((const unsigned*)((const char*)(gbase) + (voff)[_i]), (PG8_LAS unsigned*)(lds + (bufoff) + ldsw + _i * 8192), 16, 0, 0); } while (0)
#define PG8_LDA(dst, b, h) do { _Pragma("unroll") for (int m = 0; m < 4; ++m) _Pragma("unroll") for (int k = 0; k < 2; ++k) dst[m][k] = *(const PG8_LAS bf16x8*)(lds + PG8_SA(b, h) + aoff + m * 2048 + k * 1024); } while (0)
#define PG8_LDB(dst, b, h) do { _Pragma("unroll") for (int n = 0; n < 2; ++n) _Pragma("unroll") for (int k = 0; k < 2; ++k) dst[n][k] = *(const PG8_LAS bf16x8*)(lds + PG8_SB(b, h) + boff + n * 2048 + k * 1024); } while (0)
#define PG8_MMA(ai, bj, At, Bt) do { __builtin_amdgcn_s_setprio(1); _Pragma("unroll") for (int m = 0; m < 4; ++m) _Pragma("unroll") for (int n = 0; n < 2; ++n) _Pragma("unroll") for (int k = 0; k < 2; ++k) \
        acc[ai][bj][m][n] = __builtin_amdgcn_mfma_f32_16x16x32_bf16(Bt[n][k], At[m][k], acc[ai][bj][m][n], 0, 0, 0); __builtin_amdgcn_s_setprio(0); } while (0)
#define PG8_WAIT_V(n) asm volatile("s_waitcnt vmcnt(" #n ")" ::: "memory")
#define PG8_WAIT_LOOP() do { if (PG8_PF) asm volatile("s_waitcnt vmcnt(9)" ::: "memory"); else asm volatile("s_waitcnt vmcnt(8)" ::: "memory"); } while (0)
#define PG8_PREFETCH(tp) do { if (PG8_PF) { const int tp_ = (tp); const char* pb_ = (wid < 4) ? (tp_ < nt ? cA + (size_t)tp_ * kstepA : nA + (size_t)(tp_ - nt) * kstepA) : (tp_ < nt ? cB + (size_t)tp_ * kstepB : nB + (size_t)(tp_ - nt) * kstepB); \
        const unsigned ln_ = __builtin_amdgcn_mbcnt_hi(~0u, __builtin_amdgcn_mbcnt_lo(~0u, 0u)) + (unsigned)(wid & 3) * 64u; const unsigned pfl_ = ln_ * ((wid < 4) ? (ABLK ? 128u : (unsigned)K * 2u) : (BBLK ? 128u : (unsigned)K * 2u)); \
        __builtin_amdgcn_global_load_lds((const unsigned*)(pb_ + pfl_), pfjunk, 4, 0, 0); } } while (0)
#define PG8_WAIT_L(n) asm volatile("s_waitcnt lgkmcnt(" #n ")" ::: "memory")
#define PG8_BAR __builtin_amdgcn_s_barrier()
#define PG8_SCHED __builtin_amdgcn_sched_barrier(0)
    Unit cur, nxt; int ui = 0;
    if (!S.next(0, cur)) return;
    f32x4 acc[2][2][4][2];
#pragma unroll
    for (int a = 0; a < 2; ++a)
#pragma unroll
        for (int b = 0; b < 2; ++b)
#pragma unroll
            for (int m = 0; m < 4; ++m)
#pragma unroll
                for (int n = 0; n < 2; ++n) acc[a][b][m][n] = (f32x4){0.f, 0.f, 0.f, 0.f};
    bf16x8 At[4][2], B0[2][2], B1[2][2];
    const char* cA = (const char*)g.A + (size_t)cur.pm * tstep; const char* cB = (const char*)g.Bt + (size_t)cur.pn * tstep;
    S.a_ready(cur);
    if constexpr (SP2) {
        PG8_STAGE(PG8_SB(0, 0), cB, voffB); PG8_STAGE(PG8_SB(0, 1), cB + hstepB, voffB); PG8_STAGE(PG8_SA(0, 0), cA, voffA); PG8_STAGE(PG8_SA(0, 1), cA + hstepA, voffA);
        if (wr == 1) PG8_BAR;
        PG8_WAIT_V(2); PG8_BAR;
        PG8_STAGE(PG8_SB(1, 0), cB + kstepB, voffB); PG8_STAGE(PG8_SA(1, 0), cA + kstepA, voffA); PG8_STAGE(PG8_SB(1, 1), cB + hstepB + kstepB, voffB);
        PG8_WAIT_V(6); PG8_BAR;
    } else {
        PG8_STAGE(PG8_SB(0, 0), cB, voffB); PG8_STAGE(PG8_SA(0, 0), cA, voffA); PG8_STAGE(PG8_SB(0, 1), cB + hstepB, voffB); PG8_STAGE(PG8_SA(0, 1), cA + hstepA, voffA);
        if (wr == 1) PG8_BAR;
        PG8_WAIT_V(4); PG8_BAR;
        PG8_STAGE(PG8_SB(1, 0), cB + kstepB, voffB); PG8_STAGE(PG8_SA(1, 0), cA + kstepA, voffA); PG8_STAGE(PG8_SB(1, 1), cB + hstepB + kstepB, voffB);
        PG8_WAIT_V(6); PG8_BAR;
    }
    for (;;) {
        const bool has_next = S.next(ui + 1, nxt);
        const char* nA = has_next ? (const char*)g.A + (size_t)nxt.pm * tstep : cA; const char* nB = has_next ? (const char*)g.Bt + (size_t)nxt.pn * tstep : cB;
        for (int t = 0; t < nt; t += 2) {
            const bool last = (t == nt - 2);
            const char* a1 = cA + (size_t)(t + 1) * kstepA;
            const char* a2 = last ? nA : cA + (size_t)(t + 2) * kstepA; const char* b2 = last ? nB : cB + (size_t)(t + 2) * kstepB;
            const char* a3 = a2 + kstepA; const char* b3 = b2 + kstepB;
            if (last && has_next) S.a_ready(nxt);
            if constexpr (SP2) {
            PG8_LDB(B0, 0, 0); PG8_LDB(B1, 0, 1); PG8_SCHED; PG8_LDA(At, 0, 0); PG8_STAGE(PG8_SA(1, 1), a1 + hstepA, voffA); PG8_PREFETCH(t + PG8_PF);
            PG8_WAIT_LOOP(); PG8_WAIT_L(0); PG8_BAR; PG8_MMA(0, 0, At, B0); PG8_MMA(0, 1, At, B1); PG8_BAR; PG8_SCHED;
            PG8_LDA(At, 0, 1); PG8_STAGE(PG8_SB(0, 0), b2, voffB); PG8_STAGE(PG8_SB(0, 1), b2 + hstepB, voffB); PG8_STAGE(PG8_SA(0, 0), a2, voffA);
            PG8_WAIT_LOOP(); PG8_WAIT_L(0); PG8_BAR; PG8_MMA(1, 0, At, B0); PG8_MMA(1, 1, At, B1); PG8_BAR; PG8_SCHED;
            PG8_LDB(B0, 1, 0); PG8_LDB(B1, 1, 1); PG8_SCHED; PG8_LDA(At, 1, 0); PG8_STAGE(PG8_SA(0, 1), a2 + hstepA, voffA); PG8_PREFETCH(t + 1 + PG8_PF);
            PG8_WAIT_LOOP(); PG8_WAIT_L(0); PG8_BAR; PG8_MMA(0, 0, At, B0); PG8_MMA(0, 1, At, B1); PG8_BAR; PG8_SCHED;
            PG8_LDA(At, 1, 1); PG8_STAGE(PG8_SB(1, 0), b3, voffB); PG8_STAGE(PG8_SB(1, 1), b3 + hstepB, voffB); PG8_STAGE(PG8_SA(1, 0), a3, voffA);
            PG8_WAIT_LOOP(); PG8_WAIT_L(0); PG8_BAR; PG8_MMA(1, 0, At, B0); PG8_MMA(1, 1, At, B1); PG8_BAR; PG8_SCHED;
            } else {
            PG8_LDB(B0, 0, 0); PG8_SCHED; PG8_LDA(At, 0, 0); PG8_STAGE(PG8_SA(1, 1), a1 + hstepA, voffA);
            PG8_WAIT_L(8); PG8_BAR; PG8_WAIT_L(0); PG8_MMA(0, 0, At, B0); PG8_BAR; PG8_SCHED;
            PG8_LDB(B1, 0, 1); PG8_STAGE(PG8_SB(0, 0), b2, voffB);
            PG8_BAR; PG8_WAIT_L(0); PG8_MMA(0, 1, At, B1); PG8_BAR;
            PG8_LDA(At, 0, 1); PG8_STAGE(PG8_SA(0, 0), a2, voffA);
            PG8_BAR; PG8_WAIT_L(0); PG8_MMA(1, 0, At, B0); PG8_BAR; PG8_SCHED;
            PG8_STAGE(PG8_SB(0, 1), b2 + hstepB, voffB);
            PG8_WAIT_V(6); PG8_BAR; PG8_MMA(1, 1, At, B1); PG8_BAR;
            PG8_LDB(B0, 1, 0); PG8_SCHED; PG8_LDA(At, 1, 0); PG8_STAGE(PG8_SA(0, 1), a2 + hstepA, voffA);
            PG8_WAIT_L(8); PG8_BAR; PG8_WAIT_L(0); PG8_MMA(0, 0, At, B0); PG8_BAR; PG8_SCHED;
            PG8_LDB(B1, 1, 1); PG8_STAGE(PG8_SB(1, 0), b3, voffB);
            PG8_BAR; PG8_WAIT_L(0); PG8_MMA(0, 1, At, B1); PG8_BAR;
            PG8_LDA(At, 1, 1); PG8_STAGE(PG8_SA(1, 0), a3, voffA);
            PG8_BAR; PG8_WAIT_L(0); PG8_MMA(1, 0, At, B0); PG8_BAR; PG8_SCHED;
            PG8_STAGE(PG8_SB(1, 1), b3 + hstepB, voffB);
            PG8_WAIT_V(6); PG8_BAR; PG8_MMA(1, 1, At, B1); PG8_BAR;
            }
        }
        if constexpr (ALIGN_EPI) { if (wr == 0) PG8_BAR; }
        if constexpr (!Epi::AFTER_DRAIN) { int fr_e = fr, fq_e = fq; asm volatile("" : "+v"(fr_e), "+v"(fq_e));
            E(acc, cur, wr, wc, fr_e, fq_e); S.done(cur); }
        if (!has_next) break;
#pragma unroll
        for (int a = 0; a < 2; ++a)
#pragma unroll
            for (int b = 0; b < 2; ++b)
#pragma unroll
                for (int m = 0; m < 4; ++m)
#pragma unroll
                    for (int n = 0; n < 2; ++n) acc[a][b][m][n] = (f32x4){0.f, 0.f, 0.f, 0.f};
        cur = nxt; cA = nA; cB = nB; ++ui;
        if constexpr (ALIGN_EPI) { if (wr == 1) PG8_BAR; }
    }
    PG8_WAIT_V(0);
    if constexpr (!ALIGN_EPI) { if (wr == 0) PG8_BAR; }
    PG8_BAR;
    if constexpr (Epi::AFTER_DRAIN) { E.fused(acc, cur, wr, wc, fr, fq, lds, wid, lane); S.done(cur); }
#undef PG8_SA
#undef PG8_SB
#undef PG8_STAGE
#undef PG8_LDA
#undef PG8_LDB
#undef PG8_MMA
#undef PG8_WAIT_V
#undef PG8_WAIT_L
#undef PG8_WAIT_LOOP
#undef PG8_PREFETCH
#undef PG8_BAR
#undef PG8_SCHED
}
}
namespace att {
constexpr int D = 128; constexpr float THR = 8.f; constexpr bool WSKIP = false;
constexpr float SCALE = 0.08838834764831845f;
constexpr int NW = 8, QBLK = 32, KVBLK = 64, QB = NW * QBLK;
constexpr int SHM_V = KVBLK * D * 2, SHM_K = KVBLK * D * 2;
constexpr int LDS_BYTES = 2 * SHM_V + 2 * SHM_K + NW * 64 * 4;

using bf16 = __hip_bfloat16;
typedef short bf16x8 __attribute__((ext_vector_type(8)));
typedef short s16x4 __attribute__((ext_vector_type(4)));
typedef float f32x16 __attribute__((ext_vector_type(16)));
typedef float f32x4 __attribute__((ext_vector_type(4)));
typedef unsigned u32x4 __attribute__((ext_vector_type(4)));
template <class A, class Bt> struct same_t { static constexpr bool v = false; };
template <class A> struct same_t<A, A> { static constexpr bool v = true; };

#define KSWZ(row, colB) ((row) * 256 + ((colB) ^ (((row) & 7) << 4)))
#define SBAR() __builtin_amdgcn_sched_barrier(0)
__device__ __forceinline__ int v_st(int k, int c) { const int kk = (k & ~0xC) | ((k & 4) << 1) | ((k & 8) >> 1); return ((kk >> 3) * 4 + (c >> 5)) * 512 + ((kk & 7) * 32 + (c & 31)) * 2; }
__device__ __forceinline__ int v_rd_base(int lane) { return ((lane & 3) << 3) | (((lane >> 2) & 3) << 6) | (((lane >> 4) & 1) << 5) | (((lane >> 5) & 1) << 8); }
constexpr int v_rd_off(int d0, int ks, int half) { return d0 * 512 + ks * 4096 + half * 2048; }
__device__ __forceinline__ int crow(int r, int hi) { return (r & 3) + 8 * (r >> 2) + 4 * hi; }
__device__ __forceinline__ unsigned cvtpk(float lo, float hi) {
    unsigned r; asm volatile("v_cvt_pk_bf16_f32 %0, %1, %2" : "=v"(r) : "v"(lo), "v"(hi)); return r;
}
__device__ __forceinline__ bf16x8 pack8(f32x4 a, f32x4 b) {
    u32x4 w = {cvtpk(a[0], a[1]), cvtpk(a[2], a[3]), cvtpk(b[0], b[1]), cvtpk(b[2], b[3])};
    return *reinterpret_cast<bf16x8*>(&w);
}
template <class T> __device__ __forceinline__ bf16x8 load8(const T* p) {
    if constexpr (same_t<T, float>::v) { return pack8(*(const f32x4*)p, *(const f32x4*)(p + 4)); }
    else { return *reinterpret_cast<const bf16x8*>(p); }
}
__device__ __forceinline__ void mask_tile(f32x16& p0, f32x16& p1, int dq, unsigned W) {
    const float NEG = -__builtin_inff();
#pragma unroll
    for (int r = 0; r < 16; ++r) {
        const int c = (r & 3) + 8 * (r >> 2);
        if ((unsigned)(dq - c) >= W) p0[r] = NEG;
        if ((unsigned)(dq - c - 32) >= W) p1[r] = NEG;
    }
}
__device__ __forceinline__ void partialSM(f32x16& p0, f32x16& p1, float& m_reg, float& mn, float& alpha) {
    float pmax = p0[0]; for (int r = 1; r < 16; ++r) pmax = fmaxf(pmax, p0[r]); for (int r = 0; r < 16; ++r) pmax = fmaxf(pmax, p1[r]);
    { auto rr = __builtin_amdgcn_permlane32_swap(__float_as_uint(pmax), __float_as_uint(pmax), false, false);
      pmax = fmaxf(__uint_as_float(rr[0]), __uint_as_float(rr[1])); }
    constexpr float C2 = 1.4426950408889634f * SCALE;
    if (__builtin_expect(__all((pmax - m_reg) * SCALE <= THR), 1)) { mn = m_reg; alpha = 1.f; }
    else { mn = fmaxf(m_reg, pmax); alpha = __builtin_amdgcn_exp2f((m_reg - mn) * C2); m_reg = mn; }
    const float mnL = -mn * C2;
    for (int r = 0; r < 16; ++r) p0[r] = fmaf(p0[r], C2, mnL); for (int r = 0; r < 16; ++r) p1[r] = fmaf(p1[r], C2, mnL);
    for (int r = 0; r < 16; ++r) p0[r] = __builtin_amdgcn_exp2f(p0[r]);
}
__device__ __forceinline__ void finishSM(f32x16& p0, f32x16& p1, float alpha, float& l_reg, bf16x8& pa0, bf16x8& pa1, bf16x8& pa2, bf16x8& pa3) {
    for (int r = 0; r < 16; ++r) p1[r] = __builtin_amdgcn_exp2f(p1[r]);
    float ps = 0; for (int r = 0; r < 16; ++r) ps += p0[r]; for (int r = 0; r < 16; ++r) ps += p1[r];
    { auto rr = __builtin_amdgcn_permlane32_swap(__float_as_uint(ps), __float_as_uint(ps), false, false);
      ps = __uint_as_float(rr[0]) + __uint_as_float(rr[1]); }
    l_reg = l_reg * alpha + ps;
#define PK4(P, B_, OUT) do { unsigned a0 = cvtpk(P[B_+0], P[B_+1]), a1 = cvtpk(P[B_+2], P[B_+3]);                          \
        unsigned b0 = cvtpk(P[B_+4], P[B_+5]), b1 = cvtpk(P[B_+6], P[B_+7]);                                             \
        auto r0 = __builtin_amdgcn_permlane32_swap(a0, b0, false, false); auto r1 = __builtin_amdgcn_permlane32_swap(a1, b1, false, false); \
        u32x4 w = {r0[0], r1[0], r0[1], r1[1]}; OUT = *reinterpret_cast<bf16x8*>(&w); } while (0)
    PK4(p0, 0, pa0); PK4(p0, 8, pa1); PK4(p1, 0, pa2); PK4(p1, 8, pa3);
#undef PK4
}
template <int KB, bool SK>
__device__ __forceinline__ void qkt(f32x16& p0, f32x16& p1, const char* K_lds, int r32, int hi, const bf16x8* qr, bool act) {
    if (SK && !act) { const float NEG = -__builtin_inff();
#pragma unroll
        for (int r = 0; r < 16; ++r) { p0[r] = NEG; p1[r] = NEG; } return; }
    p0 = f32x16{}; p1 = f32x16{};
    const char* kb[4];
#pragma unroll
    for (int dd = 0; dd < 4; ++dd) kb[dd] = K_lds + KB * SHM_K + KSWZ(r32, (dd * 16 + hi * 8) * 2);
#pragma unroll
    for (int d0 = 0; d0 < 8; ++d0) { const char* a = kb[d0 & 3] + (d0 >> 2) * 128;
        bf16x8 b0 = *reinterpret_cast<const bf16x8*>(a);
        bf16x8 b1 = *reinterpret_cast<const bf16x8*>(a + 32 * 256);
        p0 = __builtin_amdgcn_mfma_f32_32x32x16_bf16(b0, qr[d0], p0, 0, 0, 0);
        p1 = __builtin_amdgcn_mfma_f32_32x32x16_bf16(b1, qr[d0], p1, 0, 0, 0); }
}
template <int VB, bool SK>
__device__ __forceinline__ void pv_tile(f32x16* o, int vb0, bf16x8 pa0, bf16x8 pa1, bf16x8 pa2, bf16x8 pa3, bool act) {
    if (SK && !act) return;
#define TRRD(dst, off) asm volatile("ds_read_b64_tr_b16 %0, %1 offset:%2" : "=&v"(dst) : "v"(vb0), "i"(off) : "memory")
#define PV_D0(d0) do { s16x4 l0, l1, l2, l3, h0, h1, h2, h3; constexpr int b_ = VB * SHM_V + v_rd_off(d0, 0, 0);     \
        TRRD(l0, b_); TRRD(h0, b_ + 2048); TRRD(l1, b_ + 4096); TRRD(h1, b_ + 6144); TRRD(l2, b_ + 8192); TRRD(h2, b_ + 10240); TRRD(l3, b_ + 12288); TRRD(h3, b_ + 14336); \
        asm volatile("s_waitcnt lgkmcnt(0)" ::: "memory"); SBAR();                 \
        o[d0] = __builtin_amdgcn_mfma_f32_32x32x16_bf16(pa0, (bf16x8){l0[0], l0[1], l0[2], l0[3], h0[0], h0[1], h0[2], h0[3]}, o[d0], 0, 0, 0);   \
        o[d0] = __builtin_amdgcn_mfma_f32_32x32x16_bf16(pa1, (bf16x8){l1[0], l1[1], l1[2], l1[3], h1[0], h1[1], h1[2], h1[3]}, o[d0], 0, 0, 0);   \
        o[d0] = __builtin_amdgcn_mfma_f32_32x32x16_bf16(pa2, (bf16x8){l2[0], l2[1], l2[2], l2[3], h2[0], h2[1], h2[2], h2[3]}, o[d0], 0, 0, 0);   \
        o[d0] = __builtin_amdgcn_mfma_f32_32x32x16_bf16(pa3, (bf16x8){l3[0], l3[1], l3[2], l3[3], h3[0], h3[1], h3[2], h3[3]}, o[d0], 0, 0, 0); } while (0)
    PV_D0(0); PV_D0(1); PV_D0(2); PV_D0(3);
#undef PV_D0
#undef TRRD
}

template <class TIn, class TOut> struct BlockRef { const TIn* Q; const TIn* K; const TIn* V; TOut* O; int P0; int ldo; };
template <class TIn> struct Seam {
    bf16x8 qr[8];
    bf16x8 st_v0, st_v1, st_k0, st_k1; f32x4 sf0, sf1, sf2, sf3;
    f32x4 tq[16];
};
__device__ __forceinline__ int swa_jlo(int P0, int W) { const int lowk = P0 - W + 1; return lowk > 0 ? lowk / KVBLK : 0; }
#define ROW(p, k0, rr) ((p) + (size_t)((k0) + (rr)) * D + sc)
#define VMW() asm volatile("s_waitcnt vmcnt(0)" ::: "memory")
#define VMWN(n) asm volatile("s_waitcnt vmcnt(%0)" :: "i"(n) : "memory")
#define SLOAD_H(Kp, Vp, k0) do { S.st_v0 = load8<TIn>(ROW(Vp, k0, sr)); S.st_v1 = load8<TIn>(ROW(Vp, k0, 32 + sr));              \
                         S.st_k0 = load8<TIn>(ROW(Kp, k0, sr)); S.st_k1 = load8<TIn>(ROW(Kp, k0, 32 + sr)); } while (0)
#define SWRITE_HK(bf) do { *(bf16x8*)(K_lds + (bf) * SHM_K + kws) = S.st_k0; *(bf16x8*)(K_lds + (bf) * SHM_K + kws + 32 * 256) = S.st_k1; } while (0)
#define SWRITE_HV(bf) do { *(bf16x8*)(V_lds + (bf) * SHM_V + vst0) = S.st_v0; *(bf16x8*)(V_lds + (bf) * SHM_V + vst1) = S.st_v1; } while (0)
#define SWRITE_H(bf) do { SWRITE_HV(bf); SWRITE_HK(bf); } while (0)
#define SLOAD_F(p, k0) do { S.sf0 = *(const f32x4*)ROW(p, k0, sr); S.sf1 = *(const f32x4*)(ROW(p, k0, sr) + 4);                \
                            S.sf2 = *(const f32x4*)ROW(p, k0, 32 + sr); S.sf3 = *(const f32x4*)(ROW(p, k0, 32 + sr) + 4); } while (0)
#define SWRITE_KF(bf) do { *(bf16x8*)(K_lds + (bf) * SHM_K + kws) = pack8(S.sf0, S.sf1); *(bf16x8*)(K_lds + (bf) * SHM_K + kws + 32 * 256) = pack8(S.sf2, S.sf3); } while (0)
#define SWRITE_VF(bf) do { *(bf16x8*)(V_lds + (bf) * SHM_V + vst0) = pack8(S.sf0, S.sf1); *(bf16x8*)(V_lds + (bf) * SHM_V + vst1) = pack8(S.sf2, S.sf3); } while (0)
template <class TIn, class TOut>
__device__ __forceinline__ void causal_swa_prime(const BlockRef<TIn, TOut>& cur, int W, char* lds, Seam<TIn>& S) {
    constexpr bool F32 = same_t<TIn, float>::v;
    int tid_ = threadIdx.x; asm volatile("" : "+v"(tid_));
    const int tid = tid_, wid = __builtin_amdgcn_readfirstlane(tid >> 6), lane = tid & 63, r32 = lane & 31, hi = lane >> 5;
    const int sr = tid >> 4, sc = (tid & 15) * 8, kws = KSWZ(sr, sc * 2); char* K_lds = lds + 2 * SHM_V;
    const int kb0 = swa_jlo(cur.P0, W) * KVBLK;
    for (int d0 = 0; d0 < 8; ++d0) S.qr[d0] = load8<TIn>(cur.Q + (size_t)(wid * QBLK + r32) * D + d0 * 16 + hi * 8);
    if constexpr (F32) { SLOAD_F((const float*)cur.K, kb0); VMW(); SWRITE_KF(0); SBAR(); SLOAD_F((const float*)cur.V, kb0); }
    else { SLOAD_H(cur.K, cur.V, kb0); VMW(); SWRITE_HK(0); }
    __syncthreads();
}
template <class TIn, class TOut>
__device__ __forceinline__ void causal_swa_block(const BlockRef<TIn, TOut>& cur, const BlockRef<TIn, TOut>& nxt, int skv, int W, char* lds, Seam<TIn>& S) {
    constexpr bool F32 = same_t<TIn, float>::v;
    int tid_ = threadIdx.x; asm volatile("" : "+v"(tid_));
    const int tid = tid_, wid = __builtin_amdgcn_readfirstlane(tid >> 6), lane = tid & 63, r32 = lane & 31, hi = lane >> 5;
    const int j_lo = swa_jlo(cur.P0, W);
    int j_hi = (cur.P0 + QB - 1) / KVBLK + 1; if (j_hi > skv / KVBLK) j_hi = skv / KVBLK;
    const int NT = j_hi - j_lo;
    const int kbn = swa_jlo(nxt.P0, W) * KVBLK;
    const int qlo = cur.P0 + wid * QBLK, qm = qlo + r32 - 4 * hi;
    char* V_lds = lds; char* K_lds = lds + 2 * SHM_V;
    float* ws = (float*)(lds + 2 * SHM_V + 2 * SHM_K) + wid * 64; float* li_l = ws, * al_l = ws + 32;
    float m_reg = -1e30f, l_reg = 0; f32x16 o[4] = {};
    const int sr = tid >> 4, sc = (tid & 15) * 8, vst0 = v_st(sr, sc), vst1 = v_st(32 + sr, sc), kws = KSWZ(sr, sc * 2);
    const int vb0 = (int)(uintptr_t)V_lds + v_rd_base(lane);
    const TIn* Kh = cur.K; const TIn* Vh = cur.V;
#define RESC(a) do { if (__any((a) < 1.f)) { if (hi == 0) al_l[r32] = (a); asm volatile("s_waitcnt lgkmcnt(0)" ::: "memory");              \
                     for (int d_ = 0; d_ < 4; ++d_) for (int r = 0; r < 16; ++r) o[d_][r] *= al_l[crow(r, hi)]; } } while (0)
#define KBASE(t) ((j_lo + (t)) * KVBLK)
#define ACT(t) (KBASE(t) <= qlo + QBLK - 1 && KBASE(t) + KVBLK - 1 >= qlo - W + 1)
#define MASKT(P0_, P1_, t) do { const int kb_ = KBASE(t); if ((!SK || ACT(t)) && (kb_ + KVBLK - 1 > qlo || kb_ <= qlo + QBLK - 1 - W)) mask_tile(P0_, P1_, qm - kb_, (unsigned)W); } while (0)
    constexpr int NQL = F32 ? 16 : 8;
    constexpr bool SK = WSKIP && !F32;
#define SEAM_K0() do { VMWN(NQL); if constexpr (F32) { SWRITE_KF(0); SBAR(); SLOAD_F((const float*)nxt.V, kbn); } else { SWRITE_HK(0); } SBAR(); } while (0)
    f32x16 pA0, pA1, pB0, pB1; float mnA, mnB, alA, alB; bf16x8 pa0, pa1, pa2, pa3;
    if constexpr (F32) { VMW(); SWRITE_VF(0); SBAR(); } else { SWRITE_HV(0); SBAR(); }
    if (NT > 1) { if constexpr (F32) SLOAD_F((const float*)Kh, KBASE(1)); else SLOAD_H(Kh, Vh, KBASE(1)); }
    SBAR(); qkt<0, SK>(pA0, pA1, K_lds, r32, hi, S.qr, ACT(0));
    if constexpr (F32) { if (NT > 1) { VMW(); SWRITE_KF(1); SBAR(); SLOAD_F((const float*)Vh, KBASE(1)); } }
    MASKT(pA0, pA1, 0); partialSM(pA0, pA1, m_reg, mnA, alA);
    if (NT > 1) { VMW(); if constexpr (F32) { SWRITE_VF(1); SBAR(); if (NT > 2) SLOAD_F((const float*)Kh, KBASE(2)); } else SWRITE_H(1); }
    __syncthreads();
#define HALF_STEP(PX0, PX1, mnX, alX, PY0, PY1, alY, t, KB, VB, SB) do {                                                      \
        SBAR(); qkt<KB, SK>(PX0, PX1, K_lds, r32, hi, S.qr, ACT(t));                                             \
        finishSM(PY0, PY1, alY, l_reg, pa0, pa1, pa2, pa3); SBAR();                                                           \
        if ((t) + 1 < NT) { if constexpr (F32) { VMW(); SWRITE_KF(SB); SBAR(); SLOAD_F((const float*)Vh, KBASE((t) + 1)); }  \
                            else { SLOAD_H(Kh, Vh, KBASE((t) + 1)); } SBAR(); }                                               \
        pv_tile<VB, SK>(o, vb0, pa0, pa1, pa2, pa3, ACT((t) - 1)); MASKT(PX0, PX1, (t)); partialSM(PX0, PX1, m_reg, mnX, alX);                                        \
        __syncthreads();                                                                                                      \
        if ((t) + 1 < NT) { VMW(); if constexpr (F32) { SWRITE_VF(SB); SBAR(); if ((t) + 2 < NT) SLOAD_F((const float*)Kh, KBASE((t) + 2)); } \
                            else { SWRITE_H(SB); } }                                                                          \
        RESC(alX); __syncthreads(); } while (0)
    for (int t = 1; t + 1 < NT; t += 2) {
        HALF_STEP(pB0, pB1, mnB, alB, pA0, pA1, alA, t, 1, 0, 0);
        HALF_STEP(pA0, pA1, mnA, alA, pB0, pB1, alB, t + 1, 0, 1, 1);
    }
    const bool even = (NT & 1) == 0;
    if (even) { SBAR(); qkt<1, SK>(pB0, pB1, K_lds, r32, hi, S.qr, ACT(NT - 1)); SBAR(); }
#define QROW(e) (nxt.Q + (size_t)(wid * QBLK + r32) * D + ((e) >> 1) * 16 + hi * 8 + ((e) & 1) * 4)
    if constexpr (F32) { SLOAD_F((const float*)nxt.K, kbn); SBAR();
#pragma unroll
        for (int e = 0; e < 8; ++e) S.tq[e] = *(const f32x4*)QROW(e); }
    else { SLOAD_H(nxt.K, nxt.V, kbn); SBAR();
#pragma unroll
        for (int d0 = 0; d0 < 8; ++d0) S.qr[d0] = load8<TIn>(nxt.Q + (size_t)(wid * QBLK + r32) * D + d0 * 16 + hi * 8); }
    SBAR();
    finishSM(pA0, pA1, alA, l_reg, pa0, pa1, pa2, pa3); SBAR();
    if constexpr (F32) {
#pragma unroll
        for (int e = 8; e < 16; ++e) S.tq[e] = *(const f32x4*)QROW(e); SBAR(); }
#undef QROW
    pv_tile<0, SK>(o, vb0, pa0, pa1, pa2, pa3, ACT(even ? NT - 2 : NT - 1));
    if (even) { MASKT(pB0, pB1, NT - 1); partialSM(pB0, pB1, m_reg, mnB, alB); __syncthreads(); RESC(alB);
        finishSM(pB0, pB1, alB, l_reg, pa0, pa1, pa2, pa3); SBAR(); pv_tile<1, SK>(o, vb0, pa0, pa1, pa2, pa3, ACT(NT - 1)); }
    SBAR(); SEAM_K0();
    if (hi == 0) li_l[r32] = l_reg; asm volatile("s_waitcnt lgkmcnt(0)" ::: "memory");
    float rli[16];
#pragma unroll
    for (int r = 0; r < 16; ++r) rli[r] = __builtin_amdgcn_rcpf(li_l[crow(r, hi)]);
    const int LDO = cur.ldo; TOut* Ow = cur.O + (size_t)(wid * QBLK) * LDO;
#pragma unroll
    for (int r = 0; r < 16; ++r) { const int orow = crow(r, hi);
#pragma unroll
        for (int d0 = 0; d0 < 4; ++d0) { const float v = o[d0][r] * rli[r];
            if constexpr (same_t<TOut, float>::v) { Ow[(size_t)orow * LDO + d0 * 32 + r32] = v; }
            else { const float vn = __shfl_xor(v, 1);
                   if ((r32 & 1) == 0) *(unsigned*)(Ow + (size_t)orow * LDO + d0 * 32 + r32) = cvtpk(v, vn); } } }
    if constexpr (F32) {
#pragma unroll
        for (int d0 = 0; d0 < 8; ++d0) S.qr[d0] = pack8(S.tq[2 * d0], S.tq[2 * d0 + 1]); }
    __syncthreads();
#undef RESC
#undef KBASE
#undef ACT
#undef MASKT
#undef SEAM_K0
#undef HALF_STEP
}
#undef ROW
#undef VMW
#undef VMWN
#undef SLOAD_H
#undef SWRITE_HK
#undef SWRITE_HV
#undef SWRITE_H
#undef SLOAD_F
#undef SWRITE_KF
#undef SWRITE_VF


constexpr int QB2 = 128, L2_K = 0, L2_V0 = 32768, L2_V1 = 65536, L2_P = 98304;
struct Ref2 { const bf16* Q; const bf16* K; const bf16* V0; const bf16* V1; float* O0; float* O1; int P0; };
struct Seam2 { bf16x8 qr[8]; bf16x8 sk0, sk1, sa0, sa1, sb0, sb1; f32x16 pA0, pA1; };
#define LD8(p) (*reinterpret_cast<const bf16x8*>(p))
#define VMW2() asm volatile("s_waitcnt vmcnt(0)" ::: "memory")
__device__ __forceinline__ void pv3_tile(f32x16* o, int vb, bf16x8 pa0, bf16x8 pa1, bf16x8 pa2, bf16x8 pa3, bf16x8 pb0, bf16x8 pb1, bf16x8 pb2, bf16x8 pb3, float fA, float fB, const float* alA, int hi) {
#define TRRD(dst, off) asm volatile("ds_read_b64_tr_b16 %0, %1 offset:%2" : "=&v"(dst) : "v"(vb), "i"(off) : "memory")
#define RD8(X, g) do { constexpr int b_ = v_rd_off((g), 0, 0); TRRD(X##0, b_); TRRD(X##1, b_ + 2048); TRRD(X##2, b_ + 4096); TRRD(X##3, b_ + 6144); \
        TRRD(X##4, b_ + 8192); TRRD(X##5, b_ + 10240); TRRD(X##6, b_ + 12288); TRRD(X##7, b_ + 14336); } while (0)
#define VF(X, a, b) (bf16x8){X##a[0], X##a[1], X##a[2], X##a[3], X##b[0], X##b[1], X##b[2], X##b[3]}
#define MM8(X, g) do { \
        o[g] = __builtin_amdgcn_mfma_f32_32x32x16_bf16(pa0, VF(X, 0, 1), o[g], 0, 0, 0); o[4 + g] = __builtin_amdgcn_mfma_f32_32x32x16_bf16(pb0, VF(X, 0, 1), o[4 + g], 0, 0, 0); \
        o[g] = __builtin_amdgcn_mfma_f32_32x32x16_bf16(pa1, VF(X, 2, 3), o[g], 0, 0, 0); o[4 + g] = __builtin_amdgcn_mfma_f32_32x32x16_bf16(pb1, VF(X, 2, 3), o[4 + g], 0, 0, 0); \
        o[g] = __builtin_amdgcn_mfma_f32_32x32x16_bf16(pa2, VF(X, 4, 5), o[g], 0, 0, 0); o[4 + g] = __builtin_amdgcn_mfma_f32_32x32x16_bf16(pb2, VF(X, 4, 5), o[4 + g], 0, 0, 0); \
        o[g] = __builtin_amdgcn_mfma_f32_32x32x16_bf16(pa3, VF(X, 6, 7), o[g], 0, 0, 0); o[4 + g] = __builtin_amdgcn_mfma_f32_32x32x16_bf16(pb3, VF(X, 6, 7), o[4 + g], 0, 0, 0); } while (0)
#define LGK8() do { asm volatile("s_waitcnt lgkmcnt(8)" ::: "memory"); SBAR(); } while (0)
    s16x4 A0, A1, A2, A3, A4, A5, A6, A7, B0, B1, B2, B3, B4, B5, B6, B7;
    RD8(A, 0); RD8(B, 1);
    if (__builtin_amdgcn_readfirstlane(__float_as_int(fA)) != 0) {
        const f32x4* a4p = (const f32x4*)alA + hi; const f32x4 a0 = a4p[0], a1 = a4p[2], a2 = a4p[4], a3 = a4p[6];
#pragma unroll
        for (int d_ = 0; d_ < 4; ++d_)
#pragma unroll
            for (int j = 0; j < 4; ++j) { o[d_][j] *= a0[j]; o[d_][4 + j] *= a1[j]; o[d_][8 + j] *= a2[j]; o[d_][12 + j] *= a3[j]; } }
    if (__builtin_amdgcn_readfirstlane(__float_as_int(fB)) != 0) {
        const f32x4* a4p = (const f32x4*)(alA + 32) + hi; const f32x4 a0 = a4p[0], a1 = a4p[2], a2 = a4p[4], a3 = a4p[6];
#pragma unroll
        for (int d_ = 4; d_ < 8; ++d_)
#pragma unroll
            for (int j = 0; j < 4; ++j) { o[d_][j] *= a0[j]; o[d_][4 + j] *= a1[j]; o[d_][8 + j] *= a2[j]; o[d_][12 + j] *= a3[j]; } }
    asm volatile("s_waitcnt lgkmcnt(0)" ::: "memory"); SBAR(); MM8(A, 0); SBAR();
    RD8(A, 2); LGK8(); MM8(B, 1); SBAR();
    RD8(B, 3); LGK8(); MM8(A, 2); SBAR();
    asm volatile("s_waitcnt lgkmcnt(0)" ::: "memory"); SBAR(); MM8(B, 3);
#undef TRRD
#undef RD8
#undef VF
#undef MM8
#undef LGK8
}
template <bool RS>
__device__ __forceinline__ void diff2_prime(const Ref2& cur, char* lds, Seam2& S) {
    int tid_ = threadIdx.x; asm volatile("" : "+v"(tid_));
    const int tid = tid_, wid = __builtin_amdgcn_readfirstlane(tid >> 6), lane = tid & 63, r32 = lane & 31, hi = lane >> 5;
    const int sr = tid >> 4, sc = (tid & 15) * 8, kws = KSWZ(sr, sc * 2);
    if constexpr (RS) {
#pragma unroll
        for (int d0 = 0; d0 < 8; ++d0) S.qr[d0] = LD8(cur.Q + (size_t)(wid * QBLK + r32) * D + d0 * 16 + hi * 8); }
    S.sk0 = LD8(cur.K + (size_t)sr * D + sc); S.sk1 = LD8(cur.K + (size_t)(32 + sr) * D + sc);
    VMW2();
    *(bf16x8*)(lds + L2_K + kws) = S.sk0; *(bf16x8*)(lds + L2_K + kws + 32 * 256) = S.sk1;
    S.sk0 = LD8(cur.K + (size_t)(KVBLK + sr) * D + sc); S.sk1 = LD8(cur.K + (size_t)(KVBLK + 32 + sr) * D + sc);
    S.sa0 = LD8(cur.V0 + (size_t)sr * D + sc); S.sa1 = LD8(cur.V0 + (size_t)(32 + sr) * D + sc);
    S.sb0 = LD8(cur.V1 + (size_t)sr * D + sc); S.sb1 = LD8(cur.V1 + (size_t)(32 + sr) * D + sc);
    VMW2();
    *(bf16x8*)(lds + L2_K + SHM_K + kws) = S.sk0; *(bf16x8*)(lds + L2_K + SHM_K + kws + 32 * 256) = S.sk1;
    __syncthreads();
    if constexpr (RS) qkt<0, false>(S.pA0, S.pA1, lds + L2_K, r32, hi, S.qr, true);
}
template <bool RS>
__device__ __forceinline__ void diff2_block(const Ref2& cur, const Ref2& nxt, char* lds, float* xl, Seam2& S) {
    int tid_ = threadIdx.x; asm volatile("" : "+v"(tid_));
    const int tid = tid_, wid = __builtin_amdgcn_readfirstlane(tid >> 6), lane = tid & 63, r32 = lane & 31, hi = lane >> 5;
    const int w4 = wid & 3;
    const int NT = (cur.P0 + QB2 - 1) / KVBLK + 1;
    const int qlo = cur.P0 + w4 * QBLK, qm = qlo + r32 - 4 * hi;
    char* K_lds = lds + L2_K; char* V0_lds = lds + L2_V0; char* V1_lds = lds + L2_V1; char* P_lds = lds + L2_P + w4 * 4096;
    float* alp = xl + w4 * 32; float* li = xl + 256 + (RS ? w4 : (w4 >> 1) * 2) * 32; float* flg = xl + 384 + w4;
    const int sr = tid >> 4, sc = (tid & 15) * 8, vst0 = v_st(sr, sc), vst1 = v_st(32 + sr, sc), kws = KSWZ(sr, sc * 2);
    const int vbase = (int)(uintptr_t)V0_lds + v_rd_base(lane);
    float m_reg = -1e30f, l_reg = 0.f; f32x16 o[RS ? 1 : 8] = {};
    auto stage_top = [&](const int t, const bool drain) __attribute__((always_inline)) {
        const int par = t & 1;
        if (!drain) { *(bf16x8*)(V0_lds + par * SHM_V + vst0) = S.sa0; *(bf16x8*)(V0_lds + par * SHM_V + vst1) = S.sa1;
                      *(bf16x8*)(V1_lds + par * SHM_V + vst0) = S.sb0; *(bf16x8*)(V1_lds + par * SHM_V + vst1) = S.sb1; }
        const bool kc = !drain && t + 2 < NT, kn = drain || t == NT - 1;
        if (kc || kn) { const bf16* Kp = kc ? cur.K : nxt.K; const int k0 = kc ? (t + 2) * KVBLK : (drain ? KVBLK : 0);
            S.sk0 = LD8(Kp + (size_t)(k0 + sr) * D + sc); S.sk1 = LD8(Kp + (size_t)(k0 + 32 + sr) * D + sc); }
        const bool vc = !drain && t + 1 < NT;
        if (vc || drain) { const bf16* Ap = vc ? cur.V0 : nxt.V0; const bf16* Bp = vc ? cur.V1 : nxt.V1; const int k0 = vc ? (t + 1) * KVBLK : 0;
            S.sa0 = LD8(Ap + (size_t)(k0 + sr) * D + sc); S.sa1 = LD8(Ap + (size_t)(k0 + 32 + sr) * D + sc);
            S.sb0 = LD8(Bp + (size_t)(k0 + sr) * D + sc); S.sb1 = LD8(Bp + (size_t)(k0 + 32 + sr) * D + sc); }
    };
    auto stage_end = [&](const int t, const bool drain, const int nyoung) __attribute__((always_inline)) {
        const bool kc = !drain && t + 2 < NT, kn = drain || t == NT - 1;
        if (kc || kn) { const int wb = kc ? (t & 1) : (drain ? 1 : 0);
            (void)nyoung;
            *(bf16x8*)(K_lds + wb * SHM_K + kws) = S.sk0; *(bf16x8*)(K_lds + wb * SHM_K + kws + 32 * 256) = S.sk1; }
    };
    if constexpr (RS) {
        f32x16 pB0, pB1;
        auto siter = [&](f32x16& pX0, f32x16& pX1, f32x16& pY0, f32x16& pY1, const int t) __attribute__((always_inline)) {
            const int par = t & 1;
            stage_top(t, false);
            if (t == NT - 1) {
#pragma unroll
                for (int d0 = 0; d0 < 8; ++d0) S.qr[d0] = LD8(nxt.Q + (size_t)(w4 * QBLK + r32) * D + d0 * 16 + hi * 8); }
            SBAR();
            if (t + 1 < NT) qkt<0, false>(pY0, pY1, K_lds + ((t + 1) & 1) * SHM_K, r32, hi, S.qr, true);
            float mn, alpha; bf16x8 pa0, pa1, pa2, pa3;
            { const int kb = t * KVBLK; if (kb + KVBLK - 1 > qlo) mask_tile(pX0, pX1, qm - kb, 1u << 30); }
            partialSM(pX0, pX1, m_reg, mn, alpha); finishSM(pX0, pX1, alpha, l_reg, pa0, pa1, pa2, pa3);
            { bf16x8* pw = (bf16x8*)(P_lds + par * 16384) + lane; pw[0] = pa0; pw[64] = pa1; pw[128] = pa2; pw[192] = pa3; }
            const bool need = __any(alpha < 1.f);
            if (hi == 0) { alp[par * 128 + r32] = alpha; if (t == NT - 1) li[r32] = l_reg; if (r32 == 0) flg[par * 4] = need ? 1.f : 0.f; }
            SBAR();
            stage_end(t, false, t == NT - 1 ? 12 : 4);
            __syncthreads();
        };
#pragma unroll 1
        for (int t = 0; t < NT; t += 2) { siter(S.pA0, S.pA1, pB0, pB1, t); siter(pB0, pB1, S.pA0, S.pA1, t + 1); }
        stage_top(NT, true);
        SBAR();
        qkt<0, false>(S.pA0, S.pA1, K_lds, r32, hi, S.qr, true);
        SBAR();
        stage_end(NT, true, 4);
        __syncthreads();
    } else {
#pragma unroll 1
        for (int t = 0; t <= NT; ++t) {
            const bool drain = t == NT;
            stage_top(t, drain);
            SBAR();
            if (t >= 1) {
                const int pp = (t - 1) & 1, rg = w4 >> 1, hf = w4 & 1;
                char* PA = lds + L2_P + (2 * rg) * 4096 + pp * 16384; float* alA = xl + (2 * rg) * 32 + pp * 128; float* flA = xl + 384 + 2 * rg + pp * 4;
                bf16x8 pa0, pa1, pa2, pa3, pb0, pb1, pb2, pb3;
                { const bf16x8* pr = (const bf16x8*)PA + lane; pa0 = pr[0]; pa1 = pr[64]; pa2 = pr[128]; pa3 = pr[192]; pb0 = pr[256]; pb1 = pr[320]; pb2 = pr[384]; pb3 = pr[448]; }
                const float fA = flA[0], fB = flA[1];
                pv3_tile(o, vbase + hf * (L2_V1 - L2_V0) + pp * SHM_V, pa0, pa1, pa2, pa3, pb0, pb1, pb2, pb3, fA, fB, alA, hi);
            }
            SBAR();
            stage_end(t, drain, 4);
            if (drain) {
                int r32e = r32, hie = hi; asm volatile("" : "+v"(r32e), "+v"(hie));
                const f32x4* l4p = (const f32x4*)li + hie; const f32x4 l0 = l4p[0], l1 = l4p[2], l2 = l4p[4], l3 = l4p[6];
                float rli[16];
#pragma unroll
                for (int j = 0; j < 4; ++j) { rli[j] = __builtin_amdgcn_rcpf(l0[j]); rli[4 + j] = __builtin_amdgcn_rcpf(l1[j]); rli[8 + j] = __builtin_amdgcn_rcpf(l2[j]); rli[12 + j] = __builtin_amdgcn_rcpf(l3[j]); }
                const f32x4* m4p = (const f32x4*)(li + 32) + hie; const f32x4 n0 = m4p[0], n1 = m4p[2], n2 = m4p[4], n3 = m4p[6];
                float rlj[16];
#pragma unroll
                for (int j = 0; j < 4; ++j) { rlj[j] = __builtin_amdgcn_rcpf(n0[j]); rlj[4 + j] = __builtin_amdgcn_rcpf(n1[j]); rlj[8 + j] = __builtin_amdgcn_rcpf(n2[j]); rlj[12 + j] = __builtin_amdgcn_rcpf(n3[j]); }
                float* Ow = ((w4 & 1) ? cur.O1 : cur.O0) + (size_t)((w4 >> 1) * 2 * QBLK) * D;
#pragma unroll
                for (int r = 0; r < 16; ++r) { const int orow = crow(r, hie);
#pragma unroll
                    for (int d0 = 0; d0 < 4; ++d0) { Ow[(size_t)orow * D + d0 * 32 + r32e] = o[d0][r] * rli[r]; Ow[(size_t)(QBLK + orow) * D + d0 * 32 + r32e] = o[4 + d0][r] * rlj[r]; } }
            }
            __syncthreads();
        }
    }
}
#undef LD8
#undef VMW2
}
constexpr size_t al256(size_t x) { return (x + 255) & ~(size_t)255; }
constexpr size_t WS_CTL = 0, CTL_ZERO_BYTES = 1u << 20;
constexpr size_t WS_WGU   = CTL_ZERO_BYTES;
constexpr size_t WS_WDN   = WS_WGU  + (size_t)8 * NGU * DM * 2;
constexpr size_t WS_WOUT  = WS_WDN  + (size_t)8 * DM * FF * 2;
constexpr size_t WS_WMEM  = WS_WOUT + (size_t)4 * DM * DM * 2;
constexpr size_t WS_WAIN  = WS_WMEM + (size_t)4 * 1024 * DM * 2;
constexpr size_t WS_WKV   = WS_WAIN + (size_t)2 * NAIN * DM * 2;
constexpr size_t WS_WBIN  = WS_WKV  + (size_t)NKV * DM * 2;
constexpr size_t WS_COS   = WS_WBIN + (size_t)2 * NBIN * DM * 2;
constexpr size_t WS_MEMN  = WS_COS  + (size_t)SEQ * 64 * 4;
constexpr size_t WS_MK    = WS_MEMN + (size_t)4 * 1024 * DM * 2;
constexpr size_t WS_MV    = WS_MK   + (size_t)4 * 1024 * 512 * 2;
constexpr size_t WS_XB    = WS_MV   + (size_t)4 * 1024 * 512 * 2;
constexpr size_t WS_SS    = WS_XB   + (size_t)M * DM * 2;
constexpr size_t WS_XH    = WS_SS   + (size_t)M * 32 * 4;
constexpr size_t WS_HID   = WS_XH   + (size_t)M * DM * 2;
constexpr size_t WS_ZA    = WS_HID  + (size_t)M * FF * 2;
constexpr size_t WS_VSTAT = WS_ZA   + (size_t)M * 3072 * 2;
constexpr size_t WS_QB    = WS_VSTAT + (size_t)M * 24 * 4;
constexpr size_t WS_KSH   = WS_QB   + (size_t)M * 1536 * 2;
constexpr size_t WS_VSH   = WS_KSH  + (size_t)M * 1536 * 2;
constexpr size_t WS_QMB   = WS_VSH  + (size_t)M * 1536 * 2;
constexpr size_t WS_OATT  = WS_QMB  + (size_t)M * 512 * 2;
constexpr size_t WS_CAT   = WS_OATT + (size_t)2 * 96 * SEQ * 128 * 4;
constexpr size_t WS_END   = WS_CAT  + (size_t)M * DM * 2;
static_assert(WS_WGU % 256 == 0 && WS_COS % 256 == 0 && WS_VSTAT % 256 == 0 && WS_QB % 256 == 0 && WS_END % 256 == 0, "ws alignment");

constexpr int RING_OFF = 0, RING_BYTES = 131072;
constexpr int LDSCTL_OFF = 141312, MISC_OFF = LDSCTL_OFF + 320;
constexpr int LDS_BYTES = 147456;
constexpr int NWAVES = 8;

#define GAS __attribute__((address_space(1)))
#define LAS __attribute__((address_space(3)))
typedef unsigned short bf16r;
typedef unsigned v4u __attribute__((ext_vector_type(4)));
typedef unsigned v2u __attribute__((ext_vector_type(2)));
typedef float f32x4 __attribute__((ext_vector_type(4)));
typedef short bf16x8 __attribute__((ext_vector_type(8)));
typedef GAS unsigned gu32;
#define LDS_WAIT() asm volatile("s_waitcnt lgkmcnt(0)" ::: "memory")
#define VM_WAIT() asm volatile("s_waitcnt vmcnt(0)" ::: "memory")
__device__ __forceinline__ unsigned f2bf(float f) { unsigned u = __builtin_bit_cast(unsigned, f); return (u + 0x7fffu + ((u >> 16) & 1u)) >> 16; }
__device__ __forceinline__ unsigned pk2(float lo, float hi) { return f2bf(lo) | (f2bf(hi) << 16); }
__device__ __forceinline__ float bf2f(unsigned short b) { return __builtin_bit_cast(float, ((unsigned)b) << 16); }
__device__ __forceinline__ float wave_sum(float v) {
#pragma unroll
    for (int o = 1; o < 64; o <<= 1) v += __shfl_xor(v, o);
    return v;
}
#define XB_TMO      128
#define XB_XCNT(j)  (256  + 64 * (j))
#define XB_XSUB(j)  (1280 + 64 * (j))
#define XB_XGEN(j)  (2304 + 64 * (j))
#define XB_TOP      3328
#define XB_TOPGEN   3392
#define XCD_BAR_WORDS 3456
#define XB_SPIN_CAP (1u << 18)

__device__ __forceinline__ unsigned xb_ld(unsigned* p)              { return __hip_atomic_load(p, __ATOMIC_RELAXED, __HIP_MEMORY_SCOPE_AGENT); }
__device__ __forceinline__ unsigned xb_add(unsigned* p, unsigned v) { return __hip_atomic_fetch_add(p, v, __ATOMIC_RELAXED, __HIP_MEMORY_SCOPE_AGENT); }
__device__ __forceinline__ unsigned xb_xcc_id() { return (unsigned)__builtin_amdgcn_s_getreg((3 << 11) | 20) & 0xFu; }
#define XB_SPIN(cond, bar) do { unsigned _sp = 0; while (cond) { __builtin_amdgcn_s_sleep(1); \
    if ((++_sp & 255u) == 0u) { if (xb_ld(&(bar)[XB_TMO])) break; if (_sp > XB_SPIN_CAP) { atomicAdd(&(bar)[XB_TMO], 1u); break; } } } } while (0)

struct XcdBarrier {
    unsigned* bar; unsigned x;
    volatile LAS unsigned* st;
};

__device__ __forceinline__ XcdBarrier xcd_barrier_post(unsigned* bar, volatile LAS unsigned* st) {
    XcdBarrier b; b.bar = bar; b.x = xb_xcc_id(); b.st = st;
    if (threadIdx.x == 0) (void)xb_add(&bar[XB_XCNT(b.x)], 1u);
    return b;
}
__device__ __forceinline__ void xcd_barrier_complete(unsigned* bar, unsigned x, unsigned& nloc, unsigned& nx) {
    const unsigned G = gridDim.x * gridDim.y * gridDim.z;
    unsigned sum, cnt, mine, sp = 0u;
    for (;;) {
        sum = 0u; cnt = 0u; mine = 0u;
#pragma unroll
        for (unsigned j = 0; j < 16; ++j) { const unsigned c = xb_ld(&bar[XB_XCNT(j)]); sum += c; cnt += (c > 0u) ? 1u : 0u; mine = (j == x) ? c : mine; }
        if (sum == G) break;
        __builtin_amdgcn_s_sleep(1);
        if ((++sp & 255u) == 0u) { if (xb_ld(&bar[XB_TMO])) break; if (sp > XB_SPIN_CAP) { atomicAdd(&bar[XB_TMO], 1u); break; } }
    }
    nloc = mine > 0u ? mine : 1u; nx = cnt > 0u ? cnt : 1u;
}

__device__ __forceinline__ void xcd_barrier(const XcdBarrier& b) {
    asm volatile("s_waitcnt vmcnt(0)" ::: "memory");
    __syncthreads();
    if (threadIdx.x == 0) {
        unsigned* bar = b.bar;
        __builtin_amdgcn_s_waitcnt(0);
        unsigned nloc = b.st[0], nx = b.st[1];
        if (nloc == 0u) { xcd_barrier_complete(bar, b.x, nloc, nx); b.st[0] = nloc; b.st[1] = nx; }
        const unsigned old = xb_add(&bar[XB_XSUB(b.x)], 1u);
        const unsigned gen = old / nloc;
        if (old + 1u == (gen + 1u) * nloc) {
            __builtin_amdgcn_fence(__ATOMIC_RELEASE, "agent");
            asm volatile("s_waitcnt vmcnt(0)" ::: "memory");
            const unsigned og = xb_add(&bar[XB_TOP], 1u);
            const unsigned tg = og / nx;
            if (og + 1u == (tg + 1u) * nx) xb_add(&bar[XB_TOPGEN], 1u);
            else XB_SPIN(xb_ld(&bar[XB_TOPGEN]) == tg, bar);
            __builtin_amdgcn_fence(__ATOMIC_ACQUIRE, "agent");
            xb_add(&bar[XB_XGEN(b.x)], 1u);
            asm volatile("s_waitcnt vmcnt(0)" ::: "memory");
        } else {
            XB_SPIN(xb_ld(&bar[XB_XGEN(b.x)]) == gen, bar);
            __builtin_amdgcn_fence(__ATOMIC_ACQUIRE, "agent");
            asm volatile("s_waitcnt vmcnt(0)" ::: "memory");
        }
    }
    __syncthreads();
}

#define XB_LSUB(j)  (4096 + 64 * (j))
#define XB_LGEN(j)  (5120 + 64 * (j))
#define XB_XCCTAB   6144
__device__ __forceinline__ void xcd_local_barrier(const XcdBarrier& b) {
    asm volatile("s_waitcnt vmcnt(0)" ::: "memory");
    __syncthreads();
    if (threadIdx.x == 0) {
        unsigned* bar = b.bar;
        __builtin_amdgcn_s_waitcnt(0);
        const unsigned nloc = b.st[0] ? b.st[0] : 1u;
        const unsigned old = xb_add(&bar[XB_LSUB(b.x)], 1u);
        const unsigned gen = old / nloc;
        if (old + 1u == (gen + 1u) * nloc) {
#ifndef LOCAL_BAR_RELEASE
#define LOCAL_BAR_RELEASE 0
#endif
            if (LOCAL_BAR_RELEASE) { __builtin_amdgcn_fence(__ATOMIC_RELEASE, "agent"); asm volatile("s_waitcnt vmcnt(0)" ::: "memory"); }
            __builtin_amdgcn_fence(__ATOMIC_ACQUIRE, "agent");
            xb_add(&bar[XB_LGEN(b.x)], 1u);
            asm volatile("s_waitcnt vmcnt(0)" ::: "memory");
        } else {
            XB_SPIN(xb_ld(&bar[XB_LGEN(b.x)]) == gen, bar);
            __builtin_amdgcn_fence(__ATOMIC_ACQUIRE, "agent");
            asm volatile("s_waitcnt vmcnt(0)" ::: "memory");
        }
    }
    __syncthreads();
}
struct Frame {
    unsigned char* lds_g;
    LAS unsigned char* lds;
    volatile LAS unsigned* MISC;
    gu32* ctl;
    int tid, lane, wave;
    int vcu, G;
    unsigned char* ws;
};

__device__ __forceinline__ void transpose_item(const float* W, int K, int N, bf16r* WT, size_t dst_row0, int k0, int n0, LAS float* scr, int lane, const float* gain) {
    f32x4 v[16]; float gk[16];
#pragma unroll
    for (int i = 0; i < 16; ++i) { const int kk = 4 * i + (lane >> 4); v[i] = *(const f32x4*)(W + (size_t)(k0 + kk) * N + n0 + (lane & 15) * 4); gk[i] = gain ? gain[k0 + kk] : 1.0f; }
#pragma unroll
    for (int i = 0; i < 16; ++i) { const int kk = 4 * i + (lane >> 4); const f32x4 w = v[i] * gk[i];
        LAS float* s = scr + kk * 65 + (lane & 15) * 4; s[0] = w[0]; s[1] = w[1]; s[2] = w[2]; s[3] = w[3]; }
    LDS_WAIT(); asm volatile("" ::: "memory");
    const int c = lane & 7;
#pragma unroll
    for (int j = 0; j < 8; ++j) { const int n = (lane >> 3) + 8 * j; const LAS float* s = scr + (8 * c) * 65 + n;
        v4u o; o.x = pk2(s[0 * 65], s[1 * 65]); o.y = pk2(s[2 * 65], s[3 * 65]); o.z = pk2(s[4 * 65], s[5 * 65]); o.w = pk2(s[6 * 65], s[7 * 65]);
        const size_t row = dst_row0 + n;
        *(v4u*)(WT + (((row >> 8) * (size_t)(K >> 6) + (k0 >> 6)) << 14) + ((row & 255) << 6) + 8 * c) = o; }
    LDS_WAIT(); asm volatile("" ::: "memory");
}
__device__ __forceinline__ bool transpose_group(int& r, const float* src, int cnt, int K, int N, bf16r* dst, bool gu, LAS float* scr, int lane, const float* gain, int gmode) {
    const int nkb = K / 64, nnb = N / 64, per = nkb * nnb;
    if (r >= cnt * per) { r -= cnt * per; return false; }
    const int mi = r / per, q = r % per, kb = q / nnb, nb = q % nnb, n0 = nb * 64;
    size_t drow = n0;
    if (gu) { drow = (n0 < FF) ? (size_t)(n0 / 128) * 256 + (n0 % 128) : (size_t)((n0 - FF) / 128) * 256 + 128 + ((n0 - FF) % 128); }
    const float* gp = gain;
    if (gain) { if (gmode == 1) gp = gain + (size_t)((mi >> 1) * 3 + (mi & 1) * 2) * K; else if (gmode >= 2) gp = gain + (size_t)((mi + (gmode - 2)) * 3 + 1) * K; }
    transpose_item(src + (size_t)mi * K * N, K, N, dst + (size_t)mi * K * N, gu ? drow : (size_t)n0, kb * 64, n0, scr, lane, gp);
    return true;
}
__device__ __forceinline__ void norm_row(const float* xrow, const float* gain, bf16r* orow, int lane) {
    const f32x4* xr = (const f32x4*)xrow + lane; f32x4 v[8]; float s = 0.f;
#pragma unroll
    for (int j = 0; j < 8; ++j) { v[j] = xr[64 * j]; s += (v[j][0] * v[j][0] + v[j][1] * v[j][1]) + (v[j][2] * v[j][2] + v[j][3] * v[j][3]); }
    const float rstd = 1.0f / sqrtf(wave_sum(s) * (1.0f / DM) + EPS);
    const f32x4* g4 = (const f32x4*)gain + lane; v2u* o8 = (v2u*)orow + lane;
#pragma unroll
    for (int j = 0; j < 8; ++j) { const f32x4 g = g4[64 * j]; v2u w; w.x = pk2(v[j][0] * rstd * g[0], v[j][1] * rstd * g[1]); w.y = pk2(v[j][2] * rstd * g[2], v[j][3] * rstd * g[3]); o8[64 * j] = w; }
}
__device__ __forceinline__ void xb_ss_phase(const Frame& F, const float* x, bf16r* xb, float* ss) {
    const int gw = F.vcu * NWAVES + F.wave, NGW = F.G * NWAVES, lane = F.lane;
    for (int m = gw; m < M; m += NGW) { const f32x4* xr = (const f32x4*)(x + (size_t)m * DM) + lane; float s = 0.f;
#pragma unroll
        for (int j = 0; j < 8; ++j) { const f32x4 v = xr[64 * j]; s += (v[0] * v[0] + v[1] * v[1]) + (v[2] * v[2] + v[3] * v[3]); v2u w; w.x = pk2(v[0], v[1]); w.y = pk2(v[2], v[3]); const int col = 4 * lane + 256 * j; *(v2u*)(xb + (((size_t)((m >> 8) * (DM >> 6) + (col >> 6))) << 14) + ((m & 255) << 6) + (col & 63)) = w; }
        s = wave_sum(s); if (lane < 32) ss[(size_t)m * 32 + lane] = (lane == 0) ? s : 0.f; }
}
__device__ __forceinline__ void sincos_d(float angf, float& sn, float& cs) {
    const double a = (double)angf; const double k = __builtin_rint(a * 0.15915494309189535); const double r = a - k * 6.283185307179586476925286766559;
    const double r2 = r * r; double ts = r, tc = 1.0, ss = r, cc = 1.0;
#pragma unroll
    for (int n = 1; n <= 14; ++n) { tc = -tc * r2 / (double)((2 * n - 1) * (2 * n)); ts = -ts * r2 / (double)((2 * n) * (2 * n + 1)); cc += tc; ss += ts; }
    sn = (float)ss; cs = (float)cc;
}
__device__ __forceinline__ void combine_phase(const Frame& F, const float* oatt, const float* lamp  , const float* subg  , float lam_init, bf16r* cat) {
    const int gw = F.vcu * NWAVES + F.wave, NGW = F.G * NWAVES, lane = F.lane;
    const float d01 = wave_sum(lamp[lane] * lamp[128 + lane] + lamp[64 + lane] * lamp[192 + lane]);
    const float d23 = wave_sum(lamp[256 + lane] * lamp[384 + lane] + lamp[320 + lane] * lamp[448 + lane]);
    const float lam = expf(d01) - expf(d23) + lam_init;
    const int half = lane >> 5, d4 = (lane & 31) * 4; const f32x4 g = *(const f32x4*)(subg + half * 128 + d4) * (1.0f - lam_init);
    const bool own = F.G == 256; const int m0 = own ? 2048 * ((int)blockIdx.x & 7) + ((int)blockIdx.x >> 3) * NWAVES + F.wave : gw, mstep = own ? 256 : NGW, mend = own ? 2048 * ((int)blockIdx.x & 7) + 2048 : M;
    for (int m = m0; m < mend; m += mstep) { const int b = m >> 12, s = m & 4095;
        f32x4 o[DH]; float ss[DH];
#pragma unroll
        for (int h = 0; h < DH; ++h) { const size_t vh0 = (size_t)((b * 6 + h) * 2 + 0) * 2 + half, vh1 = (size_t)((b * 6 + h) * 2 + 1) * 2 + half;
            const f32x4 o0 = *(const f32x4*)(oatt + (vh0 * SEQ + s) * 128 + d4), o1 = *(const f32x4*)(oatt + (vh1 * SEQ + s) * 128 + d4);
            o[h] = o0 - o1 * lam; ss[h] = (o[h][0] * o[h][0] + o[h][1] * o[h][1]) + (o[h][2] * o[h][2] + o[h][3] * o[h][3]); }
#pragma unroll
        for (int sh = 1; sh < 64; sh <<= 1) {
#pragma unroll
            for (int h = 0; h < DH; ++h) ss[h] += __shfl_xor(ss[h], sh); }
#pragma unroll
        for (int h = 0; h < DH; ++h) { const float rstd = 1.0f / sqrtf(ss[h] * (1.0f / DV) + EPS);
            v2u w; w.x = pk2(o[h][0] * rstd * g[0], o[h][1] * rstd * g[1]); w.y = pk2(o[h][2] * rstd * g[2], o[h][3] * rstd * g[3]);
            *(v2u*)(cat + (size_t)m * DM + h * 256 + half * 128 + d4) = w; }
    }
}

constexpr int GM_WL = 0, GM_WLS = 272, GM_VT = 128 * GM_WLS, GM_VTS = 272, GM_RS = GM_VT + 256 * GM_VTS;
static_assert(GM_RS + 512 <= RING_BYTES, "gmlp LDS");
__device__ __forceinline__ void gmlp_phase(const Frame& F, const bf16r* ZA, const float* vstat, const float* w_s  , const float* b_s  , const float* gv  , bf16r* cat) {
    const int tid = F.tid, lane = F.lane, wave = F.wave, fr = lane & 15, fq = lane >> 4;
    LAS unsigned char* lds = F.lds;
    LAS float* rs = (LAS float*)(lds + GM_RS);
    const bool own = F.G == 256; const int xg = (int)blockIdx.x & 7, jg = (int)blockIdx.x >> 3;
    for (int unit = own ? jg : F.vcu; unit < (own ? 96 : 128 * GG); unit += own ? 32 : F.G) {
        const int bc = own ? 16 * xg + unit / GG : unit / GG, g = unit % GG, r0 = bc * 128;
        if (tid < 128) { const f32x4* p = (const f32x4*)(vstat + (size_t)(r0 + tid) * 24); float s = 0.f;
#pragma unroll
            for (int i = 0; i < 6; ++i) { const f32x4 v = p[i]; s += (v[0] + v[1]) + (v[2] + v[3]); }
            rs[tid] = 1.0f / sqrtf(s * (1.0f / MIXW) + EPS); }
        { const int s = tid & 127, cb = (tid >> 7) * 8;
#pragma unroll
          for (int it = 0; it < 8; ++it) { const int d8 = (cb + it) * 8; const bf16x8 v = *(const bf16x8*)(ZA + (size_t)(r0 + s) * 3072 + 1536 + g * 256 + d8);
#pragma unroll
              for (int e = 0; e < 8; ++e) *(LAS unsigned short*)(lds + GM_VT + (d8 + e) * GM_VTS + s * 2) = (unsigned short)v[e]; } }
        __syncthreads();
        for (int idx = tid; idx < 128 * 32; idx += 512) { const int t = idx >> 5, s4 = (idx & 31) * 4; const f32x4 w = *(const f32x4*)(w_s + ((size_t)g * 128 + t) * 128 + s4);
            float e[4];
#pragma unroll
            for (int j = 0; j < 4; ++j) e[j] = (s4 + j <= t) ? w[j] * rs[s4 + j] : 0.f;
            v2u o; o.x = pk2(e[0], e[1]); o.y = pk2(e[2], e[3]); *(LAS v2u*)(lds + GM_WL + t * GM_WLS + s4 * 2) = o; }
        __syncthreads();
        f32x4 acc[8][2];
#pragma unroll
        for (int tt = 0; tt < 8; ++tt) { acc[tt][0] = (f32x4){0.f, 0.f, 0.f, 0.f}; acc[tt][1] = (f32x4){0.f, 0.f, 0.f, 0.f}; }
#pragma unroll
        for (int ks = 0; ks < 4; ++ks) {
            bf16x8 bfr[2];
#pragma unroll
            for (int dd = 0; dd < 2; ++dd) bfr[dd] = *(const LAS bf16x8*)(lds + GM_VT + (32 * wave + 16 * dd + fr) * GM_VTS + (32 * ks + 8 * fq) * 2);
#pragma unroll
            for (int tt = 0; tt < 8; ++tt) { if (32 * ks <= 16 * tt + 15) {
                const bf16x8 afr = *(const LAS bf16x8*)(lds + GM_WL + (16 * tt + fr) * GM_WLS + (32 * ks + 8 * fq) * 2);
#pragma unroll
                for (int dd = 0; dd < 2; ++dd) acc[tt][dd] = __builtin_amdgcn_mfma_f32_16x16x32_bf16(bfr[dd], afr, acc[tt][dd], 0, 0, 0); } }
        }
#pragma unroll
        for (int tt = 0; tt < 8; ++tt) { const int t = 16 * tt + fr, row = r0 + t; const float bias = b_s[g * 128 + t];
#pragma unroll
            for (int dd = 0; dd < 2; ++dd) { const int d = 32 * wave + 16 * dd + 4 * fq; const f32x4 gg = *(const f32x4*)(gv + g * 256 + d);
                const v2u uu = *(const v2u*)(ZA + (size_t)row * 3072 + g * 256 + d);
                const float u0 = bf2f((unsigned short)(uu.x & 0xffff)), u1 = bf2f((unsigned short)(uu.x >> 16)), u2 = bf2f((unsigned short)(uu.y & 0xffff)), u3 = bf2f((unsigned short)(uu.y >> 16));
                const f32x4 a = acc[tt][dd]; v2u o; o.x = pk2(u0 * (a[0] * gg[0] + bias), u1 * (a[1] * gg[1] + bias)); o.y = pk2(u2 * (a[2] * gg[2] + bias), u3 * (a[3] * gg[3] + bias));
                *(v2u*)(cat + (size_t)row * DM + g * 256 + d) = o; } }
        __syncthreads();
    }
}
namespace att {
__device__ __forceinline__ BlockRef<bf16, float> diff_ref(int L, int pass, const bf16* Q, const bf16* K, const bf16* V, float* O) {
    const int vh = L >> 3, x = L & 7, qb = pass ? 15 - x : x;
    const int b = vh / 24, r = vh % 24, h = r >> 2, c = (r >> 1) & 1, half = r & 1;
    BlockRef<bf16, float> R;
    R.Q = Q + ((size_t)((b * 2 + c) * 6 + h) * SEQ + (size_t)qb * QB) * D; R.K = K + (size_t)((b * 2 + c) * 6 + h) * SEQ * D; R.V = V + (size_t)((b * 6 + h) * 2 + half) * SEQ * D;
    R.O = O + ((size_t)vh * SEQ + (size_t)qb * QB) * D; R.P0 = qb * QB; R.ldo = D;
    return R;
}
__device__ __forceinline__ void diff_attn_phase(char* lds, const bf16* Q, const bf16* K, const bf16* V, float* O, int G, int c0) {
    constexpr int total = 96 * 8; const int W = 1 << 30;
    int L = c0; if (L >= total) return;
    int pass = 0; BlockRef<bf16, float> cur = diff_ref(L, 0, Q, K, V, O);
    Seam<bf16> S;
    causal_swa_prime<bf16, float>(cur, W, lds, S);
    for (;;) {
        const bool more_pass = pass == 0, more_item = L + G < total, last = !more_pass && !more_item;
        int passn = pass + 1, Ln = L;
        if (!more_pass) { passn = 0; Ln = more_item ? L + G : L; }
        const BlockRef<bf16, float> nxt = last ? cur : diff_ref(Ln, passn, Q, K, V, O);
        causal_swa_block<bf16, float>(cur, nxt, SEQ, W, lds, S);
        if (last) break;
        cur = nxt; pass = passn; L = Ln;
    }
}
__device__ __forceinline__ Ref2 diff_ref2(int L, int pass, const bf16* Q, const bf16* K, const bf16* V, float* O) {
    const int bhc = L >> 4, x = L & 15, qb = pass ? 31 - x : x;
    const int b = bhc / 12, r = bhc % 12, h = r >> 1, c = r & 1;
    Ref2 R; const size_t qk = (size_t)((b * 2 + c) * 6 + h) * SEQ;
    R.Q = Q + (qk + (size_t)qb * QB2) * D; R.K = K + qk * D;
    R.V0 = V + (size_t)((b * 6 + h) * 2) * SEQ * D; R.V1 = R.V0 + (size_t)SEQ * D;
    const size_t vh = (size_t)b * 24 + h * 4 + c * 2;
    R.O0 = O + (vh * SEQ + (size_t)qb * QB2) * D; R.O1 = R.O0 + (size_t)SEQ * D; R.P0 = qb * QB2;
    return R;
}
template <bool RS>
__device__ __forceinline__ void diff_attn2_role(char* lds, float* xl, const bf16* Q, const bf16* K, const bf16* V, float* O, int G, int c0) {
    constexpr int total = 48 * 16;
    int L = c0; if (L >= total) return;
    int pass = 0; Ref2 cur = diff_ref2(L, 0, Q, K, V, O);
    Seam2 S;
    diff2_prime<RS>(cur, lds, S);
    for (;;) {
        const bool more_pass = pass == 0, more_item = L + G < total, last = !more_pass && !more_item;
        int passn = pass + 1, Ln = L;
        if (!more_pass) { passn = 0; Ln = more_item ? L + G : L; }
        const Ref2 nxt = last ? cur : diff_ref2(Ln, passn, Q, K, V, O);
        diff2_block<RS>(cur, nxt, lds, xl, S);
        if (last) break;
        cur = nxt; pass = passn; L = Ln;
    }
}
__device__ __forceinline__ void diff_attn2_phase(char* lds, float* xl, const bf16* Q, const bf16* K, const bf16* V, float* O, int G, int c0) {
    if (__builtin_amdgcn_readfirstlane((int)threadIdx.x >> 6) < 4) diff_attn2_role<true>(lds, xl, Q, K, V, O, G, c0);
    else diff_attn2_role<false>(lds, xl, Q, K, V, O, G, c0);
}
__device__ __forceinline__ BlockRef<bf16, bf16> mem_ref(int L, const bf16* Q, const bf16* K, const bf16* V, bf16* cat) {
    const int bh = L >> 4, qb = L & 15, b = bh >> 2, hm = bh & 3;
    BlockRef<bf16, bf16> R;
    R.Q = Q + ((size_t)bh * SEQ + (size_t)qb * QB) * D; R.K = K + (size_t)bh * MEML * D; R.V = V + (size_t)bh * MEML * D;
    R.O = cat + ((size_t)b * SEQ + (size_t)qb * QB) * DM + 1536 + hm * 128; R.P0 = 256; R.ldo = DM;
    return R;
}
__device__ __forceinline__ void mem_attn_phase(char* lds, const bf16* Q, const bf16* K, const bf16* V, bf16* cat, int G, int c0) {
    constexpr int total = 256; const int W = 1 << 30;
    int L = c0; if (L >= total) return;
    BlockRef<bf16, bf16> cur = mem_ref(L, Q, K, V, cat);
    Seam<bf16> S;
    causal_swa_prime<bf16, bf16>(cur, W, lds, S);
    for (;;) {
        const bool last = L + G >= total;
        const BlockRef<bf16, bf16> nxt = last ? cur : mem_ref(L + G, Q, K, V, cat);
        causal_swa_block<bf16, bf16>(cur, nxt, MEML, W, lds, S);
        if (last) break;
        cur = nxt; L += G;
    }
}

struct DynAttn { unsigned* qcnt; const unsigned* rq; const unsigned* rkv; unsigned tag; unsigned* tmo; volatile __attribute__((address_space(3))) unsigned* bc; };
__device__ __forceinline__ unsigned dyn_pull(const DynAttn& C, int bpref) {
    if (threadIdx.x == 0) {
        unsigned code = 0xffffffffu;
        for (unsigned spins = 0;; ++spins) {
            bool any_left = false;
#pragma unroll 1
            for (int k = 0; k < 4 && code == 0xffffffffu; ++k) { const int b = (bpref + k) & 3;
                if (__hip_atomic_load(C.qcnt + 64 * b, __ATOMIC_RELAXED, __HIP_MEMORY_SCOPE_AGENT) >= 384u) continue;
                any_left = true;
                const bool ready = __hip_atomic_load(C.rq + 64 * (2 * b), __ATOMIC_RELAXED, __HIP_MEMORY_SCOPE_AGENT) == C.tag && __hip_atomic_load(C.rq + 64 * (2 * b + 1), __ATOMIC_RELAXED, __HIP_MEMORY_SCOPE_AGENT) == C.tag &&
                                   __hip_atomic_load(C.rkv + 64 * (2 * b), __ATOMIC_RELAXED, __HIP_MEMORY_SCOPE_AGENT) != 0u && __hip_atomic_load(C.rkv + 64 * (2 * b + 1), __ATOMIC_RELAXED, __HIP_MEMORY_SCOPE_AGENT) != 0u;
                if (!ready) continue;
                const unsigned n = __hip_atomic_fetch_add(C.qcnt + 64 * b, 1u, __ATOMIC_RELAXED, __HIP_MEMORY_SCOPE_AGENT);
                if (n < 384u) code = ((unsigned)b << 16) | n;
            }
            if (code != 0xffffffffu || !any_left) break;
            __builtin_amdgcn_s_sleep(8);
            if ((spins & 255u) == 255u) { if (__hip_atomic_load(C.tmo, __ATOMIC_RELAXED, __HIP_MEMORY_SCOPE_AGENT)) break; if (spins > (1u << 20)) { __hip_atomic_store(C.tmo, 1u, __ATOMIC_RELAXED, __HIP_MEMORY_SCOPE_AGENT); break; } }
        }
        __builtin_amdgcn_fence(__ATOMIC_ACQUIRE, "agent");
        asm volatile("s_waitcnt vmcnt(0)" ::: "memory");
        C.bc[0] = code;
    }
    __syncthreads();
    const unsigned code = C.bc[0];
    __syncthreads();
    return code;
}
__device__ __forceinline__ BlockRef<bf16, float> dyn_ref(unsigned code, const bf16* Q, const bf16* K, const bf16* V, float* O) {
    const int b = (int)(code >> 16), n = (int)(code & 0xffffu), qb = 15 - (n & 15), r = n >> 4, h = r >> 2, c = (r >> 1) & 1, half = r & 1, vh = b * 24 + r;
    BlockRef<bf16, float> R;
    R.Q = Q + ((size_t)((b * 2 + c) * 6 + h) * SEQ + (size_t)qb * QB) * D; R.K = K + (size_t)((b * 2 + c) * 6 + h) * SEQ * D; R.V = V + (size_t)((b * 6 + h) * 2 + half) * SEQ * D;
    R.O = O + ((size_t)vh * SEQ + (size_t)qb * QB) * D; R.P0 = qb * QB; R.ldo = D;
    return R;
}
__device__ __forceinline__ void diff_attn_dyn_phase(char* lds, const bf16* Q, const bf16* K, const bf16* V, float* O, const DynAttn& C, int bpref) {
    const int W = 1 << 30;
    unsigned code = dyn_pull(C, bpref); if (code == 0xffffffffu) return;
    BlockRef<bf16, float> cur = dyn_ref(code, Q, K, V, O);
    Seam<bf16> S;
    causal_swa_prime<bf16, float>(cur, W, lds, S);
    for (;;) {
        const unsigned nc = dyn_pull(C, bpref); const bool last = nc == 0xffffffffu;
        const BlockRef<bf16, float> nxt = last ? cur : dyn_ref(nc, Q, K, V, O);
        causal_swa_block<bf16, float>(cur, nxt, SEQ, W, lds, S);
        if (last) break;
        cur = nxt;
    }
}
}

constexpr int NPL = 8, PH_BASE = 1, NPH = PH_BASE + DEPTH * NPL;
enum { I_X = 0, I_MEM, I_NORMG, I_WGU, I_WDN, I_WOUT, I_MEMNG, I_MEMWKV, I_MEMQG, I_MEMKG, I_AWIN, I_AVG, I_AWS, I_ABS, I_KVG, I_WKV, I_KG, I_BWIN, I_BQG, I_BLAM, I_BSUBG, N_IN };
struct Args { const float* in[N_IN]; float* out; unsigned char* ws; int ph_lo, ph_hi, li, pad; };

#ifndef EN_MASK
#define EN_MASK 0xFFFFFFFFu
#endif
#define SITE(n) (((EN_MASK) >> (n)) & 1u)
#define IN(k) (lo <= (k) && (k) < hi)
#ifndef PROBE_WAIT
#define PROBE_WAIT 0
#endif
#ifndef PROBE_PHASE
#define PROBE_PHASE 0
#endif
#ifndef LOCAL_SEAMS
#define LOCAL_SEAMS 1
#endif
#define SEAM_X(k, local) do { if (IN((k) + 1)) { unsigned long long t0_ = 0; if (PROBE_WAIT) t0_ = __builtin_amdgcn_s_memrealtime(); \
    if (LOCAL_SEAMS && (local) && F.MISC[24] != 0u) xcd_local_barrier(bar); else xcd_barrier(bar); \
    if (PROBE_WAIT && ((PROBE_WAIT >> CUR_SITE) & 1) && F.tid == 0) F.MISC[16] += (unsigned)(__builtin_amdgcn_s_memrealtime() - t0_); \
    } \
    if (PROBE_PHASE && ((PROBE_PHASE >> CUR_SITE) & 1) && F.tid == 0) F.MISC[17] += (unsigned)(__builtin_amdgcn_s_memrealtime() - tsite_); } while (0)
#define SEAM(k) SEAM_X(k, false)
#define SEAM_L(k) SEAM_X(k, true)
constexpr int CW_RQ = 70016, CW_RKV = 70656, CW_QCNT = 71296;
#define PUBLISH_FLAG(word, val) do { if (blockIdx.x < 8 && F.tid == 0) { __builtin_amdgcn_fence(__ATOMIC_RELEASE, "agent"); asm volatile("s_waitcnt vmcnt(0)" ::: "memory"); \
    __hip_atomic_store((unsigned*)F.ctl + (word) + 64 * (blockIdx.x & 7), (unsigned)(val), __ATOMIC_RELAXED, __HIP_MEMORY_SCOPE_AGENT); } } while (0)
#define SITE_T0 unsigned long long tsite_ = 0; if (PROBE_PHASE) tsite_ = __builtin_amdgcn_s_memrealtime(); (void)tsite_;
#define CAS __attribute__((address_space(4)))
#define WS_PTRS \
    const CAS Args* ap = (const CAS Args*)__builtin_amdgcn_kernarg_segment_ptr(); asm volatile("" : "+s"(ap)); \
    unsigned char* const ws = ap->ws; \
    bf16r* const Wgu = (bf16r*)(ws + WS_WGU); bf16r* const Wdn = (bf16r*)(ws + WS_WDN); bf16r* const Wout = (bf16r*)(ws + WS_WOUT); bf16r* const Wmem = (bf16r*)(ws + WS_WMEM); \
    bf16r* const Wain = (bf16r*)(ws + WS_WAIN); bf16r* const Wkv = (bf16r*)(ws + WS_WKV); bf16r* const Wbin = (bf16r*)(ws + WS_WBIN); \
    unsigned* const CS = (unsigned*)(ws + WS_COS); \
    bf16r* const MEMN = (bf16r*)(ws + WS_MEMN); bf16r* const MK = (bf16r*)(ws + WS_MK); bf16r* const MV = (bf16r*)(ws + WS_MV); \
    bf16r* const XB = (bf16r*)(ws + WS_XB); float* const SS = (float*)(ws + WS_SS); _Float16* const XH = (_Float16*)(ws + WS_XH); bf16r* const HID = (bf16r*)(ws + WS_HID); bf16r* const ZA = (bf16r*)(ws + WS_ZA); \
    float* const VSTAT = (float*)(ws + WS_VSTAT); \
    bf16r* const QB_ = (bf16r*)(ws + WS_QB); bf16r* const KSH = (bf16r*)(ws + WS_KSH); bf16r* const VSH = (bf16r*)(ws + WS_VSH); bf16r* const QMB = (bf16r*)(ws + WS_QMB); \
    float* const OATT = (float*)(ws + WS_OATT); bf16r* const CAT = (bf16r*)(ws + WS_CAT); \
    float* const X = ap->out; \
    (void)Wgu; (void)Wdn; (void)Wout; (void)Wmem; (void)Wain; (void)Wkv; (void)Wbin; (void)CS; (void)MEMN; (void)MK; (void)MV; (void)XB; (void)SS; (void)XH; (void)HID; (void)ZA; \
    (void)VSTAT; (void)QB_; (void)KSH; (void)VSH; (void)QMB; (void)OATT; (void)CAT; (void)X;

constexpr int EX_OFF = RING_BYTES + 2048;
constexpr int RTAB_OFF = RING_BYTES;
__device__ __forceinline__ pg8::RowScale fill_rstd(const Frame& F, const float* ss, const pg8::StaticOrder& So) {
    pg8::Unit u0; const int pm0 = So.next(0, u0) ? u0.pm : -1;
    { pg8::Unit ui; bool same = true; for (int i = 1; So.next(i, ui); ++i) same &= (ui.pm == pm0); if (!same && F.tid == 0) __hip_atomic_store((unsigned*)F.ctl + XB_TMO, 1u, __ATOMIC_RELAXED, __HIP_MEMORY_SCOPE_AGENT); }
    LAS float* tab = (LAS float*)(F.lds + RTAB_OFF);
    __syncthreads();
    if (pm0 >= 0 && F.tid < 256) { const f32x4* p = (const f32x4*)(ss + (size_t)(pm0 * 256 + F.tid) * 32); float s = 0.f;
#pragma unroll
        for (int i = 0; i < 8; ++i) { const f32x4 v = p[i]; s += (v[0] + v[1]) + (v[2] + v[3]); }
        const float v = s * (1.0f / DM) + EPS; tab[2 * F.tid] = 1.0f / sqrtf(v); tab[2 * F.tid + 1] = v; }
    __syncthreads();
    return pg8::RowScale{(const LAS float*)tab};
}
#ifndef RESID_BF16_TAIL
#define RESID_BF16_TAIL 1
#endif
#ifndef ATTN2
#define ATTN2 1
#endif
#ifndef DYN_ATTN
#define DYN_ATTN 0
#endif
template <int L, int S>
__device__ __forceinline__ void ffn_part(const Frame& F, const XcdBarrier& bar, unsigned char* smem, const int lo, const int hi) {
    constexpr int pf = PH_BASE + L * NPL + (S ? 6 : 0);
    if (SITE(3) && IN(pf)) { constexpr int CUR_SITE = 3; (void)CUR_SITE; SITE_T0 WS_PTRS
        pg8::Gemm g{XB, Wgu + (size_t)(L * 2 + S) * NGU * DM, M, NGU, DM}; pg8::StaticOrder So; So.init(M, NGU, F.G, (int)blockIdx.x);
        pg8::EpiSwiglu E{HID, FF, fill_rstd(F, SS, So)};
        pg8::gemm_phase<pg8::EpiSwiglu, pg8::StaticOrder, true, true, true, true>(F.lds + RING_OFF, g, So, E);
        if constexpr (L == NA && S == 0) {
            pg8::Gemm g2{XB, Wkv, M, NKV, DM}; pg8::StaticOrder S2; S2.init(M, NKV, F.G, (int)blockIdx.x);
            pg8::EpiQKRope E2{1, KSH, VSH, ap->in[I_KG], nullptr, CS, (LAS float*)(F.lds + EX_OFF), fill_rstd(F, SS, S2)};
            pg8::gemm_phase<pg8::EpiQKRope, pg8::StaticOrder, true, true, true, true>(F.lds + RING_OFF, g2, S2, E2);
        }
        SEAM_L(pf);
        if constexpr (L == NA && S == 0) { if (DYN_ATTN && IN(pf + 1)) PUBLISH_FLAG(CW_RKV, 1u); }
    }
    if (SITE(4) && IN(pf + 1)) { constexpr int CUR_SITE = 4; (void)CUR_SITE; SITE_T0 WS_PTRS
        pg8::Gemm g{HID, Wdn + (size_t)(L * 2 + S) * DM * FF, M, DM, FF}; pg8::ColSweepOrder So{(int)blockIdx.x};
        pg8::EpiResid E{(L == 0 && S == 0) ? ap->in[I_X] : nullptr, (L == DEPTH - 1 && S == 1) ? X : nullptr, DM, 0.5f, XB, SS, XH, RESID_BF16_TAIL ? (L < NA ? 0 : (L == NA && S == 0) ? 2 : 1) : 0};
        pg8::gemm_phase<pg8::EpiResid, pg8::ColSweepOrder, true, true, true, true>(F.lds + RING_OFF, g, So, E);
        SEAM_L(pf + 1);
    }
}
template <int L>
__device__ __forceinline__ void mixer_part(const Frame& F, const XcdBarrier& bar, unsigned char* smem, const int lo, const int hi) {
    constexpr int pb = PH_BASE + L * NPL;
    if (SITE(6) && IN(pb + 2)) { constexpr int CUR_SITE = 6; (void)CUR_SITE; SITE_T0 WS_PTRS
        if constexpr (L < NA) { pg8::Gemm g{XB, Wain + (size_t)L * NAIN * DM, M, NAIN, DM}; pg8::StaticOrder So; So.init(M, NAIN, F.G, (int)blockIdx.x);
            pg8::EpiAin E{ZA, VSTAT, QMB, ap->in[I_MEMQG] + L * HD, (LAS float*)(F.lds + EX_OFF), fill_rstd(F, SS, So)};
            pg8::gemm_phase<pg8::EpiAin, pg8::StaticOrder, true, true, true, true>(F.lds + RING_OFF, g, So, E);
            if constexpr (L == 0) {
                if ((int)blockIdx.x >= 128) { pg8::Gemm gm{MEMN, Wmem, 4096, 4096, DM}; pg8::MemKvOrder Sm{F.G, (int)blockIdx.x - 128};
                    pg8::EpiMemKv Em{MK, MV, ap->in[I_MEMKG], (LAS float*)(F.lds + EX_OFF)};
                    pg8::gemm_phase<pg8::EpiMemKv, pg8::MemKvOrder, true, true, false, true>(F.lds + RING_OFF, gm, Sm, Em); } } }
        else { pg8::Gemm g{XB, Wbin + (size_t)(L - NA) * NBIN * DM, M, NBIN, DM}; pg8::StaticOrder So; So.init(M, NBIN, F.G, (int)blockIdx.x);
            pg8::EpiQKRope E{0, QB_, QMB, ap->in[I_BQG] + (L - NA) * HD, ap->in[I_MEMQG] + L * HD, CS, (LAS float*)(F.lds + EX_OFF), fill_rstd(F, SS, So)};
            pg8::gemm_phase<pg8::EpiQKRope, pg8::StaticOrder, true, true, true, true>(F.lds + RING_OFF, g, So, E); }
        if constexpr (L == 1 || (L >= NA && DYN_ATTN)) SEAM_L(pb + 2); else SEAM(pb + 2);
        if constexpr (L >= NA) { if (DYN_ATTN && IN(pb + 3)) PUBLISH_FLAG(CW_RQ, (unsigned)L); }
    }
    if (SITE(8) && IN(pb + 3)) { constexpr int CUR_SITE = 8; (void)CUR_SITE; SITE_T0 WS_PTRS
        if constexpr (L < NA) gmlp_phase(F, ZA, VSTAT, ap->in[I_AWS] + (size_t)L * GG * 128 * 128, ap->in[I_ABS] + (size_t)L * GG * 128, ap->in[I_AVG] + (size_t)L * MIXW, CAT);
        { const int xg = (int)blockIdx.x & 7, jg = (int)blockIdx.x >> 3, pnl = 8 * xg + (jg >> 2);
          const int c0 = ((L < NA || DYN_ATTN) && F.G == 256) ? (((pnl >> 4) * 4 + (jg & 3)) * 16 + (pnl & 15)) : F.vcu;
          att::mem_attn_phase((char*)smem, (const att::bf16*)QMB, (const att::bf16*)(MK + (size_t)L * 1024 * 512), (const att::bf16*)(MV + (size_t)L * 1024 * 512), (att::bf16*)CAT, F.G, c0); }
        if constexpr (L >= NA) {
            float* const Ol = OATT + (size_t)(L - NA) * 96 * SEQ * 128;
            if (DYN_ATTN) { const att::DynAttn C{(unsigned*)F.ctl + CW_QCNT + 64 * 4 * (L - NA), (const unsigned*)F.ctl + CW_RQ, (const unsigned*)F.ctl + CW_RKV, (unsigned)L, (unsigned*)F.ctl + XB_TMO, F.MISC + 28};
                att::diff_attn_dyn_phase((char*)smem, (const att::bf16*)QB_, (const att::bf16*)KSH, (const att::bf16*)VSH, Ol, C, ((int)blockIdx.x & 7) >> 1); }
            else if (ATTN2) att::diff_attn2_phase((char*)smem, (float*)(smem + 133120), (const att::bf16*)QB_, (const att::bf16*)KSH, (const att::bf16*)VSH, Ol, F.G, F.vcu);
            else att::diff_attn_phase((char*)smem, (const att::bf16*)QB_, (const att::bf16*)KSH, (const att::bf16*)VSH, Ol, F.G, F.vcu);
        }
        if constexpr (L < NA) SEAM_L(pb + 3); else SEAM(pb + 3);
    }
    if constexpr (L >= NA) {
        if (SITE(9) && IN(pb + 4)) { constexpr int CUR_SITE = 9; (void)CUR_SITE; SITE_T0 WS_PTRS constexpr float lam_init = (L == 2) ? 0.47071301834358416f : 0.5560582041556405f;
            combine_phase(F, OATT + (size_t)(L - NA) * 96 * SEQ * 128, ap->in[I_BLAM] + (size_t)(L - NA) * 512, ap->in[I_BSUBG] + (size_t)(L - NA) * DV, lam_init, CAT);
            SEAM_L(pb + 4); }
    }
    if (SITE(10) && IN(pb + 5)) { constexpr int CUR_SITE = 10; (void)CUR_SITE; SITE_T0 WS_PTRS
        pg8::Gemm g{CAT, Wout + (size_t)L * DM * DM, M, DM, DM}; pg8::ColSweepOrder So{(int)blockIdx.x};
        pg8::EpiResid E{nullptr, nullptr, DM, 1.0f, XB, SS, XH, (RESID_BF16_TAIL && L >= NA) ? 1 : 0};
        pg8::gemm_phase<pg8::EpiResid, pg8::ColSweepOrder, true, true, false, true>(F.lds + RING_OFF, g, So, E);
        SEAM_L(pb + 5);
    }
}

__global__ void __launch_bounds__(NWAVES * 64, 2) yoco_fwd(Args args) {
    extern __shared__ __attribute__((aligned(16))) unsigned char smem[];
    Frame F;
    F.lds_g = smem; F.lds = (LAS unsigned char*)smem;
    F.MISC = (volatile LAS unsigned*)(F.lds + MISC_OFF);
    F.tid = threadIdx.x; F.lane = F.tid & 63; F.wave = __builtin_amdgcn_readfirstlane(F.tid >> 6);
    F.G = gridDim.x; { const int bx = blockIdx.x; F.vcu = (F.G % 8 == 0) ? (bx % 8) * (F.G / 8) + bx / 8 : bx; }
    F.ws = args.ws;
    F.ctl = (gu32*)(args.ws + WS_CTL);
    for (int u = F.tid; u < (LDS_BYTES - LDSCTL_OFF) / 4; u += NWAVES * 64) ((LAS unsigned*)(F.lds + LDSCTL_OFF))[u] = 0u;
    __syncthreads();
    XcdBarrier bar = xcd_barrier_post((unsigned*)F.ctl + (size_t)args.li * XCD_BAR_WORDS, F.MISC + 8);
    if (F.tid == 0) __hip_atomic_store((unsigned*)F.ctl + XB_XCCTAB + blockIdx.x, bar.x + 1u, __ATOMIC_RELAXED, __HIP_MEMORY_SCOPE_AGENT);
    const int lo = args.ph_lo, hi = args.ph_hi;
    {
    const int gw = F.vcu * NWAVES + F.wave, NGW = F.G * NWAVES;
    if (SITE(0) && IN(0)) { constexpr int CUR_SITE = 0; (void)CUR_SITE; SITE_T0 WS_PTRS
        LAS float* scr = (LAS float*)(F.lds + RING_OFF + F.wave * 16640);
        constexpr int NIT = 8 * (DM / 64) * (NGU / 64) + 8 * (FF / 64) * (DM / 64) + 4 * 32 * 32 + 4 * 32 * 16 + 2 * 32 * (NAIN / 64) + 32 * (NKV / 64) + 2 * 32 * 32;
        for (int it = gw; it < NIT; it += NGW) { int r = it;
            if (transpose_group(r, ap->in[I_WGU], 8, DM, NGU, Wgu, true, scr, F.lane, ap->in[I_NORMG], 1)) continue;
            if (transpose_group(r, ap->in[I_WDN], 8, FF, DM, Wdn, false, scr, F.lane, nullptr, 0)) continue;
            if (transpose_group(r, ap->in[I_WOUT], 4, DM, DM, Wout, false, scr, F.lane, nullptr, 0)) continue;
            if (transpose_group(r, ap->in[I_MEMWKV], 4, DM, 1024, Wmem, false, scr, F.lane, nullptr, 0)) continue;
            if (transpose_group(r, ap->in[I_AWIN], 2, DM, NAIN, Wain, false, scr, F.lane, ap->in[I_NORMG], 2)) continue;
            if (transpose_group(r, ap->in[I_WKV], 1, DM, NKV, Wkv, false, scr, F.lane, ap->in[I_KVG], 0)) continue;
            transpose_group(r, ap->in[I_BWIN], 2, DM, NBIN, Wbin, false, scr, F.lane, ap->in[I_NORMG], 4); }
        for (int i = gw * 64 + F.lane; i < SEQ * 64; i += NGW * 64) { const int pos = i >> 6, k = i & 63; const float inv = (float)pow(10000.0, -(double)k / 64.0); const float ang = (float)pos * inv;
            float sn, cs; sincos_d(ang, sn, cs); typedef _Float16 h2 __attribute__((ext_vector_type(2))); h2 t; t.x = (_Float16)cs; t.y = (_Float16)sn; CS[i] = __builtin_bit_cast(unsigned, t); }
        for (int r = gw; r < 4096; r += NGW) { const int l = r >> 10, mm = r & 1023; norm_row(ap->in[I_MEM] + (size_t)mm * DM, ap->in[I_MEMNG] + l * DM, MEMN + (size_t)r * DM, F.lane); }
        xb_ss_phase(F, ap->in[I_X], XB, SS);
        SEAM(0);
        if (LOCAL_SEAMS && IN(1)) { if (F.tid < 64) { bool ok = F.G == 256; unsigned mine[4];
#pragma unroll
                for (int q = 0; q < 4; ++q) { const unsigned i = F.tid + 64 * q; mine[q] = __hip_atomic_load((unsigned*)F.ctl + XB_XCCTAB + i, __ATOMIC_RELAXED, __HIP_MEMORY_SCOPE_AGENT);
                    const unsigned rep = __hip_atomic_load((unsigned*)F.ctl + XB_XCCTAB + (i & 7u), __ATOMIC_RELAXED, __HIP_MEMORY_SCOPE_AGENT); ok = ok && mine[q] != 0u && mine[q] == rep; }
                if (F.tid < 8) { for (unsigned o = 0; o < 8; ++o) { const unsigned other = __hip_atomic_load((unsigned*)F.ctl + XB_XCCTAB + o, __ATOMIC_RELAXED, __HIP_MEMORY_SCOPE_AGENT); ok = ok && (o == (unsigned)F.tid || other != mine[0]); } }
                ok = __all(ok); if (F.tid == 0) F.MISC[24] = ok ? 1u : 0u; }
            __syncthreads(); }
    }
    }
    ffn_part<0, 0>(F, bar, smem, lo, hi); mixer_part<0>(F, bar, smem, lo, hi); ffn_part<0, 1>(F, bar, smem, lo, hi);
    ffn_part<1, 0>(F, bar, smem, lo, hi); mixer_part<1>(F, bar, smem, lo, hi); ffn_part<1, 1>(F, bar, smem, lo, hi);
    ffn_part<2, 0>(F, bar, smem, lo, hi); mixer_part<2>(F, bar, smem, lo, hi); ffn_part<2, 1>(F, bar, smem, lo, hi);
    ffn_part<3, 0>(F, bar, smem, lo, hi); mixer_part<3>(F, bar, smem, lo, hi); ffn_part<3, 1>(F, bar, smem, lo, hi);
    if (PROBE_PHASE) { if (blockIdx.x == 0 && F.tid == 0) { const unsigned long long tot = F.MISC[17], t0 = __builtin_amdgcn_s_memrealtime(); while (__builtin_amdgcn_s_memrealtime() - t0 < tot) __builtin_amdgcn_s_sleep(8); } }
#ifdef PROBE_LOCALOK
    if (blockIdx.x == 0 && F.tid == 0 && F.MISC[24] != 0u) { const unsigned long long t0 = __builtin_amdgcn_s_memrealtime(); while (__builtin_amdgcn_s_memrealtime() - t0 < 50000ull) __builtin_amdgcn_s_sleep(8); }
#endif
    if (PROBE_WAIT) {
        unsigned* sumw = (unsigned*)F.ctl + 65536;
        if (F.tid == 0) __hip_atomic_fetch_add(sumw, F.MISC[16], __ATOMIC_RELAXED, __HIP_MEMORY_SCOPE_AGENT);
        xcd_barrier(bar);
        if (blockIdx.x == 0 && F.tid == 0) { const unsigned tot = __hip_atomic_load(sumw, __ATOMIC_RELAXED, __HIP_MEMORY_SCOPE_AGENT); const unsigned long long avg = tot / gridDim.x, t0 = __builtin_amdgcn_s_memrealtime();
            while (__builtin_amdgcn_s_memrealtime() - t0 < avg) __builtin_amdgcn_s_sleep(8); }
    }
}
#undef IN
#undef SEAM

#ifndef MK_MODE
#define MK_MODE 1
#endif
extern "C" void kernel_launch(void* const* d_in, const int* in_sizes, int n_in, void* d_out, int out_size, void* d_ws, size_t ws_size, hipStream_t stream) {
    static int grid = 0;
    if (grid == 0) {
        if (n_in != N_IN || out_size != M * DM || ws_size < WS_END) { fprintf(stderr, "kernel_launch: unexpected shapes: n_in %d out %d ws %zu (need %zu)\n", n_in, out_size, ws_size, (size_t)WS_END); grid = -1; return; }
        int dev = 0, cus = 0, per_cu = 0;
        if (hipGetDevice(&dev) != hipSuccess || hipDeviceGetAttribute(&cus, hipDeviceAttributeMultiprocessorCount, dev) != hipSuccess) { grid = -1; return; }
        if (hipFuncSetAttribute((const void*)yoco_fwd, hipFuncAttributeMaxDynamicSharedMemorySize, LDS_BYTES) != hipSuccess) { fprintf(stderr, "kernel_launch: hipFuncSetAttribute failed\n"); grid = -1; return; }
        if (hipOccupancyMaxActiveBlocksPerMultiprocessor(&per_cu, (const void*)yoco_fwd, NWAVES * 64, LDS_BYTES) != hipSuccess || per_cu < 1) fprintf(stderr, "kernel_launch: occupancy query says %d blocks per CU\n", per_cu);
        (void)hipGetLastError();
        grid = cus;
        if (cus != 256) { fprintf(stderr, "kernel_launch: built for a 256-CU device (got %d)\n", cus); grid = -1; return; }
    }
    if (grid < 0) return;
    (void)in_sizes;
    if (hipMemsetAsync((char*)d_ws + WS_CTL, 0, CTL_ZERO_BYTES, stream) != hipSuccess) return;
    Args a{};
    for (int i = 0; i < N_IN; ++i) a.in[i] = (const float*)d_in[i];
    a.out = (float*)d_out; a.ws = (unsigned char*)d_ws; a.pad = 0;
#if MK_MODE == 1
    a.ph_lo = 0; a.ph_hi = NPH; a.li = 0;
    hipLaunchKernelGGL(yoco_fwd, dim3(grid), dim3(NWAVES * 64), LDS_BYTES, stream, a);
#else
    for (int p = 0; p < NPH; ++p) {
        const int k = (p - PH_BASE) % NPL, l = (p - PH_BASE) / NPL;
        if (p >= PH_BASE && (k == 4 && l < NA)) continue;
        a.ph_lo = p; a.ph_hi = p + 1; a.li = 0;
        hipLaunchKernelGGL(yoco_fwd, dim3(grid), dim3(NWAVES * 64), LDS_BYTES, stream, a);
    }
#endif
}
```

```cpp
#include <hip/hip_runtime.h>
#include <hip/hip_bf16.h>
#include <cstdio>
#include <cstdint>

constexpr int BATCH = 4, SEQ = 4096, DM = 2048, DEPTH = 4, NA = 2;
constexpr int M = BATCH * SEQ;
constexpr int MEML = 256, HD = 128, MEMH = 4, MEMW = 512, MIXW = 1536, CHUNK = 128, GG = 6, GW = 256, DH = 6, DV = 256, FF = 5632;
constexpr int NGU = 2 * FF;
constexpr int NAIN = 2 * MIXW + MEMW;
constexpr int NBIN = MIXW + MEMW;
constexpr int NKV = 2 * DH * HD + DH * DV;
constexpr float EPS = 1e-6f;
namespace pg8 {
#define PG8_LAS __attribute__((address_space(3)))
typedef unsigned short bf16_t;
typedef short bf16x8 __attribute__((ext_vector_type(8)));
typedef float f32x4 __attribute__((ext_vector_type(4)));
typedef unsigned u32x4 __attribute__((ext_vector_type(4)));
constexpr int BM = 256, BK = 64, HALF = 128, HTB = HALF * BK * 2  , STAGE_BYTES = 8 * HTB, NXCD = 8, WGM = 8;

__host__ __device__ __forceinline__ int lds_byte(int r, int c) { const int st = (r >> 4) * 2 + (c >> 5), rr = r & 15, cc = c & 31, ob = rr * 64 + cc * 2; return st * 1024 + (ob ^ (((ob >> 9) & 1) << 5)); }
__host__ __device__ __forceinline__ void stage_rc(int b, int& R, int& C) { const int st = b / 1024, sb = b % 1024, swz = sb ^ (((sb >> 9) & 1) << 5); R = (st >> 1) * 16 + swz / 64; C = (st & 1) * 32 + (swz % 64) / 2; }
__host__ __device__ __forceinline__ int perm32(int rho) { const int n = rho >> 4, i = rho & 15; return 8 * (i >> 2) + 4 * n + (i & 3); }

struct Unit { int pm, pn; };
struct Gemm { const bf16_t* A; const bf16_t* Bt; int M, N, K; };

struct StaticOrder {
    int nM, nN, nwg, G, c;
    __host__ __device__ void init(int M, int N, int G_, int c_) { nM = M / BM; nN = N / BM; nwg = nM * nN; G = G_; c = c_; }
    __host__ __device__ bool next(int i, Unit& u) const {
        const long L = (long)i * G + c; if (L >= nwg) return false;
        int wgid = (int)L; { const int q = nwg / NXCD, r = nwg % NXCD, xcd = wgid % NXCD, off = wgid / NXCD; wgid = (xcd < r ? xcd * (q + 1) : r * (q + 1) + (xcd - r) * q) + off; }
        const int nig = WGM * nN, gid = wgid / nig, fm = gid * WGM, gsz = (nM - fm) < WGM ? (nM - fm) : WGM;
        u.pm = fm + ((wgid % nig) % gsz); u.pn = (wgid % nig) / gsz; return true;
    }
    __device__ __forceinline__ void a_ready(const Unit&) const {}
    __device__ __forceinline__ void done(const Unit&) const {}
};
__device__ __forceinline__ unsigned cvt_pk_bf16(float lo, float hi) { unsigned r; asm volatile("v_cvt_pk_bf16_f32 %0, %1, %2" : "=v"(r) : "v"(lo), "v"(hi)); return r; }
typedef float f32x2 __attribute__((ext_vector_type(2)));
typedef unsigned u32x2 __attribute__((ext_vector_type(2)));
__device__ __forceinline__ f32x2 gelu_pk(f32x2 v) {
    const f32x2 av = __builtin_elementwise_abs(v), d = av * 0.2316418882f + 1.0f;
    f32x2 t; t.x = __builtin_amdgcn_rcpf(d.x); t.y = __builtin_amdgcn_rcpf(d.y);
    f32x2 q = t * 0.5307027145f + (-0.7265760135f); q = q * t + 0.7107068705f; q = q * t + (-0.142248368f); q = q * t + 0.127414796f; q = q * t;
    const f32x2 s = (v * v) * (-0.72134752044f);
    f32x2 e; e.x = __builtin_amdgcn_exp2f(s.x); e.y = __builtin_amdgcn_exp2f(s.y);
    const f32x2 m = v * (q * e), r = v - m;
    f32x2 o; o.x = v.x < 0.f ? m.x : r.x; o.y = v.y < 0.f ? m.y : r.y; return o;
}
__device__ __forceinline__ float silu_f(float g) { return g * __builtin_amdgcn_rcpf(1.0f + __builtin_amdgcn_exp2f(-1.4426950408889634f * g)); }
__device__ __forceinline__ u32x4 pack8_bf16(f32x4 a, f32x4 b) { u32x4 w; w.x = cvt_pk_bf16(a[0], a[1]); w.y = cvt_pk_bf16(a[2], a[3]); w.z = cvt_pk_bf16(b[0], b[1]); w.w = cvt_pk_bf16(b[2], b[3]); return w; }

__host__ __device__ __forceinline__ size_t blk_off(int row, int col, int kt) { return ((size_t)((row >> 8) * kt + (col >> 6)) << 14) + ((row & 255) << 6) + (col & 63); }
struct RowScale { const PG8_LAS float* rtab; };
__device__ __forceinline__ void get_rstd(float (&rs)[2][4], const RowScale& R, int wr, int fr) {
#pragma unroll
    for (int ai = 0; ai < 2; ++ai)
#pragma unroll
        for (int m = 0; m < 4; ++m) rs[ai][m] = R.rtab ? R.rtab[2 * (ai * HALF + wr * 64 + m * 16 + fr)] : 1.0f;
}
struct EpiSwiglu {
    static constexpr bool PERM = true, AFTER_DRAIN = false;
    static __host__ __device__ __forceinline__ int bmap(int R) { return (R & ~31) + perm32(R & 31); }
    bf16_t* H; int ldh; RowScale R;
    __device__ __forceinline__ void operator()(const f32x4 (&acc)[2][2][4][2], const Unit& u, int wr, int wc, int fr, int fq) const {
        const int row0 = u.pm * BM + wr * 64 + fr, col0 = u.pn * HALF + wc * 32 + 8 * fq;
#pragma unroll
        for (int ai = 0; ai < 2; ++ai)
#pragma unroll
            for (int m = 0; m < 4; ++m) { const f32x2 rv = *(const PG8_LAS f32x2*)(R.rtab + 2 * (ai * HALF + wr * 64 + m * 16 + fr)); const float c1 = -1.4426950408889634f * rv.x, v = rv.y;
                const f32x4 g0 = acc[ai][0][m][0], g1 = acc[ai][0][m][1], u0 = acc[ai][1][m][0], u1 = acc[ai][1][m][1];
                f32x4 h0, h1;
#pragma unroll
                for (int j = 0; j < 4; ++j) { const float e0 = __builtin_amdgcn_exp2f(g0[j] * c1), e1 = __builtin_amdgcn_exp2f(g1[j] * c1);
                    h0[j] = (g0[j] * u0[j]) * __builtin_amdgcn_rcpf(__builtin_fmaf(e0, v, v)); h1[j] = (g1[j] * u1[j]) * __builtin_amdgcn_rcpf(__builtin_fmaf(e1, v, v)); }
                *(u32x4*)(H + blk_off(row0 + ai * HALF + m * 16, col0, ldh >> 6)) = pack8_bf16(h0, h1);
            }
    }
};
struct EpiResid {
    static constexpr bool PERM = true, AFTER_DRAIN = false;
    static __host__ __device__ __forceinline__ int bmap(int R) { return (R & ~31) + perm32(R & 31); }
    const float* base_f32; float* out_f32; int ld; float scale; bf16_t* xb; float* ss; _Float16* xh;
    int mode;
    typedef _Float16 h8 __attribute__((ext_vector_type(8)));
    static __device__ __forceinline__ void one(const f32x4 b0, const f32x4 b1, const f32x4 a0, const f32x4 a1, int row, int col, size_t off, float& s, float scale, float* out_f32, _Float16* xh, bf16_t* xb, int ld) {
        const f32x4 o0 = b0 + a0 * scale, o1 = b1 + a1 * scale;
        if (out_f32) { *(f32x4*)(out_f32 + off) = o0; *(f32x4*)(out_f32 + off + 4) = o1; }
        else { h8 w; w[0] = (_Float16)o0[0]; w[1] = (_Float16)o0[1]; w[2] = (_Float16)o0[2]; w[3] = (_Float16)o0[3]; w[4] = (_Float16)o1[0]; w[5] = (_Float16)o1[1]; w[6] = (_Float16)o1[2]; w[7] = (_Float16)o1[3];
            if (xh) *(h8*)(xh + off) = w;
            *(u32x4*)(xb + blk_off(row, col, ld >> 6)) = pack8_bf16(o0, o1);
            s += ((o0[0] * o0[0] + o0[1] * o0[1]) + (o0[2] * o0[2] + o0[3] * o0[3])) + ((o1[0] * o1[0] + o1[1] * o1[1]) + (o1[2] * o1[2] + o1[3] * o1[3])); }
    }
    __device__ __forceinline__ void operator()(const f32x4 (&acc)[2][2][4][2], const Unit& u, int wr, int wc, int fr, int fq) const {
        const int row0 = u.pm * BM + wr * 64 + fr, col0 = u.pn * BM + wc * 32 + 8 * fq;
        const float scale_ = scale; float* const out_ = out_f32; _Float16* const xh_ = mode == 0 ? xh : nullptr; bf16_t* const xb_ = xb; const int ld_ = ld; const bool rdb = mode == 1;
        if (base_f32) {
#pragma unroll
            for (int ai = 0; ai < 2; ++ai)
#pragma unroll
                for (int m = 0; m < 4; ++m) { const int row = row0 + ai * HALF + m * 16; const size_t off = (size_t)row * ld + col0; float s = 0.f;
#pragma unroll
                    for (int bj = 0; bj < 2; ++bj) one(*(const f32x4*)(base_f32 + off + bj * HALF), *(const f32x4*)(base_f32 + off + bj * HALF + 4), acc[ai][bj][m][0], acc[ai][bj][m][1], row, col0 + bj * HALF, off + bj * HALF, s, scale_, out_, xh_, xb_, ld_);
                    if (!out_f32) { s += __shfl_xor(s, 16); s += __shfl_xor(s, 32); if (fq == 0) ss[(size_t)row * 32 + u.pn * 4 + wc] = s; }
                    asm volatile("" ::: "memory"); }
            return;
        }
#pragma unroll
        for (int ai = 0; ai < 2; ++ai) {
            h8 w[4][2];
#pragma unroll
            for (int m = 0; m < 4; ++m)
#pragma unroll
                for (int bj = 0; bj < 2; ++bj) w[m][bj] = rdb ? *(const h8*)(xb + blk_off(row0 + ai * HALF + m * 16, col0 + bj * HALF, ld >> 6)) : *(const h8*)(xh + (size_t)(row0 + ai * HALF + m * 16) * ld + col0 + bj * HALF);
#pragma unroll
            for (int m = 0; m < 4; ++m) { const int row = row0 + ai * HALF + m * 16; const size_t off = (size_t)row * ld + col0; float s = 0.f;
#pragma unroll
                for (int bj = 0; bj < 2; ++bj) { const h8 v = w[m][bj]; f32x4 r0, r1;
                    if (rdb) { const u32x4 q = __builtin_bit_cast(u32x4, v);
                        r0 = (f32x4){__builtin_bit_cast(float, q[0] << 16), __builtin_bit_cast(float, q[0] & 0xffff0000u), __builtin_bit_cast(float, q[1] << 16), __builtin_bit_cast(float, q[1] & 0xffff0000u)};
                        r1 = (f32x4){__builtin_bit_cast(float, q[2] << 16), __builtin_bit_cast(float, q[2] & 0xffff0000u), __builtin_bit_cast(float, q[3] << 16), __builtin_bit_cast(float, q[3] & 0xffff0000u)}; }
                    else { r0 = (f32x4){(float)v[0], (float)v[1], (float)v[2], (float)v[3]}; r1 = (f32x4){(float)v[4], (float)v[5], (float)v[6], (float)v[7]}; }
                    one(r0, r1, acc[ai][bj][m][0], acc[ai][bj][m][1], row, col0 + bj * HALF, off + bj * HALF, s, scale_, out_, xh_, xb_, ld_); }
                if (!out_f32) { s += __shfl_xor(s, 16); s += __shfl_xor(s, 32); if (fq == 0) ss[(size_t)row * 32 + u.pn * 4 + wc] = s; } }
            asm volatile("" ::: "memory");
        }
    }
};
__device__ __forceinline__ void head_ss_put(PG8_LAS float* ex, int rl, int bj, int wc, int fq, float s) { s += __shfl_xor(s, 16); s += __shfl_xor(s, 32); if (fq == 0) ex[(rl * 2 + bj) * 4 + wc] = s; }
__device__ __forceinline__ float head_rstd_get(const PG8_LAS float* ex, int rl, int bj) { const f32x4 p = *(const PG8_LAS f32x4*)(ex + (rl * 2 + bj) * 4); return 1.0f / sqrtf(((p[0] + p[1]) + (p[2] + p[3])) * (1.0f / 128.0f) + 1e-6f); }
#define PG8_EPI_BARRIER() do { asm volatile("s_waitcnt lgkmcnt(0)" ::: "memory"); __builtin_amdgcn_s_barrier(); asm volatile("" ::: "memory"); } while (0)
struct EpiAin {
    static constexpr bool PERM = true, AFTER_DRAIN = false;
    static __host__ __device__ __forceinline__ int bmap(int R) { return (R & ~31) + perm32(R & 31); }
    bf16_t* ZA; float* vstat; bf16_t* qmb; const float* gq; PG8_LAS float* ex; RowScale R;
    __device__ __forceinline__ void operator()(const f32x4 (&acc)[2][2][4][2], const Unit& u, int wr, int wc, int fr, int fq) const {
        const int row0 = u.pm * BM + wr * 64 + fr;
        float rs[2][4]; get_rstd(rs, R, wr, fr);
        if (u.pn < 12) {
            const int col0 = u.pn * BM + wc * 32 + 8 * fq; const bool st = u.pn >= 6;
#pragma unroll
            for (int ai = 0; ai < 2; ++ai)
#pragma unroll
                for (int m = 0; m < 4; ++m) { const int row = row0 + ai * HALF + m * 16; float sq = 0.f;
#pragma unroll
                    for (int bj = 0; bj < 2; ++bj) { f32x4 v0 = acc[ai][bj][m][0] * rs[ai][m], v1 = acc[ai][bj][m][1] * rs[ai][m];
                        f32x2 a = gelu_pk((f32x2){v0[0], v0[1]}), b = gelu_pk((f32x2){v0[2], v0[3]}), c = gelu_pk((f32x2){v1[0], v1[1]}), d = gelu_pk((f32x2){v1[2], v1[3]});
                        v0 = (f32x4){a.x, a.y, b.x, b.y}; v1 = (f32x4){c.x, c.y, d.x, d.y};
                        sq += (v0[0] * v0[0] + v0[1] * v0[1]) + (v0[2] * v0[2] + v0[3] * v0[3]) + (v1[0] * v1[0] + v1[1] * v1[1]) + (v1[2] * v1[2] + v1[3] * v1[3]);
                        *(u32x4*)(ZA + (size_t)row * 3072 + col0 + bj * HALF) = pack8_bf16(v0, v1); }
                    if (st) { sq += __shfl_xor(sq, 16); sq += __shfl_xor(sq, 32); if (fq == 0) vstat[(size_t)row * 24 + (u.pn - 6) * 4 + wc] = sq; } }
        } else {
            const int d0 = wc * 32 + 8 * fq; const f32x4 g0 = *(const f32x4*)(gq + d0), g1 = *(const f32x4*)(gq + d0 + 4);
#pragma unroll
            for (int ai = 0; ai < 2; ++ai)
#pragma unroll
                for (int m = 0; m < 4; ++m) { const int rl = ai * HALF + wr * 64 + m * 16 + fr;
#pragma unroll
                    for (int bj = 0; bj < 2; ++bj) { const f32x4 v0 = acc[ai][bj][m][0], v1 = acc[ai][bj][m][1];
                        head_ss_put(ex, rl, bj, wc, fq, (((v0[0] * v0[0] + v0[1] * v0[1]) + (v0[2] * v0[2] + v0[3] * v0[3])) + ((v1[0] * v1[0] + v1[1] * v1[1]) + (v1[2] * v1[2] + v1[3] * v1[3]))) * (rs[ai][m] * rs[ai][m])); } }
            PG8_EPI_BARRIER();
#pragma unroll
            for (int ai = 0; ai < 2; ++ai)
#pragma unroll
                for (int m = 0; m < 4; ++m) { const int rl = ai * HALF + wr * 64 + m * 16 + fr, row = u.pm * BM + rl, b = row >> 12, s = row & 4095;
#pragma unroll
                    for (int bj = 0; bj < 2; ++bj) { const float sc = rs[ai][m] * head_rstd_get(ex, rl, bj); const int hm = (u.pn - 12) * 2 + bj;
                        *(u32x4*)(qmb + ((size_t)(b * 4 + hm) * 4096 + s) * 128 + d0) = pack8_bf16(acc[ai][bj][m][0] * sc * g0, acc[ai][bj][m][1] * sc * g1); } }
        }
    }
};
struct EpiF32Split {
    static constexpr bool PERM = true, AFTER_DRAIN = false;
    static __host__ __device__ __forceinline__ int bmap(int R) { return (R & ~31) + perm32(R & 31); }
    float* d0; int ld0; int split; float* d1; int ld1; int pnmod; RowScale R;
    __device__ __forceinline__ void operator()(const f32x4 (&acc)[2][2][4][2], const Unit& u, int wr, int wc, int fr, int fq) const {
        const int row0 = u.pm * BM + wr * 64 + fr; int pn = pnmod ? (u.pn % pnmod) : u.pn; float* d = d0; int ld = ld0;
        if (pn >= split) { d = d1; ld = ld1; pn -= split; }
        const int col0 = pn * BM + wc * 32 + 8 * fq;
        float rs[2][4]; get_rstd(rs, R, wr, fr);
#pragma unroll
        for (int ai = 0; ai < 2; ++ai)
#pragma unroll
            for (int m = 0; m < 4; ++m) { float* p = d + (size_t)(row0 + ai * HALF + m * 16) * ld + col0;
#pragma unroll
                for (int bj = 0; bj < 2; ++bj) { *(f32x4*)(p + bj * HALF) = acc[ai][bj][m][0] * rs[ai][m]; *(f32x4*)(p + bj * HALF + 4) = acc[ai][bj][m][1] * rs[ai][m]; } }
    }
};
struct EpiQKRope {
    static constexpr bool PERM = true, AFTER_DRAIN = false;
    static __host__ __device__ __forceinline__ int bmap(int R) { return 64 * ((R >> 4) & 1) + 16 * (R >> 5) + (R & 15); }
    int kind; bf16_t* qk; bf16_t* other; const float* gr; const float* gn; const unsigned* cs; PG8_LAS float* ex; RowScale R;
    __device__ __forceinline__ void operator()(const f32x4 (&acc)[2][2][4][2], const Unit& u, int wr, int wc, int fr, int fq) const {
        typedef _Float16 h2 __attribute__((ext_vector_type(2)));
        float rs[2][4]; get_rstd(rs, R, wr, fr);
        const int d0 = 16 * wc + 4 * fq;
        const bool rope = u.pn < 6;
        if (!rope && kind == 1) {
            const int h = u.pn - 6;
#pragma unroll
            for (int ai = 0; ai < 2; ++ai)
#pragma unroll
                for (int m = 0; m < 4; ++m) { const int row = u.pm * BM + ai * HALF + wr * 64 + m * 16 + fr, b = row >> 12, s = row & 4095;
#pragma unroll
                    for (int bj = 0; bj < 2; ++bj) { bf16_t* p = other + ((size_t)((b * 6 + h) * 2 + bj) * 4096 + s) * 128 + d0;
#pragma unroll
                        for (int n = 0; n < 2; ++n) { const f32x4 v = acc[ai][bj][m][n] * rs[ai][m]; u32x2 w; w.x = cvt_pk_bf16(v[0], v[1]); w.y = cvt_pk_bf16(v[2], v[3]); *(u32x2*)(p + 64 * n) = w; } } }
            return;
        }
        const float* g = rope ? gr : gn; const f32x4 ga = *(const f32x4*)(g + d0), gb = *(const f32x4*)(g + 64 + d0);
        u32x4 cst[2][4];
        if (rope) {
#pragma unroll
            for (int ai = 0; ai < 2; ++ai)
#pragma unroll
                for (int m = 0; m < 4; ++m) { const int s = (u.pm * BM + ai * HALF + wr * 64 + m * 16 + fr) & 4095; cst[ai][m] = *(const u32x4*)(cs + (size_t)s * 64 + d0); }
        }
#pragma unroll
        for (int ai = 0; ai < 2; ++ai)
#pragma unroll
            for (int m = 0; m < 4; ++m) { const int rl = ai * HALF + wr * 64 + m * 16 + fr;
#pragma unroll
                for (int bj = 0; bj < 2; ++bj) { const f32x4 v0 = acc[ai][bj][m][0], v1 = acc[ai][bj][m][1];
                    head_ss_put(ex, rl, bj, wc, fq, (((v0[0] * v0[0] + v0[1] * v0[1]) + (v0[2] * v0[2] + v0[3] * v0[3])) + ((v1[0] * v1[0] + v1[1] * v1[1]) + (v1[2] * v1[2] + v1[3] * v1[3]))) * (rs[ai][m] * rs[ai][m])); } }
        PG8_EPI_BARRIER();
#pragma unroll
        for (int ai = 0; ai < 2; ++ai)
#pragma unroll
            for (int m = 0; m < 4; ++m) { const int rl = ai * HALF + wr * 64 + m * 16 + fr, row = u.pm * BM + rl, b = row >> 12, s = row & 4095;
#pragma unroll
                for (int bj = 0; bj < 2; ++bj) { const float sc = rs[ai][m] * head_rstd_get(ex, rl, bj);
                    f32x4 y0 = acc[ai][bj][m][0] * sc * ga, y1 = acc[ai][bj][m][1] * sc * gb; bf16_t* p;
                    if (rope) { f32x4 o0, o1;
#pragma unroll
                        for (int j = 0; j < 4; ++j) { const unsigned cw = cst[ai][m][j]; const h2 t = __builtin_bit_cast(h2, cw); const float c = (float)t.x, sn = (float)t.y; o0[j] = y0[j] * c - y1[j] * sn; o1[j] = y1[j] * c + y0[j] * sn; }
                        y0 = o0; y1 = o1; p = qk + ((size_t)(b * 12 + u.pn * 2 + bj) * 4096 + s) * 128 + d0; }
                    else p = other + ((size_t)(b * 4 + (u.pn - 6) * 2 + bj) * 4096 + s) * 128 + d0;
                    u32x2 w0, w1; w0.x = cvt_pk_bf16(y0[0], y0[1]); w0.y = cvt_pk_bf16(y0[2], y0[3]); w1.x = cvt_pk_bf16(y1[0], y1[1]); w1.y = cvt_pk_bf16(y1[2], y1[3]);
                    *(u32x2*)p = w0; *(u32x2*)(p + 64) = w1; } }
    }
};
struct ColSweepOrder {
    int c;
    __device__ bool next(int i, Unit& u) const { if (i >= 2) return false; const int xcd = c & 7, j = c >> 3; u.pm = 8 * xcd + 4 * i + (j & 3); u.pn = j >> 2; return true; }
    __device__ __forceinline__ void a_ready(const Unit&) const {}
    __device__ __forceinline__ void done(const Unit&) const {}
};
struct EpiMemKv {
    static constexpr bool PERM = true, AFTER_DRAIN = false;
    static __host__ __device__ __forceinline__ int bmap(int R) { return (R & ~31) + perm32(R & 31); }
    bf16_t* mk; bf16_t* mv; const float* gk; PG8_LAS float* ex;
    __device__ __forceinline__ void operator()(const f32x4 (&acc)[2][2][4][2], const Unit& u, int wr, int wc, int fr, int fq) const {
        const int t = u.pn & 3, d0 = wc * 32 + 8 * fq; const size_t base = (size_t)u.pm * 4;
        if (t < 2) {
            const f32x4 g0 = *(const f32x4*)(gk + (u.pm >> 2) * 128 + d0), g1 = *(const f32x4*)(gk + (u.pm >> 2) * 128 + d0 + 4);
#pragma unroll
            for (int ai = 0; ai < 2; ++ai)
#pragma unroll
                for (int m = 0; m < 4; ++m) { const int rl = ai * HALF + wr * 64 + m * 16 + fr;
#pragma unroll
                    for (int bj = 0; bj < 2; ++bj) { const f32x4 v0 = acc[ai][bj][m][0], v1 = acc[ai][bj][m][1];
                        head_ss_put(ex, rl, bj, wc, fq, ((v0[0] * v0[0] + v0[1] * v0[1]) + (v0[2] * v0[2] + v0[3] * v0[3])) + ((v1[0] * v1[0] + v1[1] * v1[1]) + (v1[2] * v1[2] + v1[3] * v1[3]))); } }
            PG8_EPI_BARRIER();
#pragma unroll
            for (int ai = 0; ai < 2; ++ai)
#pragma unroll
                for (int m = 0; m < 4; ++m) { const int rl = ai * HALF + wr * 64 + m * 16 + fr;
#pragma unroll
                    for (int bj = 0; bj < 2; ++bj) { const float sc = head_rstd_get(ex, rl, bj);
                        *(u32x4*)(mk + ((base + t * 2 + bj) * 256 + rl) * 128 + d0) = pack8_bf16(acc[ai][bj][m][0] * sc * g0, acc[ai][bj][m][1] * sc * g1); } }
        } else {
#pragma unroll
            for (int ai = 0; ai < 2; ++ai)
#pragma unroll
                for (int m = 0; m < 4; ++m) { const int rl = ai * HALF + wr * 64 + m * 16 + fr;
#pragma unroll
                    for (int bj = 0; bj < 2; ++bj) *(u32x4*)(mv + ((base + (t - 2) * 2 + bj) * 256 + rl) * 128 + d0) = pack8_bf16(acc[ai][bj][m][0], acc[ai][bj][m][1]); }
        }
    }
};
struct MemKvOrder {
    int G, c;
    __device__ bool next(int i, Unit& u) const { const int L = i * G + c; if (L >= 64) return false; const int layer = L >> 4, r = L & 15; u.pm = layer * 4 + (r >> 2); u.pn = layer * 4 + (r & 3); return true; }
    __device__ __forceinline__ void a_ready(const Unit&) const {}
    __device__ __forceinline__ void done(const Unit&) const {}
};
template <class Epi, class Sched, bool ALIGN_EPI = false, bool SP2 = false, bool ABLK = false, bool BBLK = false>
__device__ __forceinline__ void gemm_phase(PG8_LAS unsigned char* lds, const Gemm g, const Sched& S, const Epi& E) {
    int tid_ = threadIdx.x; asm volatile("" : "+v"(tid_));
    const int tid = tid_, wid = __builtin_amdgcn_readfirstlane(tid >> 6), lane = tid & 63, wr = wid >> 2, wc = wid & 3, fr = lane & 15, fq = lane >> 4;
    const int K = g.K, nt = K / BK;
    unsigned voffA[2], voffB[2];
#pragma unroll
    for (int i = 0; i < 2; ++i) { int R, C; stage_rc(tid * 16 + i * 8192, R, C); const int Rb = Epi::bmap(R);
        voffA[i] = ABLK ? (unsigned)(R * BK + C) * 2u : (unsigned)(R * K + C) * 2u; voffB[i] = BBLK ? (unsigned)(Rb * BK + C) * 2u : (unsigned)(Rb * K + C) * 2u; }
    const size_t kstepA = ABLK ? (size_t)(BM * BK * 2) : (size_t)(BK * 2), kstepB = BBLK ? (size_t)(BM * BK * 2) : (size_t)(BK * 2);
    const size_t hstepA = ABLK ? (size_t)(HALF * BK * 2) : (size_t)HALF * K * 2, hstepB = BBLK ? (size_t)(HALF * BK * 2) : (size_t)HALF * K * 2;
    const size_t tstep = (size_t)BM * K * 2;
#ifndef PG8_PF
#define PG8_PF 0
#endif
    PG8_LAS unsigned* const pfjunk = (PG8_LAS unsigned*)(lds + 143360 + wid * 256);
    const unsigned ldsw = (unsigned)wid * 1024u;
    const int aoff = lds_byte(wr * 64 + fr, fq * 8), boff = lds_byte(wc * 32 + fr, fq * 8);
#define PG8_SA(b, h) (((b) * 2 + (h)) * HTB)
#define PG8_SB(b, h) ((4 + (b) * 2 + (h)) * HTB)
#define PG8_STAGE(bufoff, gbase, voff) do { _Pragma("unroll") for (int _i = 0; _i < 2; ++_i) \
        __builtin_amdgcn_global_load_lds((const unsigned*)((const char*)(gbase) + (voff)[_i]), (PG8_LAS unsigned*)(lds + (bufoff) + ldsw + _i * 8192), 16, 0, 0); } while (0)
#define PG8_LDA(dst, b, h) do { _Pragma("unroll") for (int m = 0; m < 4; ++m) _Pragma("unroll") for (int k = 0; k < 2; ++k) dst[m][k] = *(const PG8_LAS bf16x8*)(lds + PG8_SA(b, h) + aoff + m * 2048 + k * 1024); } while (0)
#define PG8_LDB(dst, b, h) do { _Pragma("unroll") for (int n = 0; n < 2; ++n) _Pragma("unroll") for (int k = 0; k < 2; ++k) dst[n][k] = *(const PG8_LAS bf16x8*)(lds + PG8_SB(b, h) + boff + n * 2048 + k * 1024); } while (0)
#define PG8_MMA(ai, bj, At, Bt) do { __builtin_amdgcn_s_setprio(1); _Pragma("unroll") for (int m = 0; m < 4; ++m) _Pragma("unroll") for (int n = 0; n < 2; ++n) _Pragma("unroll") for (int k = 0; k < 2; ++k) \
        acc[ai][bj][m][n] = __builtin_amdgcn_mfma_f32_16x16x32_bf16(Bt[n][k], At[m][k], acc[ai][bj][m][n], 0, 0, 0); __builtin_amdgcn_s_setprio(0); } while (0)
#define PG8_WAIT_V(n) asm volatile("s_waitcnt vmcnt(" #n ")" ::: "memory")
#define PG8_WAIT_LOOP() do { if (PG8_PF) asm volatile("s_waitcnt vmcnt(9)" ::: "memory"); else asm volatile("s_waitcnt vmcnt(8)" ::: "memory"); } while (0)
#define PG8_PREFETCH(tp) do { if (PG8_PF) { const int tp_ = (tp); const char* pb_ = (wid < 4) ? (tp_ < nt ? cA + (size_t)tp_ * kstepA : nA + (size_t)(tp_ - nt) * kstepA) : (tp_ < nt ? cB + (size_t)tp_ * kstepB : nB + (size_t)(tp_ - nt) * kstepB); \
        const unsigned ln_ = __builtin_amdgcn_mbcnt_hi(~0u, __builtin_amdgcn_mbcnt_lo(~0u, 0u)) + (unsigned)(wid & 3) * 64u; const unsigned pfl_ = ln_ * ((wid < 4) ? (ABLK ? 128u : (unsigned)K * 2u) : (BBLK ? 128u : (unsigned)K * 2u)); \
        __builtin_amdgcn_global_load_lds((const unsigned*)(pb_ + pfl_), pfjunk, 4, 0, 0); } } while (0)
#define PG8_WAIT_L(n) asm volatile("s_waitcnt lgkmcnt(" #n ")" ::: "memory")
#define PG8_BAR __builtin_amdgcn_s_barrier()
#define PG8_SCHED __builtin_amdgcn_sched_barrier(0)
    Unit cur, nxt; int ui = 0;
    if (!S.next(0, cur)) return;
    f32x4 acc[2][2][4][2];
#pragma unroll
    for (int a = 0; a < 2; ++a)
#pragma unroll
        for (int b = 0; b < 2; ++b)
#pragma unroll
            for (int m = 0; m < 4; ++m)
#pragma unroll
                for (int n = 0; n < 2; ++n) acc[a][b][m][n] = (f32x4){0.f, 0.f, 0.f, 0.f};
    bf16x8 At[4][2], B0[2][2], B1[2][2];
    const char* cA = (const char*)g.A + (size_t)cur.pm * tstep; const char* cB = (const char*)g.Bt + (size_t)cur.pn * tstep;
    S.a_ready(cur);
    if constexpr (SP2) {
        PG8_STAGE(PG8_SB(0, 0), cB, voffB); PG8_STAGE(PG8_SB(0, 1), cB + hstepB, voffB); PG8_STAGE(PG8_SA(0, 0), cA, voffA); PG8_STAGE(PG8_SA(0, 1), cA + hstepA, voffA);
        if (wr == 1) PG8_BAR;
        PG8_WAIT_V(2); PG8_BAR;
        PG8_STAGE(PG8_SB(1, 0), cB + kstepB, voffB); PG8_STAGE(PG8_SA(1, 0), cA + kstepA, voffA); PG8_STAGE(PG8_SB(1, 1), cB + hstepB + kstepB, voffB);
        PG8_WAIT_V(6); PG8_BAR;
    } else {
        PG8_STAGE(PG8_SB(0, 0), cB, voffB); PG8_STAGE(PG8_SA(0, 0), cA, voffA); PG8_STAGE(PG8_SB(0, 1), cB + hstepB, voffB); PG8_STAGE(PG8_SA(0, 1), cA + hstepA, voffA);
        if (wr == 1) PG8_BAR;
        PG8_WAIT_V(4); PG8_BAR;
        PG8_STAGE(PG8_SB(1, 0), cB + kstepB, voffB); PG8_STAGE(PG8_SA(1, 0), cA + kstepA, voffA); PG8_STAGE(PG8_SB(1, 1), cB + hstepB + kstepB, voffB);
        PG8_WAIT_V(6); PG8_BAR;
    }
    for (;;) {
        const bool has_next = S.next(ui + 1, nxt);
        const char* nA = has_next ? (const char*)g.A + (size_t)nxt.pm * tstep : cA; const char* nB = has_next ? (const char*)g.Bt + (size_t)nxt.pn * tstep : cB;
        for (int t = 0; t < nt; t += 2) {
            const bool last = (t == nt - 2);
            const char* a1 = cA + (size_t)(t + 1) * kstepA;
            const char* a2 = last ? nA : cA + (size_t)(t + 2) * kstepA; const char* b2 = last ? nB : cB + (size_t)(t + 2) * kstepB;
            const char* a3 = a2 + kstepA; const char* b3 = b2 + kstepB;
            if (last && has_next) S.a_ready(nxt);
            if constexpr (SP2) {
            PG8_LDB(B0, 0, 0); PG8_LDB(B1, 0, 1); PG8_SCHED; PG8_LDA(At, 0, 0); PG8_STAGE(PG8_SA(1, 1), a1 + hstepA, voffA); PG8_PREFETCH(t + PG8_PF);
            PG8_WAIT_LOOP(); PG8_WAIT_L(0); PG8_BAR; PG8_MMA(0, 0, At, B0); PG8_MMA(0, 1, At, B1); PG8_BAR; PG8_SCHED;
            PG8_LDA(At, 0, 1); PG8_STAGE(PG8_SB(0, 0), b2, voffB); PG8_STAGE(PG8_SB(0, 1), b2 + hstepB, voffB); PG8_STAGE(PG8_SA(0, 0), a2, voffA);
            PG8_WAIT_LOOP(); PG8_WAIT_L(0); PG8_BAR; PG8_MMA(1, 0, At, B0); PG8_MMA(1, 1, At, B1); PG8_BAR; PG8_SCHED;
            PG8_LDB(B0, 1, 0); PG8_LDB(B1, 1, 1); PG8_SCHED; PG8_LDA(At, 1, 0); PG8_STAGE(PG8_SA(0, 1), a2 + hstepA, voffA); PG8_PREFETCH(t + 1 + PG8_PF);
            PG8_WAIT_LOOP(); PG8_WAIT_L(0); PG8_BAR; PG8_MMA(0, 0, At, B0); PG8_MMA(0, 1, At, B1); PG8_BAR; PG8_SCHED;
            PG8_LDA(At, 1, 1); PG8_STAGE(PG8_SB(1, 0), b3, voffB); PG8_STAGE(PG8_SB(1, 1), b3 + hstepB, voffB); PG8_STAGE(PG8_SA(1, 0), a3, voffA);
            PG8_WAIT_LOOP(); PG8_WAIT_L(0); PG8_BAR; PG8_MMA(1, 0, At, B0); PG8_MMA(1, 1, At, B1); PG8_BAR; PG8_SCHED;
            } else {
            PG8_LDB(B0, 0, 0); PG8_SCHED; PG8_LDA(At, 0, 0); PG8_STAGE(PG8_SA(1, 1), a1 + hstepA, voffA);
            PG8_WAIT_L(8); PG8_BAR; PG8_WAIT_L(0); PG8_MMA(0, 0, At, B0); PG8_BAR; PG8_SCHED;
            PG8_LDB(B1, 0, 1); PG8_STAGE(PG8_SB(0, 0), b2, voffB);
            PG8_BAR; PG8_WAIT_L(0); PG8_MMA(0, 1, At, B1); PG8_BAR;
            PG8_LDA(At, 0, 1); PG8_STAGE(PG8_SA(0, 0), a2, voffA);
            PG8_BAR; PG8_WAIT_L(0); PG8_MMA(1, 0, At, B0); PG8_BAR; PG8_SCHED;
            PG8_STAGE(PG8_SB(0, 1), b2 + hstepB, voffB);
            PG8_WAIT_V(6); PG8_BAR; PG8_MMA(1, 1, At, B1); PG8_BAR;
            PG8_LDB(B0, 1, 0); PG8_SCHED; PG8_LDA(At, 1, 0); PG8_STAGE(PG8_SA(0, 1), a2 + hstepA, voffA);
            PG8_WAIT_L(8); PG8_BAR; PG8_WAIT_L(0); PG8_MMA(0, 0, At, B0); PG8_BAR; PG8_SCHED;
            PG8_LDB(B1, 1, 1); PG8_STAGE(PG8_SB(1, 0), b3, voffB);
            PG8_BAR; PG8_WAIT_L(0); PG8_MMA(0, 1, At, B1); PG8_BAR;
            PG8_LDA(At, 1, 1); PG8_STAGE(PG8_SA(1, 0), a3, voffA);
            PG8_BAR; PG8_WAIT_L(0); PG8_MMA(1, 0, At, B0); PG8_BAR; PG8_SCHED;
            PG8_STAGE(PG8_SB(1, 1), b3 + hstepB, voffB);
            PG8_WAIT_V(6); PG8_BAR; PG8_MMA(1, 1, At, B1); PG8_BAR;
            }
        }
        if constexpr (ALIGN_EPI) { if (wr == 0) PG8_BAR; }
        if constexpr (!Epi::AFTER_DRAIN) { int fr_e = fr, fq_e = fq; asm volatile("" : "+v"(fr_e), "+v"(fq_e));
            E(acc, cur, wr, wc, fr_e, fq_e); S.done(cur); }
        if (!has_next) break;
#pragma unroll
        for (int a = 0; a < 2; ++a)
#pragma unroll
            for (int b = 0; b < 2; ++b)
#pragma unroll
                for (int m = 0; m < 4; ++m)
#pragma unroll
                    for (int n = 0; n < 2; ++n) acc[a][b][m][n] = (f32x4){0.f, 0.f, 0.f, 0.f};
        cur = nxt; cA = nA; cB = nB; ++ui;
        if constexpr (ALIGN_EPI) { if (wr == 1) PG8_BAR; }
    }
    PG8_WAIT_V(0);
    if constexpr (!ALIGN_EPI) { if (wr == 0) PG8_BAR; }
    PG8_BAR;
    if constexpr (Epi::AFTER_DRAIN) { E.fused(acc, cur, wr, wc, fr, fq, lds, wid, lane); S.done(cur); }
#undef PG8_SA
#undef PG8_SB
#undef PG8_STAGE
#undef PG8_LDA
#undef PG8_LDB
#undef PG8_MMA
#undef PG8_WAIT_V
#undef PG8_WAIT_L
#undef PG8_WAIT_LOOP
#undef PG8_PREFETCH
#undef PG8_BAR
#undef PG8_SCHED
}
}
namespace att {
constexpr int D = 128; constexpr float THR = 8.f; constexpr bool WSKIP = false;
constexpr float SCALE = 0.08838834764831845f;
constexpr int NW = 8, QBLK = 32, KVBLK = 64, QB = NW * QBLK;
constexpr int SHM_V = KVBLK * D * 2, SHM_K = KVBLK * D * 2;
constexpr int LDS_BYTES = 2 * SHM_V + 2 * SHM_K + NW * 64 * 4;

using bf16 = __hip_bfloat16;
typedef short bf16x8 __attribute__((ext_vector_type(8)));
typedef short s16x4 __attribute__((ext_vector_type(4)));
typedef float f32x16 __attribute__((ext_vector_type(16)));
typedef float f32x4 __attribute__((ext_vector_type(4)));
typedef unsigned u32x4 __attribute__((ext_vector_type(4)));
template <class A, class Bt> struct same_t { static constexpr bool v = false; };
template <class A> struct same_t<A, A> { static constexpr bool v = true; };

#define KSWZ(row, colB) ((row) * 256 + ((colB) ^ (((row) & 7) << 4)))
#define SBAR() __builtin_amdgcn_sched_barrier(0)
__device__ __forceinline__ int v_st(int k, int c) { const int kk = (k & ~0xC) | ((k & 4) << 1) | ((k & 8) >> 1); return ((kk >> 3) * 4 + (c >> 5)) * 512 + ((kk & 7) * 32 + (c & 31)) * 2; }
__device__ __forceinline__ int v_rd_base(int lane) { return ((lane & 3) << 3) | (((lane >> 2) & 3) << 6) | (((lane >> 4) & 1) << 5) | (((lane >> 5) & 1) << 8); }
constexpr int v_rd_off(int d0, int ks, int half) { return d0 * 512 + ks * 4096 + half * 2048; }
__device__ __forceinline__ int crow(int r, int hi) { return (r & 3) + 8 * (r >> 2) + 4 * hi; }
__device__ __forceinline__ unsigned cvtpk(float lo, float hi) {
    unsigned r; asm volatile("v_cvt_pk_bf16_f32 %0, %1, %2" : "=v"(r) : "v"(lo), "v"(hi)); return r;
}
__device__ __forceinline__ bf16x8 pack8(f32x4 a, f32x4 b) {
    u32x4 w = {cvtpk(a[0], a[1]), cvtpk(a[2], a[3]), cvtpk(b[0], b[1]), cvtpk(b[2], b[3])};
    return *reinterpret_cast<bf16x8*>(&w);
}
template <class T> __device__ __forceinline__ bf16x8 load8(const T* p) {
    if constexpr (same_t<T, float>::v) { return pack8(*(const f32x4*)p, *(const f32x4*)(p + 4)); }
    else { return *reinterpret_cast<const bf16x8*>(p); }
}
__device__ __forceinline__ void mask_tile(f32x16& p0, f32x16& p1, int dq, unsigned W) {
    const float NEG = -__builtin_inff();
#pragma unroll
    for (int r = 0; r < 16; ++r) {
        const int c = (r & 3) + 8 * (r >> 2);
        if ((unsigned)(dq - c) >= W) p0[r] = NEG;
        if ((unsigned)(dq - c - 32) >= W) p1[r] = NEG;
    }
}
__device__ __forceinline__ void partialSM(f32x16& p0, f32x16& p1, float& m_reg, float& mn, float& alpha) {
    float pmax = p0[0]; for (int r = 1; r < 16; ++r) pmax = fmaxf(pmax, p0[r]); for (int r = 0; r < 16; ++r) pmax = fmaxf(pmax, p1[r]);
    { auto rr = __builtin_amdgcn_permlane32_swap(__float_as_uint(pmax), __float_as_uint(pmax), false, false);
      pmax = fmaxf(__uint_as_float(rr[0]), __uint_as_float(rr[1])); }
    constexpr float C2 = 1.4426950408889634f * SCALE;
    if (__builtin_expect(__all((pmax - m_reg) * SCALE <= THR), 1)) { mn = m_reg; alpha = 1.f; }
    else { mn = fmaxf(m_reg, pmax); alpha = __builtin_amdgcn_exp2f((m_reg - mn) * C2); m_reg = mn; }
    const float mnL = -mn * C2;
    for (int r = 0; r < 16; ++r) p0[r] = fmaf(p0[r], C2, mnL); for (int r = 0; r < 16; ++r) p1[r] = fmaf(p1[r], C2, mnL);
    for (int r = 0; r < 16; ++r) p0[r] = __builtin_amdgcn_exp2f(p0[r]);
}
__device__ __forceinline__ void finishSM(f32x16& p0, f32x16& p1, float alpha, float& l_reg, bf16x8& pa0, bf16x8& pa1, bf16x8& pa2, bf16x8& pa3) {
    for (int r = 0; r < 16; ++r) p1[r] = __builtin_amdgcn_exp2f(p1[r]);
    float ps = 0; for (int r = 0; r < 16; ++r) ps += p0[r]; for (int r = 0; r < 16; ++r) ps += p1[r];
    { auto rr = __builtin_amdgcn_permlane32_swap(__float_as_uint(ps), __float_as_uint(ps), false, false);
      ps = __uint_as_float(rr[0]) + __uint_as_float(rr[1]); }
    l_reg = l_reg * alpha + ps;
#define PK4(P, B_, OUT) do { unsigned a0 = cvtpk(P[B_+0], P[B_+1]), a1 = cvtpk(P[B_+2], P[B_+3]);                          \
        unsigned b0 = cvtpk(P[B_+4], P[B_+5]), b1 = cvtpk(P[B_+6], P[B_+7]);                                             \
        auto r0 = __builtin_amdgcn_permlane32_swap(a0, b0, false, false); auto r1 = __builtin_amdgcn_permlane32_swap(a1, b1, false, false); \
        u32x4 w = {r0[0], r1[0], r0[1], r1[1]}; OUT = *reinterpret_cast<bf16x8*>(&w); } while (0)
    PK4(p0, 0, pa0); PK4(p0, 8, pa1); PK4(p1, 0, pa2); PK4(p1, 8, pa3);
#undef PK4
}
template <int KB, bool SK>
__device__ __forceinline__ void qkt(f32x16& p0, f32x16& p1, const char* K_lds, int r32, int hi, const bf16x8* qr, bool act) {
    if (SK && !act) { const float NEG = -__builtin_inff();
#pragma unroll
        for (int r = 0; r < 16; ++r) { p0[r] = NEG; p1[r] = NEG; } return; }
    p0 = f32x16{}; p1 = f32x16{};
    const char* kb[4];
#pragma unroll
    for (int dd = 0; dd < 4; ++dd) kb[dd] = K_lds + KB * SHM_K + KSWZ(r32, (dd * 16 + hi * 8) * 2);
#pragma unroll
    for (int d0 = 0; d0 < 8; ++d0) { const char* a = kb[d0 & 3] + (d0 >> 2) * 128;
        bf16x8 b0 = *reinterpret_cast<const bf16x8*>(a);
        bf16x8 b1 = *reinterpret_cast<const bf16x8*>(a + 32 * 256);
        p0 = __builtin_amdgcn_mfma_f32_32x32x16_bf16(b0, qr[d0], p0, 0, 0, 0);
        p1 = __builtin_amdgcn_mfma_f32_32x32x16_bf16(b1, qr[d0], p1, 0, 0, 0); }
}
template <int VB, bool SK>
__device__ __forceinline__ void pv_tile(f32x16* o, int vb0, bf16x8 pa0, bf16x8 pa1, bf16x8 pa2, bf16x8 pa3, bool act) {
    if (SK && !act) return;
#define TRRD(dst, off) asm volatile("ds_read_b64_tr_b16 %0, %1 offset:%2" : "=&v"(dst) : "v"(vb0), "i"(off) : "memory")
#define PV_D0(d0) do { s16x4 l0, l1, l2, l3, h0, h1, h2, h3; constexpr int b_ = VB * SHM_V + v_rd_off(d0, 0, 0);     \
        TRRD(l0, b_); TRRD(h0, b_ + 2048); TRRD(l1, b_ + 4096); TRRD(h1, b_ + 6144); TRRD(l2, b_ + 8192); TRRD(h2, b_ + 10240); TRRD(l3, b_ + 12288); TRRD(h3, b_ + 14336); \
        asm volatile("s_waitcnt lgkmcnt(0)" ::: "memory"); SBAR();                 \
        o[d0] = __builtin_amdgcn_mfma_f32_32x32x16_bf16(pa0, (bf16x8){l0[0], l0[1], l0[2], l0[3], h0[0], h0[1], h0[2], h0[3]}, o[d0], 0, 0, 0);   \
        o[d0] = __builtin_amdgcn_mfma_f32_32x32x16_bf16(pa1, (bf16x8){l1[0], l1[1], l1[2], l1[3], h1[0], h1[1], h1[2], h1[3]}, o[d0], 0, 0, 0);   \
        o[d0] = __builtin_amdgcn_mfma_f32_32x32x16_bf16(pa2, (bf16x8){l2[0], l2[1], l2[2], l2[3], h2[0], h2[1], h2[2], h2[3]}, o[d0], 0, 0, 0);   \
        o[d0] = __builtin_amdgcn_mfma_f32_32x32x16_bf16(pa3, (bf16x8){l3[0], l3[1], l3[2], l3[3], h3[0], h3[1], h3[2], h3[3]}, o[d0], 0, 0, 0); } while (0)
    PV_D0(0); PV_D0(1); PV_D0(2); PV_D0(3);
#undef PV_D0
#undef TRRD
}

template <class TIn, class TOut> struct BlockRef { const TIn* Q; const TIn* K; const TIn* V; TOut* O; int P0; int ldo; };
template <class TIn> struct Seam {
    bf16x8 qr[8];
    bf16x8 st_v0, st_v1, st_k0, st_k1; f32x4 sf0, sf1, sf2, sf3;
    f32x4 tq[16];
};
__device__ __forceinline__ int swa_jlo(int P0, int W) { const int lowk = P0 - W + 1; return lowk > 0 ? lowk / KVBLK : 0; }
#define ROW(p, k0, rr) ((p) + (size_t)((k0) + (rr)) * D + sc)
#define VMW() asm volatile("s_waitcnt vmcnt(0)" ::: "memory")
#define VMWN(n) asm volatile("s_waitcnt vmcnt(%0)" :: "i"(n) : "memory")
#define SLOAD_H(Kp, Vp, k0) do { S.st_v0 = load8<TIn>(ROW(Vp, k0, sr)); S.st_v1 = load8<TIn>(ROW(Vp, k0, 32 + sr));              \
                         S.st_k0 = load8<TIn>(ROW(Kp, k0, sr)); S.st_k1 = load8<TIn>(ROW(Kp, k0, 32 + sr)); } while (0)
#define SWRITE_HK(bf) do { *(bf16x8*)(K_lds + (bf) * SHM_K + kws) = S.st_k0; *(bf16x8*)(K_lds + (bf) * SHM_K + kws + 32 * 256) = S.st_k1; } while (0)
#define SWRITE_HV(bf) do { *(bf16x8*)(V_lds + (bf) * SHM_V + vst0) = S.st_v0; *(bf16x8*)(V_lds + (bf) * SHM_V + vst1) = S.st_v1; } while (0)
#define SWRITE_H(bf) do { SWRITE_HV(bf); SWRITE_HK(bf); } while (0)
#define SLOAD_F(p, k0) do { S.sf0 = *(const f32x4*)ROW(p, k0, sr); S.sf1 = *(const f32x4*)(ROW(p, k0, sr) + 4);                \
                            S.sf2 = *(const f32x4*)ROW(p, k0, 32 + sr); S.sf3 = *(const f32x4*)(ROW(p, k0, 32 + sr) + 4); } while (0)
#define SWRITE_KF(bf) do { *(bf16x8*)(K_lds + (bf) * SHM_K + kws) = pack8(S.sf0, S.sf1); *(bf16x8*)(K_lds + (bf) * SHM_K + kws + 32 * 256) = pack8(S.sf2, S.sf3); } while (0)
#define SWRITE_VF(bf) do { *(bf16x8*)(V_lds + (bf) * SHM_V + vst0) = pack8(S.sf0, S.sf1); *(bf16x8*)(V_lds + (bf) * SHM_V + vst1) = pack8(S.sf2, S.sf3); } while (0)
template <class TIn, class TOut>
__device__ __forceinline__ void causal_swa_prime(const BlockRef<TIn, TOut>& cur, int W, char* lds, Seam<TIn>& S) {
    constexpr bool F32 = same_t<TIn, float>::v;
    int tid_ = threadIdx.x; asm volatile("" : "+v"(tid_));
    const int tid = tid_, wid = __builtin_amdgcn_readfirstlane(tid >> 6), lane = tid & 63, r32 = lane & 31, hi = lane >> 5;
    const int sr = tid >> 4, sc = (tid & 15) * 8, kws = KSWZ(sr, sc * 2); char* K_lds = lds + 2 * SHM_V;
    const int kb0 = swa_jlo(cur.P0, W) * KVBLK;
    for (int d0 = 0; d0 < 8; ++d0) S.qr[d0] = load8<TIn>(cur.Q + (size_t)(wid * QBLK + r32) * D + d0 * 16 + hi * 8);
    if constexpr (F32) { SLOAD_F((const float*)cur.K, kb0); VMW(); SWRITE_KF(0); SBAR(); SLOAD_F((const float*)cur.V, kb0); }
    else { SLOAD_H(cur.K, cur.V, kb0); VMW(); SWRITE_HK(0); }
    __syncthreads();
}
template <class TIn, class TOut>
__device__ __forceinline__ void causal_swa_block(const BlockRef<TIn, TOut>& cur, const BlockRef<TIn, TOut>& nxt, int skv, int W, char* lds, Seam<TIn>& S) {
    constexpr bool F32 = same_t<TIn, float>::v;
    int tid_ = threadIdx.x; asm volatile("" : "+v"(tid_));
    const int tid = tid_, wid = __builtin_amdgcn_readfirstlane(tid >> 6), lane = tid & 63, r32 = lane & 31, hi = lane >> 5;
    const int j_lo = swa_jlo(cur.P0, W);
    int j_hi = (cur.P0 + QB - 1) / KVBLK + 1; if (j_hi > skv / KVBLK) j_hi = skv / KVBLK;
    const int NT = j_hi - j_lo;
    const int kbn = swa_jlo(nxt.P0, W) * KVBLK;
    const int qlo = cur.P0 + wid * QBLK, qm = qlo + r32 - 4 * hi;
    char* V_lds = lds; char* K_lds = lds + 2 * SHM_V;
    float* ws = (float*)(lds + 2 * SHM_V + 2 * SHM_K) + wid * 64; float* li_l = ws, * al_l = ws + 32;
    float m_reg = -1e30f, l_reg = 0; f32x16 o[4] = {};
    const int sr = tid >> 4, sc = (tid & 15) * 8, vst0 = v_st(sr, sc), vst1 = v_st(32 + sr, sc), kws = KSWZ(sr, sc * 2);
    const int vb0 = (int)(uintptr_t)V_lds + v_rd_base(lane);
    const TIn* Kh = cur.K; const TIn* Vh = cur.V;
#define RESC(a) do { if (__any((a) < 1.f)) { if (hi == 0) al_l[r32] = (a); asm volatile("s_waitcnt lgkmcnt(0)" ::: "memory");              \
                     for (int d_ = 0; d_ < 4; ++d_) for (int r = 0; r < 16; ++r) o[d_][r] *= al_l[crow(r, hi)]; } } while (0)
#define KBASE(t) ((j_lo + (t)) * KVBLK)
#define ACT(t) (KBASE(t) <= qlo + QBLK - 1 && KBASE(t) + KVBLK - 1 >= qlo - W + 1)
#define MASKT(P0_, P1_, t) do { const int kb_ = KBASE(t); if ((!SK || ACT(t)) && (kb_ + KVBLK - 1 > qlo || kb_ <= qlo + QBLK - 1 - W)) mask_tile(P0_, P1_, qm - kb_, (unsigned)W); } while (0)
    constexpr int NQL = F32 ? 16 : 8;
    constexpr bool SK = WSKIP && !F32;
#define SEAM_K0() do { VMWN(NQL); if constexpr (F32) { SWRITE_KF(0); SBAR(); SLOAD_F((const float*)nxt.V, kbn); } else { SWRITE_HK(0); } SBAR(); } while (0)
    f32x16 pA0, pA1, pB0, pB1; float mnA, mnB, alA, alB; bf16x8 pa0, pa1, pa2, pa3;
    if constexpr (F32) { VMW(); SWRITE_VF(0); SBAR(); } else { SWRITE_HV(0); SBAR(); }
    if (NT > 1) { if constexpr (F32) SLOAD_F((const float*)Kh, KBASE(1)); else SLOAD_H(Kh, Vh, KBASE(1)); }
    SBAR(); qkt<0, SK>(pA0, pA1, K_lds, r32, hi, S.qr, ACT(0));
    if constexpr (F32) { if (NT > 1) { VMW(); SWRITE_KF(1); SBAR(); SLOAD_F((const float*)Vh, KBASE(1)); } }
    MASKT(pA0, pA1, 0); partialSM(pA0, pA1, m_reg, mnA, alA);
    if (NT > 1) { VMW(); if constexpr (F32) { SWRITE_VF(1); SBAR(); if (NT > 2) SLOAD_F((const float*)Kh, KBASE(2)); } else SWRITE_H(1); }
    __syncthreads();
#define HALF_STEP(PX0, PX1, mnX, alX, PY0, PY1, alY, t, KB, VB, SB) do {                                                      \
        SBAR(); qkt<KB, SK>(PX0, PX1, K_lds, r32, hi, S.qr, ACT(t));                                             \
        finishSM(PY0, PY1, alY, l_reg, pa0, pa1, pa2, pa3); SBAR();                                                           \
        if ((t) + 1 < NT) { if constexpr (F32) { VMW(); SWRITE_KF(SB); SBAR(); SLOAD_F((const float*)Vh, KBASE((t) + 1)); }  \
                            else { SLOAD_H(Kh, Vh, KBASE((t) + 1)); } SBAR(); }                                               \
        pv_tile<VB, SK>(o, vb0, pa0, pa1, pa2, pa3, ACT((t) - 1)); MASKT(PX0, PX1, (t)); partialSM(PX0, PX1, m_reg, mnX, alX);                                        \
        __syncthreads();                                                                                                      \
        if ((t) + 1 < NT) { VMW(); if constexpr (F32) { SWRITE_VF(SB); SBAR(); if ((t) + 2 < NT) SLOAD_F((const float*)Kh, KBASE((t) + 2)); } \
                            else { SWRITE_H(SB); } }                                                                          \
        RESC(alX); __syncthreads(); } while (0)
    for (int t = 1; t + 1 < NT; t += 2) {
        HALF_STEP(pB0, pB1, mnB, alB, pA0, pA1, alA, t, 1, 0, 0);
        HALF_STEP(pA0, pA1, mnA, alA, pB0, pB1, alB, t + 1, 0, 1, 1);
    }
    const bool even = (NT & 1) == 0;
    if (even) { SBAR(); qkt<1, SK>(pB0, pB1, K_lds, r32, hi, S.qr, ACT(NT - 1)); SBAR(); }
#define QROW(e) (nxt.Q + (size_t)(wid * QBLK + r32) * D + ((e) >> 1) * 16 + hi * 8 + ((e) & 1) * 4)
    if constexpr (F32) { SLOAD_F((const float*)nxt.K, kbn); SBAR();
#pragma unroll
        for (int e = 0; e < 8; ++e) S.tq[e] = *(const f32x4*)QROW(e); }
    else { SLOAD_H(nxt.K, nxt.V, kbn); SBAR();
#pragma unroll
        for (int d0 = 0; d0 < 8; ++d0) S.qr[d0] = load8<TIn>(nxt.Q + (size_t)(wid * QBLK + r32) * D + d0 * 16 + hi * 8); }
    SBAR();
    finishSM(pA0, pA1, alA, l_reg, pa0, pa1, pa2, pa3); SBAR();
    if constexpr (F32) {
#pragma unroll
        for (int e = 8; e < 16; ++e) S.tq[e] = *(const f32x4*)QROW(e); SBAR(); }
#undef QROW
    pv_tile<0, SK>(o, vb0, pa0, pa1, pa2, pa3, ACT(even ? NT - 2 : NT - 1));
    if (even) { MASKT(pB0, pB1, NT - 1); partialSM(pB0, pB1, m_reg, mnB, alB); __syncthreads(); RESC(alB);
        finishSM(pB0, pB1, alB, l_reg, pa0, pa1, pa2, pa3); SBAR(); pv_tile<1, SK>(o, vb0, pa0, pa1, pa2, pa3, ACT(NT - 1)); }
    SBAR(); SEAM_K0();
    if (hi == 0) li_l[r32] = l_reg; asm volatile("s_waitcnt lgkmcnt(0)" ::: "memory");
    float rli[16];
#pragma unroll
    for (int r = 0; r < 16; ++r) rli[r] = __builtin_amdgcn_rcpf(li_l[crow(r, hi)]);
    const int LDO = cur.ldo; TOut* Ow = cur.O + (size_t)(wid * QBLK) * LDO;
#pragma unroll
    for (int r = 0; r < 16; ++r) { const int orow = crow(r, hi);
#pragma unroll
        for (int d0 = 0; d0 < 4; ++d0) { const float v = o[d0][r] * rli[r];
            if constexpr (same_t<TOut, float>::v) { Ow[(size_t)orow * LDO + d0 * 32 + r32] = v; }
            else { const float vn = __shfl_xor(v, 1);
                   if ((r32 & 1) == 0) *(unsigned*)(Ow + (size_t)orow * LDO + d0 * 32 + r32) = cvtpk(v, vn); } } }
    if constexpr (F32) {
#pragma unroll
        for (int d0 = 0; d0 < 8; ++d0) S.qr[d0] = pack8(S.tq[2 * d0], S.tq[2 * d0 + 1]); }
    __syncthreads();
#undef RESC
#undef KBASE
#undef ACT
#undef MASKT
#undef SEAM_K0
#undef HALF_STEP
}
#undef ROW
#undef VMW
#undef VMWN
#undef SLOAD_H
#undef SWRITE_HK
#undef SWRITE_HV
#undef SWRITE_H
#undef SLOAD_F
#undef SWRITE_KF
#undef SWRITE_VF


constexpr int QB2 = 128, L2_K = 0, L2_V0 = 32768, L2_V1 = 65536, L2_P = 98304;
struct Ref2 { const bf16* Q; const bf16* K; const bf16* V0; const bf16* V1; unsigned short* O0; unsigned short* O1; int P0; };
struct Seam2 { bf16x8 qr[8]; bf16x8 sk0, sk1, sa0, sa1, sb0, sb1; f32x16 pA0, pA1; };
#define LD8(p) (*reinterpret_cast<const bf16x8*>(p))
#define VMW2() asm volatile("s_waitcnt vmcnt(0)" ::: "memory")
__device__ __forceinline__ void pv3_tile(f32x16* o, int vb, bf16x8 pa0, bf16x8 pa1, bf16x8 pa2, bf16x8 pa3, bf16x8 pb0, bf16x8 pb1, bf16x8 pb2, bf16x8 pb3, float fA, float fB, const float* alA, int hi) {
#define TRRD(dst, off) asm volatile("ds_read_b64_tr_b16 %0, %1 offset:%2" : "=&v"(dst) : "v"(vb), "i"(off) : "memory")
#define RD8(X, g) do { constexpr int b_ = v_rd_off((g), 0, 0); TRRD(X##0, b_); TRRD(X##1, b_ + 2048); TRRD(X##2, b_ + 4096); TRRD(X##3, b_ + 6144); \
        TRRD(X##4, b_ + 8192); TRRD(X##5, b_ + 10240); TRRD(X##6, b_ + 12288); TRRD(X##7, b_ + 14336); } while (0)
#define VF(X, a, b) (bf16x8){X##a[0], X##a[1], X##a[2], X##a[3], X##b[0], X##b[1], X##b[2], X##b[3]}
#define MM8(X, g) do { \
        o[g] = __builtin_amdgcn_mfma_f32_32x32x16_bf16(pa0, VF(X, 0, 1), o[g], 0, 0, 0); o[4 + g] = __builtin_amdgcn_mfma_f32_32x32x16_bf16(pb0, VF(X, 0, 1), o[4 + g], 0, 0, 0); \
        o[g] = __builtin_amdgcn_mfma_f32_32x32x16_bf16(pa1, VF(X, 2, 3), o[g], 0, 0, 0); o[4 + g] = __builtin_amdgcn_mfma_f32_32x32x16_bf16(pb1, VF(X, 2, 3), o[4 + g], 0, 0, 0); \
        o[g] = __builtin_amdgcn_mfma_f32_32x32x16_bf16(pa2, VF(X, 4, 5), o[g], 0, 0, 0); o[4 + g] = __builtin_amdgcn_mfma_f32_32x32x16_bf16(pb2, VF(X, 4, 5), o[4 + g], 0, 0, 0); \
        o[g] = __builtin_amdgcn_mfma_f32_32x32x16_bf16(pa3, VF(X, 6, 7), o[g], 0, 0, 0); o[4 + g] = __builtin_amdgcn_mfma_f32_32x32x16_bf16(pb3, VF(X, 6, 7), o[4 + g], 0, 0, 0); } while (0)
#define LGK8() do { asm volatile("s_waitcnt lgkmcnt(8)" ::: "memory"); SBAR(); } while (0)
    s16x4 A0, A1, A2, A3, A4, A5, A6, A7, B0, B1, B2, B3, B4, B5, B6, B7;
    RD8(A, 0); RD8(B, 1);
    if (__builtin_amdgcn_readfirstlane(__float_as_int(fA)) != 0) {
        const f32x4* a4p = (const f32x4*)alA + hi; const f32x4 a0 = a4p[0], a1 = a4p[2], a2 = a4p[4], a3 = a4p[6];
#pragma unroll
        for (int d_ = 0; d_ < 4; ++d_)
#pragma unroll
            for (int j = 0; j < 4; ++j) { o[d_][j] *= a0[j]; o[d_][4 + j] *= a1[j]; o[d_][8 + j] *= a2[j]; o[d_][12 + j] *= a3[j]; } }
    if (__builtin_amdgcn_readfirstlane(__float_as_int(fB)) != 0) {
        const f32x4* a4p = (const f32x4*)(alA + 32) + hi; const f32x4 a0 = a4p[0], a1 = a4p[2], a2 = a4p[4], a3 = a4p[6];
#pragma unroll
        for (int d_ = 4; d_ < 8; ++d_)
#pragma unroll
            for (int j = 0; j < 4; ++j) { o[d_][j] *= a0[j]; o[d_][4 + j] *= a1[j]; o[d_][8 + j] *= a2[j]; o[d_][12 + j] *= a3[j]; } }
    asm volatile("s_waitcnt lgkmcnt(0)" ::: "memory"); SBAR(); MM8(A, 0); SBAR();
    RD8(A, 2); LGK8(); MM8(B, 1); SBAR();
    RD8(B, 3); LGK8(); MM8(A, 2); SBAR();
    asm volatile("s_waitcnt lgkmcnt(0)" ::: "memory"); SBAR(); MM8(B, 3);
#undef TRRD
#undef RD8
#undef VF
#undef MM8
#undef LGK8
}
template <bool RS>
__device__ __forceinline__ void diff2_prime(const Ref2& cur, char* lds, Seam2& S) {
    int tid_ = threadIdx.x; asm volatile("" : "+v"(tid_));
    const int tid = tid_, wid = __builtin_amdgcn_readfirstlane(tid >> 6), lane = tid & 63, r32 = lane & 31, hi = lane >> 5;
    const int sr = tid >> 4, sc = (tid & 15) * 8, kws = KSWZ(sr, sc * 2);
    if constexpr (RS) {
#pragma unroll
        for (int d0 = 0; d0 < 8; ++d0) S.qr[d0] = LD8(cur.Q + (size_t)(wid * QBLK + r32) * D + d0 * 16 + hi * 8); }
    S.sk0 = LD8(cur.K + (size_t)sr * D + sc); S.sk1 = LD8(cur.K + (size_t)(32 + sr) * D + sc);
    VMW2();
    *(bf16x8*)(lds + L2_K + kws) = S.sk0; *(bf16x8*)(lds + L2_K + kws + 32 * 256) = S.sk1;
    S.sk0 = LD8(cur.K + (size_t)(KVBLK + sr) * D + sc); S.sk1 = LD8(cur.K + (size_t)(KVBLK + 32 + sr) * D + sc);
    S.sa0 = LD8(cur.V0 + (size_t)sr * D + sc); S.sa1 = LD8(cur.V0 + (size_t)(32 + sr) * D + sc);
    S.sb0 = LD8(cur.V1 + (size_t)sr * D + sc); S.sb1 = LD8(cur.V1 + (size_t)(32 + sr) * D + sc);
    VMW2();
    *(bf16x8*)(lds + L2_K + SHM_K + kws) = S.sk0; *(bf16x8*)(lds + L2_K + SHM_K + kws + 32 * 256) = S.sk1;
    __syncthreads();
    if constexpr (RS) qkt<0, false>(S.pA0, S.pA1, lds + L2_K, r32, hi, S.qr, true);
}
template <bool RS>
__device__ __forceinline__ void diff2_block(const Ref2& cur, const Ref2& nxt, char* lds, float* xl, Seam2& S) {
    int tid_ = threadIdx.x; asm volatile("" : "+v"(tid_));
    const int tid = tid_, wid = __builtin_amdgcn_readfirstlane(tid >> 6), lane = tid & 63, r32 = lane & 31, hi = lane >> 5;
    const int w4 = wid & 3;
    const int NT = (cur.P0 + QB2 - 1) / KVBLK + 1;
    const int qlo = cur.P0 + w4 * QBLK, qm = qlo + r32 - 4 * hi;
    char* K_lds = lds + L2_K; char* V0_lds = lds + L2_V0; char* V1_lds = lds + L2_V1; char* P_lds = lds + L2_P + w4 * 4096;
    float* alp = xl + w4 * 32; float* li = xl + 256 + (RS ? w4 : (w4 >> 1) * 2) * 32; float* flg = xl + 384 + w4;
    const int sr = tid >> 4, sc = (tid & 15) * 8, vst0 = v_st(sr, sc), vst1 = v_st(32 + sr, sc), kws = KSWZ(sr, sc * 2);
    const int vbase = (int)(uintptr_t)V0_lds + v_rd_base(lane);
    float m_reg = -1e30f, l_reg = 0.f; f32x16 o[RS ? 1 : 8] = {};
    auto stage_top = [&](const int t, const bool drain) __attribute__((always_inline)) {
        const int par = t & 1;
        if (!drain) { *(bf16x8*)(V0_lds + par * SHM_V + vst0) = S.sa0; *(bf16x8*)(V0_lds + par * SHM_V + vst1) = S.sa1;
                      *(bf16x8*)(V1_lds + par * SHM_V + vst0) = S.sb0; *(bf16x8*)(V1_lds + par * SHM_V + vst1) = S.sb1; }
        const bool kc = !drain && t + 2 < NT, kn = drain || t == NT - 1;
        if (kc || kn) { const bf16* Kp = kc ? cur.K : nxt.K; const int k0 = kc ? (t + 2) * KVBLK : (drain ? KVBLK : 0);
            S.sk0 = LD8(Kp + (size_t)(k0 + sr) * D + sc); S.sk1 = LD8(Kp + (size_t)(k0 + 32 + sr) * D + sc); }
        const bool vc = !drain && t + 1 < NT;
        if (vc || drain) { const bf16* Ap = vc ? cur.V0 : nxt.V0; const bf16* Bp = vc ? cur.V1 : nxt.V1; const int k0 = vc ? (t + 1) * KVBLK : 0;
            S.sa0 = LD8(Ap + (size_t)(k0 + sr) * D + sc); S.sa1 = LD8(Ap + (size_t)(k0 + 32 + sr) * D + sc);
            S.sb0 = LD8(Bp + (size_t)(k0 + sr) * D + sc); S.sb1 = LD8(Bp + (size_t)(k0 + 32 + sr) * D + sc); }
    };
    auto stage_end = [&](const int t, const bool drain, const int nyoung) __attribute__((always_inline)) {
        const bool kc = !drain && t + 2 < NT, kn = drain || t == NT - 1;
        if (kc || kn) { const int wb = kc ? (t & 1) : (drain ? 1 : 0);
            (void)nyoung;
            *(bf16x8*)(K_lds + wb * SHM_K + kws) = S.sk0; *(bf16x8*)(K_lds + wb * SHM_K + kws + 32 * 256) = S.sk1; }
    };
    if constexpr (RS) {
        f32x16 pB0, pB1;
        auto siter = [&](f32x16& pX0, f32x16& pX1, f32x16& pY0, f32x16& pY1, const int t) __attribute__((always_inline)) {
            const int par = t & 1;
            stage_top(t, false);
            if (t == NT - 1) {
#pragma unroll
                for (int d0 = 0; d0 < 8; ++d0) S.qr[d0] = LD8(nxt.Q + (size_t)(w4 * QBLK + r32) * D + d0 * 16 + hi * 8); }
            SBAR();
            if (t + 1 < NT) qkt<0, false>(pY0, pY1, K_lds + ((t + 1) & 1) * SHM_K, r32, hi, S.qr, true);
            float mn, alpha; bf16x8 pa0, pa1, pa2, pa3;
            { const int kb = t * KVBLK; if (kb + KVBLK - 1 > qlo) mask_tile(pX0, pX1, qm - kb, 1u << 30); }
            partialSM(pX0, pX1, m_reg, mn, alpha); finishSM(pX0, pX1, alpha, l_reg, pa0, pa1, pa2, pa3);
            { bf16x8* pw = (bf16x8*)(P_lds + par * 16384) + lane; pw[0] = pa0; pw[64] = pa1; pw[128] = pa2; pw[192] = pa3; }
            const bool need = __any(alpha < 1.f);
            if (hi == 0) { alp[par * 128 + r32] = alpha; if (t == NT - 1) li[r32] = l_reg; if (r32 == 0) flg[par * 4] = need ? 1.f : 0.f; }
            SBAR();
            stage_end(t, false, t == NT - 1 ? 12 : 4);
            __syncthreads();
        };
#pragma unroll 1
        for (int t = 0; t < NT; t += 2) { siter(S.pA0, S.pA1, pB0, pB1, t); siter(pB0, pB1, S.pA0, S.pA1, t + 1); }
        stage_top(NT, true);
        SBAR();
        qkt<0, false>(S.pA0, S.pA1, K_lds, r32, hi, S.qr, true);
        SBAR();
        stage_end(NT, true, 4);
        __syncthreads();
    } else {
#pragma unroll 1
        for (int t = 0; t <= NT; ++t) {
            const bool drain = t == NT;
            stage_top(t, drain);
            SBAR();
            if (t >= 1) {
                const int pp = (t - 1) & 1, rg = w4 >> 1, hf = w4 & 1;
                char* PA = lds + L2_P + (2 * rg) * 4096 + pp * 16384; float* alA = xl + (2 * rg) * 32 + pp * 128; float* flA = xl + 384 + 2 * rg + pp * 4;
                bf16x8 pa0, pa1, pa2, pa3, pb0, pb1, pb2, pb3;
                { const bf16x8* pr = (const bf16x8*)PA + lane; pa0 = pr[0]; pa1 = pr[64]; pa2 = pr[128]; pa3 = pr[192]; pb0 = pr[256]; pb1 = pr[320]; pb2 = pr[384]; pb3 = pr[448]; }
                const float fA = flA[0], fB = flA[1];
                pv3_tile(o, vbase + hf * (L2_V1 - L2_V0) + pp * SHM_V, pa0, pa1, pa2, pa3, pb0, pb1, pb2, pb3, fA, fB, alA, hi);
            }
            SBAR();
            stage_end(t, drain, 4);
            if (drain) {
                int r32e = r32, hie = hi; asm volatile("" : "+v"(r32e), "+v"(hie));
                const f32x4* l4p = (const f32x4*)li + hie; const f32x4 l0 = l4p[0], l1 = l4p[2], l2 = l4p[4], l3 = l4p[6];
                float rli[16];
#pragma unroll
                for (int j = 0; j < 4; ++j) { rli[j] = __builtin_amdgcn_rcpf(l0[j]); rli[4 + j] = __builtin_amdgcn_rcpf(l1[j]); rli[8 + j] = __builtin_amdgcn_rcpf(l2[j]); rli[12 + j] = __builtin_amdgcn_rcpf(l3[j]); }
                const f32x4* m4p = (const f32x4*)(li + 32) + hie; const f32x4 n0 = m4p[0], n1 = m4p[2], n2 = m4p[4], n3 = m4p[6];
                float rlj[16];
#pragma unroll
                for (int j = 0; j < 4; ++j) { rlj[j] = __builtin_amdgcn_rcpf(n0[j]); rlj[4 + j] = __builtin_amdgcn_rcpf(n1[j]); rlj[8 + j] = __builtin_amdgcn_rcpf(n2[j]); rlj[12 + j] = __builtin_amdgcn_rcpf(n3[j]); }
                unsigned short* Ow = ((w4 & 1) ? cur.O1 : cur.O0) + (size_t)((w4 >> 1) * 2 * QBLK) * D;
#pragma unroll
                for (int r = 0; r < 16; r += 2) { const int orow = crow(r, hie);
#pragma unroll
                    for (int d0 = 0; d0 < 4; ++d0) {
                        *(unsigned*)(Ow + (size_t)(orow >> 1) * (2 * D) + (d0 * 32 + r32e) * 2) = cvtpk(o[d0][r] * rli[r], o[d0][r + 1] * rli[r + 1]);
                        *(unsigned*)(Ow + (size_t)((QBLK + orow) >> 1) * (2 * D) + (d0 * 32 + r32e) * 2) = cvtpk(o[4 + d0][r] * rlj[r], o[4 + d0][r + 1] * rlj[r + 1]); } }
            }
            __syncthreads();
        }
    }
}
#undef LD8
#undef VMW2
}
constexpr size_t al256(size_t x) { return (x + 255) & ~(size_t)255; }
constexpr size_t WS_CTL = 0, CTL_ZERO_BYTES = 1u << 20;
constexpr size_t WS_WGU   = CTL_ZERO_BYTES;
constexpr size_t WS_WDN   = WS_WGU  + (size_t)8 * NGU * DM * 2;
constexpr size_t WS_WOUT  = WS_WDN  + (size_t)8 * DM * FF * 2;
constexpr size_t WS_WMEM  = WS_WOUT + (size_t)4 * DM * DM * 2;
constexpr size_t WS_WAIN  = WS_WMEM + (size_t)4 * 1024 * DM * 2;
constexpr size_t WS_WKV   = WS_WAIN + (size_t)2 * NAIN * DM * 2;
constexpr size_t WS_WBIN  = WS_WKV  + (size_t)NKV * DM * 2;
constexpr size_t WS_COS   = WS_WBIN + (size_t)2 * NBIN * DM * 2;
constexpr size_t WS_MEMN  = WS_COS  + (size_t)SEQ * 64 * 4;
constexpr size_t WS_MK    = WS_MEMN + (size_t)4 * 1024 * DM * 2;
constexpr size_t WS_MV    = WS_MK   + (size_t)4 * 1024 * 512 * 2;
constexpr size_t WS_XB    = WS_MV   + (size_t)4 * 1024 * 512 * 2;
constexpr size_t WS_SS    = WS_XB   + (size_t)M * DM * 2;
constexpr size_t WS_XH    = WS_SS   + (size_t)M * 32 * 4;
constexpr size_t WS_HID   = WS_XH   + (size_t)M * DM * 2;
constexpr size_t WS_ZA    = WS_HID  + (size_t)M * FF * 2;
constexpr size_t WS_VSTAT = WS_ZA   + (size_t)M * 3072 * 2;
constexpr size_t WS_QB    = WS_VSTAT + (size_t)M * 24 * 4;
constexpr size_t WS_KSH   = WS_QB   + (size_t)M * 1536 * 2;
constexpr size_t WS_VSH   = WS_KSH  + (size_t)M * 1536 * 2;
constexpr size_t WS_QMB   = WS_VSH  + (size_t)M * 1536 * 2;
constexpr size_t WS_OATT  = WS_QMB  + (size_t)M * 512 * 2;
constexpr size_t WS_CAT   = WS_OATT + (size_t)2 * 96 * SEQ * 128 * 4;
constexpr size_t WS_END   = WS_CAT  + (size_t)M * DM * 2;
static_assert(WS_WGU % 256 == 0 && WS_COS % 256 == 0 && WS_VSTAT % 256 == 0 && WS_QB % 256 == 0 && WS_END % 256 == 0, "ws alignment");

constexpr int RING_OFF = 0, RING_BYTES = 131072;
constexpr int LDSCTL_OFF = 141312, MISC_OFF = LDSCTL_OFF + 320;
constexpr int LDS_BYTES = 147456;
constexpr int NWAVES = 8;

#define GAS __attribute__((address_space(1)))
#define LAS __attribute__((address_space(3)))
typedef unsigned short bf16r;
typedef unsigned v4u __attribute__((ext_vector_type(4)));
typedef unsigned v2u __attribute__((ext_vector_type(2)));
typedef float f32x4 __attribute__((ext_vector_type(4)));
typedef short bf16x8 __attribute__((ext_vector_type(8)));
typedef GAS unsigned gu32;
#define LDS_WAIT() asm volatile("s_waitcnt lgkmcnt(0)" ::: "memory")
#define VM_WAIT() asm volatile("s_waitcnt vmcnt(0)" ::: "memory")
__device__ __forceinline__ unsigned f2bf(float f) { unsigned u = __builtin_bit_cast(unsigned, f); return (u + 0x7fffu + ((u >> 16) & 1u)) >> 16; }
__device__ __forceinline__ unsigned pk2(float lo, float hi) { return f2bf(lo) | (f2bf(hi) << 16); }
__device__ __forceinline__ float bf2f(unsigned short b) { return __builtin_bit_cast(float, ((unsigned)b) << 16); }
__device__ __forceinline__ float wave_sum(float v) {
#pragma unroll
    for (int o = 1; o < 64; o <<= 1) v += __shfl_xor(v, o);
    return v;
}
#define XB_TMO      128
#define XB_XCNT(j)  (256  + 64 * (j))
#define XB_XSUB(j)  (1280 + 64 * (j))
#define XB_XGEN(j)  (2304 + 64 * (j))
#define XB_TOP      3328
#define XB_TOPGEN   3392
#define XCD_BAR_WORDS 3456
#define XB_SPIN_CAP (1u << 18)

__device__ __forceinline__ unsigned xb_ld(unsigned* p)              { return __hip_atomic_load(p, __ATOMIC_RELAXED, __HIP_MEMORY_SCOPE_AGENT); }
__device__ __forceinline__ unsigned xb_add(unsigned* p, unsigned v) { return __hip_atomic_fetch_add(p, v, __ATOMIC_RELAXED, __HIP_MEMORY_SCOPE_AGENT); }
__device__ __forceinline__ unsigned xb_xcc_id() { return (unsigned)__builtin_amdgcn_s_getreg((3 << 11) | 20) & 0xFu; }
#define XB_SPIN(cond, bar) do { unsigned _sp = 0; while (cond) { __builtin_amdgcn_s_sleep(1); \
    if ((++_sp & 255u) == 0u) { if (xb_ld(&(bar)[XB_TMO])) break; if (_sp > XB_SPIN_CAP) { atomicAdd(&(bar)[XB_TMO], 1u); break; } } } } while (0)

struct XcdBarrier {
    unsigned* bar; unsigned x;
    volatile LAS unsigned* st;
};

__device__ __forceinline__ XcdBarrier xcd_barrier_post(unsigned* bar, volatile LAS unsigned* st) {
    XcdBarrier b; b.bar = bar; b.x = xb_xcc_id(); b.st = st;
    if (threadIdx.x == 0) (void)xb_add(&bar[XB_XCNT(b.x)], 1u);
    return b;
}
__device__ __forceinline__ void xcd_barrier_complete(unsigned* bar, unsigned x, unsigned& nloc, unsigned& nx) {
    const unsigned G = gridDim.x * gridDim.y * gridDim.z;
    unsigned sum, cnt, mine, sp = 0u;
    for (;;) {
        sum = 0u; cnt = 0u; mine = 0u;
#pragma unroll
        for (unsigned j = 0; j < 16; ++j) { const unsigned c = xb_ld(&bar[XB_XCNT(j)]); sum += c; cnt += (c > 0u) ? 1u : 0u; mine = (j == x) ? c : mine; }
        if (sum == G) break;
        __builtin_amdgcn_s_sleep(1);
        if ((++sp & 255u) == 0u) { if (xb_ld(&bar[XB_TMO])) break; if (sp > XB_SPIN_CAP) { atomicAdd(&bar[XB_TMO], 1u); break; } }
    }
    nloc = mine > 0u ? mine : 1u; nx = cnt > 0u ? cnt : 1u;
}

__device__ __forceinline__ void xcd_barrier(const XcdBarrier& b) {
    asm volatile("s_waitcnt vmcnt(0)" ::: "memory");
    __syncthreads();
    if (threadIdx.x == 0) {
        unsigned* bar = b.bar;
        __builtin_amdgcn_s_waitcnt(0);
        unsigned nloc = b.st[0], nx = b.st[1];
        if (nloc == 0u) { xcd_barrier_complete(bar, b.x, nloc, nx); b.st[0] = nloc; b.st[1] = nx; }
        const unsigned old = xb_add(&bar[XB_XSUB(b.x)], 1u);
        const unsigned gen = old / nloc;
        if (old + 1u == (gen + 1u) * nloc) {
            __builtin_amdgcn_fence(__ATOMIC_RELEASE, "agent");
            asm volatile("s_waitcnt vmcnt(0)" ::: "memory");
            const unsigned og = xb_add(&bar[XB_TOP], 1u);
            const unsigned tg = og / nx;
            if (og + 1u == (tg + 1u) * nx) xb_add(&bar[XB_TOPGEN], 1u);
            else XB_SPIN(xb_ld(&bar[XB_TOPGEN]) == tg, bar);
            __builtin_amdgcn_fence(__ATOMIC_ACQUIRE, "agent");
            xb_add(&bar[XB_XGEN(b.x)], 1u);
            asm volatile("s_waitcnt vmcnt(0)" ::: "memory");
        } else {
            XB_SPIN(xb_ld(&bar[XB_XGEN(b.x)]) == gen, bar);
            __builtin_amdgcn_fence(__ATOMIC_ACQUIRE, "agent");
            asm volatile("s_waitcnt vmcnt(0)" ::: "memory");
        }
    }
    __syncthreads();
}

#define XB_LSUB(j)  (4096 + 64 * (j))
#define XB_LGEN(j)  (5120 + 64 * (j))
#define XB_XCCTAB   6144
__device__ __forceinline__ void xcd_local_barrier(const XcdBarrier& b) {
    asm volatile("s_waitcnt vmcnt(0)" ::: "memory");
    __syncthreads();
    if (threadIdx.x == 0) {
        unsigned* bar = b.bar;
        __builtin_amdgcn_s_waitcnt(0);
        const unsigned nloc = b.st[0] ? b.st[0] : 1u;
        const unsigned old = xb_add(&bar[XB_LSUB(b.x)], 1u);
        const unsigned gen = old / nloc;
        if (old + 1u == (gen + 1u) * nloc) {
#ifndef LOCAL_BAR_RELEASE
#define LOCAL_BAR_RELEASE 0
#endif
            if (LOCAL_BAR_RELEASE) { __builtin_amdgcn_fence(__ATOMIC_RELEASE, "agent"); asm volatile("s_waitcnt vmcnt(0)" ::: "memory"); }
            __builtin_amdgcn_fence(__ATOMIC_ACQUIRE, "agent");
            xb_add(&bar[XB_LGEN(b.x)], 1u);
            asm volatile("s_waitcnt vmcnt(0)" ::: "memory");
        } else {
            XB_SPIN(xb_ld(&bar[XB_LGEN(b.x)]) == gen, bar);
            __builtin_amdgcn_fence(__ATOMIC_ACQUIRE, "agent");
            asm volatile("s_waitcnt vmcnt(0)" ::: "memory");
        }
    }
    __syncthreads();
}
struct Frame {
    unsigned char* lds_g;
    LAS unsigned char* lds;
    volatile LAS unsigned* MISC;
    gu32* ctl;
    int tid, lane, wave;
    int vcu, G;
    unsigned char* ws;
};

__device__ __forceinline__ void transpose_item(const float* W, int K, int N, bf16r* WT, size_t dst_row0, int k0, int n0, LAS float* scr, int lane, const float* gain) {
    f32x4 v[16]; float gk[16];
#pragma unroll
    for (int i = 0; i < 16; ++i) { const int kk = 4 * i + (lane >> 4); v[i] = *(const f32x4*)(W + (size_t)(k0 + kk) * N + n0 + (lane & 15) * 4); gk[i] = gain ? gain[k0 + kk] : 1.0f; }
#pragma unroll
    for (int i = 0; i < 16; ++i) { const int kk = 4 * i + (lane >> 4); const f32x4 w = v[i] * gk[i];
        LAS float* s = scr + kk * 65 + (lane & 15) * 4; s[0] = w[0]; s[1] = w[1]; s[2] = w[2]; s[3] = w[3]; }
    LDS_WAIT(); asm volatile("" ::: "memory");
    const int c = lane & 7;
#pragma unroll
    for (int j = 0; j < 8; ++j) { const int n = (lane >> 3) + 8 * j; const LAS float* s = scr + (8 * c) * 65 + n;
        v4u o; o.x = pk2(s[0 * 65], s[1 * 65]); o.y = pk2(s[2 * 65], s[3 * 65]); o.z = pk2(s[4 * 65], s[5 * 65]); o.w = pk2(s[6 * 65], s[7 * 65]);
        const size_t row = dst_row0 + n;
        *(v4u*)(WT + (((row >> 8) * (size_t)(K >> 6) + (k0 >> 6)) << 14) + ((row & 255) << 6) + 8 * c) = o; }
    LDS_WAIT(); asm volatile("" ::: "memory");
}
__device__ __forceinline__ bool transpose_group(int& r, const float* src, int cnt, int K, int N, bf16r* dst, bool gu, LAS float* scr, int lane, const float* gain, int gmode) {
    const int nkb = K / 64, nnb = N / 64, per = nkb * nnb;
    if (r >= cnt * per) { r -= cnt * per; return false; }
    const int mi = r / per, q = r % per, kb = q / nnb, nb = q % nnb, n0 = nb * 64;
    size_t drow = n0;
    if (gu) { drow = (n0 < FF) ? (size_t)(n0 / 128) * 256 + (n0 % 128) : (size_t)((n0 - FF) / 128) * 256 + 128 + ((n0 - FF) % 128); }
    const float* gp = gain;
    if (gain) { if (gmode == 1) gp = gain + (size_t)((mi >> 1) * 3 + (mi & 1) * 2) * K; else if (gmode >= 2) gp = gain + (size_t)((mi + (gmode - 2)) * 3 + 1) * K; }
    transpose_item(src + (size_t)mi * K * N, K, N, dst + (size_t)mi * K * N, gu ? drow : (size_t)n0, kb * 64, n0, scr, lane, gp);
    return true;
}
__device__ __forceinline__ void norm_row(const float* xrow, const float* gain, bf16r* orow, int lane) {
    const f32x4* xr = (const f32x4*)xrow + lane; f32x4 v[8]; float s = 0.f;
#pragma unroll
    for (int j = 0; j < 8; ++j) { v[j] = xr[64 * j]; s += (v[j][0] * v[j][0] + v[j][1] * v[j][1]) + (v[j][2] * v[j][2] + v[j][3] * v[j][3]); }
    const float rstd = 1.0f / sqrtf(wave_sum(s) * (1.0f / DM) + EPS);
    const f32x4* g4 = (const f32x4*)gain + lane; v2u* o8 = (v2u*)orow + lane;
#pragma unroll
    for (int j = 0; j < 8; ++j) { const f32x4 g = g4[64 * j]; v2u w; w.x = pk2(v[j][0] * rstd * g[0], v[j][1] * rstd * g[1]); w.y = pk2(v[j][2] * rstd * g[2], v[j][3] * rstd * g[3]); o8[64 * j] = w; }
}
__device__ __forceinline__ void xb_ss_phase(const Frame& F, const float* x, bf16r* xb, float* ss) {
    const int gw = F.vcu * NWAVES + F.wave, NGW = F.G * NWAVES, lane = F.lane;
    for (int m = gw; m < M; m += NGW) { const f32x4* xr = (const f32x4*)(x + (size_t)m * DM) + lane; float s = 0.f;
#pragma unroll
        for (int j = 0; j < 8; ++j) { const f32x4 v = xr[64 * j]; s += (v[0] * v[0] + v[1] * v[1]) + (v[2] * v[2] + v[3] * v[3]); v2u w; w.x = pk2(v[0], v[1]); w.y = pk2(v[2], v[3]); const int col = 4 * lane + 256 * j; *(v2u*)(xb + (((size_t)((m >> 8) * (DM >> 6) + (col >> 6))) << 14) + ((m & 255) << 6) + (col & 63)) = w; }
        s = wave_sum(s); if (lane < 32) ss[(size_t)m * 32 + lane] = (lane == 0) ? s : 0.f; }
}
__device__ __forceinline__ void sincos_d(float angf, float& sn, float& cs) {
    const double a = (double)angf; const double k = __builtin_rint(a * 0.15915494309189535); const double r = a - k * 6.283185307179586476925286766559;
    const double r2 = r * r; double ts = r, tc = 1.0, ss = r, cc = 1.0;
#pragma unroll
    for (int n = 1; n <= 14; ++n) { tc = -tc * r2 / (double)((2 * n - 1) * (2 * n)); ts = -ts * r2 / (double)((2 * n) * (2 * n + 1)); cc += tc; ss += ts; }
    sn = (float)ss; cs = (float)cc;
}
__device__ __forceinline__ void combine_phase(const Frame& F, const bf16r* oatt  , const float* lamp  , const float* subg  , float lam_init, bf16r* cat) {
    const int gw = F.vcu * NWAVES + F.wave, NGW = F.G * NWAVES, lane = F.lane;
    const float d01 = wave_sum(lamp[lane] * lamp[128 + lane] + lamp[64 + lane] * lamp[192 + lane]);
    const float d23 = wave_sum(lamp[256 + lane] * lamp[384 + lane] + lamp[320 + lane] * lamp[448 + lane]);
    const float lam = expf(d01) - expf(d23) + lam_init;
    const int half = lane >> 5, d4 = (lane & 31) * 4; const f32x4 g = *(const f32x4*)(subg + half * 128 + d4) * (1.0f - lam_init);
    const bool own = F.G == 256; const int p0 = own ? 1024 * ((int)blockIdx.x & 7) + ((int)blockIdx.x >> 3) * NWAVES + F.wave : gw, pstep = own ? 256 : NGW, pend = own ? 1024 * ((int)blockIdx.x & 7) + 1024 : M / 2;
    for (int pi = p0; pi < pend; pi += pstep) { const int m = 2 * pi, b = m >> 12, s = m & 4095;
        f32x4 o[2][DH]; float ss[2][DH];
#pragma unroll
        for (int h = 0; h < DH; ++h) { const size_t vh0 = (size_t)((b * 6 + h) * 2 + 0) * 2 + half, vh1 = (size_t)((b * 6 + h) * 2 + 1) * 2 + half;
            const v4u r0 = *(const v4u*)(oatt + (vh0 * SEQ + s) * 128 + d4 * 2), r1 = *(const v4u*)(oatt + (vh1 * SEQ + s) * 128 + d4 * 2);
#pragma unroll
            for (int e = 0; e < 2; ++e) {
                const f32x4 a = e ? (f32x4){__builtin_bit_cast(float, r0.x & 0xffff0000u), __builtin_bit_cast(float, r0.y & 0xffff0000u), __builtin_bit_cast(float, r0.z & 0xffff0000u), __builtin_bit_cast(float, r0.w & 0xffff0000u)}
                                  : (f32x4){__builtin_bit_cast(float, r0.x << 16), __builtin_bit_cast(float, r0.y << 16), __builtin_bit_cast(float, r0.z << 16), __builtin_bit_cast(float, r0.w << 16)};
                const f32x4 c = e ? (f32x4){__builtin_bit_cast(float, r1.x & 0xffff0000u), __builtin_bit_cast(float, r1.y & 0xffff0000u), __builtin_bit_cast(float, r1.z & 0xffff0000u), __builtin_bit_cast(float, r1.w & 0xffff0000u)}
                                  : (f32x4){__builtin_bit_cast(float, r1.x << 16), __builtin_bit_cast(float, r1.y << 16), __builtin_bit_cast(float, r1.z << 16), __builtin_bit_cast(float, r1.w << 16)};
                o[e][h] = a - c * lam; ss[e][h] = (o[e][h][0] * o[e][h][0] + o[e][h][1] * o[e][h][1]) + (o[e][h][2] * o[e][h][2] + o[e][h][3] * o[e][h][3]); } }
#pragma unroll
        for (int sh = 1; sh < 64; sh <<= 1) {
#pragma unroll
            for (int h = 0; h < DH; ++h) { ss[0][h] += __shfl_xor(ss[0][h], sh); ss[1][h] += __shfl_xor(ss[1][h], sh); } }
#pragma unroll
        for (int e = 0; e < 2; ++e)
#pragma unroll
            for (int h = 0; h < DH; ++h) { const float rstd = 1.0f / sqrtf(ss[e][h] * (1.0f / DV) + EPS);
                v2u w; w.x = pk2(o[e][h][0] * rstd * g[0], o[e][h][1] * rstd * g[1]); w.y = pk2(o[e][h][2] * rstd * g[2], o[e][h][3] * rstd * g[3]);
                *(v2u*)(cat + (size_t)(m + e) * DM + h * 256 + half * 128 + d4) = w; }
    }
}

constexpr int GM_WL = 0, GM_WLS = 272, GM_VT = 128 * GM_WLS, GM_VTS = 272, GM_RS = GM_VT + 256 * GM_VTS;
static_assert(GM_RS + 512 <= RING_BYTES, "gmlp LDS");
__device__ __forceinline__ void gmlp_phase(const Frame& F, const bf16r* ZA, const float* vstat, const float* w_s  , const float* b_s  , const float* gv  , bf16r* cat) {
    const int tid = F.tid, lane = F.lane, wave = F.wave, fr = lane & 15, fq = lane >> 4;
    LAS unsigned char* lds = F.lds;
    LAS float* rs = (LAS float*)(lds + GM_RS);
    const bool own = F.G == 256; const int xg = (int)blockIdx.x & 7, jg = (int)blockIdx.x >> 3;
    for (int unit = own ? jg : F.vcu; unit < (own ? 96 : 128 * GG); unit += own ? 32 : F.G) {
        const int bc = own ? 16 * xg + unit / GG : unit / GG, g = unit % GG, r0 = bc * 128;
        if (tid < 128) { const f32x4* p = (const f32x4*)(vstat + (size_t)(r0 + tid) * 24); float s = 0.f;
#pragma unroll
            for (int i = 0; i < 6; ++i) { const f32x4 v = p[i]; s += (v[0] + v[1]) + (v[2] + v[3]); }
            rs[tid] = 1.0f / sqrtf(s * (1.0f / MIXW) + EPS); }
        { const int s = tid & 127, cb = (tid >> 7) * 8;
#pragma unroll
          for (int it = 0; it < 8; ++it) { const int d8 = (cb + it) * 8; const bf16x8 v = *(const bf16x8*)(ZA + (size_t)(r0 + s) * 3072 + 1536 + g * 256 + d8);
#pragma unroll
              for (int e = 0; e < 8; ++e) *(LAS unsigned short*)(lds + GM_VT + (d8 + e) * GM_VTS + s * 2) = (unsigned short)v[e]; } }
        __syncthreads();
        for (int idx = tid; idx < 128 * 32; idx += 512) { const int t = idx >> 5, s4 = (idx & 31) * 4; const f32x4 w = *(const f32x4*)(w_s + ((size_t)g * 128 + t) * 128 + s4);
            float e[4];
#pragma unroll
            for (int j = 0; j < 4; ++j) e[j] = (s4 + j <= t) ? w[j] * rs[s4 + j] : 0.f;
            v2u o; o.x = pk2(e[0], e[1]); o.y = pk2(e[2], e[3]); *(LAS v2u*)(lds + GM_WL + t * GM_WLS + s4 * 2) = o; }
        __syncthreads();
        f32x4 acc[8][2];
#pragma unroll
        for (int tt = 0; tt < 8; ++tt) { acc[tt][0] = (f32x4){0.f, 0.f, 0.f, 0.f}; acc[tt][1] = (f32x4){0.f, 0.f, 0.f, 0.f}; }
#pragma unroll
        for (int ks = 0; ks < 4; ++ks) {
            bf16x8 bfr[2];
#pragma unroll
            for (int dd = 0; dd < 2; ++dd) bfr[dd] = *(const LAS bf16x8*)(lds + GM_VT + (32 * wave + 16 * dd + fr) * GM_VTS + (32 * ks + 8 * fq) * 2);
#pragma unroll
            for (int tt = 0; tt < 8; ++tt) { if (32 * ks <= 16 * tt + 15) {
                const bf16x8 afr = *(const LAS bf16x8*)(lds + GM_WL + (16 * tt + fr) * GM_WLS + (32 * ks + 8 * fq) * 2);
#pragma unroll
                for (int dd = 0; dd < 2; ++dd) acc[tt][dd] = __builtin_amdgcn_mfma_f32_16x16x32_bf16(bfr[dd], afr, acc[tt][dd], 0, 0, 0); } }
        }
#pragma unroll
        for (int tt = 0; tt < 8; ++tt) { const int t = 16 * tt + fr, row = r0 + t; const float bias = b_s[g * 128 + t];
#pragma unroll
            for (int dd = 0; dd < 2; ++dd) { const int d = 32 * wave + 16 * dd + 4 * fq; const f32x4 gg = *(const f32x4*)(gv + g * 256 + d);
                const v2u uu = *(const v2u*)(ZA + (size_t)row * 3072 + g * 256 + d);
                const float u0 = bf2f((unsigned short)(uu.x & 0xffff)), u1 = bf2f((unsigned short)(uu.x >> 16)), u2 = bf2f((unsigned short)(uu.y & 0xffff)), u3 = bf2f((unsigned short)(uu.y >> 16));
                const f32x4 a = acc[tt][dd]; v2u o; o.x = pk2(u0 * (a[0] * gg[0] + bias), u1 * (a[1] * gg[1] + bias)); o.y = pk2(u2 * (a[2] * gg[2] + bias), u3 * (a[3] * gg[3] + bias));
                *(v2u*)(cat + (size_t)row * DM + g * 256 + d) = o; } }
        __syncthreads();
    }
}
namespace att {
__device__ __forceinline__ BlockRef<bf16, float> diff_ref(int L, int pass, const bf16* Q, const bf16* K, const bf16* V, float* O) {
    const int vh = L >> 3, x = L & 7, qb = pass ? 15 - x : x;
    const int b = vh / 24, r = vh % 24, h = r >> 2, c = (r >> 1) & 1, half = r & 1;
    BlockRef<bf16, float> R;
    R.Q = Q + ((size_t)((b * 2 + c) * 6 + h) * SEQ + (size_t)qb * QB) * D; R.K = K + (size_t)((b * 2 + c) * 6 + h) * SEQ * D; R.V = V + (size_t)((b * 6 + h) * 2 + half) * SEQ * D;
    R.O = O + ((size_t)vh * SEQ + (size_t)qb * QB) * D; R.P0 = qb * QB; R.ldo = D;
    return R;
}
__device__ __forceinline__ void diff_attn_phase(char* lds, const bf16* Q, const bf16* K, const bf16* V, float* O, int G, int c0) {
    constexpr int total = 96 * 8; const int W = 1 << 30;
    int L = c0; if (L >= total) return;
    int pass = 0; BlockRef<bf16, float> cur = diff_ref(L, 0, Q, K, V, O);
    Seam<bf16> S;
    causal_swa_prime<bf16, float>(cur, W, lds, S);
    for (;;) {
        const bool more_pass = pass == 0, more_item = L + G < total, last = !more_pass && !more_item;
        int passn = pass + 1, Ln = L;
        if (!more_pass) { passn = 0; Ln = more_item ? L + G : L; }
        const BlockRef<bf16, float> nxt = last ? cur : diff_ref(Ln, passn, Q, K, V, O);
        causal_swa_block<bf16, float>(cur, nxt, SEQ, W, lds, S);
        if (last) break;
        cur = nxt; pass = passn; L = Ln;
    }
}
__device__ __forceinline__ Ref2 diff_ref2(int L, int pass, const bf16* Q, const bf16* K, const bf16* V, unsigned short* O) {
    const int bhc = L >> 4, x = L & 15, qb = pass ? 31 - x : x;
    const int b = bhc / 12, r = bhc % 12, h = r >> 1, c = r & 1;
    Ref2 R; const size_t qk = (size_t)((b * 2 + c) * 6 + h) * SEQ;
    R.Q = Q + (qk + (size_t)qb * QB2) * D; R.K = K + qk * D;
    R.V0 = V + (size_t)((b * 6 + h) * 2) * SEQ * D; R.V1 = R.V0 + (size_t)SEQ * D;
    const size_t vh = (size_t)b * 24 + h * 4 + c * 2;
    R.O0 = O + (vh * SEQ + (size_t)qb * QB2) * D; R.O1 = R.O0 + (size_t)SEQ * D; R.P0 = qb * QB2;
    return R;
}
template <bool RS>
__device__ __forceinline__ void diff_attn2_role(char* lds, float* xl, const bf16* Q, const bf16* K, const bf16* V, unsigned short* O, int G, int c0) {
    constexpr int total = 48 * 16;
    int L = c0; if (L >= total) return;
    int pass = 0; Ref2 cur = diff_ref2(L, 0, Q, K, V, O);
    Seam2 S;
    diff2_prime<RS>(cur, lds, S);
    for (;;) {
        const bool more_pass = pass == 0, more_item = L + G < total, last = !more_pass && !more_item;
        int passn = pass + 1, Ln = L;
        if (!more_pass) { passn = 0; Ln = more_item ? L + G : L; }
        const Ref2 nxt = last ? cur : diff_ref2(Ln, passn, Q, K, V, O);
        diff2_block<RS>(cur, nxt, lds, xl, S);
        if (last) break;
        cur = nxt; pass = passn; L = Ln;
    }
}
__device__ __forceinline__ void diff_attn2_phase(char* lds, float* xl, const bf16* Q, const bf16* K, const bf16* V, unsigned short* O, int G, int c0) {
    if (__builtin_amdgcn_readfirstlane((int)threadIdx.x >> 6) < 4) diff_attn2_role<true>(lds, xl, Q, K, V, O, G, c0);
    else diff_attn2_role<false>(lds, xl, Q, K, V, O, G, c0);
}
__device__ __forceinline__ BlockRef<bf16, bf16> mem_ref(int L, const bf16* Q, const bf16* K, const bf16* V, bf16* cat) {
    const int bh = L >> 4, qb = L & 15, b = bh >> 2, hm = bh & 3;
    BlockRef<bf16, bf16> R;
    R.Q = Q + ((size_t)bh * SEQ + (size_t)qb * QB) * D; R.K = K + (size_t)bh * MEML * D; R.V = V + (size_t)bh * MEML * D;
    R.O = cat + ((size_t)b * SEQ + (size_t)qb * QB) * DM + 1536 + hm * 128; R.P0 = 256; R.ldo = DM;
    return R;
}
__device__ __forceinline__ void mem_attn_phase(char* lds, const bf16* Q, const bf16* K, const bf16* V, bf16* cat, int G, int c0) {
    constexpr int total = 256; const int W = 1 << 30;
    int L = c0; if (L >= total) return;
    BlockRef<bf16, bf16> cur = mem_ref(L, Q, K, V, cat);
    Seam<bf16> S;
    causal_swa_prime<bf16, bf16>(cur, W, lds, S);
    for (;;) {
        const bool last = L + G >= total;
        const BlockRef<bf16, bf16> nxt = last ? cur : mem_ref(L + G, Q, K, V, cat);
        causal_swa_block<bf16, bf16>(cur, nxt, MEML, W, lds, S);
        if (last) break;
        cur = nxt; L += G;
    }
}

struct DynAttn { unsigned* qcnt; const unsigned* rq; const unsigned* rkv; unsigned tag; unsigned* tmo; volatile __attribute__((address_space(3))) unsigned* bc; };
__device__ __forceinline__ unsigned dyn_pull(const DynAttn& C, int bpref) {
    if (threadIdx.x == 0) {
        unsigned code = 0xffffffffu;
        for (unsigned spins = 0;; ++spins) {
            bool any_left = false;
#pragma unroll 1
            for (int k = 0; k < 4 && code == 0xffffffffu; ++k) { const int b = (bpref + k) & 3;
                if (__hip_atomic_load(C.qcnt + 64 * b, __ATOMIC_RELAXED, __HIP_MEMORY_SCOPE_AGENT) >= 384u) continue;
                any_left = true;
                const bool ready = __hip_atomic_load(C.rq + 64 * (2 * b), __ATOMIC_RELAXED, __HIP_MEMORY_SCOPE_AGENT) == C.tag && __hip_atomic_load(C.rq + 64 * (2 * b + 1), __ATOMIC_RELAXED, __HIP_MEMORY_SCOPE_AGENT) == C.tag &&
                                   __hip_atomic_load(C.rkv + 64 * (2 * b), __ATOMIC_RELAXED, __HIP_MEMORY_SCOPE_AGENT) != 0u && __hip_atomic_load(C.rkv + 64 * (2 * b + 1), __ATOMIC_RELAXED, __HIP_MEMORY_SCOPE_AGENT) != 0u;
                if (!ready) continue;
                const unsigned n = __hip_atomic_fetch_add(C.qcnt + 64 * b, 1u, __ATOMIC_RELAXED, __HIP_MEMORY_SCOPE_AGENT);
                if (n < 384u) code = ((unsigned)b << 16) | n;
            }
            if (code != 0xffffffffu || !any_left) break;
            __builtin_amdgcn_s_sleep(8);
            if ((spins & 255u) == 255u) { if (__hip_atomic_load(C.tmo, __ATOMIC_RELAXED, __HIP_MEMORY_SCOPE_AGENT)) break; if (spins > (1u << 20)) { __hip_atomic_store(C.tmo, 1u, __ATOMIC_RELAXED, __HIP_MEMORY_SCOPE_AGENT); break; } }
        }
        __builtin_amdgcn_fence(__ATOMIC_ACQUIRE, "agent");
        asm volatile("s_waitcnt vmcnt(0)" ::: "memory");
        C.bc[0] = code;
    }
    __syncthreads();
    const unsigned code = C.bc[0];
    __syncthreads();
    return code;
}
__device__ __forceinline__ BlockRef<bf16, float> dyn_ref(unsigned code, const bf16* Q, const bf16* K, const bf16* V, float* O) {
    const int b = (int)(code >> 16), n = (int)(code & 0xffffu), qb = 15 - (n & 15), r = n >> 4, h = r >> 2, c = (r >> 1) & 1, half = r & 1, vh = b * 24 + r;
    BlockRef<bf16, float> R;
    R.Q = Q + ((size_t)((b * 2 + c) * 6 + h) * SEQ + (size_t)qb * QB) * D; R.K = K + (size_t)((b * 2 + c) * 6 + h) * SEQ * D; R.V = V + (size_t)((b * 6 + h) * 2 + half) * SEQ * D;
    R.O = O + ((size_t)vh * SEQ + (size_t)qb * QB) * D; R.P0 = qb * QB; R.ldo = D;
    return R;
}
__device__ __forceinline__ void diff_attn_dyn_phase(char* lds, const bf16* Q, const bf16* K, const bf16* V, float* O, const DynAttn& C, int bpref) {
    const int W = 1 << 30;
    unsigned code = dyn_pull(C, bpref); if (code == 0xffffffffu) return;
    BlockRef<bf16, float> cur = dyn_ref(code, Q, K, V, O);
    Seam<bf16> S;
    causal_swa_prime<bf16, float>(cur, W, lds, S);
    for (;;) {
        const unsigned nc = dyn_pull(C, bpref); const bool last = nc == 0xffffffffu;
        const BlockRef<bf16, float> nxt = last ? cur : dyn_ref(nc, Q, K, V, O);
        causal_swa_block<bf16, float>(cur, nxt, SEQ, W, lds, S);
        if (last) break;
        cur = nxt;
    }
}
}

constexpr int NPL = 8, PH_BASE = 1, NPH = PH_BASE + DEPTH * NPL;
enum { I_X = 0, I_MEM, I_NORMG, I_WGU, I_WDN, I_WOUT, I_MEMNG, I_MEMWKV, I_MEMQG, I_MEMKG, I_AWIN, I_AVG, I_AWS, I_ABS, I_KVG, I_WKV, I_KG, I_BWIN, I_BQG, I_BLAM, I_BSUBG, N_IN };
struct Args { const float* in[N_IN]; float* out; unsigned char* ws; int ph_lo, ph_hi, li, pad; };

#ifndef EN_MASK
#define EN_MASK 0xFFFFFFFFu
#endif
#define SITE(n) (((EN_MASK) >> (n)) & 1u)
#define IN(k) (lo <= (k) && (k) < hi)
#ifndef PROBE_WAIT
#define PROBE_WAIT 0
#endif
#ifndef PROBE_PHASE
#define PROBE_PHASE 0
#endif
#ifndef LOCAL_SEAMS
#define LOCAL_SEAMS 1
#endif
#define SEAM_X(k, local) do { if (IN((k) + 1)) { unsigned long long t0_ = 0; if (PROBE_WAIT) t0_ = __builtin_amdgcn_s_memrealtime(); \
    if (LOCAL_SEAMS && (local) && F.MISC[24] != 0u) xcd_local_barrier(bar); else xcd_barrier(bar); \
    if (PROBE_WAIT && ((PROBE_WAIT >> CUR_SITE) & 1) && F.tid == 0) F.MISC[16] += (unsigned)(__builtin_amdgcn_s_memrealtime() - t0_); \
    } \
    if (PROBE_PHASE && ((PROBE_PHASE >> CUR_SITE) & 1) && F.tid == 0) F.MISC[17] += (unsigned)(__builtin_amdgcn_s_memrealtime() - tsite_); } while (0)
#define SEAM(k) SEAM_X(k, false)
#define SEAM_L(k) SEAM_X(k, true)
constexpr int CW_RQ = 70016, CW_RKV = 70656, CW_QCNT = 71296;
#define PUBLISH_FLAG(word, val) do { if (blockIdx.x < 8 && F.tid == 0) { __builtin_amdgcn_fence(__ATOMIC_RELEASE, "agent"); asm volatile("s_waitcnt vmcnt(0)" ::: "memory"); \
    __hip_atomic_store((unsigned*)F.ctl + (word) + 64 * (blockIdx.x & 7), (unsigned)(val), __ATOMIC_RELAXED, __HIP_MEMORY_SCOPE_AGENT); } } while (0)
#define SITE_T0 unsigned long long tsite_ = 0; if (PROBE_PHASE) tsite_ = __builtin_amdgcn_s_memrealtime(); (void)tsite_;
#define CAS __attribute__((address_space(4)))
#define WS_PTRS \
    const CAS Args* ap = (const CAS Args*)__builtin_amdgcn_kernarg_segment_ptr(); asm volatile("" : "+s"(ap)); \
    unsigned char* const ws = ap->ws; \
    bf16r* const Wgu = (bf16r*)(ws + WS_WGU); bf16r* const Wdn = (bf16r*)(ws + WS_WDN); bf16r* const Wout = (bf16r*)(ws + WS_WOUT); bf16r* const Wmem = (bf16r*)(ws + WS_WMEM); \
    bf16r* const Wain = (bf16r*)(ws + WS_WAIN); bf16r* const Wkv = (bf16r*)(ws + WS_WKV); bf16r* const Wbin = (bf16r*)(ws + WS_WBIN); \
    unsigned* const CS = (unsigned*)(ws + WS_COS); \
    bf16r* const MEMN = (bf16r*)(ws + WS_MEMN); bf16r* const MK = (bf16r*)(ws + WS_MK); bf16r* const MV = (bf16r*)(ws + WS_MV); \
    bf16r* const XB = (bf16r*)(ws + WS_XB); float* const SS = (float*)(ws + WS_SS); _Float16* const XH = (_Float16*)(ws + WS_XH); bf16r* const HID = (bf16r*)(ws + WS_HID); bf16r* const ZA = (bf16r*)(ws + WS_ZA); \
    float* const VSTAT = (float*)(ws + WS_VSTAT); \
    bf16r* const QB_ = (bf16r*)(ws + WS_QB); bf16r* const KSH = (bf16r*)(ws + WS_KSH); bf16r* const VSH = (bf16r*)(ws + WS_VSH); bf16r* const QMB = (bf16r*)(ws + WS_QMB); \
    float* const OATT = (float*)(ws + WS_OATT); bf16r* const CAT = (bf16r*)(ws + WS_CAT); \
    float* const X = ap->out; \
    (void)Wgu; (void)Wdn; (void)Wout; (void)Wmem; (void)Wain; (void)Wkv; (void)Wbin; (void)CS; (void)MEMN; (void)MK; (void)MV; (void)XB; (void)SS; (void)XH; (void)HID; (void)ZA; \
    (void)VSTAT; (void)QB_; (void)KSH; (void)VSH; (void)QMB; (void)OATT; (void)CAT; (void)X;

constexpr int EX_OFF = RING_BYTES + 2048;
constexpr int RTAB_OFF = RING_BYTES;
__device__ __forceinline__ pg8::RowScale fill_rstd(const Frame& F, const float* ss, const pg8::StaticOrder& So) {
    pg8::Unit u0; const int pm0 = So.next(0, u0) ? u0.pm : -1;
    { pg8::Unit ui; bool same = true; for (int i = 1; So.next(i, ui); ++i) same &= (ui.pm == pm0); if (!same && F.tid == 0) __hip_atomic_store((unsigned*)F.ctl + XB_TMO, 1u, __ATOMIC_RELAXED, __HIP_MEMORY_SCOPE_AGENT); }
    LAS float* tab = (LAS float*)(F.lds + RTAB_OFF);
    __syncthreads();
    if (pm0 >= 0 && F.tid < 256) { const f32x4* p = (const f32x4*)(ss + (size_t)(pm0 * 256 + F.tid) * 32); float s = 0.f;
#pragma unroll
        for (int i = 0; i < 8; ++i) { const f32x4 v = p[i]; s += (v[0] + v[1]) + (v[2] + v[3]); }
        const float v = s * (1.0f / DM) + EPS; tab[2 * F.tid] = 1.0f / sqrtf(v); tab[2 * F.tid + 1] = v; }
    __syncthreads();
    return pg8::RowScale{(const LAS float*)tab};
}
#ifndef RESID_BF16_TAIL
#define RESID_BF16_TAIL 1
#endif
#ifndef ATTN2
#define ATTN2 1
#endif
#ifndef DYN_ATTN
#define DYN_ATTN 0
#endif
template <int L, int S>
__device__ __forceinline__ void ffn_part(const Frame& F, const XcdBarrier& bar, unsigned char* smem, const int lo, const int hi) {
    constexpr int pf = PH_BASE + L * NPL + (S ? 6 : 0);
    if (SITE(3) && IN(pf)) { constexpr int CUR_SITE = 3; (void)CUR_SITE; SITE_T0 WS_PTRS
        pg8::Gemm g{XB, Wgu + (size_t)(L * 2 + S) * NGU * DM, M, NGU, DM}; pg8::StaticOrder So; So.init(M, NGU, F.G, (int)blockIdx.x);
        pg8::EpiSwiglu E{HID, FF, fill_rstd(F, SS, So)};
        pg8::gemm_phase<pg8::EpiSwiglu, pg8::StaticOrder, true, true, true, true>(F.lds + RING_OFF, g, So, E);
        if constexpr (L == NA && S == 0) {
            pg8::Gemm g2{XB, Wkv, M, NKV, DM}; pg8::StaticOrder S2; S2.init(M, NKV, F.G, (int)blockIdx.x);
            pg8::EpiQKRope E2{1, KSH, VSH, ap->in[I_KG], nullptr, CS, (LAS float*)(F.lds + EX_OFF), fill_rstd(F, SS, S2)};
            pg8::gemm_phase<pg8::EpiQKRope, pg8::StaticOrder, true, true, true, true>(F.lds + RING_OFF, g2, S2, E2);
        }
        SEAM_L(pf);
        if constexpr (L == NA && S == 0) { if (DYN_ATTN && IN(pf + 1)) PUBLISH_FLAG(CW_RKV, 1u); }
    }
    if (SITE(4) && IN(pf + 1)) { constexpr int CUR_SITE = 4; (void)CUR_SITE; SITE_T0 WS_PTRS
        pg8::Gemm g{HID, Wdn + (size_t)(L * 2 + S) * DM * FF, M, DM, FF}; pg8::ColSweepOrder So{(int)blockIdx.x};
        pg8::EpiResid E{(L == 0 && S == 0) ? ap->in[I_X] : nullptr, (L == DEPTH - 1 && S == 1) ? X : nullptr, DM, 0.5f, XB, SS, XH, RESID_BF16_TAIL ? (L < NA ? 0 : (L == NA && S == 0) ? 2 : 1) : 0};
        pg8::gemm_phase<pg8::EpiResid, pg8::ColSweepOrder, true, true, true, true>(F.lds + RING_OFF, g, So, E);
        SEAM_L(pf + 1);
    }
}
template <int L>
__device__ __forceinline__ void mixer_part(const Frame& F, const XcdBarrier& bar, unsigned char* smem, const int lo, const int hi) {
    constexpr int pb = PH_BASE + L * NPL;
    if (SITE(6) && IN(pb + 2)) { constexpr int CUR_SITE = 6; (void)CUR_SITE; SITE_T0 WS_PTRS
        if constexpr (L < NA) { pg8::Gemm g{XB, Wain + (size_t)L * NAIN * DM, M, NAIN, DM}; pg8::StaticOrder So; So.init(M, NAIN, F.G, (int)blockIdx.x);
            pg8::EpiAin E{ZA, VSTAT, QMB, ap->in[I_MEMQG] + L * HD, (LAS float*)(F.lds + EX_OFF), fill_rstd(F, SS, So)};
            pg8::gemm_phase<pg8::EpiAin, pg8::StaticOrder, true, true, true, true>(F.lds + RING_OFF, g, So, E);
            if constexpr (L == 0) {
                if ((int)blockIdx.x >= 128) { pg8::Gemm gm{MEMN, Wmem, 4096, 4096, DM}; pg8::MemKvOrder Sm{F.G, (int)blockIdx.x - 128};
                    pg8::EpiMemKv Em{MK, MV, ap->in[I_MEMKG], (LAS float*)(F.lds + EX_OFF)};
                    pg8::gemm_phase<pg8::EpiMemKv, pg8::MemKvOrder, true, true, false, true>(F.lds + RING_OFF, gm, Sm, Em); } } }
        else { pg8::Gemm g{XB, Wbin + (size_t)(L - NA) * NBIN * DM, M, NBIN, DM}; pg8::StaticOrder So; So.init(M, NBIN, F.G, (int)blockIdx.x);
            pg8::EpiQKRope E{0, QB_, QMB, ap->in[I_BQG] + (L - NA) * HD, ap->in[I_MEMQG] + L * HD, CS, (LAS float*)(F.lds + EX_OFF), fill_rstd(F, SS, So)};
            pg8::gemm_phase<pg8::EpiQKRope, pg8::StaticOrder, true, true, true, true>(F.lds + RING_OFF, g, So, E); }
        if constexpr (L == 1 || (L >= NA && DYN_ATTN)) SEAM_L(pb + 2); else SEAM(pb + 2);
        if constexpr (L >= NA) { if (DYN_ATTN && IN(pb + 3)) PUBLISH_FLAG(CW_RQ, (unsigned)L); }
    }
    if (SITE(8) && IN(pb + 3)) { constexpr int CUR_SITE = 8; (void)CUR_SITE; SITE_T0 WS_PTRS
        if constexpr (L < NA) gmlp_phase(F, ZA, VSTAT, ap->in[I_AWS] + (size_t)L * GG * 128 * 128, ap->in[I_ABS] + (size_t)L * GG * 128, ap->in[I_AVG] + (size_t)L * MIXW, CAT);
        { const int xg = (int)blockIdx.x & 7, jg = (int)blockIdx.x >> 3, pnl = 8 * xg + (jg >> 2);
          const int c0 = ((L < NA || DYN_ATTN) && F.G == 256) ? (((pnl >> 4) * 4 + (jg & 3)) * 16 + (pnl & 15)) : F.vcu;
          att::mem_attn_phase((char*)smem, (const att::bf16*)QMB, (const att::bf16*)(MK + (size_t)L * 1024 * 512), (const att::bf16*)(MV + (size_t)L * 1024 * 512), (att::bf16*)CAT, F.G, c0); }
        if constexpr (L >= NA) {
            float* const Ol = OATT + (size_t)(L - NA) * 96 * SEQ * 128;
            if (DYN_ATTN) { const att::DynAttn C{(unsigned*)F.ctl + CW_QCNT + 64 * 4 * (L - NA), (const unsigned*)F.ctl + CW_RQ, (const unsigned*)F.ctl + CW_RKV, (unsigned)L, (unsigned*)F.ctl + XB_TMO, F.MISC + 28};
                att::diff_attn_dyn_phase((char*)smem, (const att::bf16*)QB_, (const att::bf16*)KSH, (const att::bf16*)VSH, Ol, C, ((int)blockIdx.x & 7) >> 1); }
            else if (ATTN2) att::diff_attn2_phase((char*)smem, (float*)(smem + 133120), (const att::bf16*)QB_, (const att::bf16*)KSH, (const att::bf16*)VSH, (unsigned short*)Ol, F.G, F.vcu);
            else att::diff_attn_phase((char*)smem, (const att::bf16*)QB_, (const att::bf16*)KSH, (const att::bf16*)VSH, Ol, F.G, F.vcu);
        }
        if constexpr (L < NA) SEAM_L(pb + 3); else SEAM(pb + 3);
    }
    if constexpr (L >= NA) {
        if (SITE(9) && IN(pb + 4)) { constexpr int CUR_SITE = 9; (void)CUR_SITE; SITE_T0 WS_PTRS constexpr float lam_init = (L == 2) ? 0.47071301834358416f : 0.5560582041556405f;
            combine_phase(F, (const bf16r*)(OATT + (size_t)(L - NA) * 96 * SEQ * 128), ap->in[I_BLAM] + (size_t)(L - NA) * 512, ap->in[I_BSUBG] + (size_t)(L - NA) * DV, lam_init, CAT);
            SEAM_L(pb + 4); }
    }
    if (SITE(10) && IN(pb + 5)) { constexpr int CUR_SITE = 10; (void)CUR_SITE; SITE_T0 WS_PTRS
        pg8::Gemm g{CAT, Wout + (size_t)L * DM * DM, M, DM, DM}; pg8::ColSweepOrder So{(int)blockIdx.x};
        pg8::EpiResid E{nullptr, nullptr, DM, 1.0f, XB, SS, XH, (RESID_BF16_TAIL && L >= NA) ? 1 : 0};
        pg8::gemm_phase<pg8::EpiResid, pg8::ColSweepOrder, true, true, false, true>(F.lds + RING_OFF, g, So, E);
        SEAM_L(pb + 5);
    }
}

__global__ void __launch_bounds__(NWAVES * 64, 2) yoco_fwd(Args args) {
    extern __shared__ __attribute__((aligned(16))) unsigned char smem[];
    Frame F;
    F.lds_g = smem; F.lds = (LAS unsigned char*)smem;
    F.MISC = (volatile LAS unsigned*)(F.lds + MISC_OFF);
    F.tid = threadIdx.x; F.lane = F.tid & 63; F.wave = __builtin_amdgcn_readfirstlane(F.tid >> 6);
    F.G = gridDim.x; { const int bx = blockIdx.x; F.vcu = (F.G % 8 == 0) ? (bx % 8) * (F.G / 8) + bx / 8 : bx; }
    F.ws = args.ws;
    F.ctl = (gu32*)(args.ws + WS_CTL);
    for (int u = F.tid; u < (LDS_BYTES - LDSCTL_OFF) / 4; u += NWAVES * 64) ((LAS unsigned*)(F.lds + LDSCTL_OFF))[u] = 0u;
    __syncthreads();
    XcdBarrier bar = xcd_barrier_post((unsigned*)F.ctl + (size_t)args.li * XCD_BAR_WORDS, F.MISC + 8);
    if (F.tid == 0) __hip_atomic_store((unsigned*)F.ctl + XB_XCCTAB + blockIdx.x, bar.x + 1u, __ATOMIC_RELAXED, __HIP_MEMORY_SCOPE_AGENT);
    const int lo = args.ph_lo, hi = args.ph_hi;
    {
    const int gw = F.vcu * NWAVES + F.wave, NGW = F.G * NWAVES;
    if (SITE(0) && IN(0)) { constexpr int CUR_SITE = 0; (void)CUR_SITE; SITE_T0 WS_PTRS
        LAS float* scr = (LAS float*)(F.lds + RING_OFF + F.wave * 16640);
        constexpr int NIT = 8 * (DM / 64) * (NGU / 64) + 8 * (FF / 64) * (DM / 64) + 4 * 32 * 32 + 4 * 32 * 16 + 2 * 32 * (NAIN / 64) + 32 * (NKV / 64) + 2 * 32 * 32;
        for (int it = gw; it < NIT; it += NGW) { int r = it;
            if (transpose_group(r, ap->in[I_WGU], 8, DM, NGU, Wgu, true, scr, F.lane, ap->in[I_NORMG], 1)) continue;
            if (transpose_group(r, ap->in[I_WDN], 8, FF, DM, Wdn, false, scr, F.lane, nullptr, 0)) continue;
            if (transpose_group(r, ap->in[I_WOUT], 4, DM, DM, Wout, false, scr, F.lane, nullptr, 0)) continue;
            if (transpose_group(r, ap->in[I_MEMWKV], 4, DM, 1024, Wmem, false, scr, F.lane, nullptr, 0)) continue;
            if (transpose_group(r, ap->in[I_AWIN], 2, DM, NAIN, Wain, false, scr, F.lane, ap->in[I_NORMG], 2)) continue;
            if (transpose_group(r, ap->in[I_WKV], 1, DM, NKV, Wkv, false, scr, F.lane, ap->in[I_KVG], 0)) continue;
            transpose_group(r, ap->in[I_BWIN], 2, DM, NBIN, Wbin, false, scr, F.lane, ap->in[I_NORMG], 4); }
        for (int i = gw * 64 + F.lane; i < SEQ * 64; i += NGW * 64) { const int pos = i >> 6, k = i & 63; const float inv = (float)pow(10000.0, -(double)k / 64.0); const float ang = (float)pos * inv;
            float sn, cs; sincos_d(ang, sn, cs); typedef _Float16 h2 __attribute__((ext_vector_type(2))); h2 t; t.x = (_Float16)cs; t.y = (_Float16)sn; CS[i] = __builtin_bit_cast(unsigned, t); }
        for (int r = gw; r < 4096; r += NGW) { const int l = r >> 10, mm = r & 1023; norm_row(ap->in[I_MEM] + (size_t)mm * DM, ap->in[I_MEMNG] + l * DM, MEMN + (size_t)r * DM, F.lane); }
        xb_ss_phase(F, ap->in[I_X], XB, SS);
        SEAM(0);
        if (LOCAL_SEAMS && IN(1)) { if (F.tid < 64) { bool ok = F.G == 256; unsigned mine[4];
#pragma unroll
                for (int q = 0; q < 4; ++q) { const unsigned i = F.tid + 64 * q; mine[q] = __hip_atomic_load((unsigned*)F.ctl + XB_XCCTAB + i, __ATOMIC_RELAXED, __HIP_MEMORY_SCOPE_AGENT);
                    const unsigned rep = __hip_atomic_load((unsigned*)F.ctl + XB_XCCTAB + (i & 7u), __ATOMIC_RELAXED, __HIP_MEMORY_SCOPE_AGENT); ok = ok && mine[q] != 0u && mine[q] == rep; }
                if (F.tid < 8) { for (unsigned o = 0; o < 8; ++o) { const unsigned other = __hip_atomic_load((unsigned*)F.ctl + XB_XCCTAB + o, __ATOMIC_RELAXED, __HIP_MEMORY_SCOPE_AGENT); ok = ok && (o == (unsigned)F.tid || other != mine[0]); } }
                ok = __all(ok); if (F.tid == 0) F.MISC[24] = ok ? 1u : 0u; }
            __syncthreads(); }
    }
    }
    ffn_part<0, 0>(F, bar, smem, lo, hi); mixer_part<0>(F, bar, smem, lo, hi); ffn_part<0, 1>(F, bar, smem, lo, hi);
    ffn_part<1, 0>(F, bar, smem, lo, hi); mixer_part<1>(F, bar, smem, lo, hi); ffn_part<1, 1>(F, bar, smem, lo, hi);
    ffn_part<2, 0>(F, bar, smem, lo, hi); mixer_part<2>(F, bar, smem, lo, hi); ffn_part<2, 1>(F, bar, smem, lo, hi);
    ffn_part<3, 0>(F, bar, smem, lo, hi); mixer_part<3>(F, bar, smem, lo, hi); ffn_part<3, 1>(F, bar, smem, lo, hi);
    if (PROBE_PHASE) { if (blockIdx.x == 0 && F.tid == 0) { const unsigned long long tot = F.MISC[17], t0 = __builtin_amdgcn_s_memrealtime(); while (__builtin_amdgcn_s_memrealtime() - t0 < tot) __builtin_amdgcn_s_sleep(8); } }
#ifdef PROBE_LOCALOK
    if (blockIdx.x == 0 && F.tid == 0 && F.MISC[24] != 0u) { const unsigned long long t0 = __builtin_amdgcn_s_memrealtime(); while (__builtin_amdgcn_s_memrealtime() - t0 < 50000ull) __builtin_amdgcn_s_sleep(8); }
#endif
    if (PROBE_WAIT) {
        unsigned* sumw = (unsigned*)F.ctl + 65536;
        if (F.tid == 0) __hip_atomic_fetch_add(sumw, F.MISC[16], __ATOMIC_RELAXED, __HIP_MEMORY_SCOPE_AGENT);
        xcd_barrier(bar);
        if (blockIdx.x == 0 && F.tid == 0) { const unsigned tot = __hip_atomic_load(sumw, __ATOMIC_RELAXED, __HIP_MEMORY_SCOPE_AGENT); const unsigned long long avg = tot / gridDim.x, t0 = __builtin_amdgcn_s_memrealtime();
            while (__builtin_amdgcn_s_memrealtime() - t0 < avg) __builtin_amdgcn_s_sleep(8); }
    }
}
#undef IN
#undef SEAM

#ifndef MK_MODE
#define MK_MODE 1
#endif
extern "C" void kernel_launch(void* const* d_in, const int* in_sizes, int n_in, void* d_out, int out_size, void* d_ws, size_t ws_size, hipStream_t stream) {
    static int grid = 0;
    if (grid == 0) {
        if (n_in != N_IN || out_size != M * DM || ws_size < WS_END) { fprintf(stderr, "kernel_launch: unexpected shapes: n_in %d out %d ws %zu (need %zu)\n", n_in, out_size, ws_size, (size_t)WS_END); grid = -1; return; }
        int dev = 0, cus = 0, per_cu = 0;
        if (hipGetDevice(&dev) != hipSuccess || hipDeviceGetAttribute(&cus, hipDeviceAttributeMultiprocessorCount, dev) != hipSuccess) { grid = -1; return; }
        if (hipFuncSetAttribute((const void*)yoco_fwd, hipFuncAttributeMaxDynamicSharedMemorySize, LDS_BYTES) != hipSuccess) { fprintf(stderr, "kernel_launch: hipFuncSetAttribute failed\n"); grid = -1; return; }
        if (hipOccupancyMaxActiveBlocksPerMultiprocessor(&per_cu, (const void*)yoco_fwd, NWAVES * 64, LDS_BYTES) != hipSuccess || per_cu < 1) fprintf(stderr, "kernel_launch: occupancy query says %d blocks per CU\n", per_cu);
        (void)hipGetLastError();
        grid = cus;
        if (cus != 256) { fprintf(stderr, "kernel_launch: built for a 256-CU device (got %d)\n", cus); grid = -1; return; }
    }
    if (grid < 0) return;
    (void)in_sizes;
    if (hipMemsetAsync((char*)d_ws + WS_CTL, 0, CTL_ZERO_BYTES, stream) != hipSuccess) return;
    Args a{};
    for (int i = 0; i < N_IN; ++i) a.in[i] = (const float*)d_in[i];
    a.out = (float*)d_out; a.ws = (unsigned char*)d_ws; a.pad = 0;
#if MK_MODE == 1
    a.ph_lo = 0; a.ph_hi = NPH; a.li = 0;
    hipLaunchKernelGGL(yoco_fwd, dim3(grid), dim3(NWAVES * 64), LDS_BYTES, stream, a);
#else
    for (int p = 0; p < NPH; ++p) {
        const int k = (p - PH_BASE) % NPL, l = (p - PH_BASE) / NPL;
        if (p >= PH_BASE && (k == 4 && l < NA)) continue;
        a.ph_lo = p; a.ph_hi = p + 1; a.li = 0;
        hipLaunchKernelGGL(yoco_fwd, dim3(grid), dim3(NWAVES * 64), LDS_BYTES, stream, a);
    }
#endif
}
```

```cpp
#include <hip/hip_runtime.h>
#include <hip/hip_bf16.h>
#include <cstdio>
#include <cstdint>

constexpr int BATCH = 4, SEQ = 4096, DM = 2048, DEPTH = 4, NA = 2;
constexpr int M = BATCH * SEQ;
constexpr int MEML = 256, HD = 128, MEMH = 4, MEMW = 512, MIXW = 1536, CHUNK = 128, GG = 6, GW = 256, DH = 6, DV = 256, FF = 5632;
constexpr int NGU = 2 * FF;
constexpr int NAIN = 2 * MIXW + MEMW;
constexpr int NBIN = MIXW + MEMW;
constexpr int NKV = 2 * DH * HD + DH * DV;
constexpr float EPS = 1e-6f;
namespace pg8 {
#define PG8_LAS __attribute__((address_space(3)))
typedef unsigned short bf16_t;
typedef short bf16x8 __attribute__((ext_vector_type(8)));
typedef float f32x4 __attribute__((ext_vector_type(4)));
typedef unsigned u32x4 __attribute__((ext_vector_type(4)));
constexpr int BM = 256, BK = 64, HALF = 128, HTB = HALF * BK * 2  , STAGE_BYTES = 8 * HTB, NXCD = 8, WGM = 8;

__host__ __device__ __forceinline__ int lds_byte(int r, int c) { const int st = (r >> 4) * 2 + (c >> 5), rr = r & 15, cc = c & 31, ob = rr * 64 + cc * 2; return st * 1024 + (ob ^ (((ob >> 9) & 1) << 5)); }
__host__ __device__ __forceinline__ void stage_rc(int b, int& R, int& C) { const int st = b / 1024, sb = b % 1024, swz = sb ^ (((sb >> 9) & 1) << 5); R = (st >> 1) * 16 + swz / 64; C = (st & 1) * 32 + (swz % 64) / 2; }
__host__ __device__ __forceinline__ int perm32(int rho) { const int n = rho >> 4, i = rho & 15; return 8 * (i >> 2) + 4 * n + (i & 3); }

struct Unit { int pm, pn; };
struct Gemm { const bf16_t* A; const bf16_t* Bt; int M, N, K; };

struct StaticOrder {
    int nM, nN, nwg, G, c;
    __host__ __device__ void init(int M, int N, int G_, int c_) { nM = M / BM; nN = N / BM; nwg = nM * nN; G = G_; c = c_; }
    __host__ __device__ bool next(int i, Unit& u) const {
        const long L = (long)i * G + c; if (L >= nwg) return false;
        int wgid = (int)L; { const int q = nwg / NXCD, r = nwg % NXCD, xcd = wgid % NXCD, off = wgid / NXCD; wgid = (xcd < r ? xcd * (q + 1) : r * (q + 1) + (xcd - r) * q) + off; }
        const int nig = WGM * nN, gid = wgid / nig, fm = gid * WGM, gsz = (nM - fm) < WGM ? (nM - fm) : WGM;
        u.pm = fm + ((wgid % nig) % gsz); u.pn = (wgid % nig) / gsz; return true;
    }
    __device__ __forceinline__ void a_ready(const Unit&) const {}
    __device__ __forceinline__ void done(const Unit&) const {}
};
__device__ __forceinline__ unsigned cvt_pk_bf16(float lo, float hi) { unsigned r; asm volatile("v_cvt_pk_bf16_f32 %0, %1, %2" : "=v"(r) : "v"(lo), "v"(hi)); return r; }
typedef float f32x2 __attribute__((ext_vector_type(2)));
typedef unsigned u32x2 __attribute__((ext_vector_type(2)));
__device__ __forceinline__ f32x2 gelu_pk(f32x2 v) {
    const f32x2 av = __builtin_elementwise_abs(v), d = av * 0.2316418882f + 1.0f;
    f32x2 t; t.x = __builtin_amdgcn_rcpf(d.x); t.y = __builtin_amdgcn_rcpf(d.y);
    f32x2 q = t * 0.5307027145f + (-0.7265760135f); q = q * t + 0.7107068705f; q = q * t + (-0.142248368f); q = q * t + 0.127414796f; q = q * t;
    const f32x2 s = (v * v) * (-0.72134752044f);
    f32x2 e; e.x = __builtin_amdgcn_exp2f(s.x); e.y = __builtin_amdgcn_exp2f(s.y);
    const f32x2 m = v * (q * e), r = v - m;
    f32x2 o; o.x = v.x < 0.f ? m.x : r.x; o.y = v.y < 0.f ? m.y : r.y; return o;
}
__device__ __forceinline__ float silu_f(float g) { return g * __builtin_amdgcn_rcpf(1.0f + __builtin_amdgcn_exp2f(-1.4426950408889634f * g)); }
__device__ __forceinline__ u32x4 pack8_bf16(f32x4 a, f32x4 b) { u32x4 w; w.x = cvt_pk_bf16(a[0], a[1]); w.y = cvt_pk_bf16(a[2], a[3]); w.z = cvt_pk_bf16(b[0], b[1]); w.w = cvt_pk_bf16(b[2], b[3]); return w; }

__host__ __device__ __forceinline__ size_t blk_off(int row, int col, int kt) { return ((size_t)((row >> 8) * kt + (col >> 6)) << 14) + ((row & 255) << 6) + (col & 63); }
struct RowScale { const PG8_LAS float* rtab; };
__device__ __forceinline__ void get_rstd(float (&rs)[2][4], const RowScale& R, int wr, int fr) {
#pragma unroll
    for (int ai = 0; ai < 2; ++ai)
#pragma unroll
        for (int m = 0; m < 4; ++m) rs[ai][m] = R.rtab ? R.rtab[2 * (ai * HALF + wr * 64 + m * 16 + fr)] : 1.0f;
}
struct EpiSwiglu {
    static constexpr bool PERM = true, AFTER_DRAIN = false;
    static __host__ __device__ __forceinline__ int bmap(int R) { return (R & ~31) + perm32(R & 31); }
    bf16_t* H; int ldh; RowScale R;
    __device__ __forceinline__ void operator()(const f32x4 (&acc)[2][2][4][2], const Unit& u, int wr, int wc, int fr, int fq) const {
        const int row0 = u.pm * BM + wr * 64 + fr, col0 = u.pn * HALF + wc * 32 + 8 * fq;
#pragma unroll
        for (int ai = 0; ai < 2; ++ai)
#pragma unroll
            for (int m = 0; m < 4; ++m) { const f32x2 rv = *(const PG8_LAS f32x2*)(R.rtab + 2 * (ai * HALF + wr * 64 + m * 16 + fr)); const float c1 = -1.4426950408889634f * rv.x, v = rv.y;
                const f32x4 g0 = acc[ai][0][m][0], g1 = acc[ai][0][m][1], u0 = acc[ai][1][m][0], u1 = acc[ai][1][m][1];
                f32x4 h0, h1;
#pragma unroll
                for (int j = 0; j < 4; ++j) { const float e0 = __builtin_amdgcn_exp2f(g0[j] * c1), e1 = __builtin_amdgcn_exp2f(g1[j] * c1);
                    h0[j] = (g0[j] * u0[j]) * __builtin_amdgcn_rcpf(__builtin_fmaf(e0, v, v)); h1[j] = (g1[j] * u1[j]) * __builtin_amdgcn_rcpf(__builtin_fmaf(e1, v, v)); }
                *(u32x4*)(H + blk_off(row0 + ai * HALF + m * 16, col0, ldh >> 6)) = pack8_bf16(h0, h1);
            }
    }
};
struct EpiResid {
    static constexpr bool PERM = true, AFTER_DRAIN = false;
    static __host__ __device__ __forceinline__ int bmap(int R) { return (R & ~31) + perm32(R & 31); }
    const float* base_f32; float* out_f32; int ld; float scale; bf16_t* xb; float* ss; _Float16* xh;
    int mode;
    typedef _Float16 h8 __attribute__((ext_vector_type(8)));
    static __device__ __forceinline__ void one(const f32x4 b0, const f32x4 b1, const f32x4 a0, const f32x4 a1, int row, int col, size_t off, float& s, float scale, float* out_f32, _Float16* xh, bf16_t* xb, int ld) {
        const f32x4 o0 = b0 + a0 * scale, o1 = b1 + a1 * scale;
        if (out_f32) { *(f32x4*)(out_f32 + off) = o0; *(f32x4*)(out_f32 + off + 4) = o1; }
        else { h8 w; w[0] = (_Float16)o0[0]; w[1] = (_Float16)o0[1]; w[2] = (_Float16)o0[2]; w[3] = (_Float16)o0[3]; w[4] = (_Float16)o1[0]; w[5] = (_Float16)o1[1]; w[6] = (_Float16)o1[2]; w[7] = (_Float16)o1[3];
            if (xh) *(h8*)(xh + off) = w;
            *(u32x4*)(xb + blk_off(row, col, ld >> 6)) = pack8_bf16(o0, o1);
            s += ((o0[0] * o0[0] + o0[1] * o0[1]) + (o0[2] * o0[2] + o0[3] * o0[3])) + ((o1[0] * o1[0] + o1[1] * o1[1]) + (o1[2] * o1[2] + o1[3] * o1[3])); }
    }
    __device__ __forceinline__ void operator()(const f32x4 (&acc)[2][2][4][2], const Unit& u, int wr, int wc, int fr, int fq) const {
        const int row0 = u.pm * BM + wr * 64 + fr, col0 = u.pn * BM + wc * 32 + 8 * fq;
        const float scale_ = scale; float* const out_ = out_f32; _Float16* const xh_ = mode == 0 ? xh : nullptr; bf16_t* const xb_ = xb; const int ld_ = ld; const bool rdb = mode == 1;
        if (base_f32) {
#pragma unroll
            for (int ai = 0; ai < 2; ++ai)
#pragma unroll
                for (int m = 0; m < 4; ++m) { const int row = row0 + ai * HALF + m * 16; const size_t off = (size_t)row * ld + col0; float s = 0.f;
#pragma unroll
                    for (int bj = 0; bj < 2; ++bj) one(*(const f32x4*)(base_f32 + off + bj * HALF), *(const f32x4*)(base_f32 + off + bj * HALF + 4), acc[ai][bj][m][0], acc[ai][bj][m][1], row, col0 + bj * HALF, off + bj * HALF, s, scale_, out_, xh_, xb_, ld_);
                    if (!out_f32) { s += __shfl_xor(s, 16); s += __shfl_xor(s, 32); if (fq == 0) ss[(size_t)row * 32 + u.pn * 4 + wc] = s; }
                    asm volatile("" ::: "memory"); }
            return;
        }
#pragma unroll
        for (int ai = 0; ai < 2; ++ai) {
            h8 w[4][2];
#pragma unroll
            for (int m = 0; m < 4; ++m)
#pragma unroll
                for (int bj = 0; bj < 2; ++bj) w[m][bj] = rdb ? *(const h8*)(xb + blk_off(row0 + ai * HALF + m * 16, col0 + bj * HALF, ld >> 6)) : *(const h8*)(xh + (size_t)(row0 + ai * HALF + m * 16) * ld + col0 + bj * HALF);
#pragma unroll
            for (int m = 0; m < 4; ++m) { const int row = row0 + ai * HALF + m * 16; const size_t off = (size_t)row * ld + col0; float s = 0.f;
#pragma unroll
                for (int bj = 0; bj < 2; ++bj) { const h8 v = w[m][bj]; f32x4 r0, r1;
                    if (rdb) { const u32x4 q = __builtin_bit_cast(u32x4, v);
                        r0 = (f32x4){__builtin_bit_cast(float, q[0] << 16), __builtin_bit_cast(float, q[0] & 0xffff0000u), __builtin_bit_cast(float, q[1] << 16), __builtin_bit_cast(float, q[1] & 0xffff0000u)};
                        r1 = (f32x4){__builtin_bit_cast(float, q[2] << 16), __builtin_bit_cast(float, q[2] & 0xffff0000u), __builtin_bit_cast(float, q[3] << 16), __builtin_bit_cast(float, q[3] & 0xffff0000u)}; }
                    else { r0 = (f32x4){(float)v[0], (float)v[1], (float)v[2], (float)v[3]}; r1 = (f32x4){(float)v[4], (float)v[5], (float)v[6], (float)v[7]}; }
                    one(r0, r1, acc[ai][bj][m][0], acc[ai][bj][m][1], row, col0 + bj * HALF, off + bj * HALF, s, scale_, out_, xh_, xb_, ld_); }
                if (!out_f32) { s += __shfl_xor(s, 16); s += __shfl_xor(s, 32); if (fq == 0) ss[(size_t)row * 32 + u.pn * 4 + wc] = s; } }
            asm volatile("" ::: "memory");
        }
    }
};
__device__ __forceinline__ void head_ss_put(PG8_LAS float* ex, int rl, int bj, int wc, int fq, float s) { s += __shfl_xor(s, 16); s += __shfl_xor(s, 32); if (fq == 0) ex[(rl * 2 + bj) * 4 + wc] = s; }
__device__ __forceinline__ float head_rstd_get(const PG8_LAS float* ex, int rl, int bj) { const f32x4 p = *(const PG8_LAS f32x4*)(ex + (rl * 2 + bj) * 4); return 1.0f / sqrtf(((p[0] + p[1]) + (p[2] + p[3])) * (1.0f / 128.0f) + 1e-6f); }
#define PG8_EPI_BARRIER() do { asm volatile("s_waitcnt lgkmcnt(0)" ::: "memory"); __builtin_amdgcn_s_barrier(); asm volatile("" ::: "memory"); } while (0)
struct EpiAin {
    static constexpr bool PERM = true, AFTER_DRAIN = false;
    static __host__ __device__ __forceinline__ int bmap(int R) { return (R & ~31) + perm32(R & 31); }
    bf16_t* ZA; float* vstat; bf16_t* qmb; const float* gq; PG8_LAS float* ex; RowScale R;
    __device__ __forceinline__ void operator()(const f32x4 (&acc)[2][2][4][2], const Unit& u, int wr, int wc, int fr, int fq) const {
        const int row0 = u.pm * BM + wr * 64 + fr;
        float rs[2][4]; get_rstd(rs, R, wr, fr);
        if (u.pn < 12) {
            const int col0 = u.pn * BM + wc * 32 + 8 * fq; const bool st = u.pn >= 6;
#pragma unroll
            for (int ai = 0; ai < 2; ++ai)
#pragma unroll
                for (int m = 0; m < 4; ++m) { const int row = row0 + ai * HALF + m * 16; float sq = 0.f;
#pragma unroll
                    for (int bj = 0; bj < 2; ++bj) { f32x4 v0 = acc[ai][bj][m][0] * rs[ai][m], v1 = acc[ai][bj][m][1] * rs[ai][m];
                        f32x2 a = gelu_pk((f32x2){v0[0], v0[1]}), b = gelu_pk((f32x2){v0[2], v0[3]}), c = gelu_pk((f32x2){v1[0], v1[1]}), d = gelu_pk((f32x2){v1[2], v1[3]});
                        v0 = (f32x4){a.x, a.y, b.x, b.y}; v1 = (f32x4){c.x, c.y, d.x, d.y};
                        sq += (v0[0] * v0[0] + v0[1] * v0[1]) + (v0[2] * v0[2] + v0[3] * v0[3]) + (v1[0] * v1[0] + v1[1] * v1[1]) + (v1[2] * v1[2] + v1[3] * v1[3]);
                        *(u32x4*)(ZA + (size_t)row * 3072 + col0 + bj * HALF) = pack8_bf16(v0, v1); }
                    if (st) { sq += __shfl_xor(sq, 16); sq += __shfl_xor(sq, 32); if (fq == 0) vstat[(size_t)row * 24 + (u.pn - 6) * 4 + wc] = sq; } }
        } else {
            const int d0 = wc * 32 + 8 * fq; const f32x4 g0 = *(const f32x4*)(gq + d0), g1 = *(const f32x4*)(gq + d0 + 4);
#pragma unroll
            for (int ai = 0; ai < 2; ++ai)
#pragma unroll
                for (int m = 0; m < 4; ++m) { const int rl = ai * HALF + wr * 64 + m * 16 + fr;
#pragma unroll
                    for (int bj = 0; bj < 2; ++bj) { const f32x4 v0 = acc[ai][bj][m][0], v1 = acc[ai][bj][m][1];
                        head_ss_put(ex, rl, bj, wc, fq, (((v0[0] * v0[0] + v0[1] * v0[1]) + (v0[2] * v0[2] + v0[3] * v0[3])) + ((v1[0] * v1[0] + v1[1] * v1[1]) + (v1[2] * v1[2] + v1[3] * v1[3]))) * (rs[ai][m] * rs[ai][m])); } }
            PG8_EPI_BARRIER();
#pragma unroll
            for (int ai = 0; ai < 2; ++ai)
#pragma unroll
                for (int m = 0; m < 4; ++m) { const int rl = ai * HALF + wr * 64 + m * 16 + fr, row = u.pm * BM + rl, b = row >> 12, s = row & 4095;
#pragma unroll
                    for (int bj = 0; bj < 2; ++bj) { const float sc = rs[ai][m] * head_rstd_get(ex, rl, bj); const int hm = (u.pn - 12) * 2 + bj;
                        *(u32x4*)(qmb + ((size_t)(b * 4 + hm) * 4096 + s) * 128 + d0) = pack8_bf16(acc[ai][bj][m][0] * sc * g0, acc[ai][bj][m][1] * sc * g1); } }
        }
    }
};
struct EpiF32Split {
    static constexpr bool PERM = true, AFTER_DRAIN = false;
    static __host__ __device__ __forceinline__ int bmap(int R) { return (R & ~31) + perm32(R & 31); }
    float* d0; int ld0; int split; float* d1; int ld1; int pnmod; RowScale R;
    __device__ __forceinline__ void operator()(const f32x4 (&acc)[2][2][4][2], const Unit& u, int wr, int wc, int fr, int fq) const {
        const int row0 = u.pm * BM + wr * 64 + fr; int pn = pnmod ? (u.pn % pnmod) : u.pn; float* d = d0; int ld = ld0;
        if (pn >= split) { d = d1; ld = ld1; pn -= split; }
        const int col0 = pn * BM + wc * 32 + 8 * fq;
        float rs[2][4]; get_rstd(rs, R, wr, fr);
#pragma unroll
        for (int ai = 0; ai < 2; ++ai)
#pragma unroll
            for (int m = 0; m < 4; ++m) { float* p = d + (size_t)(row0 + ai * HALF + m * 16) * ld + col0;
#pragma unroll
                for (int bj = 0; bj < 2; ++bj) { *(f32x4*)(p + bj * HALF) = acc[ai][bj][m][0] * rs[ai][m]; *(f32x4*)(p + bj * HALF + 4) = acc[ai][bj][m][1] * rs[ai][m]; } }
    }
};
struct EpiQKRope {
    static constexpr bool PERM = true, AFTER_DRAIN = false;
    static __host__ __device__ __forceinline__ int bmap(int R) { return 64 * ((R >> 4) & 1) + 16 * (R >> 5) + (R & 15); }
    int kind; bf16_t* qk; bf16_t* other; const float* gr; const float* gn; const unsigned* cs; PG8_LAS float* ex; RowScale R;
    __device__ __forceinline__ void operator()(const f32x4 (&acc)[2][2][4][2], const Unit& u, int wr, int wc, int fr, int fq) const {
        typedef _Float16 h2 __attribute__((ext_vector_type(2)));
        float rs[2][4]; get_rstd(rs, R, wr, fr);
        const int d0 = 16 * wc + 4 * fq;
        const bool rope = u.pn < 6;
        if (!rope && kind == 1) {
            const int h = u.pn - 6;
#pragma unroll
            for (int ai = 0; ai < 2; ++ai)
#pragma unroll
                for (int m = 0; m < 4; ++m) { const int row = u.pm * BM + ai * HALF + wr * 64 + m * 16 + fr, b = row >> 12, s = row & 4095;
#pragma unroll
                    for (int bj = 0; bj < 2; ++bj) { bf16_t* p = other + ((size_t)((b * 6 + h) * 2 + bj) * 4096 + s) * 128 + d0;
#pragma unroll
                        for (int n = 0; n < 2; ++n) { const f32x4 v = acc[ai][bj][m][n] * rs[ai][m]; u32x2 w; w.x = cvt_pk_bf16(v[0], v[1]); w.y = cvt_pk_bf16(v[2], v[3]); *(u32x2*)(p + 64 * n) = w; } } }
            return;
        }
        const float* g = rope ? gr : gn; const f32x4 ga = *(const f32x4*)(g + d0), gb = *(const f32x4*)(g + 64 + d0);
        u32x4 cst[2][4];
        if (rope) {
#pragma unroll
            for (int ai = 0; ai < 2; ++ai)
#pragma unroll
                for (int m = 0; m < 4; ++m) { const int s = (u.pm * BM + ai * HALF + wr * 64 + m * 16 + fr) & 4095; cst[ai][m] = *(const u32x4*)(cs + (size_t)s * 64 + d0); }
        }
#pragma unroll
        for (int ai = 0; ai < 2; ++ai)
#pragma unroll
            for (int m = 0; m < 4; ++m) { const int rl = ai * HALF + wr * 64 + m * 16 + fr;
#pragma unroll
                for (int bj = 0; bj < 2; ++bj) { const f32x4 v0 = acc[ai][bj][m][0], v1 = acc[ai][bj][m][1];
                    head_ss_put(ex, rl, bj, wc, fq, (((v0[0] * v0[0] + v0[1] * v0[1]) + (v0[2] * v0[2] + v0[3] * v0[3])) + ((v1[0] * v1[0] + v1[1] * v1[1]) + (v1[2] * v1[2] + v1[3] * v1[3]))) * (rs[ai][m] * rs[ai][m])); } }
        PG8_EPI_BARRIER();
#pragma unroll
        for (int ai = 0; ai < 2; ++ai)
#pragma unroll
            for (int m = 0; m < 4; ++m) { const int rl = ai * HALF + wr * 64 + m * 16 + fr, row = u.pm * BM + rl, b = row >> 12, s = row & 4095;
#pragma unroll
                for (int bj = 0; bj < 2; ++bj) { const float sc = rs[ai][m] * head_rstd_get(ex, rl, bj);
                    f32x4 y0 = acc[ai][bj][m][0] * sc * ga, y1 = acc[ai][bj][m][1] * sc * gb; bf16_t* p;
                    if (rope) { f32x4 o0, o1;
#pragma unroll
                        for (int j = 0; j < 4; ++j) { const unsigned cw = cst[ai][m][j]; const h2 t = __builtin_bit_cast(h2, cw); const float c = (float)t.x, sn = (float)t.y; o0[j] = y0[j] * c - y1[j] * sn; o1[j] = y1[j] * c + y0[j] * sn; }
                        y0 = o0; y1 = o1; p = qk + ((size_t)(b * 12 + u.pn * 2 + bj) * 4096 + s) * 128 + d0; }
                    else p = other + ((size_t)(b * 4 + (u.pn - 6) * 2 + bj) * 4096 + s) * 128 + d0;
                    u32x2 w0, w1; w0.x = cvt_pk_bf16(y0[0], y0[1]); w0.y = cvt_pk_bf16(y0[2], y0[3]); w1.x = cvt_pk_bf16(y1[0], y1[1]); w1.y = cvt_pk_bf16(y1[2], y1[3]);
                    *(u32x2*)p = w0; *(u32x2*)(p + 64) = w1; } }
    }
};
struct ColSweepOrder {
    int c;
    __device__ bool next(int i, Unit& u) const { if (i >= 2) return false; const int xcd = c & 7, j = c >> 3; u.pm = 8 * xcd + 4 * i + (j & 3); u.pn = j >> 2; return true; }
    __device__ __forceinline__ void a_ready(const Unit&) const {}
    __device__ __forceinline__ void done(const Unit&) const {}
};
struct EpiMemKv {
    static constexpr bool PERM = true, AFTER_DRAIN = false;
    static __host__ __device__ __forceinline__ int bmap(int R) { return (R & ~31) + perm32(R & 31); }
    bf16_t* mk; bf16_t* mv; const float* gk; PG8_LAS float* ex;
    __device__ __forceinline__ void operator()(const f32x4 (&acc)[2][2][4][2], const Unit& u, int wr, int wc, int fr, int fq) const {
        const int t = u.pn & 3, d0 = wc * 32 + 8 * fq; const size_t base = (size_t)u.pm * 4;
        if (t < 2) {
            const f32x4 g0 = *(const f32x4*)(gk + (u.pm >> 2) * 128 + d0), g1 = *(const f32x4*)(gk + (u.pm >> 2) * 128 + d0 + 4);
#pragma unroll
            for (int ai = 0; ai < 2; ++ai)
#pragma unroll
                for (int m = 0; m < 4; ++m) { const int rl = ai * HALF + wr * 64 + m * 16 + fr;
#pragma unroll
                    for (int bj = 0; bj < 2; ++bj) { const f32x4 v0 = acc[ai][bj][m][0], v1 = acc[ai][bj][m][1];
                        head_ss_put(ex, rl, bj, wc, fq, ((v0[0] * v0[0] + v0[1] * v0[1]) + (v0[2] * v0[2] + v0[3] * v0[3])) + ((v1[0] * v1[0] + v1[1] * v1[1]) + (v1[2] * v1[2] + v1[3] * v1[3]))); } }
            PG8_EPI_BARRIER();
#pragma unroll
            for (int ai = 0; ai < 2; ++ai)
#pragma unroll
                for (int m = 0; m < 4; ++m) { const int rl = ai * HALF + wr * 64 + m * 16 + fr;
#pragma unroll
                    for (int bj = 0; bj < 2; ++bj) { const float sc = head_rstd_get(ex, rl, bj);
                        *(u32x4*)(mk + ((base + t * 2 + bj) * 256 + rl) * 128 + d0) = pack8_bf16(acc[ai][bj][m][0] * sc * g0, acc[ai][bj][m][1] * sc * g1); } }
        } else {
#pragma unroll
            for (int ai = 0; ai < 2; ++ai)
#pragma unroll
                for (int m = 0; m < 4; ++m) { const int rl = ai * HALF + wr * 64 + m * 16 + fr;
#pragma unroll
                    for (int bj = 0; bj < 2; ++bj) *(u32x4*)(mv + ((base + (t - 2) * 2 + bj) * 256 + rl) * 128 + d0) = pack8_bf16(acc[ai][bj][m][0], acc[ai][bj][m][1]); }
        }
    }
};
struct MemKvOrder {
    int G, c;
    __device__ bool next(int i, Unit& u) const { const int L = i * G + c; if (L >= 64) return false; const int layer = L >> 4, r = L & 15; u.pm = layer * 4 + (r >> 2); u.pn = layer * 4 + (r & 3); return true; }
    __device__ __forceinline__ void a_ready(const Unit&) const {}
    __device__ __forceinline__ void done(const Unit&) const {}
};
template <class Epi, class Sched, bool ALIGN_EPI = false, bool SP2 = false, bool ABLK = false, bool BBLK = false>
__device__ __forceinline__ void gemm_phase(PG8_LAS unsigned char* lds, const Gemm g, const Sched& S, const Epi& E) {
    int tid_ = threadIdx.x; asm volatile("" : "+v"(tid_));
    const int tid = tid_, wid = __builtin_amdgcn_readfirstlane(tid >> 6), lane = tid & 63, wr = wid >> 2, wc = wid & 3, fr = lane & 15, fq = lane >> 4;
    const int K = g.K, nt = K / BK;
    unsigned voffA[2], voffB[2];
#pragma unroll
    for (int i = 0; i < 2; ++i) { int R, C; stage_rc(tid * 16 + i * 8192, R, C); const int Rb = Epi::bmap(R);
        voffA[i] = ABLK ? (unsigned)(R * BK + C) * 2u : (unsigned)(R * K + C) * 2u; voffB[i] = BBLK ? (unsigned)(Rb * BK + C) * 2u : (unsigned)(Rb * K + C) * 2u; }
    const size_t kstepA = ABLK ? (size_t)(BM * BK * 2) : (size_t)(BK * 2), kstepB = BBLK ? (size_t)(BM * BK * 2) : (size_t)(BK * 2);
    const size_t hstepA = ABLK ? (size_t)(HALF * BK * 2) : (size_t)HALF * K * 2, hstepB = BBLK ? (size_t)(HALF * BK * 2) : (size_t)HALF * K * 2;
    const size_t tstep = (size_t)BM * K * 2;
#ifndef PG8_PF
#define PG8_PF 0
#endif
    PG8_LAS unsigned* const pfjunk = (PG8_LAS unsigned*)(lds + 143360 + wid * 256);
    const unsigned ldsw = (unsigned)wid * 1024u;
    const int aoff = lds_byte(wr * 64 + fr, fq * 8), boff = lds_byte(wc * 32 + fr, fq * 8);
#define PG8_SA(b, h) (((b) * 2 + (h)) * HTB)
#define PG8_SB(b, h) ((4 + (b) * 2 + (h)) * HTB)
#define PG8_STAGE(bufoff, gbase, voff) do { _Pragma("unroll") for (int _i = 0; _i < 2; ++_i) \
        __builtin_amdgcn_global_load_lds((const unsigned*)((const char*)(gbase) + (voff)[_i]), (PG8_LAS unsigned*)(lds + (bufoff) + ldsw + _i * 8192), 16, 0, 0); } while (0)
#define PG8_LDA(dst, b, h) do { _Pragma("unroll") for (int m = 0; m < 4; ++m) _Pragma("unroll") for (int k = 0; k < 2; ++k) dst[m][k] = *(const PG8_LAS bf16x8*)(lds + PG8_SA(b, h) + aoff + m * 2048 + k * 1024); } while (0)
#define PG8_LDB(dst, b, h) do { _Pragma("unroll") for (int n = 0; n < 2; ++n) _Pragma("unroll") for (int k = 0; k < 2; ++k) dst[n][k] = *(const PG8_LAS bf16x8*)(lds + PG8_SB(b, h) + boff + n * 2048 + k * 1024); } while (0)
#define PG8_MMA(ai, bj, At, Bt) do { __builtin_amdgcn_s_setprio(1); _Pragma("unroll") for (int m = 0; m < 4; ++m) _Pragma("unroll") for (int n = 0; n < 2; ++n) _Pragma("unroll") for (int k = 0; k < 2; ++k) \
        acc[ai][bj][m][n] = __builtin_amdgcn_mfma_f32_16x16x32_bf16(Bt[n][k], At[m][k], acc[ai][bj][m][n], 0, 0, 0); __builtin_amdgcn_s_setprio(0); } while (0)
#define PG8_WAIT_V(n) asm volatile("s_waitcnt vmcnt(" #n ")" ::: "memory")
#define PG8_WAIT_LOOP() do { if (PG8_PF) asm volatile("s_waitcnt vmcnt(9)" ::: "memory"); else asm volatile("s_waitcnt vmcnt(8)" ::: "memory"); } while (0)
#define PG8_PREFETCH(tp) do { if (PG8_PF) { const int tp_ = (tp); const char* pb_ = (wid < 4) ? (tp_ < nt ? cA + (size_t)tp_ * kstepA : nA + (size_t)(tp_ - nt) * kstepA) : (tp_ < nt ? cB + (size_t)tp_ * kstepB : nB + (size_t)(tp_ - nt) * kstepB); \
        const unsigned ln_ = __builtin_amdgcn_mbcnt_hi(~0u, __builtin_amdgcn_mbcnt_lo(~0u, 0u)) + (unsigned)(wid & 3) * 64u; const unsigned pfl_ = ln_ * ((wid < 4) ? (ABLK ? 128u : (unsigned)K * 2u) : (BBLK ? 128u : (unsigned)K * 2u)); \
        __builtin_amdgcn_global_load_lds((const unsigned*)(pb_ + pfl_), pfjunk, 4, 0, 0); } } while (0)
#define PG8_WAIT_L(n) asm volatile("s_waitcnt lgkmcnt(" #n ")" ::: "memory")
#define PG8_BAR __builtin_amdgcn_s_barrier()
#define PG8_SCHED __builtin_amdgcn_sched_barrier(0)
    Unit cur, nxt; int ui = 0;
    if (!S.next(0, cur)) return;
    f32x4 acc[2][2][4][2];
#pragma unroll
    for (int a = 0; a < 2; ++a)
#pragma unroll
        for (int b = 0; b < 2; ++b)
#pragma unroll
            for (int m = 0; m < 4; ++m)
#pragma unroll
                for (int n = 0; n < 2; ++n) acc[a][b][m][n] = (f32x4){0.f, 0.f, 0.f, 0.f};
    bf16x8 At[4][2], B0[2][2], B1[2][2];
    const char* cA = (const char*)g.A + (size_t)cur.pm * tstep; const char* cB = (const char*)g.Bt + (size_t)cur.pn * tstep;
    S.a_ready(cur);
    if constexpr (SP2) {
        PG8_STAGE(PG8_SB(0, 0), cB, voffB); PG8_STAGE(PG8_SB(0, 1), cB + hstepB, voffB); PG8_STAGE(PG8_SA(0, 0), cA, voffA); PG8_STAGE(PG8_SA(0, 1), cA + hstepA, voffA);
        if (wr == 1) PG8_BAR;
        PG8_WAIT_V(2); PG8_BAR;
        PG8_STAGE(PG8_SB(1, 0), cB + kstepB, voffB); PG8_STAGE(PG8_SA(1, 0), cA + kstepA, voffA); PG8_STAGE(PG8_SB(1, 1), cB + hstepB + kstepB, voffB);
        PG8_WAIT_V(6); PG8_BAR;
    } else {
        PG8_STAGE(PG8_SB(0, 0), cB, voffB); PG8_STAGE(PG8_SA(0, 0), cA, voffA); PG8_STAGE(PG8_SB(0, 1), cB + hstepB, voffB); PG8_STAGE(PG8_SA(0, 1), cA + hstepA, voffA);
        if (wr == 1) PG8_BAR;
        PG8_WAIT_V(4); PG8_BAR;
        PG8_STAGE(PG8_SB(1, 0), cB + kstepB, voffB); PG8_STAGE(PG8_SA(1, 0), cA + kstepA, voffA); PG8_STAGE(PG8_SB(1, 1), cB + hstepB + kstepB, voffB);
        PG8_WAIT_V(6); PG8_BAR;
    }
    for (;;) {
        const bool has_next = S.next(ui + 1, nxt);
        const char* nA = has_next ? (const char*)g.A + (size_t)nxt.pm * tstep : cA; const char* nB = has_next ? (const char*)g.Bt + (size_t)nxt.pn * tstep : cB;
        for (int t = 0; t < nt; t += 2) {
            const bool last = (t == nt - 2);
            const char* a1 = cA + (size_t)(t + 1) * kstepA;
            const char* a2 = last ? nA : cA + (size_t)(t + 2) * kstepA; const char* b2 = last ? nB : cB + (size_t)(t + 2) * kstepB;
            const char* a3 = a2 + kstepA; const char* b3 = b2 + kstepB;
            if (last && has_next) S.a_ready(nxt);
            if constexpr (SP2) {
            PG8_LDB(B0, 0, 0); PG8_LDB(B1, 0, 1); PG8_SCHED; PG8_LDA(At, 0, 0); PG8_STAGE(PG8_SA(1, 1), a1 + hstepA, voffA); PG8_PREFETCH(t + PG8_PF);
            PG8_WAIT_LOOP(); PG8_WAIT_L(0); PG8_BAR; PG8_MMA(0, 0, At, B0); PG8_MMA(0, 1, At, B1); PG8_BAR; PG8_SCHED;
            PG8_LDA(At, 0, 1); PG8_STAGE(PG8_SB(0, 0), b2, voffB); PG8_STAGE(PG8_SB(0, 1), b2 + hstepB, voffB); PG8_STAGE(PG8_SA(0, 0), a2, voffA);
            PG8_WAIT_LOOP(); PG8_WAIT_L(0); PG8_BAR; PG8_MMA(1, 0, At, B0); PG8_MMA(1, 1, At, B1); PG8_BAR; PG8_SCHED;
            PG8_LDB(B0, 1, 0); PG8_LDB(B1, 1, 1); PG8_SCHED; PG8_LDA(At, 1, 0); PG8_STAGE(PG8_SA(0, 1), a2 + hstepA, voffA); PG8_PREFETCH(t + 1 + PG8_PF);
            PG8_WAIT_LOOP(); PG8_WAIT_L(0); PG8_BAR; PG8_MMA(0, 0, At, B0); PG8_MMA(0, 1, At, B1); PG8_BAR; PG8_SCHED;
            PG8_LDA(At, 1, 1); PG8_STAGE(PG8_SB(1, 0), b3, voffB); PG8_STAGE(PG8_SB(1, 1), b3 + hstepB, voffB); PG8_STAGE(PG8_SA(1, 0), a3, voffA);
            PG8_WAIT_LOOP(); PG8_WAIT_L(0); PG8_BAR; PG8_MMA(1, 0, At, B0); PG8_MMA(1, 1, At, B1); PG8_BAR; PG8_SCHED;
            } else {
            PG8_LDB(B0, 0, 0); PG8_SCHED; PG8_LDA(At, 0, 0); PG8_STAGE(PG8_SA(1, 1), a1 + hstepA, voffA);
            PG8_WAIT_L(8); PG8_BAR; PG8_WAIT_L(0); PG8_MMA(0, 0, At, B0); PG8_BAR; PG8_SCHED;
            PG8_LDB(B1, 0, 1); PG8_STAGE(PG8_SB(0, 0), b2, voffB);
            PG8_BAR; PG8_WAIT_L(0); PG8_MMA(0, 1, At, B1); PG8_BAR;
            PG8_LDA(At, 0, 1); PG8_STAGE(PG8_SA(0, 0), a2, voffA);
            PG8_BAR; PG8_WAIT_L(0); PG8_MMA(1, 0, At, B0); PG8_BAR; PG8_SCHED;
            PG8_STAGE(PG8_SB(0, 1), b2 + hstepB, voffB);
            PG8_WAIT_V(6); PG8_BAR; PG8_MMA(1, 1, At, B1); PG8_BAR;
            PG8_LDB(B0, 1, 0); PG8_SCHED; PG8_LDA(At, 1, 0); PG8_STAGE(PG8_SA(0, 1), a2 + hstepA, voffA);
            PG8_WAIT_L(8); PG8_BAR; PG8_WAIT_L(0); PG8_MMA(0, 0, At, B0); PG8_BAR; PG8_SCHED;
            PG8_LDB(B1, 1, 1); PG8_STAGE(PG8_SB(1, 0), b3, voffB);
            PG8_BAR; PG8_WAIT_L(0); PG8_MMA(0, 1, At, B1); PG8_BAR;
            PG8_LDA(At, 1, 1); PG8_STAGE(PG8_SA(1, 0), a3, voffA);
            PG8_BAR; PG8_WAIT_L(0); PG8_MMA(1, 0, At, B0); PG8_BAR; PG8_SCHED;
            PG8_STAGE(PG8_SB(1, 1), b3 + hstepB, voffB);
            PG8_WAIT_V(6); PG8_BAR; PG8_MMA(1, 1, At, B1); PG8_BAR;
            }
        }
        if constexpr (ALIGN_EPI) { if (wr == 0) PG8_BAR; }
        if constexpr (!Epi::AFTER_DRAIN) { int fr_e = fr, fq_e = fq; asm volatile("" : "+v"(fr_e), "+v"(fq_e));
            E(acc, cur, wr, wc, fr_e, fq_e); S.done(cur); }
        if (!has_next) break;
#pragma unroll
        for (int a = 0; a < 2; ++a)
#pragma unroll
            for (int b = 0; b < 2; ++b)
#pragma unroll
                for (int m = 0; m < 4; ++m)
#pragma unroll
                    for (int n = 0; n < 2; ++n) acc[a][b][m][n] = (f32x4){0.f, 0.f, 0.f, 0.f};
        cur = nxt; cA = nA; cB = nB; ++ui;
        if constexpr (ALIGN_EPI) { if (wr == 1) PG8_BAR; }
    }
    PG8_WAIT_V(0);
    if constexpr (!ALIGN_EPI) { if (wr == 0) PG8_BAR; }
    PG8_BAR;
    if constexpr (Epi::AFTER_DRAIN) { E.fused(acc, cur, wr, wc, fr, fq, lds, wid, lane); S.done(cur); }
#undef PG8_SA
#undef PG8_SB
#undef PG8_STAGE
#undef PG8_LDA
#undef PG8_LDB
#undef PG8_MMA
#undef PG8_WAIT_V
#undef PG8_WAIT_L
#undef PG8_WAIT_LOOP
#undef PG8_PREFETCH
#undef PG8_BAR
#undef PG8_SCHED
}
}
namespace att {
constexpr int D = 128; constexpr float THR = 8.f; constexpr bool WSKIP = false;
constexpr float SCALE = 0.08838834764831845f;
constexpr int NW = 8, QBLK = 32, KVBLK = 64, QB = NW * QBLK;
constexpr int SHM_V = KVBLK * D * 2, SHM_K = KVBLK * D * 2;
constexpr int LDS_BYTES = 2 * SHM_V + 2 * SHM_K + NW * 64 * 4;

using bf16 = __hip_bfloat16;
typedef short bf16x8 __attribute__((ext_vector_type(8)));
typedef short s16x4 __attribute__((ext_vector_type(4)));
typedef float f32x16 __attribute__((ext_vector_type(16)));
typedef float f32x4 __attribute__((ext_vector_type(4)));
typedef unsigned u32x4 __attribute__((ext_vector_type(4)));
template <class A, class Bt> struct same_t { static constexpr bool v = false; };
template <class A> struct same_t<A, A> { static constexpr bool v = true; };

#define KSWZ(row, colB) ((row) * 256 + ((colB) ^ (((row) & 7) << 4)))
#define SBAR() __builtin_amdgcn_sched_barrier(0)
__device__ __forceinline__ int v_st(int k, int c) { const int kk = (k & ~0xC) | ((k & 4) << 1) | ((k & 8) >> 1); return ((kk >> 3) * 4 + (c >> 5)) * 512 + ((kk & 7) * 32 + (c & 31)) * 2; }
__device__ __forceinline__ int v_rd_base(int lane) { return ((lane & 3) << 3) | (((lane >> 2) & 3) << 6) | (((lane >> 4) & 1) << 5) | (((lane >> 5) & 1) << 8); }
constexpr int v_rd_off(int d0, int ks, int half) { return d0 * 512 + ks * 4096 + half * 2048; }
__device__ __forceinline__ int crow(int r, int hi) { return (r & 3) + 8 * (r >> 2) + 4 * hi; }
__device__ __forceinline__ unsigned cvtpk(float lo, float hi) {
    unsigned r; asm volatile("v_cvt_pk_bf16_f32 %0, %1, %2" : "=v"(r) : "v"(lo), "v"(hi)); return r;
}
__device__ __forceinline__ bf16x8 pack8(f32x4 a, f32x4 b) {
    u32x4 w = {cvtpk(a[0], a[1]), cvtpk(a[2], a[3]), cvtpk(b[0], b[1]), cvtpk(b[2], b[3])};
    return *reinterpret_cast<bf16x8*>(&w);
}
template <class T> __device__ __forceinline__ bf16x8 load8(const T* p) {
    if constexpr (same_t<T, float>::v) { return pack8(*(const f32x4*)p, *(const f32x4*)(p + 4)); }
    else { return *reinterpret_cast<const bf16x8*>(p); }
}
__device__ __forceinline__ void mask_tile(f32x16& p0, f32x16& p1, int dq, unsigned W) {
    const float NEG = -__builtin_inff();
#pragma unroll
    for (int r = 0; r < 16; ++r) {
        const int c = (r & 3) + 8 * (r >> 2);
        if ((unsigned)(dq - c) >= W) p0[r] = NEG;
        if ((unsigned)(dq - c - 32) >= W) p1[r] = NEG;
    }
}
__device__ __forceinline__ void partialSM(f32x16& p0, f32x16& p1, float& m_reg, float& mn, float& alpha) {
    float pmax = p0[0]; for (int r = 1; r < 16; ++r) pmax = fmaxf(pmax, p0[r]); for (int r = 0; r < 16; ++r) pmax = fmaxf(pmax, p1[r]);
    { auto rr = __builtin_amdgcn_permlane32_swap(__float_as_uint(pmax), __float_as_uint(pmax), false, false);
      pmax = fmaxf(__uint_as_float(rr[0]), __uint_as_float(rr[1])); }
    constexpr float C2 = 1.4426950408889634f * SCALE;
    if (__builtin_expect(__all((pmax - m_reg) * SCALE <= THR), 1)) { mn = m_reg; alpha = 1.f; }
    else { mn = fmaxf(m_reg, pmax); alpha = __builtin_amdgcn_exp2f((m_reg - mn) * C2); m_reg = mn; }
    const float mnL = -mn * C2;
    for (int r = 0; r < 16; ++r) p0[r] = fmaf(p0[r], C2, mnL); for (int r = 0; r < 16; ++r) p1[r] = fmaf(p1[r], C2, mnL);
    for (int r = 0; r < 16; ++r) p0[r] = __builtin_amdgcn_exp2f(p0[r]);
}
__device__ __forceinline__ void finishSM(f32x16& p0, f32x16& p1, float alpha, float& l_reg, bf16x8& pa0, bf16x8& pa1, bf16x8& pa2, bf16x8& pa3) {
    for (int r = 0; r < 16; ++r) p1[r] = __builtin_amdgcn_exp2f(p1[r]);
    float ps = 0; for (int r = 0; r < 16; ++r) ps += p0[r]; for (int r = 0; r < 16; ++r) ps += p1[r];
    { auto rr = __builtin_amdgcn_permlane32_swap(__float_as_uint(ps), __float_as_uint(ps), false, false);
      ps = __uint_as_float(rr[0]) + __uint_as_float(rr[1]); }
    l_reg = l_reg * alpha + ps;
#define PK4(P, B_, OUT) do { unsigned a0 = cvtpk(P[B_+0], P[B_+1]), a1 = cvtpk(P[B_+2], P[B_+3]);                          \
        unsigned b0 = cvtpk(P[B_+4], P[B_+5]), b1 = cvtpk(P[B_+6], P[B_+7]);                                             \
        auto r0 = __builtin_amdgcn_permlane32_swap(a0, b0, false, false); auto r1 = __builtin_amdgcn_permlane32_swap(a1, b1, false, false); \
        u32x4 w = {r0[0], r1[0], r0[1], r1[1]}; OUT = *reinterpret_cast<bf16x8*>(&w); } while (0)
    PK4(p0, 0, pa0); PK4(p0, 8, pa1); PK4(p1, 0, pa2); PK4(p1, 8, pa3);
#undef PK4
}
template <int KB, bool SK>
__device__ __forceinline__ void qkt(f32x16& p0, f32x16& p1, const char* K_lds, int r32, int hi, const bf16x8* qr, bool act) {
    if (SK && !act) { const float NEG = -__builtin_inff();
#pragma unroll
        for (int r = 0; r < 16; ++r) { p0[r] = NEG; p1[r] = NEG; } return; }
    p0 = f32x16{}; p1 = f32x16{};
    const char* kb[4];
#pragma unroll
    for (int dd = 0; dd < 4; ++dd) kb[dd] = K_lds + KB * SHM_K + KSWZ(r32, (dd * 16 + hi * 8) * 2);
#pragma unroll
    for (int d0 = 0; d0 < 8; ++d0) { const char* a = kb[d0 & 3] + (d0 >> 2) * 128;
        bf16x8 b0 = *reinterpret_cast<const bf16x8*>(a);
        bf16x8 b1 = *reinterpret_cast<const bf16x8*>(a + 32 * 256);
        p0 = __builtin_amdgcn_mfma_f32_32x32x16_bf16(b0, qr[d0], p0, 0, 0, 0);
        p1 = __builtin_amdgcn_mfma_f32_32x32x16_bf16(b1, qr[d0], p1, 0, 0, 0); }
}
template <int VB, bool SK>
__device__ __forceinline__ void pv_tile(f32x16* o, int vb0, bf16x8 pa0, bf16x8 pa1, bf16x8 pa2, bf16x8 pa3, bool act) {
    if (SK && !act) return;
#define TRRD(dst, off) asm volatile("ds_read_b64_tr_b16 %0, %1 offset:%2" : "=&v"(dst) : "v"(vb0), "i"(off) : "memory")
#define PV_D0(d0) do { s16x4 l0, l1, l2, l3, h0, h1, h2, h3; constexpr int b_ = VB * SHM_V + v_rd_off(d0, 0, 0);     \
        TRRD(l0, b_); TRRD(h0, b_ + 2048); TRRD(l1, b_ + 4096); TRRD(h1, b_ + 6144); TRRD(l2, b_ + 8192); TRRD(h2, b_ + 10240); TRRD(l3, b_ + 12288); TRRD(h3, b_ + 14336); \
        asm volatile("s_waitcnt lgkmcnt(0)" ::: "memory"); SBAR();                 \
        o[d0] = __builtin_amdgcn_mfma_f32_32x32x16_bf16(pa0, (bf16x8){l0[0], l0[1], l0[2], l0[3], h0[0], h0[1], h0[2], h0[3]}, o[d0], 0, 0, 0);   \
        o[d0] = __builtin_amdgcn_mfma_f32_32x32x16_bf16(pa1, (bf16x8){l1[0], l1[1], l1[2], l1[3], h1[0], h1[1], h1[2], h1[3]}, o[d0], 0, 0, 0);   \
        o[d0] = __builtin_amdgcn_mfma_f32_32x32x16_bf16(pa2, (bf16x8){l2[0], l2[1], l2[2], l2[3], h2[0], h2[1], h2[2], h2[3]}, o[d0], 0, 0, 0);   \
        o[d0] = __builtin_amdgcn_mfma_f32_32x32x16_bf16(pa3, (bf16x8){l3[0], l3[1], l3[2], l3[3], h3[0], h3[1], h3[2], h3[3]}, o[d0], 0, 0, 0); } while (0)
    PV_D0(0); PV_D0(1); PV_D0(2); PV_D0(3);
#undef PV_D0
#undef TRRD
}

template <class TIn, class TOut> struct BlockRef { const TIn* Q; const TIn* K; const TIn* V; TOut* O; int P0; int ldo; };
template <class TIn> struct Seam {
    bf16x8 qr[8];
    bf16x8 st_v0, st_v1, st_k0, st_k1; f32x4 sf0, sf1, sf2, sf3;
    f32x4 tq[16];
};
__device__ __forceinline__ int swa_jlo(int P0, int W) { const int lowk = P0 - W + 1; return lowk > 0 ? lowk / KVBLK : 0; }
#define ROW(p, k0, rr) ((p) + (size_t)((k0) + (rr)) * D + sc)
#define VMW() asm volatile("s_waitcnt vmcnt(0)" ::: "memory")
#define VMWN(n) asm volatile("s_waitcnt vmcnt(%0)" :: "i"(n) : "memory")
#define SLOAD_H(Kp, Vp, k0) do { S.st_v0 = load8<TIn>(ROW(Vp, k0, sr)); S.st_v1 = load8<TIn>(ROW(Vp, k0, 32 + sr));              \
                         S.st_k0 = load8<TIn>(ROW(Kp, k0, sr)); S.st_k1 = load8<TIn>(ROW(Kp, k0, 32 + sr)); } while (0)
#define SWRITE_HK(bf) do { *(bf16x8*)(K_lds + (bf) * SHM_K + kws) = S.st_k0; *(bf16x8*)(K_lds + (bf) * SHM_K + kws + 32 * 256) = S.st_k1; } while (0)
#define SWRITE_HV(bf) do { *(bf16x8*)(V_lds + (bf) * SHM_V + vst0) = S.st_v0; *(bf16x8*)(V_lds + (bf) * SHM_V + vst1) = S.st_v1; } while (0)
#define SWRITE_H(bf) do { SWRITE_HV(bf); SWRITE_HK(bf); } while (0)
#define SLOAD_F(p, k0) do { S.sf0 = *(const f32x4*)ROW(p, k0, sr); S.sf1 = *(const f32x4*)(ROW(p, k0, sr) + 4);                \
                            S.sf2 = *(const f32x4*)ROW(p, k0, 32 + sr); S.sf3 = *(const f32x4*)(ROW(p, k0, 32 + sr) + 4); } while (0)
#define SWRITE_KF(bf) do { *(bf16x8*)(K_lds + (bf) * SHM_K + kws) = pack8(S.sf0, S.sf1); *(bf16x8*)(K_lds + (bf) * SHM_K + kws + 32 * 256) = pack8(S.sf2, S.sf3); } while (0)
#define SWRITE_VF(bf) do { *(bf16x8*)(V_lds + (bf) * SHM_V + vst0) = pack8(S.sf0, S.sf1); *(bf16x8*)(V_lds + (bf) * SHM_V + vst1) = pack8(S.sf2, S.sf3); } while (0)
template <class TIn, class TOut>
__device__ __forceinline__ void causal_swa_prime(const BlockRef<TIn, TOut>& cur, int W, char* lds, Seam<TIn>& S) {
    constexpr bool F32 = same_t<TIn, float>::v;
    int tid_ = threadIdx.x; asm volatile("" : "+v"(tid_));
    const int tid = tid_, wid = __builtin_amdgcn_readfirstlane(tid >> 6), lane = tid & 63, r32 = lane & 31, hi = lane >> 5;
    const int sr = tid >> 4, sc = (tid & 15) * 8, kws = KSWZ(sr, sc * 2); char* K_lds = lds + 2 * SHM_V;
    const int kb0 = swa_jlo(cur.P0, W) * KVBLK;
    for (int d0 = 0; d0 < 8; ++d0) S.qr[d0] = load8<TIn>(cur.Q + (size_t)(wid * QBLK + r32) * D + d0 * 16 + hi * 8);
    if constexpr (F32) { SLOAD_F((const float*)cur.K, kb0); VMW(); SWRITE_KF(0); SBAR(); SLOAD_F((const float*)cur.V, kb0); }
    else { SLOAD_H(cur.K, cur.V, kb0); VMW(); SWRITE_HK(0); }
    __syncthreads();
}
template <class TIn, class TOut>
__device__ __forceinline__ void causal_swa_block(const BlockRef<TIn, TOut>& cur, const BlockRef<TIn, TOut>& nxt, int skv, int W, char* lds, Seam<TIn>& S) {
    constexpr bool F32 = same_t<TIn, float>::v;
    int tid_ = threadIdx.x; asm volatile("" : "+v"(tid_));
    const int tid = tid_, wid = __builtin_amdgcn_readfirstlane(tid >> 6), lane = tid & 63, r32 = lane & 31, hi = lane >> 5;
    const int j_lo = swa_jlo(cur.P0, W);
    int j_hi = (cur.P0 + QB - 1) / KVBLK + 1; if (j_hi > skv / KVBLK) j_hi = skv / KVBLK;
    const int NT = j_hi - j_lo;
    const int kbn = swa_jlo(nxt.P0, W) * KVBLK;
    const int qlo = cur.P0 + wid * QBLK, qm = qlo + r32 - 4 * hi;
    char* V_lds = lds; char* K_lds = lds + 2 * SHM_V;
    float* ws = (float*)(lds + 2 * SHM_V + 2 * SHM_K) + wid * 64; float* li_l = ws, * al_l = ws + 32;
    float m_reg = -1e30f, l_reg = 0; f32x16 o[4] = {};
    const int sr = tid >> 4, sc = (tid & 15) * 8, vst0 = v_st(sr, sc), vst1 = v_st(32 + sr, sc), kws = KSWZ(sr, sc * 2);
    const int vb0 = (int)(uintptr_t)V_lds + v_rd_base(lane);
    const TIn* Kh = cur.K; const TIn* Vh = cur.V;
#define RESC(a) do { if (__any((a) < 1.f)) { if (hi == 0) al_l[r32] = (a); asm volatile("s_waitcnt lgkmcnt(0)" ::: "memory");              \
                     for (int d_ = 0; d_ < 4; ++d_) for (int r = 0; r < 16; ++r) o[d_][r] *= al_l[crow(r, hi)]; } } while (0)
#define KBASE(t) ((j_lo + (t)) * KVBLK)
#define ACT(t) (KBASE(t) <= qlo + QBLK - 1 && KBASE(t) + KVBLK - 1 >= qlo - W + 1)
#define MASKT(P0_, P1_, t) do { const int kb_ = KBASE(t); if ((!SK || ACT(t)) && (kb_ + KVBLK - 1 > qlo || kb_ <= qlo + QBLK - 1 - W)) mask_tile(P0_, P1_, qm - kb_, (unsigned)W); } while (0)
    constexpr int NQL = F32 ? 16 : 8;
    constexpr bool SK = WSKIP && !F32;
#define SEAM_K0() do { VMWN(NQL); if constexpr (F32) { SWRITE_KF(0); SBAR(); SLOAD_F((const float*)nxt.V, kbn); } else { SWRITE_HK(0); } SBAR(); } while (0)
    f32x16 pA0, pA1, pB0, pB1; float mnA, mnB, alA, alB; bf16x8 pa0, pa1, pa2, pa3;
    if constexpr (F32) { VMW(); SWRITE_VF(0); SBAR(); } else { SWRITE_HV(0); SBAR(); }
    if (NT > 1) { if constexpr (F32) SLOAD_F((const float*)Kh, KBASE(1)); else SLOAD_H(Kh, Vh, KBASE(1)); }
    SBAR(); qkt<0, SK>(pA0, pA1, K_lds, r32, hi, S.qr, ACT(0));
    if constexpr (F32) { if (NT > 1) { VMW(); SWRITE_KF(1); SBAR(); SLOAD_F((const float*)Vh, KBASE(1)); } }
    MASKT(pA0, pA1, 0); partialSM(pA0, pA1, m_reg, mnA, alA);
    if (NT > 1) { VMW(); if constexpr (F32) { SWRITE_VF(1); SBAR(); if (NT > 2) SLOAD_F((const float*)Kh, KBASE(2)); } else SWRITE_H(1); }
    __syncthreads();
#define HALF_STEP(PX0, PX1, mnX, alX, PY0, PY1, alY, t, KB, VB, SB) do {                                                      \
        SBAR(); qkt<KB, SK>(PX0, PX1, K_lds, r32, hi, S.qr, ACT(t));                                             \
        finishSM(PY0, PY1, alY, l_reg, pa0, pa1, pa2, pa3); SBAR();                                                           \
        if ((t) + 1 < NT) { if constexpr (F32) { VMW(); SWRITE_KF(SB); SBAR(); SLOAD_F((const float*)Vh, KBASE((t) + 1)); }  \
                            else { SLOAD_H(Kh, Vh, KBASE((t) + 1)); } SBAR(); }                                               \
        pv_tile<VB, SK>(o, vb0, pa0, pa1, pa2, pa3, ACT((t) - 1)); MASKT(PX0, PX1, (t)); partialSM(PX0, PX1, m_reg, mnX, alX);                                        \
        __syncthreads();                                                                                                      \
        if ((t) + 1 < NT) { VMW(); if constexpr (F32) { SWRITE_VF(SB); SBAR(); if ((t) + 2 < NT) SLOAD_F((const float*)Kh, KBASE((t) + 2)); } \
                            else { SWRITE_H(SB); } }                                                                          \
        RESC(alX); __syncthreads(); } while (0)
    for (int t = 1; t + 1 < NT; t += 2) {
        HALF_STEP(pB0, pB1, mnB, alB, pA0, pA1, alA, t, 1, 0, 0);
        HALF_STEP(pA0, pA1, mnA, alA, pB0, pB1, alB, t + 1, 0, 1, 1);
    }
    const bool even = (NT & 1) == 0;
    if (even) { SBAR(); qkt<1, SK>(pB0, pB1, K_lds, r32, hi, S.qr, ACT(NT - 1)); SBAR(); }
#define QROW(e) (nxt.Q + (size_t)(wid * QBLK + r32) * D + ((e) >> 1) * 16 + hi * 8 + ((e) & 1) * 4)
    if constexpr (F32) { SLOAD_F((const float*)nxt.K, kbn); SBAR();
#pragma unroll
        for (int e = 0; e < 8; ++e) S.tq[e] = *(const f32x4*)QROW(e); }
    else { SLOAD_H(nxt.K, nxt.V, kbn); SBAR();
#pragma unroll
        for (int d0 = 0; d0 < 8; ++d0) S.qr[d0] = load8<TIn>(nxt.Q + (size_t)(wid * QBLK + r32) * D + d0 * 16 + hi * 8); }
    SBAR();
    finishSM(pA0, pA1, alA, l_reg, pa0, pa1, pa2, pa3); SBAR();
    if constexpr (F32) {
#pragma unroll
        for (int e = 8; e < 16; ++e) S.tq[e] = *(const f32x4*)QROW(e); SBAR(); }
#undef QROW
    pv_tile<0, SK>(o, vb0, pa0, pa1, pa2, pa3, ACT(even ? NT - 2 : NT - 1));
    if (even) { MASKT(pB0, pB1, NT - 1); partialSM(pB0, pB1, m_reg, mnB, alB); __syncthreads(); RESC(alB);
        finishSM(pB0, pB1, alB, l_reg, pa0, pa1, pa2, pa3); SBAR(); pv_tile<1, SK>(o, vb0, pa0, pa1, pa2, pa3, ACT(NT - 1)); }
    SBAR(); SEAM_K0();
    if (hi == 0) li_l[r32] = l_reg; asm volatile("s_waitcnt lgkmcnt(0)" ::: "memory");
    float rli[16];
#pragma unroll
    for (int r = 0; r < 16; ++r) rli[r] = __builtin_amdgcn_rcpf(li_l[crow(r, hi)]);
    const int LDO = cur.ldo; TOut* Ow = cur.O + (size_t)(wid * QBLK) * LDO;
#pragma unroll
    for (int r = 0; r < 16; ++r) { const int orow = crow(r, hi);
#pragma unroll
        for (int d0 = 0; d0 < 4; ++d0) { const float v = o[d0][r] * rli[r];
            if constexpr (same_t<TOut, float>::v) { Ow[(size_t)orow * LDO + d0 * 32 + r32] = v; }
            else { const float vn = __shfl_xor(v, 1);
                   if ((r32 & 1) == 0) *(unsigned*)(Ow + (size_t)orow * LDO + d0 * 32 + r32) = cvtpk(v, vn); } } }
    if constexpr (F32) {
#pragma unroll
        for (int d0 = 0; d0 < 8; ++d0) S.qr[d0] = pack8(S.tq[2 * d0], S.tq[2 * d0 + 1]); }
    __syncthreads();
#undef RESC
#undef KBASE
#undef ACT
#undef MASKT
#undef SEAM_K0
#undef HALF_STEP
}
#undef ROW
#undef VMW
#undef VMWN
#undef SLOAD_H
#undef SWRITE_HK
#undef SWRITE_HV
#undef SWRITE_H
#undef SLOAD_F
#undef SWRITE_KF
#undef SWRITE_VF


constexpr int QB2 = 128, L2_K = 0, L2_V0 = 32768, L2_V1 = 65536, L2_P = 98304;
struct Ref2 { const bf16* Q; const bf16* K; const bf16* V0; const bf16* V1; unsigned short* O0; unsigned short* O1; int P0; };
struct Seam2 { bf16x8 qr[8]; bf16x8 sk0, sk1, sa0, sa1, sb0, sb1; f32x16 pA0, pA1; };
#define LD8(p) (*reinterpret_cast<const bf16x8*>(p))
#define VMW2() asm volatile("s_waitcnt vmcnt(0)" ::: "memory")
__device__ __forceinline__ void pv3_tile(f32x16* o, int vb, bf16x8 pa0, bf16x8 pa1, bf16x8 pa2, bf16x8 pa3, bf16x8 pb0, bf16x8 pb1, bf16x8 pb2, bf16x8 pb3, float fA, float fB, const float* alA, int hi) {
#define TRRD(dst, off) asm volatile("ds_read_b64_tr_b16 %0, %1 offset:%2" : "=&v"(dst) : "v"(vb), "i"(off) : "memory")
#define RD8(X, g) do { constexpr int b_ = v_rd_off((g), 0, 0); TRRD(X##0, b_); TRRD(X##1, b_ + 2048); TRRD(X##2, b_ + 4096); TRRD(X##3, b_ + 6144); \
        TRRD(X##4, b_ + 8192); TRRD(X##5, b_ + 10240); TRRD(X##6, b_ + 12288); TRRD(X##7, b_ + 14336); } while (0)
#define VF(X, a, b) (bf16x8){X##a[0], X##a[1], X##a[2], X##a[3], X##b[0], X##b[1], X##b[2], X##b[3]}
#define MM8(X, g) do { \
        o[g] = __builtin_amdgcn_mfma_f32_32x32x16_bf16(pa0, VF(X, 0, 1), o[g], 0, 0, 0); o[4 + g] = __builtin_amdgcn_mfma_f32_32x32x16_bf16(pb0, VF(X, 0, 1), o[4 + g], 0, 0, 0); \
        o[g] = __builtin_amdgcn_mfma_f32_32x32x16_bf16(pa1, VF(X, 2, 3), o[g], 0, 0, 0); o[4 + g] = __builtin_amdgcn_mfma_f32_32x32x16_bf16(pb1, VF(X, 2, 3), o[4 + g], 0, 0, 0); \
        o[g] = __builtin_amdgcn_mfma_f32_32x32x16_bf16(pa2, VF(X, 4, 5), o[g], 0, 0, 0); o[4 + g] = __builtin_amdgcn_mfma_f32_32x32x16_bf16(pb2, VF(X, 4, 5), o[4 + g], 0, 0, 0); \
        o[g] = __builtin_amdgcn_mfma_f32_32x32x16_bf16(pa3, VF(X, 6, 7), o[g], 0, 0, 0); o[4 + g] = __builtin_amdgcn_mfma_f32_32x32x16_bf16(pb3, VF(X, 6, 7), o[4 + g], 0, 0, 0); } while (0)
#define LGK8() do { asm volatile("s_waitcnt lgkmcnt(8)" ::: "memory"); SBAR(); } while (0)
    s16x4 A0, A1, A2, A3, A4, A5, A6, A7, B0, B1, B2, B3, B4, B5, B6, B7;
    RD8(A, 0); RD8(B, 1);
    if (__builtin_amdgcn_readfirstlane(__float_as_int(fA)) != 0) {
        const f32x4* a4p = (const f32x4*)alA + hi; const f32x4 a0 = a4p[0], a1 = a4p[2], a2 = a4p[4], a3 = a4p[6];
#pragma unroll
        for (int d_ = 0; d_ < 4; ++d_)
#pragma unroll
            for (int j = 0; j < 4; ++j) { o[d_][j] *= a0[j]; o[d_][4 + j] *= a1[j]; o[d_][8 + j] *= a2[j]; o[d_][12 + j] *= a3[j]; } }
    if (__builtin_amdgcn_readfirstlane(__float_as_int(fB)) != 0) {
        const f32x4* a4p = (const f32x4*)(alA + 32) + hi; const f32x4 a0 = a4p[0], a1 = a4p[2], a2 = a4p[4], a3 = a4p[6];
#pragma unroll
        for (int d_ = 4; d_ < 8; ++d_)
#pragma unroll
            for (int j = 0; j < 4; ++j) { o[d_][j] *= a0[j]; o[d_][4 + j] *= a1[j]; o[d_][8 + j] *= a2[j]; o[d_][12 + j] *= a3[j]; } }
    asm volatile("s_waitcnt lgkmcnt(0)" ::: "memory"); SBAR(); MM8(A, 0); SBAR();
    RD8(A, 2); LGK8(); MM8(B, 1); SBAR();
    RD8(B, 3); LGK8(); MM8(A, 2); SBAR();
    asm volatile("s_waitcnt lgkmcnt(0)" ::: "memory"); SBAR(); MM8(B, 3);
#undef TRRD
#undef RD8
#undef VF
#undef MM8
#undef LGK8
}
template <bool RS>
__device__ __forceinline__ void diff2_prime(const Ref2& cur, char* lds, Seam2& S) {
    int tid_ = threadIdx.x; asm volatile("" : "+v"(tid_));
    const int tid = tid_, wid = __builtin_amdgcn_readfirstlane(tid >> 6), lane = tid & 63, r32 = lane & 31, hi = lane >> 5;
    const int sr = tid >> 4, sc = (tid & 15) * 8, kws = KSWZ(sr, sc * 2);
    if constexpr (RS) {
#pragma unroll
        for (int d0 = 0; d0 < 8; ++d0) S.qr[d0] = LD8(cur.Q + (size_t)(wid * QBLK + r32) * D + d0 * 16 + hi * 8); }
    S.sk0 = LD8(cur.K + (size_t)sr * D + sc); S.sk1 = LD8(cur.K + (size_t)(32 + sr) * D + sc);
    VMW2();
    *(bf16x8*)(lds + L2_K + kws) = S.sk0; *(bf16x8*)(lds + L2_K + kws + 32 * 256) = S.sk1;
    S.sk0 = LD8(cur.K + (size_t)(KVBLK + sr) * D + sc); S.sk1 = LD8(cur.K + (size_t)(KVBLK + 32 + sr) * D + sc);
    S.sa0 = LD8(cur.V0 + (size_t)sr * D + sc); S.sa1 = LD8(cur.V0 + (size_t)(32 + sr) * D + sc);
    S.sb0 = LD8(cur.V1 + (size_t)sr * D + sc); S.sb1 = LD8(cur.V1 + (size_t)(32 + sr) * D + sc);
    VMW2();
    *(bf16x8*)(lds + L2_K + SHM_K + kws) = S.sk0; *(bf16x8*)(lds + L2_K + SHM_K + kws + 32 * 256) = S.sk1;
    __syncthreads();
    if constexpr (RS) qkt<0, false>(S.pA0, S.pA1, lds + L2_K, r32, hi, S.qr, true);
}
template <bool RS>
__device__ __forceinline__ void diff2_block(const Ref2& cur, const Ref2& nxt, char* lds, float* xl, Seam2& S) {
    int tid_ = threadIdx.x; asm volatile("" : "+v"(tid_));
    const int tid = tid_, wid = __builtin_amdgcn_readfirstlane(tid >> 6), lane = tid & 63, r32 = lane & 31, hi = lane >> 5;
    const int w4 = wid & 3;
    const int NT = (cur.P0 + QB2 - 1) / KVBLK + 1;
    const int qlo = cur.P0 + w4 * QBLK, qm = qlo + r32 - 4 * hi;
    char* K_lds = lds + L2_K; char* V0_lds = lds + L2_V0; char* V1_lds = lds + L2_V1; char* P_lds = lds + L2_P + w4 * 4096;
    float* alp = xl + w4 * 32; float* li = xl + 256 + (RS ? w4 : (w4 >> 1) * 2) * 32; float* flg = xl + 384 + w4;
    const int sr = tid >> 4, sc = (tid & 15) * 8, vst0 = v_st(sr, sc), vst1 = v_st(32 + sr, sc), kws = KSWZ(sr, sc * 2);
    const int vbase = (int)(uintptr_t)V0_lds + v_rd_base(lane);
    float m_reg = -1e30f, l_reg = 0.f; f32x16 o[RS ? 1 : 8] = {};
    auto stage_top = [&](const int t, const bool drain) __attribute__((always_inline)) {
        const int par = t & 1;
        if (!drain) { *(bf16x8*)(V0_lds + par * SHM_V + vst0) = S.sa0; *(bf16x8*)(V0_lds + par * SHM_V + vst1) = S.sa1;
                      *(bf16x8*)(V1_lds + par * SHM_V + vst0) = S.sb0; *(bf16x8*)(V1_lds + par * SHM_V + vst1) = S.sb1; }
        const bool kc = !drain && t + 2 < NT, kn = drain || t == NT - 1;
        if (kc || kn) { const bf16* Kp = kc ? cur.K : nxt.K; const int k0 = kc ? (t + 2) * KVBLK : (drain ? KVBLK : 0);
            S.sk0 = LD8(Kp + (size_t)(k0 + sr) * D + sc); S.sk1 = LD8(Kp + (size_t)(k0 + 32 + sr) * D + sc); }
        const bool vc = !drain && t + 1 < NT;
        if (vc || drain) { const bf16* Ap = vc ? cur.V0 : nxt.V0; const bf16* Bp = vc ? cur.V1 : nxt.V1; const int k0 = vc ? (t + 1) * KVBLK : 0;
            S.sa0 = LD8(Ap + (size_t)(k0 + sr) * D + sc); S.sa1 = LD8(Ap + (size_t)(k0 + 32 + sr) * D + sc);
            S.sb0 = LD8(Bp + (size_t)(k0 + sr) * D + sc); S.sb1 = LD8(Bp + (size_t)(k0 + 32 + sr) * D + sc); }
    };
    auto stage_end = [&](const int t, const bool drain, const int nyoung) __attribute__((always_inline)) {
        const bool kc = !drain && t + 2 < NT, kn = drain || t == NT - 1;
        if (kc || kn) { const int wb = kc ? (t & 1) : (drain ? 1 : 0);
            (void)nyoung;
            *(bf16x8*)(K_lds + wb * SHM_K + kws) = S.sk0; *(bf16x8*)(K_lds + wb * SHM_K + kws + 32 * 256) = S.sk1; }
    };
    if constexpr (RS) {
        f32x16 pB0, pB1;
        auto siter = [&](f32x16& pX0, f32x16& pX1, f32x16& pY0, f32x16& pY1, const int t) __attribute__((always_inline)) {
            const int par = t & 1;
            stage_top(t, false);
            if (t == NT - 1) {
#pragma unroll
                for (int d0 = 0; d0 < 8; ++d0) S.qr[d0] = LD8(nxt.Q + (size_t)(w4 * QBLK + r32) * D + d0 * 16 + hi * 8); }
            SBAR();
            if (t + 1 < NT) qkt<0, false>(pY0, pY1, K_lds + ((t + 1) & 1) * SHM_K, r32, hi, S.qr, true);
            float mn, alpha; bf16x8 pa0, pa1, pa2, pa3;
            { const int kb = t * KVBLK; if (kb + KVBLK - 1 > qlo) mask_tile(pX0, pX1, qm - kb, 1u << 30); }
            partialSM(pX0, pX1, m_reg, mn, alpha); finishSM(pX0, pX1, alpha, l_reg, pa0, pa1, pa2, pa3);
            { bf16x8* pw = (bf16x8*)(P_lds + par * 16384) + lane; pw[0] = pa0; pw[64] = pa1; pw[128] = pa2; pw[192] = pa3; }
            const bool need = __any(alpha < 1.f);
            if (hi == 0) { alp[par * 128 + r32] = alpha; if (t == NT - 1) li[r32] = l_reg; if (r32 == 0) flg[par * 4] = need ? 1.f : 0.f; }
            SBAR();
            stage_end(t, false, t == NT - 1 ? 12 : 4);
            __syncthreads();
        };
#pragma unroll 1
        for (int t = 0; t < NT; t += 2) { siter(S.pA0, S.pA1, pB0, pB1, t); siter(pB0, pB1, S.pA0, S.pA1, t + 1); }
        stage_top(NT, true);
        SBAR();
        qkt<0, false>(S.pA0, S.pA1, K_lds, r32, hi, S.qr, true);
        SBAR();
        stage_end(NT, true, 4);
        __syncthreads();
    } else {
#pragma unroll 1
        for (int t = 0; t <= NT; ++t) {
            const bool drain = t == NT;
            stage_top(t, drain);
            SBAR();
            if (t >= 1) {
                const int pp = (t - 1) & 1, rg = w4 >> 1, hf = w4 & 1;
                char* PA = lds + L2_P + (2 * rg) * 4096 + pp * 16384; float* alA = xl + (2 * rg) * 32 + pp * 128; float* flA = xl + 384 + 2 * rg + pp * 4;
                bf16x8 pa0, pa1, pa2, pa3, pb0, pb1, pb2, pb3;
                { const bf16x8* pr = (const bf16x8*)PA + lane; pa0 = pr[0]; pa1 = pr[64]; pa2 = pr[128]; pa3 = pr[192]; pb0 = pr[256]; pb1 = pr[320]; pb2 = pr[384]; pb3 = pr[448]; }
                const float fA = flA[0], fB = flA[1];
                pv3_tile(o, vbase + hf * (L2_V1 - L2_V0) + pp * SHM_V, pa0, pa1, pa2, pa3, pb0, pb1, pb2, pb3, fA, fB, alA, hi);
            }
            SBAR();
            stage_end(t, drain, 4);
            if (drain) {
                int r32e = r32, hie = hi; asm volatile("" : "+v"(r32e), "+v"(hie));
                const f32x4* l4p = (const f32x4*)li + hie; const f32x4 l0 = l4p[0], l1 = l4p[2], l2 = l4p[4], l3 = l4p[6];
                float rli[16];
#pragma unroll
                for (int j = 0; j < 4; ++j) { rli[j] = __builtin_amdgcn_rcpf(l0[j]); rli[4 + j] = __builtin_amdgcn_rcpf(l1[j]); rli[8 + j] = __builtin_amdgcn_rcpf(l2[j]); rli[12 + j] = __builtin_amdgcn_rcpf(l3[j]); }
                const f32x4* m4p = (const f32x4*)(li + 32) + hie; const f32x4 n0 = m4p[0], n1 = m4p[2], n2 = m4p[4], n3 = m4p[6];
                float rlj[16];
#pragma unroll
                for (int j = 0; j < 4; ++j) { rlj[j] = __builtin_amdgcn_rcpf(n0[j]); rlj[4 + j] = __builtin_amdgcn_rcpf(n1[j]); rlj[8 + j] = __builtin_amdgcn_rcpf(n2[j]); rlj[12 + j] = __builtin_amdgcn_rcpf(n3[j]); }
                unsigned short* Ow = ((w4 & 1) ? cur.O1 : cur.O0) + (size_t)((w4 >> 1) * 2 * QBLK) * D;
#pragma unroll
                for (int r = 0; r < 16; r += 2) { const int orow = crow(r, hie);
#pragma unroll
                    for (int d0 = 0; d0 < 4; ++d0) {
                        *(unsigned*)(Ow + (size_t)(orow >> 1) * (2 * D) + (d0 * 32 + r32e) * 2) = cvtpk(o[d0][r] * rli[r], o[d0][r + 1] * rli[r + 1]);
                        *(unsigned*)(Ow + (size_t)((QBLK + orow) >> 1) * (2 * D) + (d0 * 32 + r32e) * 2) = cvtpk(o[4 + d0][r] * rlj[r], o[4 + d0][r + 1] * rlj[r + 1]); } }
            }
            __syncthreads();
        }
    }
}
#undef LD8
#undef VMW2
}
constexpr size_t al256(size_t x) { return (x + 255) & ~(size_t)255; }
constexpr size_t WS_CTL = 0, CTL_ZERO_BYTES = 1u << 20;
constexpr size_t WS_WGU   = CTL_ZERO_BYTES;
constexpr size_t WS_WDN   = WS_WGU  + (size_t)8 * NGU * DM * 2;
constexpr size_t WS_WOUT  = WS_WDN  + (size_t)8 * DM * FF * 2;
constexpr size_t WS_WMEM  = WS_WOUT + (size_t)4 * DM * DM * 2;
constexpr size_t WS_WAIN  = WS_WMEM + (size_t)4 * 1024 * DM * 2;
constexpr size_t WS_WKV   = WS_WAIN + (size_t)2 * NAIN * DM * 2;
constexpr size_t WS_WBIN  = WS_WKV  + (size_t)NKV * DM * 2;
constexpr size_t WS_COS   = WS_WBIN + (size_t)2 * NBIN * DM * 2;
constexpr size_t WS_MEMN  = WS_COS  + (size_t)SEQ * 64 * 4;
constexpr size_t WS_MK    = WS_MEMN + (size_t)4 * 1024 * DM * 2;
constexpr size_t WS_MV    = WS_MK   + (size_t)4 * 1024 * 512 * 2;
constexpr size_t WS_XB    = WS_MV   + (size_t)4 * 1024 * 512 * 2;
constexpr size_t WS_SS    = WS_XB   + (size_t)M * DM * 2;
constexpr size_t WS_XH    = WS_SS   + (size_t)M * 32 * 4;
constexpr size_t WS_HID   = WS_XH   + (size_t)M * DM * 2;
constexpr size_t WS_ZA    = WS_HID  + (size_t)M * FF * 2;
constexpr size_t WS_VSTAT = WS_ZA   + (size_t)M * 3072 * 2;
constexpr size_t WS_QB    = WS_VSTAT + (size_t)M * 24 * 4;
constexpr size_t WS_KSH   = WS_QB   + (size_t)M * 1536 * 2;
constexpr size_t WS_VSH   = WS_KSH  + (size_t)M * 1536 * 2;
constexpr size_t WS_QMB   = WS_VSH  + (size_t)M * 1536 * 2;
constexpr size_t WS_OATT  = WS_QMB  + (size_t)M * 512 * 2;
constexpr size_t WS_CAT   = WS_OATT + (size_t)2 * 96 * SEQ * 128 * 4;
constexpr size_t WS_END   = WS_CAT  + (size_t)M * DM * 2;
static_assert(WS_WGU % 256 == 0 && WS_COS % 256 == 0 && WS_VSTAT % 256 == 0 && WS_QB % 256 == 0 && WS_END % 256 == 0, "ws alignment");

constexpr int RING_OFF = 0, RING_BYTES = 131072;
constexpr int LDSCTL_OFF = 141312, MISC_OFF = LDSCTL_OFF + 320;
constexpr int LDS_BYTES = 147456;
constexpr int NWAVES = 8;

#define GAS __attribute__((address_space(1)))
#define LAS __attribute__((address_space(3)))
typedef unsigned short bf16r;
typedef unsigned v4u __attribute__((ext_vector_type(4)));
typedef unsigned v2u __attribute__((ext_vector_type(2)));
typedef float f32x4 __attribute__((ext_vector_type(4)));
typedef short bf16x8 __attribute__((ext_vector_type(8)));
typedef GAS unsigned gu32;
#define LDS_WAIT() asm volatile("s_waitcnt lgkmcnt(0)" ::: "memory")
#define VM_WAIT() asm volatile("s_waitcnt vmcnt(0)" ::: "memory")
__device__ __forceinline__ unsigned f2bf(float f) { unsigned u = __builtin_bit_cast(unsigned, f); return (u + 0x7fffu + ((u >> 16) & 1u)) >> 16; }
__device__ __forceinline__ unsigned pk2(float lo, float hi) { return f2bf(lo) | (f2bf(hi) << 16); }
__device__ __forceinline__ float bf2f(unsigned short b) { return __builtin_bit_cast(float, ((unsigned)b) << 16); }
__device__ __forceinline__ float wave_sum(float v) {
#pragma unroll
    for (int o = 1; o < 64; o <<= 1) v += __shfl_xor(v, o);
    return v;
}
#define XB_TMO      128
#define XB_XCNT(j)  (256  + 64 * (j))
#define XB_XSUB(j)  (1280 + 64 * (j))
#define XB_XGEN(j)  (2304 + 64 * (j))
#define XB_TOP      3328
#define XB_TOPGEN   3392
#define XCD_BAR_WORDS 3456
#define XB_SPIN_CAP (1u << 18)

__device__ __forceinline__ unsigned xb_ld(unsigned* p)              { return __hip_atomic_load(p, __ATOMIC_RELAXED, __HIP_MEMORY_SCOPE_AGENT); }
__device__ __forceinline__ unsigned xb_add(unsigned* p, unsigned v) { return __hip_atomic_fetch_add(p, v, __ATOMIC_RELAXED, __HIP_MEMORY_SCOPE_AGENT); }
__device__ __forceinline__ unsigned xb_xcc_id() { return (unsigned)__builtin_amdgcn_s_getreg((3 << 11) | 20) & 0xFu; }
#define XB_SPIN(cond, bar) do { unsigned _sp = 0; while (cond) { __builtin_amdgcn_s_sleep(1); \
    if ((++_sp & 255u) == 0u) { if (xb_ld(&(bar)[XB_TMO])) break; if (_sp > XB_SPIN_CAP) { atomicAdd(&(bar)[XB_TMO], 1u); break; } } } } while (0)

struct XcdBarrier {
    unsigned* bar; unsigned x;
    volatile LAS unsigned* st;
};

__device__ __forceinline__ XcdBarrier xcd_barrier_post(unsigned* bar, volatile LAS unsigned* st) {
    XcdBarrier b; b.bar = bar; b.x = xb_xcc_id(); b.st = st;
    if (threadIdx.x == 0) (void)xb_add(&bar[XB_XCNT(b.x)], 1u);
    return b;
}
__device__ __forceinline__ void xcd_barrier_complete(unsigned* bar, unsigned x, unsigned& nloc, unsigned& nx) {
    const unsigned G = gridDim.x * gridDim.y * gridDim.z;
    unsigned sum, cnt, mine, sp = 0u;
    for (;;) {
        sum = 0u; cnt = 0u; mine = 0u;
#pragma unroll
        for (unsigned j = 0; j < 16; ++j) { const unsigned c = xb_ld(&bar[XB_XCNT(j)]); sum += c; cnt += (c > 0u) ? 1u : 0u; mine = (j == x) ? c : mine; }
        if (sum == G) break;
        __builtin_amdgcn_s_sleep(1);
        if ((++sp & 255u) == 0u) { if (xb_ld(&bar[XB_TMO])) break; if (sp > XB_SPIN_CAP) { atomicAdd(&bar[XB_TMO], 1u); break; } }
    }
    nloc = mine > 0u ? mine : 1u; nx = cnt > 0u ? cnt : 1u;
}

__device__ __forceinline__ void xcd_barrier(const XcdBarrier& b) {
    asm volatile("s_waitcnt vmcnt(0)" ::: "memory");
    __syncthreads();
    if (threadIdx.x == 0) {
        unsigned* bar = b.bar;
        __builtin_amdgcn_s_waitcnt(0);
        unsigned nloc = b.st[0], nx = b.st[1];
        if (nloc == 0u) { xcd_barrier_complete(bar, b.x, nloc, nx); b.st[0] = nloc; b.st[1] = nx; }
        const unsigned old = xb_add(&bar[XB_XSUB(b.x)], 1u);
        const unsigned gen = old / nloc;
        if (old + 1u == (gen + 1u) * nloc) {
            __builtin_amdgcn_fence(__ATOMIC_RELEASE, "agent");
            asm volatile("s_waitcnt vmcnt(0)" ::: "memory");
            const unsigned og = xb_add(&bar[XB_TOP], 1u);
            const unsigned tg = og / nx;
            if (og + 1u == (tg + 1u) * nx) xb_add(&bar[XB_TOPGEN], 1u);
            else XB_SPIN(xb_ld(&bar[XB_TOPGEN]) == tg, bar);
            __builtin_amdgcn_fence(__ATOMIC_ACQUIRE, "agent");
            xb_add(&bar[XB_XGEN(b.x)], 1u);
            asm volatile("s_waitcnt vmcnt(0)" ::: "memory");
        } else {
            XB_SPIN(xb_ld(&bar[XB_XGEN(b.x)]) == gen, bar);
            __builtin_amdgcn_fence(__ATOMIC_ACQUIRE, "agent");
            asm volatile("s_waitcnt vmcnt(0)" ::: "memory");
        }
    }
    __syncthreads();
}

#define XB_LSUB(j)  (4096 + 64 * (j))
#define XB_LGEN(j)  (5120 + 64 * (j))
#define XB_XCCTAB   6144
__device__ __forceinline__ void xcd_local_barrier(const XcdBarrier& b) {
    asm volatile("s_waitcnt vmcnt(0)" ::: "memory");
    __syncthreads();
    if (threadIdx.x == 0) {
        unsigned* bar = b.bar;
        __builtin_amdgcn_s_waitcnt(0);
        const unsigned nloc = b.st[0] ? b.st[0] : 1u;
        const unsigned old = xb_add(&bar[XB_LSUB(b.x)], 1u);
        const unsigned gen = old / nloc;
        if (old + 1u == (gen + 1u) * nloc) {
#ifndef LOCAL_BAR_RELEASE
#define LOCAL_BAR_RELEASE 0
#endif
            if (LOCAL_BAR_RELEASE) { __builtin_amdgcn_fence(__ATOMIC_RELEASE, "agent"); asm volatile("s_waitcnt vmcnt(0)" ::: "memory"); }
            __builtin_amdgcn_fence(__ATOMIC_ACQUIRE, "agent");
            xb_add(&bar[XB_LGEN(b.x)], 1u);
            asm volatile("s_waitcnt vmcnt(0)" ::: "memory");
        } else {
            XB_SPIN(xb_ld(&bar[XB_LGEN(b.x)]) == gen, bar);
            __builtin_amdgcn_fence(__ATOMIC_ACQUIRE, "agent");
            asm volatile("s_waitcnt vmcnt(0)" ::: "memory");
        }
    }
    __syncthreads();
}
struct Frame {
    unsigned char* lds_g;
    LAS unsigned char* lds;
    volatile LAS unsigned* MISC;
    gu32* ctl;
    int tid, lane, wave;
    int vcu, G;
    unsigned char* ws;
};

__device__ __forceinline__ void transpose_item(const float* W, int K, int N, bf16r* WT, size_t dst_row0, int k0, int n0, LAS float* scr, int lane, const float* gain) {
    f32x4 v[16]; float gk[16];
#pragma unroll
    for (int i = 0; i < 16; ++i) { const int kk = 4 * i + (lane >> 4); v[i] = *(const f32x4*)(W + (size_t)(k0 + kk) * N + n0 + (lane & 15) * 4); gk[i] = gain ? gain[k0 + kk] : 1.0f; }
#pragma unroll
    for (int i = 0; i < 16; ++i) { const int kk = 4 * i + (lane >> 4); const f32x4 w = v[i] * gk[i];
        LAS float* s = scr + kk * 65 + (lane & 15) * 4; s[0] = w[0]; s[1] = w[1]; s[2] = w[2]; s[3] = w[3]; }
    LDS_WAIT(); asm volatile("" ::: "memory");
    const int c = lane & 7;
#pragma unroll
    for (int j = 0; j < 8; ++j) { const int n = (lane >> 3) + 8 * j; const LAS float* s = scr + (8 * c) * 65 + n;
        v4u o; o.x = pk2(s[0 * 65], s[1 * 65]); o.y = pk2(s[2 * 65], s[3 * 65]); o.z = pk2(s[4 * 65], s[5 * 65]); o.w = pk2(s[6 * 65], s[7 * 65]);
        const size_t row = dst_row0 + n;
        *(v4u*)(WT + (((row >> 8) * (size_t)(K >> 6) + (k0 >> 6)) << 14) + ((row & 255) << 6) + 8 * c) = o; }
    LDS_WAIT(); asm volatile("" ::: "memory");
}
__device__ __forceinline__ bool transpose_group(int& r, const float* src, int cnt, int K, int N, bf16r* dst, bool gu, LAS float* scr, int lane, const float* gain, int gmode) {
    const int nkb = K / 64, nnb = N / 64, per = nkb * nnb;
    if (r >= cnt * per) { r -= cnt * per; return false; }
    const int mi = r / per, q = r % per, kb = q / nnb, nb = q % nnb, n0 = nb * 64;
    size_t drow = n0;
    if (gu) { drow = (n0 < FF) ? (size_t)(n0 / 128) * 256 + (n0 % 128) : (size_t)((n0 - FF) / 128) * 256 + 128 + ((n0 - FF) % 128); }
    const float* gp = gain;
    if (gain) { if (gmode == 1) gp = gain + (size_t)((mi >> 1) * 3 + (mi & 1) * 2) * K; else if (gmode >= 2) gp = gain + (size_t)((mi + (gmode - 2)) * 3 + 1) * K; }
    transpose_item(src + (size_t)mi * K * N, K, N, dst + (size_t)mi * K * N, gu ? drow : (size_t)n0, kb * 64, n0, scr, lane, gp);
    return true;
}
__device__ __forceinline__ void norm_row(const float* xrow, const float* gain, bf16r* orow, int lane) {
    const f32x4* xr = (const f32x4*)xrow + lane; f32x4 v[8]; float s = 0.f;
#pragma unroll
    for (int j = 0; j < 8; ++j) { v[j] = xr[64 * j]; s += (v[j][0] * v[j][0] + v[j][1] * v[j][1]) + (v[j][2] * v[j][2] + v[j][3] * v[j][3]); }
    const float rstd = 1.0f / sqrtf(wave_sum(s) * (1.0f / DM) + EPS);
    const f32x4* g4 = (const f32x4*)gain + lane; v2u* o8 = (v2u*)orow + lane;
#pragma unroll
    for (int j = 0; j < 8; ++j) { const f32x4 g = g4[64 * j]; v2u w; w.x = pk2(v[j][0] * rstd * g[0], v[j][1] * rstd * g[1]); w.y = pk2(v[j][2] * rstd * g[2], v[j][3] * rstd * g[3]); o8[64 * j] = w; }
}
__device__ __forceinline__ void xb_ss_phase(const Frame& F, const float* x, bf16r* xb, float* ss) {
    const int gw = F.vcu * NWAVES + F.wave, NGW = F.G * NWAVES, lane = F.lane;
    for (int m = gw; m < M; m += NGW) { const f32x4* xr = (const f32x4*)(x + (size_t)m * DM) + lane; float s = 0.f;
#pragma unroll
        for (int j = 0; j < 8; ++j) { const f32x4 v = xr[64 * j]; s += (v[0] * v[0] + v[1] * v[1]) + (v[2] * v[2] + v[3] * v[3]); v2u w; w.x = pk2(v[0], v[1]); w.y = pk2(v[2], v[3]); const int col = 4 * lane + 256 * j; *(v2u*)(xb + (((size_t)((m >> 8) * (DM >> 6) + (col >> 6))) << 14) + ((m & 255) << 6) + (col & 63)) = w; }
        s = wave_sum(s); if (lane < 32) ss[(size_t)m * 32 + lane] = (lane == 0) ? s : 0.f; }
}
__device__ __forceinline__ void sincos_d(float angf, float& sn, float& cs) {
    const double a = (double)angf; const double k = __builtin_rint(a * 0.15915494309189535); const double r = a - k * 6.283185307179586476925286766559;
    const double r2 = r * r; double ts = r, tc = 1.0, ss = r, cc = 1.0;
#pragma unroll
    for (int n = 1; n <= 14; ++n) { tc = -tc * r2 / (double)((2 * n - 1) * (2 * n)); ts = -ts * r2 / (double)((2 * n) * (2 * n + 1)); cc += tc; ss += ts; }
    sn = (float)ss; cs = (float)cc;
}
__device__ __forceinline__ void combine_phase(const Frame& F, const bf16r* oatt  , const float* lamp  , const float* subg  , float lam_init, bf16r* cat) {
    const int gw = F.vcu * NWAVES + F.wave, NGW = F.G * NWAVES, lane = F.lane;
    const float d01 = wave_sum(lamp[lane] * lamp[128 + lane] + lamp[64 + lane] * lamp[192 + lane]);
    const float d23 = wave_sum(lamp[256 + lane] * lamp[384 + lane] + lamp[320 + lane] * lamp[448 + lane]);
    const float lam = expf(d01) - expf(d23) + lam_init;
    const int half = lane >> 5, d4 = (lane & 31) * 4; const f32x4 g = *(const f32x4*)(subg + half * 128 + d4) * (1.0f - lam_init);
    const bool own = F.G == 256; const int p0 = own ? 1024 * ((int)blockIdx.x & 7) + ((int)blockIdx.x >> 3) * NWAVES + F.wave : gw, pstep = own ? 256 : NGW, pend = own ? 1024 * ((int)blockIdx.x & 7) + 1024 : M / 2;
    for (int pi = p0; pi < pend; pi += pstep) { const int m = 2 * pi, b = m >> 12, s = m & 4095;
        f32x4 o[2][DH]; float ss[2][DH];
#pragma unroll
        for (int h = 0; h < DH; ++h) { const size_t vh0 = (size_t)((b * 6 + h) * 2 + 0) * 2 + half, vh1 = (size_t)((b * 6 + h) * 2 + 1) * 2 + half;
            const v4u r0 = *(const v4u*)(oatt + (vh0 * SEQ + s) * 128 + d4 * 2), r1 = *(const v4u*)(oatt + (vh1 * SEQ + s) * 128 + d4 * 2);
#pragma unroll
            for (int e = 0; e < 2; ++e) {
                const f32x4 a = e ? (f32x4){__builtin_bit_cast(float, r0.x & 0xffff0000u), __builtin_bit_cast(float, r0.y & 0xffff0000u), __builtin_bit_cast(float, r0.z & 0xffff0000u), __builtin_bit_cast(float, r0.w & 0xffff0000u)}
                                  : (f32x4){__builtin_bit_cast(float, r0.x << 16), __builtin_bit_cast(float, r0.y << 16), __builtin_bit_cast(float, r0.z << 16), __builtin_bit_cast(float, r0.w << 16)};
                const f32x4 c = e ? (f32x4){__builtin_bit_cast(float, r1.x & 0xffff0000u), __builtin_bit_cast(float, r1.y & 0xffff0000u), __builtin_bit_cast(float, r1.z & 0xffff0000u), __builtin_bit_cast(float, r1.w & 0xffff0000u)}
                                  : (f32x4){__builtin_bit_cast(float, r1.x << 16), __builtin_bit_cast(float, r1.y << 16), __builtin_bit_cast(float, r1.z << 16), __builtin_bit_cast(float, r1.w << 16)};
                o[e][h] = a - c * lam; ss[e][h] = (o[e][h][0] * o[e][h][0] + o[e][h][1] * o[e][h][1]) + (o[e][h][2] * o[e][h][2] + o[e][h][3] * o[e][h][3]); } }
#pragma unroll
        for (int sh = 1; sh < 64; sh <<= 1) {
#pragma unroll
            for (int h = 0; h < DH; ++h) { ss[0][h] += __shfl_xor(ss[0][h], sh); ss[1][h] += __shfl_xor(ss[1][h], sh); } }
#pragma unroll
        for (int e = 0; e < 2; ++e)
#pragma unroll
            for (int h = 0; h < DH; ++h) { const float rstd = 1.0f / sqrtf(ss[e][h] * (1.0f / DV) + EPS);
                v2u w; w.x = pk2(o[e][h][0] * rstd * g[0], o[e][h][1] * rstd * g[1]); w.y = pk2(o[e][h][2] * rstd * g[2], o[e][h][3] * rstd * g[3]);
                *(v2u*)(cat + (size_t)(m + e) * DM + h * 256 + half * 128 + d4) = w; }
    }
}

constexpr int GM_WL = 0, GM_WLS = 272, GM_VT = 128 * GM_WLS, GM_VTS = 272, GM_RS = GM_VT + 256 * GM_VTS;
static_assert(GM_RS + 512 <= RING_BYTES, "gmlp LDS");
__device__ __forceinline__ void gmlp_phase(const Frame& F, const bf16r* ZA, const float* vstat, const float* w_s  , const float* b_s  , const float* gv  , bf16r* cat) {
    const int tid = F.tid, lane = F.lane, wave = F.wave, fr = lane & 15, fq = lane >> 4;
    LAS unsigned char* lds = F.lds;
    LAS float* rs = (LAS float*)(lds + GM_RS);
    const bool own = F.G == 256; const int xg = (int)blockIdx.x & 7, jg = (int)blockIdx.x >> 3;
    for (int unit = own ? jg : F.vcu; unit < (own ? 96 : 128 * GG); unit += own ? 32 : F.G) {
        const int bc = own ? 16 * xg + unit / GG : unit / GG, g = unit % GG, r0 = bc * 128;
        if (tid < 128) { const f32x4* p = (const f32x4*)(vstat + (size_t)(r0 + tid) * 24); float s = 0.f;
#pragma unroll
            for (int i = 0; i < 6; ++i) { const f32x4 v = p[i]; s += (v[0] + v[1]) + (v[2] + v[3]); }
            rs[tid] = 1.0f / sqrtf(s * (1.0f / MIXW) + EPS); }
        { const int s = tid & 127, cb = (tid >> 7) * 8;
#pragma unroll
          for (int it = 0; it < 8; ++it) { const int d8 = (cb + it) * 8; const bf16x8 v = *(const bf16x8*)(ZA + (size_t)(r0 + s) * 3072 + 1536 + g * 256 + d8);
#pragma unroll
              for (int e = 0; e < 8; ++e) *(LAS unsigned short*)(lds + GM_VT + (d8 + e) * GM_VTS + s * 2) = (unsigned short)v[e]; } }
        __syncthreads();
        for (int idx = tid; idx < 128 * 32; idx += 512) { const int t = idx >> 5, s4 = (idx & 31) * 4; const f32x4 w = *(const f32x4*)(w_s + ((size_t)g * 128 + t) * 128 + s4);
            float e[4];
#pragma unroll
            for (int j = 0; j < 4; ++j) e[j] = (s4 + j <= t) ? w[j] * rs[s4 + j] : 0.f;
            v2u o; o.x = pk2(e[0], e[1]); o.y = pk2(e[2], e[3]); *(LAS v2u*)(lds + GM_WL + t * GM_WLS + s4 * 2) = o; }
        __syncthreads();
        f32x4 acc[8][2];
#pragma unroll
        for (int tt = 0; tt < 8; ++tt) { acc[tt][0] = (f32x4){0.f, 0.f, 0.f, 0.f}; acc[tt][1] = (f32x4){0.f, 0.f, 0.f, 0.f}; }
#pragma unroll
        for (int ks = 0; ks < 4; ++ks) {
            bf16x8 bfr[2];
#pragma unroll
            for (int dd = 0; dd < 2; ++dd) bfr[dd] = *(const LAS bf16x8*)(lds + GM_VT + (32 * wave + 16 * dd + fr) * GM_VTS + (32 * ks + 8 * fq) * 2);
#pragma unroll
            for (int tt = 0; tt < 8; ++tt) { if (32 * ks <= 16 * tt + 15) {
                const bf16x8 afr = *(const LAS bf16x8*)(lds + GM_WL + (16 * tt + fr) * GM_WLS + (32 * ks + 8 * fq) * 2);
#pragma unroll
                for (int dd = 0; dd < 2; ++dd) acc[tt][dd] = __builtin_amdgcn_mfma_f32_16x16x32_bf16(bfr[dd], afr, acc[tt][dd], 0, 0, 0); } }
        }
#pragma unroll
        for (int tt = 0; tt < 8; ++tt) { const int t = 16 * tt + fr, row = r0 + t; const float bias = b_s[g * 128 + t];
#pragma unroll
            for (int dd = 0; dd < 2; ++dd) { const int d = 32 * wave + 16 * dd + 4 * fq; const f32x4 gg = *(const f32x4*)(gv + g * 256 + d);
                const v2u uu = *(const v2u*)(ZA + (size_t)row * 3072 + g * 256 + d);
                const float u0 = bf2f((unsigned short)(uu.x & 0xffff)), u1 = bf2f((unsigned short)(uu.x >> 16)), u2 = bf2f((unsigned short)(uu.y & 0xffff)), u3 = bf2f((unsigned short)(uu.y >> 16));
                const f32x4 a = acc[tt][dd]; v2u o; o.x = pk2(u0 * (a[0] * gg[0] + bias), u1 * (a[1] * gg[1] + bias)); o.y = pk2(u2 * (a[2] * gg[2] + bias), u3 * (a[3] * gg[3] + bias));
                *(v2u*)(cat + (size_t)row * DM + g * 256 + d) = o; } }
        __syncthreads();
    }
}
namespace att {
__device__ __forceinline__ BlockRef<bf16, float> diff_ref(int L, int pass, const bf16* Q, const bf16* K, const bf16* V, float* O) {
    const int vh = L >> 3, x = L & 7, qb = pass ? 15 - x : x;
    const int b = vh / 24, r = vh % 24, h = r >> 2, c = (r >> 1) & 1, half = r & 1;
    BlockRef<bf16, float> R;
    R.Q = Q + ((size_t)((b * 2 + c) * 6 + h) * SEQ + (size_t)qb * QB) * D; R.K = K + (size_t)((b * 2 + c) * 6 + h) * SEQ * D; R.V = V + (size_t)((b * 6 + h) * 2 + half) * SEQ * D;
    R.O = O + ((size_t)vh * SEQ + (size_t)qb * QB) * D; R.P0 = qb * QB; R.ldo = D;
    return R;
}
__device__ __forceinline__ void diff_attn_phase(char* lds, const bf16* Q, const bf16* K, const bf16* V, float* O, int G, int c0) {
    constexpr int total = 96 * 8; const int W = 1 << 30;
    int L = c0; if (L >= total) return;
    int pass = 0; BlockRef<bf16, float> cur = diff_ref(L, 0, Q, K, V, O);
    Seam<bf16> S;
    causal_swa_prime<bf16, float>(cur, W, lds, S);
    for (;;) {
        const bool more_pass = pass == 0, more_item = L + G < total, last = !more_pass && !more_item;
        int passn = pass + 1, Ln = L;
        if (!more_pass) { passn = 0; Ln = more_item ? L + G : L; }
        const BlockRef<bf16, float> nxt = last ? cur : diff_ref(Ln, passn, Q, K, V, O);
        causal_swa_block<bf16, float>(cur, nxt, SEQ, W, lds, S);
        if (last) break;
        cur = nxt; pass = passn; L = Ln;
    }
}
__device__ __forceinline__ Ref2 diff_ref2(int L, int pass, const bf16* Q, const bf16* K, const bf16* V, unsigned short* O) {
    const int bhc = L >> 4, x = L & 15, qb = pass ? 31 - x : x;
    const int b = bhc / 12, r = bhc % 12, h = r >> 1, c = r & 1;
    Ref2 R; const size_t qk = (size_t)((b * 2 + c) * 6 + h) * SEQ;
    R.Q = Q + (qk + (size_t)qb * QB2) * D; R.K = K + qk * D;
    R.V0 = V + (size_t)((b * 6 + h) * 2) * SEQ * D; R.V1 = R.V0 + (size_t)SEQ * D;
    const size_t vh = (size_t)b * 24 + h * 4 + c * 2;
    R.O0 = O + (vh * SEQ + (size_t)qb * QB2) * D; R.O1 = R.O0 + (size_t)SEQ * D; R.P0 = qb * QB2;
    return R;
}
template <bool RS>
__device__ __forceinline__ void diff_attn2_role(char* lds, float* xl, const bf16* Q, const bf16* K, const bf16* V, unsigned short* O, int G, int c0) {
    constexpr int total = 48 * 16;
    int L = c0; if (L >= total) return;
    int pass = 0; Ref2 cur = diff_ref2(L, 0, Q, K, V, O);
    Seam2 S;
    diff2_prime<RS>(cur, lds, S);
    for (;;) {
        const bool more_pass = pass == 0, more_item = L + G < total, last = !more_pass && !more_item;
        int passn = pass + 1, Ln = L;
        if (!more_pass) { passn = 0; Ln = more_item ? L + G : L; }
        const Ref2 nxt = last ? cur : diff_ref2(Ln, passn, Q, K, V, O);
        diff2_block<RS>(cur, nxt, lds, xl, S);
        if (last) break;
        cur = nxt; pass = passn; L = Ln;
    }
}
__device__ __forceinline__ void diff_attn2_phase(char* lds, float* xl, const bf16* Q, const bf16* K, const bf16* V, unsigned short* O, int G, int c0) {
    if (__builtin_amdgcn_readfirstlane((int)threadIdx.x >> 6) < 4) diff_attn2_role<true>(lds, xl, Q, K, V, O, G, c0);
    else diff_attn2_role<false>(lds, xl, Q, K, V, O, G, c0);
}
__device__ __forceinline__ BlockRef<bf16, bf16> mem_ref(int L, const bf16* Q, const bf16* K, const bf16* V, bf16* cat) {
    const int bh = L >> 4, qb = L & 15, b = bh >> 2, hm = bh & 3;
    BlockRef<bf16, bf16> R;
    R.Q = Q + ((size_t)bh * SEQ + (size_t)qb * QB) * D; R.K = K + (size_t)bh * MEML * D; R.V = V + (size_t)bh * MEML * D;
    R.O = cat + ((size_t)b * SEQ + (size_t)qb * QB) * DM + 1536 + hm * 128; R.P0 = 256; R.ldo = DM;
    return R;
}
__device__ __forceinline__ void mem_attn_phase(char* lds, const bf16* Q, const bf16* K, const bf16* V, bf16* cat, int G, int c0) {
    constexpr int total = 256; const int W = 1 << 30;
    int L = c0; if (L >= total) return;
    BlockRef<bf16, bf16> cur = mem_ref(L, Q, K, V, cat);
    Seam<bf16> S;
    causal_swa_prime<bf16, bf16>(cur, W, lds, S);
    for (;;) {
        const bool last = L + G >= total;
        const BlockRef<bf16, bf16> nxt = last ? cur : mem_ref(L + G, Q, K, V, cat);
        causal_swa_block<bf16, bf16>(cur, nxt, MEML, W, lds, S);
        if (last) break;
        cur = nxt; L += G;
    }
}

struct DynAttn { unsigned* qcnt; const unsigned* rq; const unsigned* rkv; unsigned tag; unsigned* tmo; volatile __attribute__((address_space(3))) unsigned* bc; };
__device__ __forceinline__ unsigned dyn_pull(const DynAttn& C, int bpref) {
    if (threadIdx.x == 0) {
        unsigned code = 0xffffffffu;
        for (unsigned spins = 0;; ++spins) {
            bool any_left = false;
#pragma unroll 1
            for (int k = 0; k < 4 && code == 0xffffffffu; ++k) { const int b = (bpref + k) & 3;
                if (__hip_atomic_load(C.qcnt + 64 * b, __ATOMIC_RELAXED, __HIP_MEMORY_SCOPE_AGENT) >= 384u) continue;
                any_left = true;
                const bool ready = __hip_atomic_load(C.rq + 64 * (2 * b), __ATOMIC_RELAXED, __HIP_MEMORY_SCOPE_AGENT) == C.tag && __hip_atomic_load(C.rq + 64 * (2 * b + 1), __ATOMIC_RELAXED, __HIP_MEMORY_SCOPE_AGENT) == C.tag &&
                                   __hip_atomic_load(C.rkv + 64 * (2 * b), __ATOMIC_RELAXED, __HIP_MEMORY_SCOPE_AGENT) != 0u && __hip_atomic_load(C.rkv + 64 * (2 * b + 1), __ATOMIC_RELAXED, __HIP_MEMORY_SCOPE_AGENT) != 0u;
                if (!ready) continue;
                const unsigned n = __hip_atomic_fetch_add(C.qcnt + 64 * b, 1u, __ATOMIC_RELAXED, __HIP_MEMORY_SCOPE_AGENT);
                if (n < 384u) code = ((unsigned)b << 16) | n;
            }
            if (code != 0xffffffffu || !any_left) break;
            __builtin_amdgcn_s_sleep(8);
            if ((spins & 255u) == 255u) { if (__hip_atomic_load(C.tmo, __ATOMIC_RELAXED, __HIP_MEMORY_SCOPE_AGENT)) break; if (spins > (1u << 20)) { __hip_atomic_store(C.tmo, 1u, __ATOMIC_RELAXED, __HIP_MEMORY_SCOPE_AGENT); break; } }
        }
        __builtin_amdgcn_fence(__ATOMIC_ACQUIRE, "agent");
        asm volatile("s_waitcnt vmcnt(0)" ::: "memory");
        C.bc[0] = code;
    }
    __syncthreads();
    const unsigned code = C.bc[0];
    __syncthreads();
    return code;
}
__device__ __forceinline__ BlockRef<bf16, float> dyn_ref(unsigned code, const bf16* Q, const bf16* K, const bf16* V, float* O) {
    const int b = (int)(code >> 16), n = (int)(code & 0xffffu), qb = 15 - (n & 15), r = n >> 4, h = r >> 2, c = (r >> 1) & 1, half = r & 1, vh = b * 24 + r;
    BlockRef<bf16, float> R;
    R.Q = Q + ((size_t)((b * 2 + c) * 6 + h) * SEQ + (size_t)qb * QB) * D; R.K = K + (size_t)((b * 2 + c) * 6 + h) * SEQ * D; R.V = V + (size_t)((b * 6 + h) * 2 + half) * SEQ * D;
    R.O = O + ((size_t)vh * SEQ + (size_t)qb * QB) * D; R.P0 = qb * QB; R.ldo = D;
    return R;
}
__device__ __forceinline__ void diff_attn_dyn_phase(char* lds, const bf16* Q, const bf16* K, const bf16* V, float* O, const DynAttn& C, int bpref) {
    const int W = 1 << 30;
    unsigned code = dyn_pull(C, bpref); if (code == 0xffffffffu) return;
    BlockRef<bf16, float> cur = dyn_ref(code, Q, K, V, O);
    Seam<bf16> S;
    causal_swa_prime<bf16, float>(cur, W, lds, S);
    for (;;) {
        const unsigned nc = dyn_pull(C, bpref); const bool last = nc == 0xffffffffu;
        const BlockRef<bf16, float> nxt = last ? cur : dyn_ref(nc, Q, K, V, O);
        causal_swa_block<bf16, float>(cur, nxt, SEQ, W, lds, S);
        if (last) break;
        cur = nxt;
    }
}
}

constexpr int NPL = 8, PH_BASE = 1, NPH = PH_BASE + DEPTH * NPL;
enum { I_X = 0, I_MEM, I_NORMG, I_WGU, I_WDN, I_WOUT, I_MEMNG, I_MEMWKV, I_MEMQG, I_MEMKG, I_AWIN, I_AVG, I_AWS, I_ABS, I_KVG, I_WKV, I_KG, I_BWIN, I_BQG, I_BLAM, I_BSUBG, N_IN };
struct Args { const float* in[N_IN]; float* out; unsigned char* ws; int ph_lo, ph_hi, li, pad; };

#ifndef EN_MASK
#define EN_MASK 0xFFFFFFFFu
#endif
#define SITE(n) (((EN_MASK) >> (n)) & 1u)
#define IN(k) (lo <= (k) && (k) < hi)
#ifndef PROBE_WAIT
#define PROBE_WAIT 0
#endif
#ifndef PROBE_PHASE
#define PROBE_PHASE 0
#endif
#ifndef LOCAL_SEAMS
#define LOCAL_SEAMS 1
#endif
#define SEAM_X(k, local) do { if (IN((k) + 1)) { unsigned long long t0_ = 0; if (PROBE_WAIT) t0_ = __builtin_amdgcn_s_memrealtime(); \
    if (LOCAL_SEAMS && (local) && F.MISC[24] != 0u) xcd_local_barrier(bar); else xcd_barrier(bar); \
    if (PROBE_WAIT && ((PROBE_WAIT >> CUR_SITE) & 1) && F.tid == 0) F.MISC[16] += (unsigned)(__builtin_amdgcn_s_memrealtime() - t0_); \
    } \
    if (PROBE_PHASE && ((PROBE_PHASE >> CUR_SITE) & 1) && F.tid == 0) F.MISC[17] += (unsigned)(__builtin_amdgcn_s_memrealtime() - tsite_); } while (0)
#define SEAM(k) SEAM_X(k, false)
#define SEAM_L(k) SEAM_X(k, true)
constexpr int CW_RQ = 70016, CW_RKV = 70656, CW_QCNT = 71296;
#define PUBLISH_FLAG(word, val) do { if (blockIdx.x < 8 && F.tid == 0) { __builtin_amdgcn_fence(__ATOMIC_RELEASE, "agent"); asm volatile("s_waitcnt vmcnt(0)" ::: "memory"); \
    __hip_atomic_store((unsigned*)F.ctl + (word) + 64 * (blockIdx.x & 7), (unsigned)(val), __ATOMIC_RELAXED, __HIP_MEMORY_SCOPE_AGENT); } } while (0)
#define SITE_T0 unsigned long long tsite_ = 0; if (PROBE_PHASE) tsite_ = __builtin_amdgcn_s_memrealtime(); (void)tsite_;
#define CAS __attribute__((address_space(4)))
#define WS_PTRS \
    const CAS Args* ap = (const CAS Args*)__builtin_amdgcn_kernarg_segment_ptr(); asm volatile("" : "+s"(ap)); \
    unsigned char* const ws = ap->ws; \
    bf16r* const Wgu = (bf16r*)(ws + WS_WGU); bf16r* const Wdn = (bf16r*)(ws + WS_WDN); bf16r* const Wout = (bf16r*)(ws + WS_WOUT); bf16r* const Wmem = (bf16r*)(ws + WS_WMEM); \
    bf16r* const Wain = (bf16r*)(ws + WS_WAIN); bf16r* const Wkv = (bf16r*)(ws + WS_WKV); bf16r* const Wbin = (bf16r*)(ws + WS_WBIN); \
    unsigned* const CS = (unsigned*)(ws + WS_COS); \
    bf16r* const MEMN = (bf16r*)(ws + WS_MEMN); bf16r* const MK = (bf16r*)(ws + WS_MK); bf16r* const MV = (bf16r*)(ws + WS_MV); \
    bf16r* const XB = (bf16r*)(ws + WS_XB); float* const SS = (float*)(ws + WS_SS); _Float16* const XH = (_Float16*)(ws + WS_XH); bf16r* const HID = (bf16r*)(ws + WS_HID); bf16r* const ZA = (bf16r*)(ws + WS_ZA); \
    float* const VSTAT = (float*)(ws + WS_VSTAT); \
    bf16r* const QB_ = (bf16r*)(ws + WS_QB); bf16r* const KSH = (bf16r*)(ws + WS_KSH); bf16r* const VSH = (bf16r*)(ws + WS_VSH); bf16r* const QMB = (bf16r*)(ws + WS_QMB); \
    float* const OATT = (float*)(ws + WS_OATT); bf16r* const CAT = (bf16r*)(ws + WS_CAT); \
    float* const X = ap->out; \
    (void)Wgu; (void)Wdn; (void)Wout; (void)Wmem; (void)Wain; (void)Wkv; (void)Wbin; (void)CS; (void)MEMN; (void)MK; (void)MV; (void)XB; (void)SS; (void)XH; (void)HID; (void)ZA; \
    (void)VSTAT; (void)QB_; (void)KSH; (void)VSH; (void)QMB; (void)OATT; (void)CAT; (void)X;

constexpr int EX_OFF = RING_BYTES + 2048;
constexpr int RTAB_OFF = RING_BYTES;
__device__ __forceinline__ pg8::RowScale fill_rstd(const Frame& F, const float* ss, const pg8::StaticOrder& So) {
    pg8::Unit u0; const int pm0 = So.next(0, u0) ? u0.pm : -1;
    { pg8::Unit ui; bool same = true; for (int i = 1; So.next(i, ui); ++i) same &= (ui.pm == pm0); if (!same && F.tid == 0) __hip_atomic_store((unsigned*)F.ctl + XB_TMO, 1u, __ATOMIC_RELAXED, __HIP_MEMORY_SCOPE_AGENT); }
    LAS float* tab = (LAS float*)(F.lds + RTAB_OFF);
    __syncthreads();
    if (pm0 >= 0 && F.tid < 256) { const f32x4* p = (const f32x4*)(ss + (size_t)(pm0 * 256 + F.tid) * 32); float s = 0.f;
#pragma unroll
        for (int i = 0; i < 8; ++i) { const f32x4 v = p[i]; s += (v[0] + v[1]) + (v[2] + v[3]); }
        const float v = s * (1.0f / DM) + EPS; tab[2 * F.tid] = 1.0f / sqrtf(v); tab[2 * F.tid + 1] = v; }
    __syncthreads();
    return pg8::RowScale{(const LAS float*)tab};
}
#ifndef RESID_BF16_FROM
#define RESID_BF16_FROM 1
#endif
#ifndef RESID_BF16_TAIL
#define RESID_BF16_TAIL 1
#endif
#ifndef ATTN2
#define ATTN2 1
#endif
#ifndef DYN_ATTN
#define DYN_ATTN 0
#endif
template <int L, int S>
__device__ __forceinline__ void ffn_part(const Frame& F, const XcdBarrier& bar, unsigned char* smem, const int lo, const int hi) {
    constexpr int pf = PH_BASE + L * NPL + (S ? 6 : 0);
    if (SITE(3) && IN(pf)) { constexpr int CUR_SITE = 3; (void)CUR_SITE; SITE_T0 WS_PTRS
        pg8::Gemm g{XB, Wgu + (size_t)(L * 2 + S) * NGU * DM, M, NGU, DM}; pg8::StaticOrder So; So.init(M, NGU, F.G, (int)blockIdx.x);
        pg8::EpiSwiglu E{HID, FF, fill_rstd(F, SS, So)};
        pg8::gemm_phase<pg8::EpiSwiglu, pg8::StaticOrder, true, true, true, true>(F.lds + RING_OFF, g, So, E);
        if constexpr (L == NA && S == 0) {
            pg8::Gemm g2{XB, Wkv, M, NKV, DM}; pg8::StaticOrder S2; S2.init(M, NKV, F.G, (int)blockIdx.x);
            pg8::EpiQKRope E2{1, KSH, VSH, ap->in[I_KG], nullptr, CS, (LAS float*)(F.lds + EX_OFF), fill_rstd(F, SS, S2)};
            pg8::gemm_phase<pg8::EpiQKRope, pg8::StaticOrder, true, true, true, true>(F.lds + RING_OFF, g2, S2, E2);
        }
        SEAM_L(pf);
        if constexpr (L == NA && S == 0) { if (DYN_ATTN && IN(pf + 1)) PUBLISH_FLAG(CW_RKV, 1u); }
    }
    if (SITE(4) && IN(pf + 1)) { constexpr int CUR_SITE = 4; (void)CUR_SITE; SITE_T0 WS_PTRS
        pg8::Gemm g{HID, Wdn + (size_t)(L * 2 + S) * DM * FF, M, DM, FF}; pg8::ColSweepOrder So{(int)blockIdx.x};
        pg8::EpiResid E{(L == 0 && S == 0) ? ap->in[I_X] : nullptr, (L == DEPTH - 1 && S == 1) ? X : nullptr, DM, 0.5f, XB, SS, XH, RESID_BF16_TAIL ? (L < RESID_BF16_FROM ? 0 : (L == RESID_BF16_FROM && S == 0) ? 2 : 1) : 0};
        pg8::gemm_phase<pg8::EpiResid, pg8::ColSweepOrder, true, true, true, true>(F.lds + RING_OFF, g, So, E);
        SEAM_L(pf + 1);
    }
}
template <int L>
__device__ __forceinline__ void mixer_part(const Frame& F, const XcdBarrier& bar, unsigned char* smem, const int lo, const int hi) {
    constexpr int pb = PH_BASE + L * NPL;
    if (SITE(6) && IN(pb + 2)) { constexpr int CUR_SITE = 6; (void)CUR_SITE; SITE_T0 WS_PTRS
        if constexpr (L < NA) { pg8::Gemm g{XB, Wain + (size_t)L * NAIN * DM, M, NAIN, DM}; pg8::StaticOrder So; So.init(M, NAIN, F.G, (int)blockIdx.x);
            pg8::EpiAin E{ZA, VSTAT, QMB, ap->in[I_MEMQG] + L * HD, (LAS float*)(F.lds + EX_OFF), fill_rstd(F, SS, So)};
            pg8::gemm_phase<pg8::EpiAin, pg8::StaticOrder, true, true, true, true>(F.lds + RING_OFF, g, So, E);
            if constexpr (L == 0) {
                if ((int)blockIdx.x >= 128) { pg8::Gemm gm{MEMN, Wmem, 4096, 4096, DM}; pg8::MemKvOrder Sm{F.G, (int)blockIdx.x - 128};
                    pg8::EpiMemKv Em{MK, MV, ap->in[I_MEMKG], (LAS float*)(F.lds + EX_OFF)};
                    pg8::gemm_phase<pg8::EpiMemKv, pg8::MemKvOrder, true, true, false, true>(F.lds + RING_OFF, gm, Sm, Em); } } }
        else { pg8::Gemm g{XB, Wbin + (size_t)(L - NA) * NBIN * DM, M, NBIN, DM}; pg8::StaticOrder So; So.init(M, NBIN, F.G, (int)blockIdx.x);
            pg8::EpiQKRope E{0, QB_, QMB, ap->in[I_BQG] + (L - NA) * HD, ap->in[I_MEMQG] + L * HD, CS, (LAS float*)(F.lds + EX_OFF), fill_rstd(F, SS, So)};
            pg8::gemm_phase<pg8::EpiQKRope, pg8::StaticOrder, true, true, true, true>(F.lds + RING_OFF, g, So, E); }
        if constexpr (L == 1 || (L >= NA && DYN_ATTN)) SEAM_L(pb + 2); else SEAM(pb + 2);
        if constexpr (L >= NA) { if (DYN_ATTN && IN(pb + 3)) PUBLISH_FLAG(CW_RQ, (unsigned)L); }
    }
    if (SITE(8) && IN(pb + 3)) { constexpr int CUR_SITE = 8; (void)CUR_SITE; SITE_T0 WS_PTRS
        if constexpr (L < NA) gmlp_phase(F, ZA, VSTAT, ap->in[I_AWS] + (size_t)L * GG * 128 * 128, ap->in[I_ABS] + (size_t)L * GG * 128, ap->in[I_AVG] + (size_t)L * MIXW, CAT);
        { const int xg = (int)blockIdx.x & 7, jg = (int)blockIdx.x >> 3, pnl = 8 * xg + (jg >> 2);
          const int c0 = ((L < NA || DYN_ATTN) && F.G == 256) ? (((pnl >> 4) * 4 + (jg & 3)) * 16 + (pnl & 15)) : F.vcu;
          att::mem_attn_phase((char*)smem, (const att::bf16*)QMB, (const att::bf16*)(MK + (size_t)L * 1024 * 512), (const att::bf16*)(MV + (size_t)L * 1024 * 512), (att::bf16*)CAT, F.G, c0); }
        if constexpr (L >= NA) {
            float* const Ol = OATT + (size_t)(L - NA) * 96 * SEQ * 128;
            if (DYN_ATTN) { const att::DynAttn C{(unsigned*)F.ctl + CW_QCNT + 64 * 4 * (L - NA), (const unsigned*)F.ctl + CW_RQ, (const unsigned*)F.ctl + CW_RKV, (unsigned)L, (unsigned*)F.ctl + XB_TMO, F.MISC + 28};
                att::diff_attn_dyn_phase((char*)smem, (const att::bf16*)QB_, (const att::bf16*)KSH, (const att::bf16*)VSH, Ol, C, ((int)blockIdx.x & 7) >> 1); }
            else if (ATTN2) att::diff_attn2_phase((char*)smem, (float*)(smem + 133120), (const att::bf16*)QB_, (const att::bf16*)KSH, (const att::bf16*)VSH, (unsigned short*)Ol, F.G, F.vcu);
            else att::diff_attn_phase((char*)smem, (const att::bf16*)QB_, (const att::bf16*)KSH, (const att::bf16*)VSH, Ol, F.G, F.vcu);
        }
        if constexpr (L < NA) SEAM_L(pb + 3); else SEAM(pb + 3);
    }
    if constexpr (L >= NA) {
        if (SITE(9) && IN(pb + 4)) { constexpr int CUR_SITE = 9; (void)CUR_SITE; SITE_T0 WS_PTRS constexpr float lam_init = (L == 2) ? 0.47071301834358416f : 0.5560582041556405f;
            combine_phase(F, (const bf16r*)(OATT + (size_t)(L - NA) * 96 * SEQ * 128), ap->in[I_BLAM] + (size_t)(L - NA) * 512, ap->in[I_BSUBG] + (size_t)(L - NA) * DV, lam_init, CAT);
            SEAM_L(pb + 4); }
    }
    if (SITE(10) && IN(pb + 5)) { constexpr int CUR_SITE = 10; (void)CUR_SITE; SITE_T0 WS_PTRS
        pg8::Gemm g{CAT, Wout + (size_t)L * DM * DM, M, DM, DM}; pg8::ColSweepOrder So{(int)blockIdx.x};
        pg8::EpiResid E{nullptr, nullptr, DM, 1.0f, XB, SS, XH, (RESID_BF16_TAIL && L >= RESID_BF16_FROM) ? 1 : 0};
        pg8::gemm_phase<pg8::EpiResid, pg8::ColSweepOrder, true, true, false, true>(F.lds + RING_OFF, g, So, E);
        SEAM_L(pb + 5);
    }
}

__global__ void __launch_bounds__(NWAVES * 64, 2) yoco_fwd(Args args) {
    extern __shared__ __attribute__((aligned(16))) unsigned char smem[];
    Frame F;
    F.lds_g = smem; F.lds = (LAS unsigned char*)smem;
    F.MISC = (volatile LAS unsigned*)(F.lds + MISC_OFF);
    F.tid = threadIdx.x; F.lane = F.tid & 63; F.wave = __builtin_amdgcn_readfirstlane(F.tid >> 6);
    F.G = gridDim.x; { const int bx = blockIdx.x; F.vcu = (F.G % 8 == 0) ? (bx % 8) * (F.G / 8) + bx / 8 : bx; }
    F.ws = args.ws;
    F.ctl = (gu32*)(args.ws + WS_CTL);
    for (int u = F.tid; u < (LDS_BYTES - LDSCTL_OFF) / 4; u += NWAVES * 64) ((LAS unsigned*)(F.lds + LDSCTL_OFF))[u] = 0u;
    __syncthreads();
    XcdBarrier bar = xcd_barrier_post((unsigned*)F.ctl + (size_t)args.li * XCD_BAR_WORDS, F.MISC + 8);
    if (F.tid == 0) __hip_atomic_store((unsigned*)F.ctl + XB_XCCTAB + blockIdx.x, bar.x + 1u, __ATOMIC_RELAXED, __HIP_MEMORY_SCOPE_AGENT);
    const int lo = args.ph_lo, hi = args.ph_hi;
    {
    const int gw = F.vcu * NWAVES + F.wave, NGW = F.G * NWAVES;
    if (SITE(0) && IN(0)) { constexpr int CUR_SITE = 0; (void)CUR_SITE; SITE_T0 WS_PTRS
        LAS float* scr = (LAS float*)(F.lds + RING_OFF + F.wave * 16640);
        constexpr int NIT = 8 * (DM / 64) * (NGU / 64) + 8 * (FF / 64) * (DM / 64) + 4 * 32 * 32 + 4 * 32 * 16 + 2 * 32 * (NAIN / 64) + 32 * (NKV / 64) + 2 * 32 * 32;
        for (int it = gw; it < NIT; it += NGW) { int r = it;
            if (transpose_group(r, ap->in[I_WGU], 8, DM, NGU, Wgu, true, scr, F.lane, ap->in[I_NORMG], 1)) continue;
            if (transpose_group(r, ap->in[I_WDN], 8, FF, DM, Wdn, false, scr, F.lane, nullptr, 0)) continue;
            if (transpose_group(r, ap->in[I_WOUT], 4, DM, DM, Wout, false, scr, F.lane, nullptr, 0)) continue;
            if (transpose_group(r, ap->in[I_MEMWKV], 4, DM, 1024, Wmem, false, scr, F.lane, nullptr, 0)) continue;
            if (transpose_group(r, ap->in[I_AWIN], 2, DM, NAIN, Wain, false, scr, F.lane, ap->in[I_NORMG], 2)) continue;
            if (transpose_group(r, ap->in[I_WKV], 1, DM, NKV, Wkv, false, scr, F.lane, ap->in[I_KVG], 0)) continue;
            transpose_group(r, ap->in[I_BWIN], 2, DM, NBIN, Wbin, false, scr, F.lane, ap->in[I_NORMG], 4); }
        for (int i = gw * 64 + F.lane; i < SEQ * 64; i += NGW * 64) { const int pos = i >> 6, k = i & 63; const float inv = (float)pow(10000.0, -(double)k / 64.0); const float ang = (float)pos * inv;
            float sn, cs; sincos_d(ang, sn, cs); typedef _Float16 h2 __attribute__((ext_vector_type(2))); h2 t; t.x = (_Float16)cs; t.y = (_Float16)sn; CS[i] = __builtin_bit_cast(unsigned, t); }
        for (int r = gw; r < 4096; r += NGW) { const int l = r >> 10, mm = r & 1023; norm_row(ap->in[I_MEM] + (size_t)mm * DM, ap->in[I_MEMNG] + l * DM, MEMN + (size_t)r * DM, F.lane); }
        xb_ss_phase(F, ap->in[I_X], XB, SS);
        SEAM(0);
        if (LOCAL_SEAMS && IN(1)) { if (F.tid < 64) { bool ok = F.G == 256; unsigned mine[4];
#pragma unroll
                for (int q = 0; q < 4; ++q) { const unsigned i = F.tid + 64 * q; mine[q] = __hip_atomic_load((unsigned*)F.ctl + XB_XCCTAB + i, __ATOMIC_RELAXED, __HIP_MEMORY_SCOPE_AGENT);
                    const unsigned rep = __hip_atomic_load((unsigned*)F.ctl + XB_XCCTAB + (i & 7u), __ATOMIC_RELAXED, __HIP_MEMORY_SCOPE_AGENT); ok = ok && mine[q] != 0u && mine[q] == rep; }
                if (F.tid < 8) { for (unsigned o = 0; o < 8; ++o) { const unsigned other = __hip_atomic_load((unsigned*)F.ctl + XB_XCCTAB + o, __ATOMIC_RELAXED, __HIP_MEMORY_SCOPE_AGENT); ok = ok && (o == (unsigned)F.tid || other != mine[0]); } }
                ok = __all(ok); if (F.tid == 0) F.MISC[24] = ok ? 1u : 0u; }
            __syncthreads(); }
    }
    }
    ffn_part<0, 0>(F, bar, smem, lo, hi); mixer_part<0>(F, bar, smem, lo, hi); ffn_part<0, 1>(F, bar, smem, lo, hi);
    ffn_part<1, 0>(F, bar, smem, lo, hi); mixer_part<1>(F, bar, smem, lo, hi); ffn_part<1, 1>(F, bar, smem, lo, hi);
    ffn_part<2, 0>(F, bar, smem, lo, hi); mixer_part<2>(F, bar, smem, lo, hi); ffn_part<2, 1>(F, bar, smem, lo, hi);
    ffn_part<3, 0>(F, bar, smem, lo, hi); mixer_part<3>(F, bar, smem, lo, hi); ffn_part<3, 1>(F, bar, smem, lo, hi);
    if (PROBE_PHASE) { if (blockIdx.x == 0 && F.tid == 0) { const unsigned long long tot = F.MISC[17], t0 = __builtin_amdgcn_s_memrealtime(); while (__builtin_amdgcn_s_memrealtime() - t0 < tot) __builtin_amdgcn_s_sleep(8); } }
#ifdef PROBE_LOCALOK
    if (blockIdx.x == 0 && F.tid == 0 && F.MISC[24] != 0u) { const unsigned long long t0 = __builtin_amdgcn_s_memrealtime(); while (__builtin_amdgcn_s_memrealtime() - t0 < 50000ull) __builtin_amdgcn_s_sleep(8); }
#endif
    if (PROBE_WAIT) {
        unsigned* sumw = (unsigned*)F.ctl + 65536;
        if (F.tid == 0) __hip_atomic_fetch_add(sumw, F.MISC[16], __ATOMIC_RELAXED, __HIP_MEMORY_SCOPE_AGENT);
        xcd_barrier(bar);
        if (blockIdx.x == 0 && F.tid == 0) { const unsigned tot = __hip_atomic_load(sumw, __ATOMIC_RELAXED, __HIP_MEMORY_SCOPE_AGENT); const unsigned long long avg = tot / gridDim.x, t0 = __builtin_amdgcn_s_memrealtime();
            while (__builtin_amdgcn_s_memrealtime() - t0 < avg) __builtin_amdgcn_s_sleep(8); }
    }
}
#undef IN
#undef SEAM

#ifndef MK_MODE
#define MK_MODE 1
#endif
extern "C" void kernel_launch(void* const* d_in, const int* in_sizes, int n_in, void* d_out, int out_size, void* d_ws, size_t ws_size, hipStream_t stream) {
    static int grid = 0;
    if (grid == 0) {
        if (n_in != N_IN || out_size != M * DM || ws_size < WS_END) { fprintf(stderr, "kernel_launch: unexpected shapes: n_in %d out %d ws %zu (need %zu)\n", n_in, out_size, ws_size, (size_t)WS_END); grid = -1; return; }
        int dev = 0, cus = 0, per_cu = 0;
        if (hipGetDevice(&dev) != hipSuccess || hipDeviceGetAttribute(&cus, hipDeviceAttributeMultiprocessorCount, dev) != hipSuccess) { grid = -1; return; }
        if (hipFuncSetAttribute((const void*)yoco_fwd, hipFuncAttributeMaxDynamicSharedMemorySize, LDS_BYTES) != hipSuccess) { fprintf(stderr, "kernel_launch: hipFuncSetAttribute failed\n"); grid = -1; return; }
        if (hipOccupancyMaxActiveBlocksPerMultiprocessor(&per_cu, (const void*)yoco_fwd, NWAVES * 64, LDS_BYTES) != hipSuccess || per_cu < 1) fprintf(stderr, "kernel_launch: occupancy query says %d blocks per CU\n", per_cu);
        (void)hipGetLastError();
        grid = cus;
        if (cus != 256) { fprintf(stderr, "kernel_launch: built for a 256-CU device (got %d)\n", cus); grid = -1; return; }
    }
    if (grid < 0) return;
    (void)in_sizes;
    if (hipMemsetAsync((char*)d_ws + WS_CTL, 0, CTL_ZERO_BYTES, stream) != hipSuccess) return;
    Args a{};
    for (int i = 0; i < N_IN; ++i) a.in[i] = (const float*)d_in[i];
    a.out = (float*)d_out; a.ws = (unsigned char*)d_ws; a.pad = 0;
#if MK_MODE == 1
    a.ph_lo = 0; a.ph_hi = NPH; a.li = 0;
    hipLaunchKernelGGL(yoco_fwd, dim3(grid), dim3(NWAVES * 64), LDS_BYTES, stream, a);
#else
    for (int p = 0; p < NPH; ++p) {
        const int k = (p - PH_BASE) % NPL, l = (p - PH_BASE) / NPL;
        if (p >= PH_BASE && (k == 4 && l < NA)) continue;
        a.ph_lo = p; a.ph_hi = p + 1; a.li = 0;
        hipLaunchKernelGGL(yoco_fwd, dim3(grid), dim3(NWAVES * 64), LDS_BYTES, stream, a);
    }
#endif
}
```
